# Optimizing an MI355X kernel written in HIP

```python
import math
import jax, jax.numpy as jnp
from jax import lax
import numpy as np


D_MODEL = 1024
BATCH = 8
SEQ = 4096
DEPTH = 1

GRID_W = 64
CTX_LEN = 256
D_MIX = D_MODEL
D_S5 = D_MIX // 2
D_LRU = D_MIX - D_S5
S5_GROUP = 16
S5_GROUPS = D_S5 // S5_GROUP
S5_STATE = 64
S5_DT_MIN = 0.001
S5_DT_MAX = 0.1
LRU_HEADS = 8
LRU_HEAD_DIM = D_LRU // LRU_HEADS
LRU_C = 8.0
CONV_W = 4
CONV_LEFT = 2
N_EXPERTS = 64
TOP_K = 8
N_GROUPS = 8
TOPK_GROUPS = 4
D_EXPERT = 256
D_SHARED = 256
ROUTED_SCALE = 2.5
MOE_BLOCK = 256
ALPHA = (2.0 * DEPTH) ** 0.25
BETA = (8.0 * DEPTH) ** -0.25
LN_EPS = 1e-5

kernel_name = 'hybrid_s5_rglru_moe_dit'


def layer_norm(x, g, b):
    xf = x.astype(jnp.float32)
    mu = xf.mean(-1, keepdims=True)
    var = jnp.square(xf - mu).mean(-1, keepdims=True)
    return ((xf - mu) * lax.rsqrt(var + LN_EPS) * g + b).astype(x.dtype)


def _lin_combine(e1, e2):
    a1, b1 = e1
    a2, b2 = e2
    return a1 * a2, a2 * b1 + b2


def linear_scan(a, b, h0, reverse):
    if h0 is not None:
        idx = -1 if reverse else 0
        b = b.at[:, idx].add(a[:, idx] * h0)
    return lax.associative_scan(_lin_combine, (a, b), reverse=reverse, axis=1)[1]


def _cplx_combine(e1, e2):
    a1r, a1i, b1r, b1i = e1
    a2r, a2i, b2r, b2i = e2
    return (a2r * a1r - a2i * a1i, a2r * a1i + a2i * a1r,
            a2r * b1r - a2i * b1i + b2r, a2r * b1i + a2i * b1r + b2i)


def s5_discretize(lam_re, lam_im, log_dt, b_re, b_im):
    f32 = jnp.float32
    lam_re = lam_re.astype(f32)
    lam_im = lam_im.astype(f32)
    dt = jnp.exp(log_dt.astype(f32))[:, None]
    mag = jnp.exp(lam_re * dt)
    ar = mag * jnp.cos(lam_im * dt)
    ai = mag * jnp.sin(lam_im * dt)
    den = lam_re * lam_re + lam_im * lam_im
    nr = ar - 1.0
    fr = ((nr * lam_re + ai * lam_im) / den)[..., None]
    fi = ((ai * lam_re - nr * lam_im) / den)[..., None]
    b_re = b_re.astype(f32)
    b_im = b_im.astype(f32)
    return ar, ai, fr * b_re - fi * b_im, fr * b_im + fi * b_re


def s5_states(u, ar, ai, bbr, bbi, h0, reverse):
    br = jnp.einsum('blgc,gpc->blgp', u, bbr)
    bi = jnp.einsum('blgc,gpc->blgp', u, bbi)
    n = u.shape[1]
    a_r = jnp.broadcast_to(ar[None, None], (1, n) + ar.shape)
    a_i = jnp.broadcast_to(ai[None, None], (1, n) + ai.shape)
    if h0 is not None:
        idx = -1 if reverse else 0
        hr, hi = h0
        br = br.at[:, idx].add(ar * hr - ai * hi)
        bi = bi.at[:, idx].add(ar * hi + ai * hr)
    _, _, xr, xi = lax.associative_scan(_cplx_combine, (a_r, a_i, br, bi), reverse=reverse, axis=1)
    return xr, xi


def s5_readout(xr, xi, c_re, c_im):
    return jnp.einsum('blgp,gcp->blgc', xr, c_re) - jnp.einsum('blgp,gcp->blgc', xi, c_im)


def s5_mixer(ul, uc, lam_re, lam_im, log_dt, b_re, b_im, c_re, c_im, d, w_glu, b_glu, need_ctx):
    f32 = jnp.float32
    bsz, seq, _ = ul.shape
    ul = ul.astype(f32).reshape(bsz, seq, S5_GROUPS, S5_GROUP)
    uc = uc.astype(f32).reshape(bsz, uc.shape[1], S5_GROUPS, S5_GROUP)
    dg = d.astype(f32).reshape(S5_GROUPS, S5_GROUP)
    y_lat = dg * ul
    y_ctx = dg * uc if need_ctx else None
    for dr, rev in ((0, False), (1, True)):
        ar, ai, bbr, bbi = s5_discretize(lam_re[dr], lam_im[dr], log_dt[dr], b_re[dr], b_im[dr])
        cr, ci = s5_states(uc, ar, ai, bbr, bbi, None, rev)
        end = 0 if rev else -1
        lr, li = s5_states(ul, ar, ai, bbr, bbi, (cr[:, end], ci[:, end]), rev)
        cre = c_re[dr].astype(f32)
        cim = c_im[dr].astype(f32)
        y_lat = y_lat + s5_readout(lr, li, cre, cim)
        if need_ctx:
            y_ctx = y_ctx + s5_readout(cr, ci, cre, cim)

    def glu(y):
        y = jax.nn.gelu(y.reshape(y.shape[0], y.shape[1], D_S5))
        return y * jax.nn.sigmoid(y @ w_glu + b_glu)

    return glu(y_lat), (glu(y_ctx) if need_ctx else None)


def centred_dwconv(x, w, bias):
    n = x.shape[1]
    pad = [(0, 0)] * x.ndim
    pad[1] = (CONV_LEFT, CONV_W - 1 - CONV_LEFT)
    xp = jnp.pad(x, pad)
    out = bias + w[0] * lax.slice_in_dim(xp, 0, n, axis=1)
    for k in range(1, CONV_W):
        out = out + w[k] * lax.slice_in_dim(xp, k, k + n, axis=1)
    return out


def rglru_coeffs(x, w_a, b_a, w_x, b_x, lam):
    bsz, n, _ = x.shape
    xh = x.reshape(bsz, n, LRU_HEADS, LRU_HEAD_DIM)
    r = jax.nn.sigmoid(jnp.einsum('blhi,hij->blhj', xh, w_a).reshape(bsz, n, D_LRU) + b_a)
    i = jax.nn.sigmoid(jnp.einsum('blhi,hij->blhj', xh, w_x).reshape(bsz, n, D_LRU) + b_x)
    log_a = -LRU_C * r * jax.nn.softplus(-lam.astype(jnp.float32))
    a = jnp.exp(log_a)
    b = jnp.sqrt(-jnp.expm1(2.0 * log_a)) * (i * x)
    return a, b


def lru_mixer(xl, xc, conv_w, conv_b, w_a, b_a, w_x, b_x, lam, rows, need_ctx):
    f32 = jnp.float32
    bsz, seq, ch = xl.shape
    grid = centred_dwconv(xl.astype(f32).reshape(bsz, rows, GRID_W, ch), conv_w, conv_b)
    xs = grid.transpose(0, 2, 1, 3).reshape(bsz, seq, ch)
    xcs = centred_dwconv(xc.astype(f32), conv_w, conv_b)
    h_lat = None
    h_ctx = None
    for dr, rev in ((0, False), (1, True)):
        a_c, b_c = rglru_coeffs(xcs, w_a[dr], b_a[dr], w_x[dr], b_x[dr], lam[dr])
        hc = linear_scan(a_c, b_c, None, rev)
        a_l, b_l = rglru_coeffs(xs, w_a[dr], b_a[dr], w_x[dr], b_x[dr], lam[dr])
        hl = linear_scan(a_l, b_l, hc[:, 0 if rev else -1], rev)
        h_lat = hl if h_lat is None else h_lat + hl
        if need_ctx:
            h_ctx = hc if h_ctx is None else h_ctx + hc
    h_lat = h_lat.reshape(bsz, GRID_W, rows, ch).transpose(0, 2, 1, 3).reshape(bsz, seq, ch)
    return h_lat, h_ctx


def swiglu(v, w_gate, w_up, w_down):
    return (jax.nn.silu(v @ w_gate) * (v @ w_up)) @ w_down


def moe(v, router_w, router_bias, w_gate, w_up, w_down, sh_gate, sh_up, sh_down):
    n_tok, dm = v.shape
    scores = jax.nn.sigmoid(v.astype(jnp.float32) @ router_w.astype(jnp.float32))
    sel = scores + router_bias.astype(jnp.float32)
    grp = sel.reshape(n_tok, N_GROUPS, N_EXPERTS // N_GROUPS)
    grp_score = lax.top_k(grp, 2)[0].sum(-1)
    _, top_groups = lax.top_k(grp_score, TOPK_GROUPS)
    group_mask = jnp.any(top_groups[..., None] == jnp.arange(N_GROUPS), axis=1)
    expert_mask = jnp.repeat(group_mask, N_EXPERTS // N_GROUPS, axis=1)
    _, top_idx = lax.top_k(jnp.where(expert_mask, sel, -jnp.inf), TOP_K)
    wts = jnp.take_along_axis(scores, top_idx, axis=1)
    wts = wts / wts.sum(-1, keepdims=True) * ROUTED_SCALE

    tk = n_tok * TOP_K
    flat_e = top_idx.reshape(-1)
    flat_tok = jnp.arange(tk, dtype=jnp.int32) // TOP_K
    order = jnp.argsort(flat_e)
    e_sorted = flat_e[order]
    tok_sorted = flat_tok[order]
    w_sorted = wts.reshape(-1)[order]
    counts = jnp.bincount(flat_e, length=N_EXPERTS)
    padded = (counts + MOE_BLOCK - 1) // MOE_BLOCK * MOE_BLOCK
    pad_end = jnp.cumsum(padded)
    pad_start = pad_end - padded
    start = jnp.cumsum(counts) - counts
    dest = pad_start[e_sorted] + (jnp.arange(tk) - start[e_sorted])
    n_blocks = -(-(tk + N_EXPERTS * (MOE_BLOCK - 1)) // MOE_BLOCK)
    n_pad = n_blocks * MOE_BLOCK
    buf_tok = jnp.full((n_pad,), n_tok, jnp.int32).at[dest].set(tok_sorted)
    buf_w = jnp.zeros((n_pad,), jnp.float32).at[dest].set(w_sorted)
    block_e = jnp.minimum(jnp.searchsorted(pad_end, jnp.arange(n_blocks) * MOE_BLOCK, side='right'),
                          N_EXPERTS - 1)
    v_pad = jnp.concatenate([v, jnp.zeros((1, dm), v.dtype)], axis=0)

    def step(acc, inp):
        tok, wt, e = inp
        xb = v_pad[tok]
        out = swiglu(xb, w_gate[e], w_up[e], w_down[e]) * wt[:, None]
        return acc.at[tok].add(out.astype(acc.dtype)), None

    acc, _ = lax.scan(step, jnp.zeros((n_tok + 1, dm), v.dtype),
                      (buf_tok.reshape(n_blocks, MOE_BLOCK), buf_w.reshape(n_blocks, MOE_BLOCK), block_e))
    return acc[:n_tok] + swiglu(v, sh_gate, sh_up, sh_down)


def setup_inputs(seed: int = 0) -> dict:
    key = jax.random.key(seed)
    ks = iter(jax.random.split(key, 64))
    f32 = jnp.float32

    def nrm(shape, std):
        return std * jax.random.normal(next(ks), shape, f32)

    L = DEPTH
    G, P = S5_GROUPS, S5_STATE
    hd = LRU_HEAD_DIM
    n_idx = jnp.arange(P, dtype=f32)
    a_c = jax.random.uniform(next(ks), (L, 2, D_LRU), f32, 0.9, 0.999)
    sig = a_c ** (1.0 / LRU_C)
    return {
        'x': nrm((BATCH, SEQ, D_MODEL), 1.0),
        'c': nrm((BATCH, D_MODEL), 1.0),
        'ctx': nrm((BATCH, CTX_LEN, D_MODEL), 1.0),
        'c_ctx': nrm((D_MODEL,), 1.0),
        'ln_in_g': 1.0 + nrm((D_MODEL,), 0.02),
        'ln_in_b': nrm((D_MODEL,), 0.02),
        'ada_w': nrm((L, D_MODEL, 6 * D_MODEL), D_MODEL ** -0.5),
        'ada_b': nrm((L, 6 * D_MODEL), 0.02),
        'w_in': nrm((L, D_MODEL, D_S5 + 2 * D_LRU), D_MODEL ** -0.5),
        's5_lam_re': -0.5 + nrm((L, 2, G, P), 0.01),
        's5_lam_im': math.pi * n_idx + nrm((L, 2, G, P), 0.01),
        's5_log_dt': jax.random.uniform(next(ks), (L, 2, G), f32, math.log(S5_DT_MIN), math.log(S5_DT_MAX)),
        's5_b_re': nrm((L, 2, G, P, S5_GROUP), (2 * S5_GROUP) ** -0.5),
        's5_b_im': nrm((L, 2, G, P, S5_GROUP), (2 * S5_GROUP) ** -0.5),
        's5_c_re': nrm((L, 2, G, S5_GROUP, P), P ** -0.5),
        's5_c_im': nrm((L, 2, G, S5_GROUP, P), P ** -0.5),
        's5_d': nrm((L, D_S5), 1.0),
        's5_w_glu': nrm((L, D_S5, D_S5), D_S5 ** -0.5),
        's5_b_glu': nrm((L, D_S5), 0.02),
        'lru_conv_w': nrm((L, CONV_W, D_LRU), CONV_W ** -0.5),
        'lru_conv_b': nrm((L, D_LRU), 0.02),
        'lru_w_a': nrm((L, 2, LRU_HEADS, hd, hd), hd ** -0.5),
        'lru_b_a': nrm((L, 2, D_LRU), 0.02),
        'lru_w_x': nrm((L, 2, LRU_HEADS, hd, hd), hd ** -0.5),
        'lru_b_x': nrm((L, 2, D_LRU), 0.02),
        'lru_lam': jnp.log(sig) - jnp.log1p(-sig),
        'w_out': nrm((L, D_MIX, D_MODEL), BETA * D_MIX ** -0.5),
        'ln1_g': 1.0 + nrm((L, D_MODEL), 0.02),
        'ln1_b': nrm((L, D_MODEL), 0.02),
        'router_w': nrm((L, D_MODEL, N_EXPERTS), D_MODEL ** -0.5),
        'router_bias': nrm((L, N_EXPERTS), 0.01),
        'exp_w_gate': nrm((L, N_EXPERTS, D_MODEL, D_EXPERT), D_MODEL ** -0.5),
        'exp_w_up': nrm((L, N_EXPERTS, D_MODEL, D_EXPERT), D_MODEL ** -0.5),
        'exp_w_down': nrm((L, N_EXPERTS, D_EXPERT, D_MODEL), BETA * D_EXPERT ** -0.5),
        'sh_w_gate': nrm((L, D_MODEL, D_SHARED), D_MODEL ** -0.5),
        'sh_w_up': nrm((L, D_MODEL, D_SHARED), D_MODEL ** -0.5),
        'sh_w_down': nrm((L, D_SHARED, D_MODEL), BETA * D_SHARED ** -0.5),
        'ln2_g': 1.0 + nrm((L, D_MODEL), 0.02),
        'ln2_b': nrm((L, D_MODEL), 0.02),
    }


def reference(x, c, ctx, c_ctx, ln_in_g, ln_in_b, ada_w, ada_b, w_in,
              s5_lam_re, s5_lam_im, s5_log_dt, s5_b_re, s5_b_im, s5_c_re, s5_c_im,
              s5_d, s5_w_glu, s5_b_glu,
              lru_conv_w, lru_conv_b, lru_w_a, lru_b_a, lru_w_x, lru_b_x, lru_lam,
              w_out, ln1_g, ln1_b, router_w, router_bias,
              exp_w_gate, exp_w_up, exp_w_down, sh_w_gate, sh_w_up, sh_w_down,
              ln2_g, ln2_b):
    bsz, seq, dm = x.shape
    rows = seq // GRID_W
    h = layer_norm(x, ln_in_g, ln_in_b)
    hc = layer_norm(ctx, ln_in_g, ln_in_b)
    s_lat = jax.nn.silu(c)
    s_ctx = jax.nn.silu(c_ctx)
    o1, o2 = D_S5, D_S5 + D_LRU
    for l in range(DEPTH):
        last = l == DEPTH - 1
        sh1, sc1, g1, sh2, sc2, g2 = jnp.split((s_lat @ ada_w[l] + ada_b[l])[:, None, :], 6, axis=-1)
        csh1, csc1, cg1, csh2, csc2, cg2 = jnp.split(s_ctx @ ada_w[l] + ada_b[l], 6, axis=-1)
        u = (h * (1.0 + sc1) + sh1) @ w_in[l]
        uc = (hc * (1.0 + csc1) + csh1) @ w_in[l]
        s5_lat, s5_ctx = s5_mixer(u[..., :o1], uc[..., :o1], s5_lam_re[l], s5_lam_im[l], s5_log_dt[l],
                                  s5_b_re[l], s5_b_im[l], s5_c_re[l], s5_c_im[l], s5_d[l],
                                  s5_w_glu[l], s5_b_glu[l], not last)
        lru_lat, lru_ctx = lru_mixer(u[..., o1:o2], uc[..., o1:o2], lru_conv_w[l], lru_conv_b[l],
                                     lru_w_a[l], lru_b_a[l], lru_w_x[l], lru_b_x[l], lru_lam[l],
                                     rows, not last)
        y = jnp.concatenate([s5_lat, lru_lat * jax.nn.gelu(u[..., o2:])], axis=-1) @ w_out[l]
        h = layer_norm(ALPHA * h + g1 * y, ln1_g[l], ln1_b[l])
        if not last:
            yc = jnp.concatenate([s5_ctx, lru_ctx * jax.nn.gelu(uc[..., o2:])], axis=-1) @ w_out[l]
            hc = layer_norm(ALPHA * hc + cg1 * yc, ln1_g[l], ln1_b[l])
        v = (h * (1.0 + sc2) + sh2).reshape(bsz * seq, dm)
        moe_args = (router_w[l], router_bias[l], exp_w_gate[l], exp_w_up[l], exp_w_down[l],
                    sh_w_gate[l], sh_w_up[l], sh_w_down[l])
        if last:
            f = moe(v, *moe_args).reshape(bsz, seq, dm)
        else:
            vc = (hc * (1.0 + csc2) + csh2).reshape(-1, dm)
            fall = moe(jnp.concatenate([v, vc.astype(v.dtype)], axis=0), *moe_args)
            f = fall[:bsz * seq].reshape(bsz, seq, dm)
            fc = fall[bsz * seq:].reshape(hc.shape)
            hc = layer_norm(ALPHA * hc + cg2 * fc, ln2_g[l], ln2_b[l])
        h = layer_norm(ALPHA * h + g2 * f, ln2_g[l], ln2_b[l])
    return h.astype(x.dtype)
```

```cpp
#include <hip/hip_runtime.h>
#include <cstdio>
#include <cstdint>

#ifndef MK_N_LAUNCHES
#define MK_N_LAUNCHES 12
#endif

#define DEV __device__ __forceinline__
#define LAS __attribute__((address_space(3)))
typedef unsigned short bf16_t;
typedef short bf16x8 __attribute__((ext_vector_type(8)));
typedef float f32x4 __attribute__((ext_vector_type(4)));
typedef unsigned u32x2 __attribute__((ext_vector_type(2)));
typedef unsigned u32x4 __attribute__((ext_vector_type(4)));

constexpr int D = 1024, NBATCH = 8, SEQ = 4096, T = NBATCH * SEQ, CTXL = 256, TC = NBATCH * CTXL, TT = T + TC;
constexpr int NWIN = 1536;
constexpr int LC = 32, KT5 = 768, NCH = SEQ / LC  , NCC = CTXL / LC  ;
constexpr int M5LAT = NBATCH * NCH  , M5 = M5LAT + NBATCH * NCC  , M5PAD = 1280;
constexpr int NE = 64;
constexpr int NPHASE = 12;
constexpr float ALPHA_F = 1.189207115002721f, LN_EPS_F = 1e-5f;

constexpr size_t MiB = 1u << 20;
constexpr size_t WS_CTL = 0, CTL_ZERO_BYTES = 65536;
constexpr size_t WS_CNT = 32768;
constexpr size_t WS_ADA = 65536;
constexpr size_t WS_BIASIN = 512 * 1024;
constexpr size_t WS_ALC = 640 * 1024;
constexpr size_t WS_SA = 1 * MiB, WS_SB = 4 * MiB, WS_HIN = 7 * MiB;
constexpr size_t WS_BTGLU = 10 * MiB;
constexpr size_t WS_BTOUT = 10 * MiB + 512 * 1024;
constexpr size_t WS_BTLRU = 12 * MiB + 512 * 1024;
constexpr size_t WS_BS5 = 13 * MiB;
constexpr size_t WS_ES5 = 37 * MiB;
constexpr size_t WS_BTGU = 45 * MiB;
constexpr size_t WS_BTDN = 110 * MiB;
constexpr size_t WS_HB = 143 * MiB;
constexpr size_t WS_BTIN = 211 * MiB;
constexpr size_t WS_US5 = 238 * MiB;
constexpr size_t WS_ULRU = 298 * MiB;
constexpr size_t WS_SLOC = 366 * MiB;
constexpr size_t WS_YS5 = 400 * MiB;
constexpr size_t WS_YCAT = 448 * MiB;
constexpr size_t WS_Y = 295 * MiB;
constexpr size_t WS_VB = 423 * MiB;
constexpr size_t WS_LTOK = 487 * MiB;
constexpr size_t WS_LWT = 495 * MiB;
constexpr size_t WS_HMID = 143 * MiB;
constexpr size_t WS_END = 512 * MiB;

constexpr int LDS_BYTES = 155648;
constexpr int MISC_OFF = LDS_BYTES - 256;

DEV float bf2f(bf16_t h) { return __uint_as_float(((unsigned)h) << 16); }
DEV unsigned f2bf(float f) { unsigned u = __float_as_uint(f); return (u + 0x7fffu + ((u >> 16) & 1u)) >> 16; }
DEV unsigned pack2(float a, float b) { return f2bf(a) | (f2bf(b) << 16); }
DEV float sigmoid_f(float x) { return 1.f / (1.f + __expf(-x)); }
DEV float gelu_tanh(float x) {
    const float z = 0.7978845608028654f * (x + 0.044715f * x * x * x);
    const float e = __expf(2.f * z);
    const float t = 1.f - 2.f / (e + 1.f);
    return 0.5f * x * (1.f + t);
}
DEV float wave_sum(float v) {
#pragma unroll
    for (int o = 1; o < 64; o <<= 1) v += __shfl_xor(v, o);
    return v;
}

struct Params { const float* in[39]; float* out; unsigned char* ws; int ph_lo, ph_hi; };

#define XB_TMO      128
#define XB_XCNT(j)  (256  + 64 * (j))
#define XB_XSUB(j)  (1280 + 64 * (j))
#define XB_XGEN(j)  (2304 + 64 * (j))
#define XB_TOP      3328
#define XB_TOPGEN   3392
#define XCD_BAR_WORDS 3456
#define XB_SPIN_CAP (1u << 20)
DEV unsigned xb_ld(unsigned* p)              { return __hip_atomic_load(p, __ATOMIC_RELAXED, __HIP_MEMORY_SCOPE_AGENT); }
DEV unsigned xb_add(unsigned* p, unsigned v) { return __hip_atomic_fetch_add(p, v, __ATOMIC_RELAXED, __HIP_MEMORY_SCOPE_AGENT); }
DEV unsigned xb_xcc_id() { return (unsigned)__builtin_amdgcn_s_getreg((3 << 11) | 20) & 0xFu; }
#define XB_SPIN(cond, bar) do { unsigned _sp = 0; while (cond) { __builtin_amdgcn_s_sleep(1); \
    if ((++_sp & 255u) == 0u) { if (xb_ld(&(bar)[XB_TMO])) break; if (_sp > XB_SPIN_CAP) { atomicAdd(&(bar)[XB_TMO], 1u); break; } } } } while (0)
struct XcdBarrier { unsigned* bar; unsigned x; volatile LAS unsigned* st; };
DEV XcdBarrier xcd_barrier_post(unsigned* bar, volatile LAS unsigned* st) {
    XcdBarrier b; b.bar = bar; b.x = xb_xcc_id(); b.st = st;
    if (threadIdx.x == 0) (void)xb_add(&bar[XB_XCNT(b.x)], 1u);
    return b;
}
DEV void xcd_barrier_complete(unsigned* bar, unsigned x, unsigned& nloc, unsigned& nx) {
    const unsigned G = gridDim.x * gridDim.y * gridDim.z;
    unsigned sum, cnt, mine, sp = 0u;
    for (;;) {
        sum = 0u; cnt = 0u; mine = 0u;
#pragma unroll
        for (unsigned j = 0; j < 16; ++j) { const unsigned c = xb_ld(&bar[XB_XCNT(j)]); sum += c; cnt += (c > 0u) ? 1u : 0u; mine = (j == x) ? c : mine; }
        if (sum == G) break;
        __builtin_amdgcn_s_sleep(1);
        if ((++sp & 255u) == 0u) { if (xb_ld(&bar[XB_TMO])) break; if (sp > XB_SPIN_CAP) { atomicAdd(&bar[XB_TMO], 1u); break; } }
    }
    nloc = mine > 0u ? mine : 1u; nx = cnt > 0u ? cnt : 1u;
}
DEV void xcd_barrier(const XcdBarrier& b) {
    asm volatile("s_waitcnt vmcnt(0)" ::: "memory");
    __syncthreads();
    if (threadIdx.x == 0) {
        unsigned* bar = b.bar;
        __builtin_amdgcn_s_waitcnt(0);
        unsigned nloc = b.st[0], nx = b.st[1];
        if (nloc == 0u) { xcd_barrier_complete(bar, b.x, nloc, nx); b.st[0] = nloc; b.st[1] = nx; }
        const unsigned old = xb_add(&bar[XB_XSUB(b.x)], 1u);
        const unsigned gen = old / nloc;
        if (old + 1u == (gen + 1u) * nloc) {
            __builtin_amdgcn_fence(__ATOMIC_RELEASE, "agent");
            asm volatile("s_waitcnt vmcnt(0)" ::: "memory");
            const unsigned og = xb_add(&bar[XB_TOP], 1u);
            const unsigned tg = og / nx;
            if (og + 1u == (tg + 1u) * nx) xb_add(&bar[XB_TOPGEN], 1u);
            else XB_SPIN(xb_ld(&bar[XB_TOPGEN]) == tg, bar);
            __builtin_amdgcn_fence(__ATOMIC_ACQUIRE, "agent");
            xb_add(&bar[XB_XGEN(b.x)], 1u);
            asm volatile("s_waitcnt vmcnt(0)" ::: "memory");
        } else {
            XB_SPIN(xb_ld(&bar[XB_XGEN(b.x)]) == gen, bar);
            __builtin_amdgcn_fence(__ATOMIC_ACQUIRE, "agent");
            asm volatile("s_waitcnt vmcnt(0)" ::: "memory");
        }
    }
    __syncthreads();
}

constexpr int GEMM_LDS = 61440;
template <class ARow, class Epi>
DEV void gemm_unit(LAS unsigned char* lds, const ARow& arow, const bf16_t* __restrict__ Bt, int K, const Epi& epi) {
    const int tid = threadIdx.x, wid = tid >> 6, lane = tid & 63, wr = wid >> 1, wc = wid & 1, fr = lane & 15, fq = lane >> 4;
    LAS unsigned char* As = lds;
    LAS unsigned char* Bs = lds + 40960;
    const u32x4* pa0 = (const u32x4*)arow(tid >> 2) + (tid & 3);
    const u32x4* pa1 = (const u32x4*)arow(128 + (tid >> 2)) + (tid & 3);
    const u32x4* pb = (const u32x4*)(Bt + (size_t)(tid >> 2) * K) + (tid & 3);
    const int sa0 = (tid >> 2) * 80 + (tid & 3) * 16, sa1 = sa0 + 128 * 80;
    f32x4 acc[4][4];
#pragma unroll
    for (int i = 0; i < 4; ++i)
#pragma unroll
        for (int j = 0; j < 4; ++j) acc[i][j] = (f32x4){0.f, 0.f, 0.f, 0.f};
    const int nk = K >> 5;
    u32x4 ra0 = pa0[0], ra1 = pa1[0], rb = pb[0];
    *(LAS u32x4*)(As + sa0) = ra0; *(LAS u32x4*)(As + sa1) = ra1; *(LAS u32x4*)(Bs + sa0) = rb;
    __syncthreads();
    for (int kt = 0; kt < nk; ++kt) {
        const int cur = kt & 1;
        if (kt + 1 < nk) { ra0 = pa0[(kt + 1) * 4]; ra1 = pa1[(kt + 1) * 4]; rb = pb[(kt + 1) * 4]; }
        LAS const unsigned char* Ac = As + cur * 20480 + (wr * 64 + fr) * 80 + fq * 16;
        LAS const unsigned char* Bc = Bs + cur * 10240 + (wc * 64 + fr) * 80 + fq * 16;
        bf16x8 af[4], bfv[4];
#pragma unroll
        for (int i = 0; i < 4; ++i) af[i] = *(LAS const bf16x8*)(Ac + i * 1280);
#pragma unroll
        for (int j = 0; j < 4; ++j) bfv[j] = *(LAS const bf16x8*)(Bc + j * 1280);
#pragma unroll
        for (int i = 0; i < 4; ++i)
#pragma unroll
            for (int j = 0; j < 4; ++j) acc[i][j] = __builtin_amdgcn_mfma_f32_16x16x32_bf16(bfv[j], af[i], acc[i][j], 0, 0, 0);
        if (kt + 1 < nk) {
            const int nx = cur ^ 1;
            *(LAS u32x4*)(As + nx * 20480 + sa0) = ra0; *(LAS u32x4*)(As + nx * 20480 + sa1) = ra1; *(LAS u32x4*)(Bs + nx * 10240 + sa0) = rb;
        }
        __syncthreads();
    }
    epi(acc, wr * 64 + fr, wc * 64 + 4 * fq);
}

DEV void tr_tile(const float* __restrict__ W, int ldw, int k0, int n0, bf16_t* __restrict__ dst, int ldd, int mode, LAS float* tile, const float* __restrict__ kscale1p) {
    const int tid = threadIdx.x;
#pragma unroll
    for (int i = 0; i < 2; ++i) {
        const int idx = tid + i * 512, kk = idx >> 4, n4 = (idx & 15) * 4;
        f32x4 v = *(const f32x4*)(W + (size_t)(k0 + kk) * ldw + n0 + n4);
        if (kscale1p) { const float s = 1.f + kscale1p[k0 + kk]; v = v * s; }
        LAS float* tp = tile + kk * 65 + n4;
        tp[0] = v[0]; tp[1] = v[1]; tp[2] = v[2]; tp[3] = v[3];
    }
    __syncthreads();
    {
        const int nn = tid >> 3, kc = tid & 7;
        float e[8];
#pragma unroll
        for (int jj = 0; jj < 8; ++jj) e[jj] = tile[(kc * 8 + jj) * 65 + nn];
        const int j = n0 + nn;
        const int row = mode == 0 ? j : (((j >> 4) << 5) + (j & 15) + (mode == 2 ? 16 : 0));
        u32x4 w; w.x = pack2(e[0], e[1]); w.y = pack2(e[2], e[3]); w.z = pack2(e[4], e[5]); w.w = pack2(e[6], e[7]);
        *(u32x4*)(dst + (size_t)row * ldd + k0 + kc * 8) = w;
    }
    __syncthreads();
}

DEV void gemv9_item(LAS const float* S, const float* __restrict__ W, int ldw, int col0, const float* __restrict__ bias, float* __restrict__ out, int ldo, LAS float* red) {
    const int tid = threadIdx.x, col = tid & 31, kp = tid >> 5;
    float acc[9];
#pragma unroll
    for (int b = 0; b < 9; ++b) acc[b] = 0.f;
    for (int k = kp * 64; k < kp * 64 + 64; ++k) {
        const float w = W[(size_t)k * ldw + col0 + col];
#pragma unroll
        for (int b = 0; b < 9; ++b) acc[b] += S[b * 1024 + k] * w;
    }
#pragma unroll
    for (int b = 0; b < 9; ++b) red[(kp * 9 + b) * 32 + col] = acc[b];
    __syncthreads();
    if (tid < 288) {
        const int b = tid >> 5, c = tid & 31; float s = 0.f;
#pragma unroll
        for (int q = 0; q < 16; ++q) s += red[(q * 9 + b) * 32 + c];
        out[b * ldo + col0 + c] = s + (bias ? bias[col0 + c] : 0.f);
    }
    __syncthreads();
}

DEV void cpow_d(double lr, double li, double dt, int l, double& re, double& im) {
    const double mag = exp(lr * dt * (double)l);
    const double ang = li * dt * (double)l;
    const double kq = rint(ang * 0.63661977236758134308);
    double x = fma(-kq, 1.57079632679489655800e+00, ang);
    x = fma(-kq, 6.12323399573676603587e-17, x);
    const double x2 = x * x;
    double s = -1.0 / 6227020800.0; s = fma(s, x2, 1.0 / 39916800.0); s = fma(s, x2, -1.0 / 362880.0); s = fma(s, x2, 1.0 / 5040.0);
    s = fma(s, x2, -1.0 / 120.0); s = fma(s, x2, 1.0 / 6.0); s = fma(-s, x2, 1.0); s = s * x;
    double c = 1.0 / 479001600.0; c = fma(c, x2, -1.0 / 3628800.0); c = fma(c, x2, 1.0 / 40320.0); c = fma(c, x2, -1.0 / 720.0);
    c = fma(c, x2, 1.0 / 24.0); c = fma(c, x2, -0.5); c = fma(c, x2, 1.0);
    const int q = ((int)(long long)kq) & 3;
    const double sn = (q == 0) ? s : (q == 1) ? c : (q == 2) ? -s : -c;
    const double cs = (q == 0) ? c : (q == 1) ? -s : (q == 2) ? -c : s;
    re = mag * cs; im = mag * sn;
}

DEV void s5_gen(const Params& p, LAS unsigned char* lds, int g) {
    const int tid = threadIdx.x;
    LAS float* apr = (LAS float*)lds;
    LAS float* api = apr + 4224;
    LAS float* bbr = api + 4224;
    LAS float* bbi = bbr + 2048;
    LAS float* ccr = bbi + 2048;
    LAS float* cci = ccr + 2048;
    LAS float* Kt = cci + 2048;
    const float* lam_re = p.in[9]; const float* lam_im = p.in[10]; const float* log_dt = p.in[11];
    const float* b_re = p.in[12]; const float* b_im = p.in[13]; const float* c_re = p.in[14]; const float* c_im = p.in[15]; const float* dvec = p.in[16];
    bf16_t* BS5 = (bf16_t*)(p.ws + WS_BS5); bf16_t* ES5 = (bf16_t*)(p.ws + WS_ES5); float* ALC = (float*)(p.ws + WS_ALC);
    for (int i = tid; i < 4224; i += 512) {
        const int dir = i / 2112, rem = i % 2112, l = rem >> 6, pp = rem & 63, gi = dir * 32 + g;
        const double dt = exp((double)log_dt[gi]);
        double re, im; cpow_d((double)lam_re[gi * 64 + pp], (double)lam_im[gi * 64 + pp], dt, l, re, im);
        apr[i] = (float)re; api[i] = (float)im;
    }
    for (int i = tid; i < 2048; i += 512) {
        const int dir = i >> 10, cc = (i >> 6) & 15, pp = i & 63; const size_t src = ((size_t)((dir * 32 + g) * 16 + cc)) * 64 + pp;
        ccr[i] = c_re[src]; cci[i] = c_im[src];
    }
    for (int i = tid; i < 2048; i += 512) {
        const int dir = i >> 10, pp = (i >> 4) & 63, c = i & 15, gi = dir * 32 + g;
        const double dt = exp((double)log_dt[gi]);
        const double lr = (double)lam_re[gi * 64 + pp], li = (double)lam_im[gi * 64 + pp];
        double ar, ai; cpow_d(lr, li, dt, 1, ar, ai);
        const double nr = ar - 1.0, den = lr * lr + li * li;
        const double fr = (nr * lr + ai * li) / den, fi = (ai * lr - nr * li) / den;
        const double br = (double)b_re[((size_t)(gi * 64 + pp)) * 16 + c], bi = (double)b_im[((size_t)(gi * 64 + pp)) * 16 + c];
        bbr[i] = (float)(fr * br - fi * bi); bbi[i] = (float)(fr * bi + fi * br);
    }
    __syncthreads();
    for (int o = tid; o < 16384; o += 512) {
        const int dir = o >> 13, l = (o >> 8) & 31, c = (o >> 4) & 15, c2 = o & 15;
        float sum = 0.f;
        for (int pp = 0; pp < 64; ++pp) {
            const float ar = apr[(dir * 33 + l) * 64 + pp], ai = api[(dir * 33 + l) * 64 + pp];
            const float br = bbr[(dir * 64 + pp) * 16 + c2], bi = bbi[(dir * 64 + pp) * 16 + c2];
            const float tr = ar * br - ai * bi, ti = ar * bi + ai * br;
            sum += ccr[(dir * 16 + c) * 64 + pp] * tr - cci[(dir * 16 + c) * 64 + pp] * ti;
        }
        Kt[o] = sum;
    }
    __syncthreads();
    for (int q = tid; q < 512 * 96; q += 512) {
        const int n = q / 96, k8 = (q % 96) * 8, t = n >> 4, c = n & 15;
        float e[8];
        if (k8 < 512) {
            const int s = k8 >> 4, c0 = k8 & 15, delta = t - s;
#pragma unroll
            for (int i = 0; i < 8; ++i) {
                const int c2 = c0 + i; float v;
                if (delta > 0) v = Kt[delta * 256 + c * 16 + c2];
                else if (delta < 0) v = Kt[(32 - delta) * 256 + c * 16 + c2];
                else v = Kt[c * 16 + c2] + Kt[32 * 256 + c * 16 + c2] + (c == c2 ? dvec[g * 16 + c] : 0.f);
                e[i] = v;
            }
        } else {
            const int kk = k8 - 512, seg = kk >> 6, p0 = kk & 63, dir = seg >> 1, l = dir == 0 ? t + 1 : 32 - t;
#pragma unroll
            for (int i = 0; i < 8; ++i) {
                const int pp = p0 + i;
                const float ar = apr[(dir * 33 + l) * 64 + pp], ai = api[(dir * 33 + l) * 64 + pp];
                const float cr = ccr[(dir * 16 + c) * 64 + pp], ci = cci[(dir * 16 + c) * 64 + pp];
                e[i] = (seg & 1) ? -(cr * ai + ci * ar) : (cr * ar - ci * ai);
            }
        }
        u32x4 w; w.x = pack2(e[0], e[1]); w.y = pack2(e[2], e[3]); w.z = pack2(e[4], e[5]); w.w = pack2(e[6], e[7]);
        *(u32x4*)(BS5 + ((size_t)g * 512 + n) * 768 + k8) = w;
    }
    for (int q = tid; q < 256 * 64; q += 512) {
        const int n = q >> 6, k8 = (q & 63) * 8, s = k8 >> 4, c0 = k8 & 15, seg = n >> 6, pp = n & 63, dir = seg >> 1, l = dir == 0 ? 31 - s : s;
        const float ar = apr[(dir * 33 + l) * 64 + pp], ai = api[(dir * 33 + l) * 64 + pp];
        float e[8];
#pragma unroll
        for (int i = 0; i < 8; ++i) {
            const float br = bbr[(dir * 64 + pp) * 16 + c0 + i], bi = bbi[(dir * 64 + pp) * 16 + c0 + i];
            e[i] = (seg & 1) ? (ar * bi + ai * br) : (ar * br - ai * bi);
        }
        u32x4 w; w.x = pack2(e[0], e[1]); w.y = pack2(e[2], e[3]); w.z = pack2(e[4], e[5]); w.w = pack2(e[6], e[7]);
        *(u32x4*)(ES5 + ((size_t)g * 256 + n) * 512 + k8) = w;
    }
    if (tid < 128) {
        const int dir = tid >> 6, pp = tid & 63;
        ALC[((dir * 32 + g) * 64 + pp) * 2 + 0] = apr[(dir * 33 + 32) * 64 + pp];
        ALC[((dir * 32 + g) * 64 + pp) * 2 + 1] = api[(dir * 33 + 32) * 64 + pp];
    }
    __syncthreads();
}

template <bool APPLY>
DEV void lru_item(const Params& p, LAS unsigned char* lds, int b, int ch, int h) {
    const int tid = threadIdx.x, wid = tid >> 6, lane = tid & 63, fr = lane & 15, fq = lane >> 4;
    LAS float* xin = (LAS float*)lds;
    LAS float* xs = (LAS float*)(lds + 17408);
    LAS unsigned short* xsb = (LAS unsigned short*)(lds + 33792);
    LAS float* aa = (LAS float*)(lds + 43008);
    LAS float* bb = (LAS float*)(lds + 75776);
    LAS float* cAs = (LAS float*)(lds + 108544);
    const bf16_t* ULRU = (const bf16_t*)(p.ws + WS_ULRU);
    const bf16_t* BTLRU = (const bf16_t*)(p.ws + WS_BTLRU);
    const float* conv_w = p.in[19]; const float* conv_b = p.in[20];
    if (tid < 128) {
        const int dir = tid >> 6, j = tid & 63, o = dir * 512 + h * 64 + j;
        cAs[tid] = -8.f * log1pf(__expf(-p.in[25][o])); cAs[128 + tid] = p.in[22][o]; cAs[256 + tid] = p.in[24][o];
    }
#pragma unroll 1
    for (int idx = tid; idx < 67 * 64; idx += 512) {
        const int rr = idx >> 6, cc = idx & 63, pos = rr - 2;
        float v = 0.f;
        if (ch < 64) { if (pos >= 0 && pos < 64) v = bf2f(ULRU[((size_t)b * 4096 + pos * 64 + ch) * 1024 + h * 64 + cc]); }
        else { const int jt = (ch - 64) * 64 + pos; if (jt >= 0 && jt < 256) v = bf2f(ULRU[((size_t)T + b * 256 + jt) * 1024 + h * 64 + cc]); }
        xin[idx] = v;
    }
    __syncthreads();
    {
        const int cc = tid & 63, chn = h * 64 + cc;
        const float w0 = conv_w[chn], w1 = conv_w[512 + chn], w2 = conv_w[1024 + chn], w3 = conv_w[1536 + chn], cb = conv_b[chn];
#pragma unroll 2
        for (int r = tid >> 6; r < 64; r += 8) {
            const float v = cb + w0 * xin[r * 64 + cc] + w1 * xin[(r + 1) * 64 + cc] + w2 * xin[(r + 2) * 64 + cc] + w3 * xin[(r + 3) * 64 + cc];
            xs[r * 64 + cc] = v; xsb[r * 72 + cc] = (unsigned short)f2bf(v);
        }
    }
    __syncthreads();
    {
        const int mt = wid & 3, dir = wid >> 2;
        bf16x8 af[2];
#pragma unroll
        for (int ks = 0; ks < 2; ++ks) af[ks] = *(LAS const bf16x8*)((LAS const unsigned char*)xsb + (mt * 16 + fr) * 144 + ks * 64 + fq * 16);
        const int r = mt * 16 + fr;
#pragma unroll
        for (int jt = 0; jt < 8; ++jt) {
            const int n = dir * 128 + jt * 16 + fr;
            const bf16_t* bp = BTLRU + ((size_t)(h * 256 + n)) * 64 + fq * 8;
            const bf16x8 b0 = *(const bf16x8*)bp, b1 = *(const bf16x8*)(bp + 32);
            f32x4 a = (f32x4){0.f, 0.f, 0.f, 0.f};
            a = __builtin_amdgcn_mfma_f32_16x16x32_bf16(b0, af[0], a, 0, 0, 0);
            a = __builtin_amdgcn_mfma_f32_16x16x32_bf16(b1, af[1], a, 0, 0, 0);
            LAS float* dst = (jt < 4 ? aa : bb) + (dir * 64 + r) * 64 + (jt & 3) * 16 + 4 * fq;
            *(LAS f32x4*)dst = a;
        }
    }
    __syncthreads();
#pragma unroll 2
    for (int idx = tid; idx < 8192; idx += 512) {
        const int dir = idx >> 12, j = idx & 63, r = (idx >> 6) & 63;
        const float za = aa[idx] + cAs[128 + dir * 64 + j], zx = bb[idx] + cAs[256 + dir * 64 + j];
        const float la = cAs[dir * 64 + j] * sigmoid_f(za);
        const float a = __expf(la);
        const float x2 = 2.f * la;
        const float em = -x2 * (1.f + x2 * (0.5f + x2 * (0.16666667f + x2 * (0.041666668f + x2 * (0.0083333338f + x2 * 0.0013888889f)))));
        aa[idx] = a; bb[idx] = sqrtf(em) * sigmoid_f(zx) * xs[r * 64 + j];
    }
    __syncthreads();
    if (tid < 128) {
        const int dir = tid >> 6, j = tid & 63, chn = h * 64 + j;
        if (!APPLY) {
            float H = 0.f, P = 1.f;
#pragma unroll 4
            for (int s = 0; s < 64; ++s) { const int r = dir ? 63 - s : s; const float a = aa[(dir * 64 + r) * 64 + j]; H = a * H + bb[(dir * 64 + r) * 64 + j]; P *= a; }
            float* SA = (float*)(p.ws + WS_SA); float* SB = (float*)(p.ws + WS_SB);
            const size_t o = ((size_t)(b * 68 + ch) * 2 + dir) * 512 + chn;
            SA[o] = P; SB[o] = H;
        } else {
            const float* HIN = (const float*)(p.ws + WS_HIN);
            float H = HIN[((size_t)(b * 64 + ch) * 2 + dir) * 512 + chn];
#pragma unroll 4
            for (int s = 0; s < 64; ++s) { const int r = dir ? 63 - s : s; H = aa[(dir * 64 + r) * 64 + j] * H + bb[(dir * 64 + r) * 64 + j]; bb[(dir * 64 + r) * 64 + j] = H; }
        }
    }
    __syncthreads();
    if (APPLY) {
        bf16_t* YCAT = (bf16_t*)(p.ws + WS_YCAT);
#pragma unroll 2
        for (int idx = tid; idx < 4096; idx += 512) {
            const int r = idx >> 6, j = idx & 63;
            const size_t row = (size_t)b * 4096 + r * 64 + ch;
            const float gate = bf2f(ULRU[row * 1024 + 512 + h * 64 + j]);
            const float hs = bb[r * 64 + j] + bb[(64 + r) * 64 + j];
            YCAT[row * 1024 + 512 + h * 64 + j] = (bf16_t)f2bf(hs * gelu_tanh(gate));
        }
        __syncthreads();
    }
}

constexpr int MOE_TAB_OFF = 65536;
DEV void moe_tables(const Params& p, LAS unsigned char* lds) {
    LAS int* tp = (LAS int*)(lds + MOE_TAB_OFF); LAS int* pp = tp + 72; LAS int* cn = pp + 72;
    if (threadIdx.x == 0) {
        const int* cnt = (const int*)(p.ws + WS_CNT);
        int t = 0, q = 0;
        for (int e = 0; e < 65; ++e) { const int c = e < 64 ? cnt[e] : T; cn[e] = c; tp[e] = t; pp[e] = q; const int nt = (c + 255) >> 8; t += nt; q += nt * 256; }
        tp[65] = t; pp[65] = q;
    }
    __syncthreads();
}

__global__ void __launch_bounds__(512) mk_fwd(Params p) {
    extern __shared__ __attribute__((aligned(16))) unsigned char lds_raw[];
    LAS unsigned char* lds = (LAS unsigned char*)lds_raw;
    const int tid = threadIdx.x, wid = tid >> 6, lane = tid & 63, bid = blockIdx.x, nb = gridDim.x;
    volatile LAS unsigned* MISC = (volatile LAS unsigned*)(lds + MISC_OFF);
    if (tid < 64) MISC[tid] = 0u;
    __syncthreads();
    unsigned char* ws = p.ws;
    XcdBarrier bar; bar.bar = (unsigned*)(ws + WS_CTL); bar.x = 0; bar.st = nullptr;
    const bool fused = (p.ph_hi - p.ph_lo) > 1;
    if (fused) bar = xcd_barrier_post((unsigned*)(ws + WS_CTL), MISC + 8);

    float* ADA = (float*)(ws + WS_ADA);
    float* BIASIN = (float*)(ws + WS_BIASIN);
    bf16_t* HB = (bf16_t*)(ws + WS_HB);
    bf16_t* BTIN = (bf16_t*)(ws + WS_BTIN);
    bf16_t* US5 = (bf16_t*)(ws + WS_US5);
    bf16_t* ULRU = (bf16_t*)(ws + WS_ULRU);
    float* SLOC = (float*)(ws + WS_SLOC);
    bf16_t* YS5 = (bf16_t*)(ws + WS_YS5);
    bf16_t* YCAT = (bf16_t*)(ws + WS_YCAT);
    float* Y = (float*)(ws + WS_Y);
    bf16_t* VB = (bf16_t*)(ws + WS_VB);
    int* LTOK = (int*)(ws + WS_LTOK);
    float* LWT = (float*)(ws + WS_LWT);
    bf16_t* HMID = (bf16_t*)(ws + WS_HMID);
    int* CNT = (int*)(ws + WS_CNT);

    const int lo = p.ph_lo, hi = p.ph_hi;
#define IN(k) (lo <= (k) && (k) < hi)
#define SEAM(k) do { if (IN(k) && IN((k) + 1)) xcd_barrier(bar); else __syncthreads(); } while (0)
    {
        if (IN(0)) {
            {
                LAS float* S = (LAS float*)lds; LAS float* red = S + 9216;
                for (int i = tid; i < 9216; i += 512) { const float c = i < 8192 ? p.in[1][i] : p.in[3][i - 8192]; S[i] = c * sigmoid_f(c); }
                __syncthreads();
                for (int it = bid; it < 192; it += nb) gemv9_item(S, p.in[6], 6144, it * 32, p.in[7], ADA, 6144, red);
                __syncthreads();
            }
            for (int it = bid; it < TT / 8; it += nb) {
                const int row = it * 8 + wid;
                const float* src = row < T ? p.in[0] + (size_t)row * 1024 : p.in[2] + (size_t)(row - T) * 1024;
                f32x4 v[4]; float s = 0.f;
#pragma unroll
                for (int q = 0; q < 4; ++q) { v[q] = *(const f32x4*)(src + q * 256 + lane * 4); s += (v[q][0] + v[q][1]) + (v[q][2] + v[q][3]); }
                const float mean = wave_sum(s) * (1.f / 1024.f); float qq = 0.f;
#pragma unroll
                for (int q = 0; q < 4; ++q) { const f32x4 d = v[q] - mean; qq += (d[0] * d[0] + d[1] * d[1]) + (d[2] * d[2] + d[3] * d[3]); }
                const float rstd = rsqrtf(wave_sum(qq) * (1.f / 1024.f) + LN_EPS_F);
#pragma unroll
                for (int q = 0; q < 4; ++q) {
                    const f32x4 gg = *(const f32x4*)(p.in[4] + q * 256 + lane * 4), bbv = *(const f32x4*)(p.in[5] + q * 256 + lane * 4);
                    const f32x4 o = (v[q] - mean) * rstd * gg + bbv;
                    u32x2 w; w.x = pack2(o[0], o[1]); w.y = pack2(o[2], o[3]);
                    *(u32x2*)(HB + (size_t)row * 1024 + q * 256 + lane * 4) = w;
                }
            }
            {
                LAS float* tile = (LAS float*)lds;
                __syncthreads();
                for (int it = bid; it < 12832; it += nb) {
                    if (it < 64) { tr_tile(p.in[17], 512, (it >> 3) * 64, (it & 7) * 64, (bf16_t*)(ws + WS_BTGLU), 512, 0, tile, nullptr); }
                    else if (it < 320) { const int i2 = it - 64; tr_tile(p.in[26], 1024, (i2 >> 4) * 64, (i2 & 15) * 64, (bf16_t*)(ws + WS_BTOUT), 1024, 0, tile, nullptr); }
                    else if (it < 12800) {
                        const int i2 = it - 320, e = i2 / 192, r = i2 % 192, which = r >> 6, tt = r & 63;
                        if (which < 2) {
                            const float* W = e < 64 ? (which == 0 ? p.in[31] : p.in[32]) + (size_t)e * 262144 : (which == 0 ? p.in[34] : p.in[35]);
                            tr_tile(W, 256, (tt >> 2) * 64, (tt & 3) * 64, (bf16_t*)(ws + WS_BTGU) + (size_t)e * 524288, 1024, which + 1, tile, nullptr);
                        } else {
                            const float* W = e < 64 ? p.in[33] + (size_t)e * 262144 : p.in[36];
                            tr_tile(W, 1024, (tt >> 4) * 64, (tt & 15) * 64, (bf16_t*)(ws + WS_BTDN) + (size_t)e * 262144, 256, 0, tile, nullptr);
                        }
                    } else {
                        const int i2 = it - 12800, dir = i2 >> 4, ax = (i2 >> 3) & 1, h = i2 & 7;
                        const float* W = (ax ? p.in[23] : p.in[21]) + (size_t)(dir * 8 + h) * 4096;
                        tr_tile(W, 64, 0, 0, (bf16_t*)(ws + WS_BTLRU) + (size_t)(h * 256 + dir * 128 + ax * 64) * 64, 64, 0, tile, nullptr);
                    }
                }
            }
            __syncthreads();
            for (int g = bid; g < 32; g += nb) s5_gen(p, lds, g);
        }
        SEAM(0);
        if (IN(1)) {
            {
                LAS float* tile = (LAS float*)lds;
                for (int it = bid; it < 3456; it += nb) {
                    const int bidx = it / 384, r = it % 384, kt = r / 24, nt = r % 24;
                    tr_tile(p.in[8], NWIN, kt * 64, nt * 64, BTIN + (size_t)bidx * NWIN * 1024, 1024, 0, tile, ADA + bidx * 6144 + 1024);
                }
            }
            {
                __syncthreads();
                LAS float* S = (LAS float*)lds; LAS float* red = S + 9216;
                for (int i = tid; i < 9216; i += 512) S[i] = ADA[(i >> 10) * 6144 + (i & 1023)];
                __syncthreads();
                for (int it = bid; it < 48; it += nb) gemv9_item(S, p.in[8], NWIN, it * 32, nullptr, BIASIN, NWIN, red);
            }
        }
        SEAM(1);
        if (IN(2)) {
            for (int u = bid; u < 136 * 12; u += nb) {
                const int rt = u / 12, ct = u % 12, bidx = rt < 128 ? (rt >> 4) : 8;
                const bf16_t* A = HB + (size_t)rt * 256 * 1024;
                const float* bias = BIASIN + bidx * NWIN + ct * 128;
                gemm_unit(lds, [&](int r) { return A + (size_t)r * 1024; }, BTIN + ((size_t)bidx * NWIN + ct * 128) * 1024, 1024,
                    [&](f32x4 (&acc)[4][4], int r0, int c0) {
#pragma unroll
                        for (int i = 0; i < 4; ++i) {
                            const int row = rt * 256 + r0 + 16 * i;
                            int m, s;
                            if (row < T) { const int bq = row >> 12, t = row & 4095; m = bq * 128 + (t >> 5); s = t & 31; }
                            else { const int q = row - T, bq = q >> 8, j = q & 255; m = M5LAT + bq * 8 + (j >> 5); s = j & 31; }
#pragma unroll
                            for (int j4 = 0; j4 < 4; ++j4) {
                                const int cl = c0 + 16 * j4, col = ct * 128 + cl;
                                const f32x4 v = acc[i][j4] + *(const f32x4*)(bias + cl);
                                u32x2 w; w.x = pack2(v[0], v[1]); w.y = pack2(v[2], v[3]);
                                if (col < 512) { const int g = col >> 4, cc = col & 15; *(u32x2*)(US5 + ((size_t)(g * M5PAD + m)) * KT5 + s * 16 + cc) = w; }
                                else *(u32x2*)(ULRU + (size_t)row * 1024 + (col - 512)) = w;
                            }
                        }
                    });
            }
        }
        SEAM(2);
        if (IN(3)) {
            const bf16_t* ES5 = (const bf16_t*)(ws + WS_ES5);
            for (int u = bid; u < 32 * 10; u += nb) {
                const int g = u / 10, r2 = u % 10, rt = r2 >> 1, ct = r2 & 1;
                gemm_unit(lds, [&](int r) { int m = rt * 256 + r; m = m < M5 ? m : M5 - 1; return US5 + ((size_t)(g * M5PAD + m)) * KT5; },
                    ES5 + ((size_t)g * 256 + ct * 128) * 512, 512,
                    [&](f32x4 (&acc)[4][4], int r0, int c0) {
#pragma unroll
                        for (int i = 0; i < 4; ++i) {
                            const int m = rt * 256 + r0 + 16 * i;
                            if (m < M5) {
#pragma unroll
                                for (int j4 = 0; j4 < 4; ++j4) *(f32x4*)(SLOC + ((size_t)(g * M5 + m)) * 256 + ct * 128 + c0 + 16 * j4) = acc[i][j4];
                            }
                        }
                    });
            }
            __syncthreads();
            for (int it = bid; it < NBATCH * 68 * 8; it += nb) { const int h = it & 7, q = it >> 3, ch = q % 68, b = q / 68; lru_item<false>(p, lds, b, ch, h); }
        }
        SEAM(3);
        if (IN(4)) {
            const float* ALC = (const float*)(ws + WS_ALC);
            for (int i = bid * 512 + tid; i < 32768; i += nb * 512) {
                const int pp = i & 63, dir = (i >> 6) & 1, g = (i >> 7) & 31, b = i >> 12;
                const float ar = ALC[((dir * 32 + g) * 64 + pp) * 2], ai = ALC[((dir * 32 + g) * 64 + pp) * 2 + 1];
                float xr = 0.f, xi = 0.f;
                const float* Sg = SLOC + (size_t)g * M5 * 256 + dir * 128 + pp;
                for (int s = 0; s < NCC; ++s) {
                    const int j = dir ? NCC - 1 - s : s, m = M5LAT + b * NCC + j;
                    const float sr = Sg[(size_t)m * 256], si = Sg[(size_t)m * 256 + 64];
                    const float nr = ar * xr - ai * xi + sr, ni = ar * xi + ai * xr + si; xr = nr; xi = ni;
                }
                for (int s = 0; s < NCH; ++s) {
                    const int k = dir ? NCH - 1 - s : s, m = b * NCH + k;
                    bf16_t* dst = US5 + ((size_t)(g * M5PAD + m)) * KT5 + 512 + dir * 128 + pp;
                    dst[0] = (bf16_t)f2bf(xr); dst[64] = (bf16_t)f2bf(xi);
                    const float sr = Sg[(size_t)m * 256], si = Sg[(size_t)m * 256 + 64];
                    const float nr = ar * xr - ai * xi + sr, ni = ar * xi + ai * xr + si; xr = nr; xi = ni;
                }
            }
            const float* SA = (const float*)(ws + WS_SA); const float* SB = (const float*)(ws + WS_SB); float* HIN = (float*)(ws + WS_HIN);
            for (int i = bid * 512 + tid; i < 8192; i += nb * 512) {
                const int chn = i & 511, dir = (i >> 9) & 1, b = i >> 10;
                float H = 0.f;
                for (int s = 0; s < 4; ++s) { const int c = 64 + (dir ? 3 - s : s); const size_t o = ((size_t)(b * 68 + c) * 2 + dir) * 512 + chn; H = SA[o] * H + SB[o]; }
                for (int s = 0; s < 64; ++s) {
                    const int c = dir ? 63 - s : s; const size_t o = ((size_t)(b * 68 + c) * 2 + dir) * 512 + chn;
                    HIN[((size_t)(b * 64 + c) * 2 + dir) * 512 + chn] = H;
                    H = SA[o] * H + SB[o];
                }
            }
        }
        SEAM(4);
        if (IN(5)) {
            const bf16_t* BS5 = (const bf16_t*)(ws + WS_BS5);
            for (int u = bid; u < 32 * 16; u += nb) {
                const int g = u >> 4, rt = (u >> 2) & 3, ct = u & 3;
                gemm_unit(lds, [&](int r) { return US5 + ((size_t)(g * M5PAD + rt * 256 + r)) * KT5; }, BS5 + ((size_t)g * 512 + ct * 128) * KT5, KT5,
                    [&](f32x4 (&acc)[4][4], int r0, int c0) {
#pragma unroll
                        for (int i = 0; i < 4; ++i) {
                            const int m = rt * 256 + r0 + 16 * i, bq = m >> 7, chunk = m & 127;
#pragma unroll
                            for (int j4 = 0; j4 < 4; ++j4) {
                                const int n = ct * 128 + c0 + 16 * j4, t = n >> 4, c = n & 15;
                                const size_t tok = (size_t)bq * 4096 + chunk * 32 + t;
                                const f32x4 v = acc[i][j4];
                                u32x2 w; w.x = pack2(gelu_tanh(v[0]), gelu_tanh(v[1])); w.y = pack2(gelu_tanh(v[2]), gelu_tanh(v[3]));
                                *(u32x2*)(YS5 + tok * 512 + g * 16 + c) = w;
                            }
                        }
                    });
            }
            __syncthreads();
            for (int it = bid; it < NBATCH * 64 * 8; it += nb) { const int h = it & 7, q = it >> 3, ch = q & 63, b = q >> 6; lru_item<true>(p, lds, b, ch, h); }
        }
        SEAM(5);
        if (IN(6)) {
            const bf16_t* BTGLU = (const bf16_t*)(ws + WS_BTGLU); const float* b_glu = p.in[18];
            for (int u = bid; u < 128 * 4; u += nb) {
                const int rt = u >> 2, ct = u & 3;
                const bf16_t* A = YS5 + (size_t)rt * 256 * 512;
                gemm_unit(lds, [&](int r) { return A + (size_t)r * 512; }, BTGLU + (size_t)ct * 128 * 512, 512,
                    [&](f32x4 (&acc)[4][4], int r0, int c0) {
#pragma unroll
                        for (int i = 0; i < 4; ++i) {
                            const size_t row = (size_t)rt * 256 + r0 + 16 * i;
#pragma unroll
                            for (int j4 = 0; j4 < 4; ++j4) {
                                const int col = ct * 128 + c0 + 16 * j4;
                                const f32x4 z = acc[i][j4] + *(const f32x4*)(b_glu + col);
                                const u32x2 yy = *(const u32x2*)(YS5 + row * 512 + col);
                                const float y0 = __uint_as_float(yy.x << 16), y1 = __uint_as_float(yy.x & 0xffff0000u), y2 = __uint_as_float(yy.y << 16), y3 = __uint_as_float(yy.y & 0xffff0000u);
                                u32x2 w; w.x = pack2(y0 * sigmoid_f(z[0]), y1 * sigmoid_f(z[1])); w.y = pack2(y2 * sigmoid_f(z[2]), y3 * sigmoid_f(z[3]));
                                *(u32x2*)(YCAT + row * 1024 + col) = w;
                            }
                        }
                    });
            }
        }
        SEAM(6);
        if (IN(7)) {
            const bf16_t* BTOUT = (const bf16_t*)(ws + WS_BTOUT);
            for (int u = bid; u < 128 * 8; u += nb) {
                const int rt = u >> 3, ct = u & 7;
                const bf16_t* A = YCAT + (size_t)rt * 256 * 1024;
                gemm_unit(lds, [&](int r) { return A + (size_t)r * 1024; }, BTOUT + (size_t)ct * 128 * 1024, 1024,
                    [&](f32x4 (&acc)[4][4], int r0, int c0) {
#pragma unroll
                        for (int i = 0; i < 4; ++i) {
                            const size_t row = (size_t)rt * 256 + r0 + 16 * i;
#pragma unroll
                            for (int j4 = 0; j4 < 4; ++j4) *(f32x4*)(Y + row * 1024 + ct * 128 + c0 + 16 * j4) = acc[i][j4];
                        }
                    });
            }
        }
        SEAM(7);
        if (IN(8)) {
            LAS float* Vs = (LAS float*)lds;
            LAS float* RWs = (LAS float*)(lds + 131584);
            LAS float* SEL = RWs; LAS float* SCO = RWs + 2048;
            LAS int* lcnt = (LAS int*)(lds + 147968); LAS int* gbase = lcnt + 64;
            const float* router_w = p.in[29]; const float* router_bias = p.in[30];
            for (int it = bid; it < T / 32; it += nb) {
                const int t0 = it * 32;
                if (tid < 64) lcnt[tid] = 0;
#pragma unroll 1
                for (int i = 0; i < 4; ++i) {
                    const int tl = wid * 4 + i; const size_t tok = (size_t)t0 + tl; const int b = (int)(tok >> 12);
                    const float* ada = ADA + b * 6144;
                    f32x4 z[4]; float s = 0.f;
#pragma unroll
                    for (int q = 0; q < 4; ++q) {
                        const int col = q * 256 + lane * 4;
                        const u32x2 hh = *(const u32x2*)(HB + tok * 1024 + col);
                        const f32x4 yv = *(const f32x4*)(Y + tok * 1024 + col);
                        const f32x4 g1 = *(const f32x4*)(ada + 2048 + col);
                        f32x4 hv; hv[0] = __uint_as_float(hh.x << 16); hv[1] = __uint_as_float(hh.x & 0xffff0000u); hv[2] = __uint_as_float(hh.y << 16); hv[3] = __uint_as_float(hh.y & 0xffff0000u);
                        z[q] = hv * ALPHA_F + g1 * yv;
                        s += (z[q][0] + z[q][1]) + (z[q][2] + z[q][3]);
                    }
                    const float mean = wave_sum(s) * (1.f / 1024.f); float qq = 0.f;
#pragma unroll
                    for (int q = 0; q < 4; ++q) { const f32x4 d = z[q] - mean; qq += (d[0] * d[0] + d[1] * d[1]) + (d[2] * d[2] + d[3] * d[3]); }
                    const float rstd = rsqrtf(wave_sum(qq) * (1.f / 1024.f) + LN_EPS_F);
#pragma unroll
                    for (int q = 0; q < 4; ++q) {
                        const int col = q * 256 + lane * 4;
                        const f32x4 gg = *(const f32x4*)(p.in[27] + col), bbv = *(const f32x4*)(p.in[28] + col);
                        const f32x4 h1 = (z[q] - mean) * rstd * gg + bbv;
                        *(f32x4*)(Y + tok * 1024 + col) = h1;
                        const f32x4 sc2 = *(const f32x4*)(ada + 4096 + col), sh2 = *(const f32x4*)(ada + 3072 + col);
                        const f32x4 v = h1 * (sc2 + 1.f) + sh2;
                        u32x2 w; w.x = pack2(v[0], v[1]); w.y = pack2(v[2], v[3]);
                        *(u32x2*)(VB + tok * 1024 + col) = w;
                        *(LAS f32x4*)(Vs + tl * 1028 + col) = v;
                        *(f32x4*)(p.out + tok * 1024 + col) = (f32x4){0.f, 0.f, 0.f, 0.f};
                    }
                }
                __syncthreads();
                const int tt = tid >> 4, q16 = tid & 15;
                f32x4 lg = (f32x4){0.f, 0.f, 0.f, 0.f};
                for (int k0 = 0; k0 < 1024; k0 += 64) {
#pragma unroll
                    for (int i = 0; i < 2; ++i) { const int idx = tid + i * 512, kk = idx >> 4, e4 = (idx & 15) * 4; *(LAS f32x4*)(RWs + kk * 64 + e4) = *(const f32x4*)(router_w + (size_t)(k0 + kk) * 64 + e4); }
                    __syncthreads();
#pragma unroll 2
                    for (int kk = 0; kk < 64; kk += 4) {
                        const f32x4 v = *(LAS const f32x4*)(Vs + tt * 1028 + k0 + kk);
#pragma unroll
                        for (int u = 0; u < 4; ++u) { const f32x4 w = *(LAS const f32x4*)(RWs + (kk + u) * 64 + q16 * 4); lg += w * v[u]; }
                    }
                    __syncthreads();
                }
#pragma unroll
                for (int i = 0; i < 4; ++i) { const int e = q16 * 4 + i; const float sc = sigmoid_f(lg[i]); SCO[tt * 64 + e] = sc; SEL[tt * 64 + e] = sc + router_bias[e]; }
                __syncthreads();
                float gs[8];
#pragma unroll
                for (int gi = 0; gi < 8; ++gi) {
                    float m1 = -INFINITY, m2 = -INFINITY;
#pragma unroll
                    for (int j = 0; j < 8; ++j) { const float v = SEL[tt * 64 + gi * 8 + j]; if (v > m1) { m2 = m1; m1 = v; } else if (v > m2) m2 = v; }
                    gs[gi] = m1 + m2;
                }
                unsigned gmask = 0u;
#pragma unroll
                for (int gi = 0; gi < 8; ++gi) {
                    int rank = 0;
#pragma unroll
                    for (int hh = 0; hh < 8; ++hh) rank += (gs[hh] > gs[gi] || (gs[hh] == gs[gi] && hh < gi)) ? 1 : 0;
                    if (rank < 4) gmask |= 1u << gi;
                }
                bool chosen[4]; float scv[4]; float mysum = 0.f;
#pragma unroll
                for (int i = 0; i < 4; ++i) {
                    const int e = q16 * 4 + i; chosen[i] = false; scv[i] = 0.f;
                    if ((gmask >> (e >> 3)) & 1u) {
                        const float v = SEL[tt * 64 + e]; int rank = 0;
#pragma unroll 2
                        for (int j = 0; j < 64; ++j) { if ((gmask >> (j >> 3)) & 1u) { const float vj = SEL[tt * 64 + j]; rank += (vj > v || (vj == v && j < e)) ? 1 : 0; } }
                        if (rank < 8) { chosen[i] = true; scv[i] = SCO[tt * 64 + e]; mysum += scv[i]; }
                    }
                }
                float wsum = mysum;
#pragma unroll
                for (int o = 1; o < 16; o <<= 1) wsum += __shfl_xor(wsum, o);
                int lrank[4];
#pragma unroll
                for (int i = 0; i < 4; ++i) { lrank[i] = 0; if (chosen[i]) lrank[i] = __hip_atomic_fetch_add(lcnt + q16 * 4 + i, 1, __ATOMIC_RELAXED, __HIP_MEMORY_SCOPE_WORKGROUP); }
                __syncthreads();
                if (tid < 64) gbase[tid] = atomicAdd(CNT + tid, lcnt[tid]);
                __syncthreads();
#pragma unroll
                for (int i = 0; i < 4; ++i) if (chosen[i]) {
                    const int e = q16 * 4 + i; const size_t pos = (size_t)e * T + gbase[e] + lrank[i];
                    LTOK[pos] = t0 + tt; LWT[pos] = scv[i] / wsum * 2.5f;
                }
                __syncthreads();
            }
        }
        SEAM(8);
        if (IN(9)) {
            moe_tables(p, lds);
            LAS const int* tp = (LAS const int*)(lds + MOE_TAB_OFF); LAS const int* pp = tp + 72; LAS const int* cn = pp + 72;
            const bf16_t* BTGU = (const bf16_t*)(ws + WS_BTGU);
            const int nunits = tp[65] * 4;
            for (int u = bid; u < nunits; u += nb) {
                const int rt = u >> 2, ct = u & 3;
                int e = 0; while (tp[e + 1] <= rt) ++e;
                const int r0t = (rt - tp[e]) * 256, ce = cn[e]; const size_t prow = (size_t)pp[e] + r0t;
                gemm_unit(lds, [&](int r) { int idx = r0t + r; idx = idx < ce ? idx : ce - 1; const int tok = e < 64 ? LTOK[(size_t)e * T + idx] : idx; return VB + (size_t)tok * 1024; },
                    BTGU + ((size_t)e * 512 + ct * 128) * 1024, 1024,
                    [&](f32x4 (&acc)[4][4], int r0, int c0) {
                        const int wc2 = c0 >> 6, fq4 = c0 & 63;
#pragma unroll
                        for (int i = 0; i < 4; ++i) {
                            const size_t row = prow + r0 + 16 * i;
#pragma unroll
                            for (int jp = 0; jp < 2; ++jp) {
                                const f32x4 gt = acc[i][2 * jp], up = acc[i][2 * jp + 1];
                                const int unit = (ct * 4 + wc2 * 2 + jp) * 16 + fq4;
                                u32x2 w; w.x = pack2(gt[0] * sigmoid_f(gt[0]) * up[0], gt[1] * sigmoid_f(gt[1]) * up[1]); w.y = pack2(gt[2] * sigmoid_f(gt[2]) * up[2], gt[3] * sigmoid_f(gt[3]) * up[3]);
                                *(u32x2*)(HMID + row * 256 + unit) = w;
                            }
                        }
                    });
            }
        }
        SEAM(9);
        if (IN(10)) {
            moe_tables(p, lds);
            LAS const int* tp = (LAS const int*)(lds + MOE_TAB_OFF); LAS const int* pp = tp + 72; LAS const int* cn = pp + 72;
            const bf16_t* BTDN = (const bf16_t*)(ws + WS_BTDN);
            const int nunits = tp[65] * 8;
            for (int u = bid; u < nunits; u += nb) {
                const int rt = u >> 3, ct = u & 7;
                int e = 0; while (tp[e + 1] <= rt) ++e;
                const int r0t = (rt - tp[e]) * 256, ce = cn[e]; const size_t prow = (size_t)pp[e] + r0t;
                gemm_unit(lds, [&](int r) { return HMID + (prow + r) * 256; }, BTDN + ((size_t)e * 1024 + ct * 128) * 256, 256,
                    [&](f32x4 (&acc)[4][4], int r0, int c0) {
#pragma unroll
                        for (int i = 0; i < 4; ++i) {
                            const int idx = r0t + r0 + 16 * i;
                            if (idx < ce) {
                                const int tok = e < 64 ? LTOK[(size_t)e * T + idx] : idx;
                                const float wt = e < 64 ? LWT[(size_t)e * T + idx] : 1.f;
                                float* dst = p.out + (size_t)tok * 1024 + ct * 128 + c0;
#pragma unroll
                                for (int j4 = 0; j4 < 4; ++j4) {
#pragma unroll
                                    for (int rg = 0; rg < 4; ++rg) atomicAdd(dst + 16 * j4 + rg, wt * acc[i][j4][rg]);
                                }
                            }
                        }
                    });
            }
        }
        SEAM(10);
        if (IN(11)) {
            for (int it = bid; it < T / 8; it += nb) {
                const size_t tok = (size_t)it * 8 + wid; const int b = (int)(tok >> 12);
                const float* ada = ADA + b * 6144;
                f32x4 z[4]; float s = 0.f;
#pragma unroll
                for (int q = 0; q < 4; ++q) {
                    const int col = q * 256 + lane * 4;
                    const f32x4 h1 = *(const f32x4*)(Y + tok * 1024 + col), f = *(const f32x4*)(p.out + tok * 1024 + col), g2 = *(const f32x4*)(ada + 5120 + col);
                    z[q] = h1 * ALPHA_F + g2 * f;
                    s += (z[q][0] + z[q][1]) + (z[q][2] + z[q][3]);
                }
                const float mean = wave_sum(s) * (1.f / 1024.f); float qq = 0.f;
#pragma unroll
                for (int q = 0; q < 4; ++q) { const f32x4 d = z[q] - mean; qq += (d[0] * d[0] + d[1] * d[1]) + (d[2] * d[2] + d[3] * d[3]); }
                const float rstd = rsqrtf(wave_sum(qq) * (1.f / 1024.f) + LN_EPS_F);
#pragma unroll
                for (int q = 0; q < 4; ++q) {
                    const int col = q * 256 + lane * 4;
                    const f32x4 gg = *(const f32x4*)(p.in[37] + col), bbv = *(const f32x4*)(p.in[38] + col);
                    *(f32x4*)(p.out + tok * 1024 + col) = (z[q] - mean) * rstd * gg + bbv;
                }
            }
        }
    }
}

extern "C" void kernel_launch(void* const* d_in, const int* in_sizes, int n_in, void* d_out, int out_size, void* d_ws, size_t ws_size, hipStream_t stream) {
    static int grid = 0;
    if (grid == 0) {
        if (n_in != 39 || out_size != T * D || ws_size < WS_END) { fprintf(stderr, "kernel_launch: unexpected problem (n_in %d, out %d, ws %zu); nothing launched\n", n_in, out_size, ws_size); grid = -1; return; }
        int dev = 0, cus = 0;
        if (hipGetDevice(&dev) != hipSuccess || hipDeviceGetAttribute(&cus, hipDeviceAttributeMultiprocessorCount, dev) != hipSuccess) { grid = -1; return; }
        if (hipFuncSetAttribute((const void*)mk_fwd, hipFuncAttributeMaxDynamicSharedMemorySize, LDS_BYTES) != hipSuccess) { fprintf(stderr, "kernel_launch: hipFuncSetAttribute failed\n"); grid = -1; return; }
        grid = cus > 0 ? cus : 256;
    }
    if (grid < 0) return;
    (void)in_sizes;
    if (hipMemsetAsync((char*)d_ws + WS_CTL, 0, CTL_ZERO_BYTES, stream) != hipSuccess) return;
    Params p{};
    for (int i = 0; i < 39; ++i) p.in[i] = (const float*)d_in[i];
    p.out = (float*)d_out; p.ws = (unsigned char*)d_ws;
#if MK_N_LAUNCHES == 1
    p.ph_lo = 0; p.ph_hi = NPHASE;
    hipLaunchKernelGGL(mk_fwd, dim3(grid), dim3(512), LDS_BYTES, stream, p);
#else
    for (int ph = 0; ph < NPHASE; ++ph) {
        p.ph_lo = ph; p.ph_hi = ph + 1;
        hipLaunchKernelGGL(mk_fwd, dim3(grid), dim3(512), LDS_BYTES, stream, p);
    }
#endif
}
```

```cpp
#include <hip/hip_runtime.h>
#include <cstdio>
#include <cstdint>

#ifndef MK_N_LAUNCHES
#define MK_N_LAUNCHES 1
#endif

#define DEV __device__ __forceinline__
#define LAS __attribute__((address_space(3)))
typedef unsigned short bf16_t;
typedef short bf16x8 __attribute__((ext_vector_type(8)));
typedef float f32x4 __attribute__((ext_vector_type(4)));
typedef unsigned u32x2 __attribute__((ext_vector_type(2)));
typedef unsigned u32x4 __attribute__((ext_vector_type(4)));

constexpr int D = 1024, NBATCH = 8, SEQ = 4096, T = NBATCH * SEQ, CTXL = 256, TC = NBATCH * CTXL, TT = T + TC;
constexpr int NWIN = 1536;
constexpr int LC = 32, KT5 = 768, NCH = SEQ / LC  , NCC = CTXL / LC  ;
constexpr int M5LAT = NBATCH * NCH  , M5 = M5LAT + NBATCH * NCC  , M5PAD = 1280;
constexpr int NE = 64;
constexpr int NPHASE = 12;
constexpr float ALPHA_F = 1.189207115002721f, LN_EPS_F = 1e-5f;

constexpr size_t MiB = 1u << 20;
constexpr size_t WS_CTL = 0, CTL_ZERO_BYTES = 65536;
constexpr size_t WS_CNT = 32768;
constexpr size_t WS_ADA = 65536;
constexpr size_t WS_BIASIN = 512 * 1024;
constexpr size_t WS_ALC = 640 * 1024;
constexpr size_t WS_SA = 1 * MiB, WS_SB = 4 * MiB, WS_HIN = 7 * MiB;
constexpr size_t WS_BTGLU = 10 * MiB;
constexpr size_t WS_BTOUT = 10 * MiB + 512 * 1024;
constexpr size_t WS_BTLRU = 12 * MiB + 512 * 1024;
constexpr size_t WS_BS5 = 13 * MiB;
constexpr size_t WS_ES5 = 37 * MiB;
constexpr size_t WS_BTGU = 45 * MiB;
constexpr size_t WS_BTDN = 110 * MiB;
constexpr size_t WS_HB = 143 * MiB;
constexpr size_t WS_BTIN = 211 * MiB;
constexpr size_t WS_US5 = 238 * MiB;
constexpr size_t WS_ULRU = 298 * MiB;
constexpr size_t WS_SLOC = 366 * MiB;
constexpr size_t WS_YS5 = 400 * MiB;
constexpr size_t WS_YCAT = 448 * MiB;
constexpr size_t WS_Y = 295 * MiB;
constexpr size_t WS_VB = 423 * MiB;
constexpr size_t WS_LTOK = 487 * MiB;
constexpr size_t WS_LWT = 495 * MiB;
constexpr size_t WS_HMID = 143 * MiB;
constexpr size_t WS_END = 512 * MiB;

constexpr int LDS_BYTES = 155648;
constexpr int MISC_OFF = LDS_BYTES - 256;

DEV float bf2f(bf16_t h) { return __uint_as_float(((unsigned)h) << 16); }
DEV unsigned f2bf(float f) { unsigned u = __float_as_uint(f); return (u + 0x7fffu + ((u >> 16) & 1u)) >> 16; }
DEV unsigned pack2(float a, float b) { return f2bf(a) | (f2bf(b) << 16); }
DEV float sigmoid_f(float x) { return 1.f / (1.f + __expf(-x)); }
DEV float gelu_tanh(float x) {
    const float z = 0.7978845608028654f * (x + 0.044715f * x * x * x);
    const float e = __expf(2.f * z);
    const float t = 1.f - 2.f / (e + 1.f);
    return 0.5f * x * (1.f + t);
}
DEV float wave_sum(float v) {
#pragma unroll
    for (int o = 1; o < 64; o <<= 1) v += __shfl_xor(v, o);
    return v;
}

struct Params { const float* in[39]; float* out; unsigned char* ws; int ph_lo, ph_hi; };

#define XB_TMO      128
#define XB_XCNT(j)  (256  + 64 * (j))
#define XB_XSUB(j)  (1280 + 64 * (j))
#define XB_XGEN(j)  (2304 + 64 * (j))
#define XB_TOP      3328
#define XB_TOPGEN   3392
#define XCD_BAR_WORDS 3456
#define XB_SPIN_CAP (1u << 20)
DEV unsigned xb_ld(unsigned* p)              { return __hip_atomic_load(p, __ATOMIC_RELAXED, __HIP_MEMORY_SCOPE_AGENT); }
DEV unsigned xb_add(unsigned* p, unsigned v) { return __hip_atomic_fetch_add(p, v, __ATOMIC_RELAXED, __HIP_MEMORY_SCOPE_AGENT); }
DEV unsigned xb_xcc_id() { return (unsigned)__builtin_amdgcn_s_getreg((3 << 11) | 20) & 0xFu; }
#define XB_SPIN(cond, bar) do { unsigned _sp = 0; while (cond) { __builtin_amdgcn_s_sleep(1); \
    if ((++_sp & 255u) == 0u) { if (xb_ld(&(bar)[XB_TMO])) break; if (_sp > XB_SPIN_CAP) { atomicAdd(&(bar)[XB_TMO], 1u); break; } } } } while (0)
struct XcdBarrier { unsigned* bar; unsigned x; volatile LAS unsigned* st; };
DEV XcdBarrier xcd_barrier_post(unsigned* bar, volatile LAS unsigned* st) {
    XcdBarrier b; b.bar = bar; b.x = xb_xcc_id(); b.st = st;
    if (threadIdx.x == 0) (void)xb_add(&bar[XB_XCNT(b.x)], 1u);
    return b;
}
DEV void xcd_barrier_complete(unsigned* bar, unsigned x, unsigned& nloc, unsigned& nx) {
    const unsigned G = gridDim.x * gridDim.y * gridDim.z;
    unsigned sum, cnt, mine, sp = 0u;
    for (;;) {
        sum = 0u; cnt = 0u; mine = 0u;
#pragma unroll
        for (unsigned j = 0; j < 16; ++j) { const unsigned c = xb_ld(&bar[XB_XCNT(j)]); sum += c; cnt += (c > 0u) ? 1u : 0u; mine = (j == x) ? c : mine; }
        if (sum == G) break;
        __builtin_amdgcn_s_sleep(1);
        if ((++sp & 255u) == 0u) { if (xb_ld(&bar[XB_TMO])) break; if (sp > XB_SPIN_CAP) { atomicAdd(&bar[XB_TMO], 1u); break; } }
    }
    nloc = mine > 0u ? mine : 1u; nx = cnt > 0u ? cnt : 1u;
}
DEV void xcd_barrier(const XcdBarrier& b) {
    asm volatile("s_waitcnt vmcnt(0)" ::: "memory");
    __syncthreads();
    if (threadIdx.x == 0) {
        unsigned* bar = b.bar;
        __builtin_amdgcn_s_waitcnt(0);
        unsigned nloc = b.st[0], nx = b.st[1];
        if (nloc == 0u) { xcd_barrier_complete(bar, b.x, nloc, nx); b.st[0] = nloc; b.st[1] = nx; }
        const unsigned old = xb_add(&bar[XB_XSUB(b.x)], 1u);
        const unsigned gen = old / nloc;
        if (old + 1u == (gen + 1u) * nloc) {
            __builtin_amdgcn_fence(__ATOMIC_RELEASE, "agent");
            asm volatile("s_waitcnt vmcnt(0)" ::: "memory");
            const unsigned og = xb_add(&bar[XB_TOP], 1u);
            const unsigned tg = og / nx;
            if (og + 1u == (tg + 1u) * nx) xb_add(&bar[XB_TOPGEN], 1u);
            else XB_SPIN(xb_ld(&bar[XB_TOPGEN]) == tg, bar);
            __builtin_amdgcn_fence(__ATOMIC_ACQUIRE, "agent");
            xb_add(&bar[XB_XGEN(b.x)], 1u);
            asm volatile("s_waitcnt vmcnt(0)" ::: "memory");
        } else {
            XB_SPIN(xb_ld(&bar[XB_XGEN(b.x)]) == gen, bar);
            __builtin_amdgcn_fence(__ATOMIC_ACQUIRE, "agent");
            asm volatile("s_waitcnt vmcnt(0)" ::: "memory");
        }
    }
    __syncthreads();
}

constexpr int GEMM_LDS = 61440;
template <class ARow, class Epi>
DEV void gemm_unit(LAS unsigned char* lds, const ARow& arow, const bf16_t* __restrict__ Bt, int K, const Epi& epi) {
    const int tid = threadIdx.x, wid = tid >> 6, lane = tid & 63, wr = wid >> 1, wc = wid & 1, fr = lane & 15, fq = lane >> 4;
    LAS unsigned char* As = lds;
    LAS unsigned char* Bs = lds + 40960;
    const u32x4* pa0 = (const u32x4*)arow(tid >> 2) + (tid & 3);
    const u32x4* pa1 = (const u32x4*)arow(128 + (tid >> 2)) + (tid & 3);
    const u32x4* pb = (const u32x4*)(Bt + (size_t)(tid >> 2) * K) + (tid & 3);
    const int sa0 = (tid >> 2) * 80 + (tid & 3) * 16, sa1 = sa0 + 128 * 80;
    f32x4 acc[4][4];
#pragma unroll
    for (int i = 0; i < 4; ++i)
#pragma unroll
        for (int j = 0; j < 4; ++j) acc[i][j] = (f32x4){0.f, 0.f, 0.f, 0.f};
    const int nk = K >> 5;
    u32x4 ra0 = pa0[0], ra1 = pa1[0], rb = pb[0];
    *(LAS u32x4*)(As + sa0) = ra0; *(LAS u32x4*)(As + sa1) = ra1; *(LAS u32x4*)(Bs + sa0) = rb;
    __syncthreads();
    for (int kt = 0; kt < nk; ++kt) {
        const int cur = kt & 1;
        if (kt + 1 < nk) { ra0 = pa0[(kt + 1) * 4]; ra1 = pa1[(kt + 1) * 4]; rb = pb[(kt + 1) * 4]; }
        LAS const unsigned char* Ac = As + cur * 20480 + (wr * 64 + fr) * 80 + fq * 16;
        LAS const unsigned char* Bc = Bs + cur * 10240 + (wc * 64 + fr) * 80 + fq * 16;
        bf16x8 af[4], bfv[4];
#pragma unroll
        for (int i = 0; i < 4; ++i) af[i] = *(LAS const bf16x8*)(Ac + i * 1280);
#pragma unroll
        for (int j = 0; j < 4; ++j) bfv[j] = *(LAS const bf16x8*)(Bc + j * 1280);
#pragma unroll
        for (int i = 0; i < 4; ++i)
#pragma unroll
            for (int j = 0; j < 4; ++j) acc[i][j] = __builtin_amdgcn_mfma_f32_16x16x32_bf16(bfv[j], af[i], acc[i][j], 0, 0, 0);
        if (kt + 1 < nk) {
            const int nx = cur ^ 1;
            *(LAS u32x4*)(As + nx * 20480 + sa0) = ra0; *(LAS u32x4*)(As + nx * 20480 + sa1) = ra1; *(LAS u32x4*)(Bs + nx * 10240 + sa0) = rb;
        }
        __syncthreads();
    }
    epi(acc, wr * 64 + fr, wc * 64 + 4 * fq);
}

DEV void tr_tile(const float* __restrict__ W, int ldw, int k0, int n0, bf16_t* __restrict__ dst, int ldd, int mode, LAS float* tile, const float* __restrict__ kscale1p) {
    const int tid = threadIdx.x;
#pragma unroll
    for (int i = 0; i < 2; ++i) {
        const int idx = tid + i * 512, kk = idx >> 4, n4 = (idx & 15) * 4;
        f32x4 v = *(const f32x4*)(W + (size_t)(k0 + kk) * ldw + n0 + n4);
        if (kscale1p) { const float s = 1.f + kscale1p[k0 + kk]; v = v * s; }
        LAS float* tp = tile + kk * 65 + n4;
        tp[0] = v[0]; tp[1] = v[1]; tp[2] = v[2]; tp[3] = v[3];
    }
    __syncthreads();
    {
        const int nn = tid >> 3, kc = tid & 7;
        float e[8];
#pragma unroll
        for (int jj = 0; jj < 8; ++jj) e[jj] = tile[(kc * 8 + jj) * 65 + nn];
        const int j = n0 + nn;
        const int row = mode == 0 ? j : (((j >> 4) << 5) + (j & 15) + (mode == 2 ? 16 : 0));
        u32x4 w; w.x = pack2(e[0], e[1]); w.y = pack2(e[2], e[3]); w.z = pack2(e[4], e[5]); w.w = pack2(e[6], e[7]);
        *(u32x4*)(dst + (size_t)row * ldd + k0 + kc * 8) = w;
    }
    __syncthreads();
}

DEV void gemv9_item(LAS const float* S, const float* __restrict__ W, int ldw, int col0, const float* __restrict__ bias, float* __restrict__ out, int ldo, LAS float* red) {
    const int tid = threadIdx.x, col = tid & 31, kp = tid >> 5;
    float acc[9];
#pragma unroll
    for (int b = 0; b < 9; ++b) acc[b] = 0.f;
    for (int k = kp * 64; k < kp * 64 + 64; ++k) {
        const float w = W[(size_t)k * ldw + col0 + col];
#pragma unroll
        for (int b = 0; b < 9; ++b) acc[b] += S[b * 1024 + k] * w;
    }
#pragma unroll
    for (int b = 0; b < 9; ++b) red[(kp * 9 + b) * 32 + col] = acc[b];
    __syncthreads();
    if (tid < 288) {
        const int b = tid >> 5, c = tid & 31; float s = 0.f;
#pragma unroll
        for (int q = 0; q < 16; ++q) s += red[(q * 9 + b) * 32 + c];
        out[b * ldo + col0 + c] = s + (bias ? bias[col0 + c] : 0.f);
    }
    __syncthreads();
}

DEV void cpow_d(double lr, double li, double dt, int l, double& re, double& im) {
    const double mag = exp(lr * dt * (double)l);
    const double ang = li * dt * (double)l;
    const double kq = rint(ang * 0.63661977236758134308);
    double x = fma(-kq, 1.57079632679489655800e+00, ang);
    x = fma(-kq, 6.12323399573676603587e-17, x);
    const double x2 = x * x;
    double s = -1.0 / 6227020800.0; s = fma(s, x2, 1.0 / 39916800.0); s = fma(s, x2, -1.0 / 362880.0); s = fma(s, x2, 1.0 / 5040.0);
    s = fma(s, x2, -1.0 / 120.0); s = fma(s, x2, 1.0 / 6.0); s = fma(-s, x2, 1.0); s = s * x;
    double c = 1.0 / 479001600.0; c = fma(c, x2, -1.0 / 3628800.0); c = fma(c, x2, 1.0 / 40320.0); c = fma(c, x2, -1.0 / 720.0);
    c = fma(c, x2, 1.0 / 24.0); c = fma(c, x2, -0.5); c = fma(c, x2, 1.0);
    const int q = ((int)(long long)kq) & 3;
    const double sn = (q == 0) ? s : (q == 1) ? c : (q == 2) ? -s : -c;
    const double cs = (q == 0) ? c : (q == 1) ? -s : (q == 2) ? -c : s;
    re = mag * cs; im = mag * sn;
}

DEV void s5_gen(const Params& p, LAS unsigned char* lds, int g) {
    const int tid = threadIdx.x;
    LAS float* apr = (LAS float*)lds;
    LAS float* api = apr + 4224;
    LAS float* bbr = api + 4224;
    LAS float* bbi = bbr + 2048;
    LAS float* ccr = bbi + 2048;
    LAS float* cci = ccr + 2048;
    LAS float* Kt = cci + 2048;
    const float* lam_re = p.in[9]; const float* lam_im = p.in[10]; const float* log_dt = p.in[11];
    const float* b_re = p.in[12]; const float* b_im = p.in[13]; const float* c_re = p.in[14]; const float* c_im = p.in[15]; const float* dvec = p.in[16];
    bf16_t* BS5 = (bf16_t*)(p.ws + WS_BS5); bf16_t* ES5 = (bf16_t*)(p.ws + WS_ES5); float* ALC = (float*)(p.ws + WS_ALC);
    for (int i = tid; i < 4224; i += 512) {
        const int dir = i / 2112, rem = i % 2112, l = rem >> 6, pp = rem & 63, gi = dir * 32 + g;
        const double dt = exp((double)log_dt[gi]);
        double re, im; cpow_d((double)lam_re[gi * 64 + pp], (double)lam_im[gi * 64 + pp], dt, l, re, im);
        apr[i] = (float)re; api[i] = (float)im;
    }
    for (int i = tid; i < 2048; i += 512) {
        const int dir = i >> 10, cc = (i >> 6) & 15, pp = i & 63; const size_t src = ((size_t)((dir * 32 + g) * 16 + cc)) * 64 + pp;
        ccr[i] = c_re[src]; cci[i] = c_im[src];
    }
    for (int i = tid; i < 2048; i += 512) {
        const int dir = i >> 10, pp = (i >> 4) & 63, c = i & 15, gi = dir * 32 + g;
        const double dt = exp((double)log_dt[gi]);
        const double lr = (double)lam_re[gi * 64 + pp], li = (double)lam_im[gi * 64 + pp];
        double ar, ai; cpow_d(lr, li, dt, 1, ar, ai);
        const double nr = ar - 1.0, den = lr * lr + li * li;
        const double fr = (nr * lr + ai * li) / den, fi = (ai * lr - nr * li) / den;
        const double br = (double)b_re[((size_t)(gi * 64 + pp)) * 16 + c], bi = (double)b_im[((size_t)(gi * 64 + pp)) * 16 + c];
        bbr[i] = (float)(fr * br - fi * bi); bbi[i] = (float)(fr * bi + fi * br);
    }
    __syncthreads();
    for (int o = tid; o < 16384; o += 512) {
        const int dir = o >> 13, l = (o >> 8) & 31, c = (o >> 4) & 15, c2 = o & 15;
        float sum = 0.f;
        for (int pp = 0; pp < 64; ++pp) {
            const float ar = apr[(dir * 33 + l) * 64 + pp], ai = api[(dir * 33 + l) * 64 + pp];
            const float br = bbr[(dir * 64 + pp) * 16 + c2], bi = bbi[(dir * 64 + pp) * 16 + c2];
            const float tr = ar * br - ai * bi, ti = ar * bi + ai * br;
            sum += ccr[(dir * 16 + c) * 64 + pp] * tr - cci[(dir * 16 + c) * 64 + pp] * ti;
        }
        Kt[o] = sum;
    }
    __syncthreads();
    for (int q = tid; q < 512 * 96; q += 512) {
        const int n = q / 96, k8 = (q % 96) * 8, t = n >> 4, c = n & 15;
        float e[8];
        if (k8 < 512) {
            const int s = k8 >> 4, c0 = k8 & 15, delta = t - s;
#pragma unroll
            for (int i = 0; i < 8; ++i) {
                const int c2 = c0 + i; float v;
                if (delta > 0) v = Kt[delta * 256 + c * 16 + c2];
                else if (delta < 0) v = Kt[(32 - delta) * 256 + c * 16 + c2];
                else v = Kt[c * 16 + c2] + Kt[32 * 256 + c * 16 + c2] + (c == c2 ? dvec[g * 16 + c] : 0.f);
                e[i] = v;
            }
        } else {
            const int kk = k8 - 512, seg = kk >> 6, p0 = kk & 63, dir = seg >> 1, l = dir == 0 ? t + 1 : 32 - t;
#pragma unroll
            for (int i = 0; i < 8; ++i) {
                const int pp = p0 + i;
                const float ar = apr[(dir * 33 + l) * 64 + pp], ai = api[(dir * 33 + l) * 64 + pp];
                const float cr = ccr[(dir * 16 + c) * 64 + pp], ci = cci[(dir * 16 + c) * 64 + pp];
                e[i] = (seg & 1) ? -(cr * ai + ci * ar) : (cr * ar - ci * ai);
            }
        }
        u32x4 w; w.x = pack2(e[0], e[1]); w.y = pack2(e[2], e[3]); w.z = pack2(e[4], e[5]); w.w = pack2(e[6], e[7]);
        *(u32x4*)(BS5 + ((size_t)g * 512 + n) * 768 + k8) = w;
    }
    for (int q = tid; q < 256 * 64; q += 512) {
        const int n = q >> 6, k8 = (q & 63) * 8, s = k8 >> 4, c0 = k8 & 15, seg = n >> 6, pp = n & 63, dir = seg >> 1, l = dir == 0 ? 31 - s : s;
        const float ar = apr[(dir * 33 + l) * 64 + pp], ai = api[(dir * 33 + l) * 64 + pp];
        float e[8];
#pragma unroll
        for (int i = 0; i < 8; ++i) {
            const float br = bbr[(dir * 64 + pp) * 16 + c0 + i], bi = bbi[(dir * 64 + pp) * 16 + c0 + i];
            e[i] = (seg & 1) ? (ar * bi + ai * br) : (ar * br - ai * bi);
        }
        u32x4 w; w.x = pack2(e[0], e[1]); w.y = pack2(e[2], e[3]); w.z = pack2(e[4], e[5]); w.w = pack2(e[6], e[7]);
        *(u32x4*)(ES5 + ((size_t)g * 256 + n) * 512 + k8) = w;
    }
    if (tid < 128) {
        const int dir = tid >> 6, pp = tid & 63;
        ALC[((dir * 32 + g) * 64 + pp) * 2 + 0] = apr[(dir * 33 + 32) * 64 + pp];
        ALC[((dir * 32 + g) * 64 + pp) * 2 + 1] = api[(dir * 33 + 32) * 64 + pp];
    }
    __syncthreads();
}

template <bool APPLY>
DEV void lru_item(const Params& p, LAS unsigned char* lds, int b, int ch, int h) {
    const int tid = threadIdx.x, wid = tid >> 6, lane = tid & 63, fr = lane & 15, fq = lane >> 4;
    LAS float* xin = (LAS float*)lds;
    LAS float* xs = (LAS float*)(lds + 17408);
    LAS unsigned short* xsb = (LAS unsigned short*)(lds + 33792);
    LAS float* aa = (LAS float*)(lds + 43008);
    LAS float* bb = (LAS float*)(lds + 75776);
    LAS float* cAs = (LAS float*)(lds + 108544);
    const bf16_t* ULRU = (const bf16_t*)(p.ws + WS_ULRU);
    const bf16_t* BTLRU = (const bf16_t*)(p.ws + WS_BTLRU);
    const float* conv_w = p.in[19]; const float* conv_b = p.in[20];
    if (tid < 128) {
        const int dir = tid >> 6, j = tid & 63, o = dir * 512 + h * 64 + j;
        cAs[tid] = -8.f * log1pf(__expf(-p.in[25][o])); cAs[128 + tid] = p.in[22][o]; cAs[256 + tid] = p.in[24][o];
    }
#pragma unroll 1
    for (int idx = tid; idx < 67 * 64; idx += 512) {
        const int rr = idx >> 6, cc = idx & 63, pos = rr - 2;
        float v = 0.f;
        if (ch < 64) { if (pos >= 0 && pos < 64) v = bf2f(ULRU[((size_t)b * 4096 + pos * 64 + ch) * 1024 + h * 64 + cc]); }
        else { const int jt = (ch - 64) * 64 + pos; if (jt >= 0 && jt < 256) v = bf2f(ULRU[((size_t)T + b * 256 + jt) * 1024 + h * 64 + cc]); }
        xin[idx] = v;
    }
    __syncthreads();
    {
        const int cc = tid & 63, chn = h * 64 + cc;
        const float w0 = conv_w[chn], w1 = conv_w[512 + chn], w2 = conv_w[1024 + chn], w3 = conv_w[1536 + chn], cb = conv_b[chn];
#pragma unroll 2
        for (int r = tid >> 6; r < 64; r += 8) {
            const float v = cb + w0 * xin[r * 64 + cc] + w1 * xin[(r + 1) * 64 + cc] + w2 * xin[(r + 2) * 64 + cc] + w3 * xin[(r + 3) * 64 + cc];
            xs[r * 64 + cc] = v; xsb[r * 72 + cc] = (unsigned short)f2bf(v);
        }
    }
    __syncthreads();
    {
        const int mt = wid & 3, dir = wid >> 2;
        bf16x8 af[2];
#pragma unroll
        for (int ks = 0; ks < 2; ++ks) af[ks] = *(LAS const bf16x8*)((LAS const unsigned char*)xsb + (mt * 16 + fr) * 144 + ks * 64 + fq * 16);
        const int r = mt * 16 + fr;
#pragma unroll
        for (int jt = 0; jt < 8; ++jt) {
            const int n = dir * 128 + jt * 16 + fr;
            const bf16_t* bp = BTLRU + ((size_t)(h * 256 + n)) * 64 + fq * 8;
            const bf16x8 b0 = *(const bf16x8*)bp, b1 = *(const bf16x8*)(bp + 32);
            f32x4 a = (f32x4){0.f, 0.f, 0.f, 0.f};
            a = __builtin_amdgcn_mfma_f32_16x16x32_bf16(b0, af[0], a, 0, 0, 0);
            a = __builtin_amdgcn_mfma_f32_16x16x32_bf16(b1, af[1], a, 0, 0, 0);
            LAS float* dst = (jt < 4 ? aa : bb) + (dir * 64 + r) * 64 + (jt & 3) * 16 + 4 * fq;
            *(LAS f32x4*)dst = a;
        }
    }
    __syncthreads();
#pragma unroll 2
    for (int idx = tid; idx < 8192; idx += 512) {
        const int dir = idx >> 12, j = idx & 63, r = (idx >> 6) & 63;
        const float za = aa[idx] + cAs[128 + dir * 64 + j], zx = bb[idx] + cAs[256 + dir * 64 + j];
        const float la = cAs[dir * 64 + j] * sigmoid_f(za);
        const float a = __expf(la);
        const float x2 = 2.f * la;
        const float em = -x2 * (1.f + x2 * (0.5f + x2 * (0.16666667f + x2 * (0.041666668f + x2 * (0.0083333338f + x2 * 0.0013888889f)))));
        aa[idx] = a; bb[idx] = sqrtf(em) * sigmoid_f(zx) * xs[r * 64 + j];
    }
    __syncthreads();
    if (tid < 128) {
        const int dir = tid >> 6, j = tid & 63, chn = h * 64 + j;
        if (!APPLY) {
            float H = 0.f, P = 1.f;
#pragma unroll 4
            for (int s = 0; s < 64; ++s) { const int r = dir ? 63 - s : s; const float a = aa[(dir * 64 + r) * 64 + j]; H = a * H + bb[(dir * 64 + r) * 64 + j]; P *= a; }
            float* SA = (float*)(p.ws + WS_SA); float* SB = (float*)(p.ws + WS_SB);
            const size_t o = ((size_t)(b * 68 + ch) * 2 + dir) * 512 + chn;
            SA[o] = P; SB[o] = H;
        } else {
            const float* HIN = (const float*)(p.ws + WS_HIN);
            float H = HIN[((size_t)(b * 64 + ch) * 2 + dir) * 512 + chn];
#pragma unroll 4
            for (int s = 0; s < 64; ++s) { const int r = dir ? 63 - s : s; H = aa[(dir * 64 + r) * 64 + j] * H + bb[(dir * 64 + r) * 64 + j]; bb[(dir * 64 + r) * 64 + j] = H; }
        }
    }
    __syncthreads();
    if (APPLY) {
        bf16_t* YCAT = (bf16_t*)(p.ws + WS_YCAT);
#pragma unroll 2
        for (int idx = tid; idx < 4096; idx += 512) {
            const int r = idx >> 6, j = idx & 63;
            const size_t row = (size_t)b * 4096 + r * 64 + ch;
            const float gate = bf2f(ULRU[row * 1024 + 512 + h * 64 + j]);
            const float hs = bb[r * 64 + j] + bb[(64 + r) * 64 + j];
            YCAT[row * 1024 + 512 + h * 64 + j] = (bf16_t)f2bf(hs * gelu_tanh(gate));
        }
        __syncthreads();
    }
}

constexpr int MOE_TAB_OFF = 65536;
DEV void moe_tables(const Params& p, LAS unsigned char* lds) {
    LAS int* tp = (LAS int*)(lds + MOE_TAB_OFF); LAS int* pp = tp + 72; LAS int* cn = pp + 72;
    if (threadIdx.x == 0) {
        const int* cnt = (const int*)(p.ws + WS_CNT);
        int t = 0, q = 0;
        for (int e = 0; e < 65; ++e) { const int c = e < 64 ? cnt[e] : T; cn[e] = c; tp[e] = t; pp[e] = q; const int nt = (c + 255) >> 8; t += nt; q += nt * 256; }
        tp[65] = t; pp[65] = q;
    }
    __syncthreads();
}

__global__ void __launch_bounds__(512) mk_fwd(Params p) {
    extern __shared__ __attribute__((aligned(16))) unsigned char lds_raw[];
    LAS unsigned char* lds = (LAS unsigned char*)lds_raw;
    const int tid = threadIdx.x, wid = tid >> 6, lane = tid & 63, bid = blockIdx.x, nb = gridDim.x;
    volatile LAS unsigned* MISC = (volatile LAS unsigned*)(lds + MISC_OFF);
    if (tid < 64) MISC[tid] = 0u;
    __syncthreads();
    unsigned char* ws = p.ws;
    XcdBarrier bar; bar.bar = (unsigned*)(ws + WS_CTL); bar.x = 0; bar.st = nullptr;
    const bool fused = (p.ph_hi - p.ph_lo) > 1;
    if (fused) bar = xcd_barrier_post((unsigned*)(ws + WS_CTL), MISC + 8);

    float* ADA = (float*)(ws + WS_ADA);
    float* BIASIN = (float*)(ws + WS_BIASIN);
    bf16_t* HB = (bf16_t*)(ws + WS_HB);
    bf16_t* BTIN = (bf16_t*)(ws + WS_BTIN);
    bf16_t* US5 = (bf16_t*)(ws + WS_US5);
    bf16_t* ULRU = (bf16_t*)(ws + WS_ULRU);
    float* SLOC = (float*)(ws + WS_SLOC);
    bf16_t* YS5 = (bf16_t*)(ws + WS_YS5);
    bf16_t* YCAT = (bf16_t*)(ws + WS_YCAT);
    float* Y = (float*)(ws + WS_Y);
    bf16_t* VB = (bf16_t*)(ws + WS_VB);
    int* LTOK = (int*)(ws + WS_LTOK);
    float* LWT = (float*)(ws + WS_LWT);
    bf16_t* HMID = (bf16_t*)(ws + WS_HMID);
    int* CNT = (int*)(ws + WS_CNT);

    const int lo = p.ph_lo, hi = p.ph_hi;
#define IN(k) (lo <= (k) && (k) < hi)
#define SEAM(k) do { if (IN(k) && IN((k) + 1)) xcd_barrier(bar); else __syncthreads(); } while (0)
    {
        if (IN(0)) {
            {
                LAS float* S = (LAS float*)lds; LAS float* red = S + 9216;
                for (int i = tid; i < 9216; i += 512) { const float c = i < 8192 ? p.in[1][i] : p.in[3][i - 8192]; S[i] = c * sigmoid_f(c); }
                __syncthreads();
                for (int it = bid; it < 192; it += nb) gemv9_item(S, p.in[6], 6144, it * 32, p.in[7], ADA, 6144, red);
                __syncthreads();
            }
            for (int it = bid; it < TT / 8; it += nb) {
                const int row = it * 8 + wid;
                const float* src = row < T ? p.in[0] + (size_t)row * 1024 : p.in[2] + (size_t)(row - T) * 1024;
                f32x4 v[4]; float s = 0.f;
#pragma unroll
                for (int q = 0; q < 4; ++q) { v[q] = *(const f32x4*)(src + q * 256 + lane * 4); s += (v[q][0] + v[q][1]) + (v[q][2] + v[q][3]); }
                const float mean = wave_sum(s) * (1.f / 1024.f); float qq = 0.f;
#pragma unroll
                for (int q = 0; q < 4; ++q) { const f32x4 d = v[q] - mean; qq += (d[0] * d[0] + d[1] * d[1]) + (d[2] * d[2] + d[3] * d[3]); }
                const float rstd = rsqrtf(wave_sum(qq) * (1.f / 1024.f) + LN_EPS_F);
#pragma unroll
                for (int q = 0; q < 4; ++q) {
                    const f32x4 gg = *(const f32x4*)(p.in[4] + q * 256 + lane * 4), bbv = *(const f32x4*)(p.in[5] + q * 256 + lane * 4);
                    const f32x4 o = (v[q] - mean) * rstd * gg + bbv;
                    u32x2 w; w.x = pack2(o[0], o[1]); w.y = pack2(o[2], o[3]);
                    *(u32x2*)(HB + (size_t)row * 1024 + q * 256 + lane * 4) = w;
                }
            }
            {
                LAS float* tile = (LAS float*)lds;
                __syncthreads();
                for (int it = bid; it < 12832; it += nb) {
                    if (it < 64) { tr_tile(p.in[17], 512, (it >> 3) * 64, (it & 7) * 64, (bf16_t*)(ws + WS_BTGLU), 512, 0, tile, nullptr); }
                    else if (it < 320) { const int i2 = it - 64; tr_tile(p.in[26], 1024, (i2 >> 4) * 64, (i2 & 15) * 64, (bf16_t*)(ws + WS_BTOUT), 1024, 0, tile, nullptr); }
                    else if (it < 12800) {
                        const int i2 = it - 320, e = i2 / 192, r = i2 % 192, which = r >> 6, tt = r & 63;
                        if (which < 2) {
                            const float* W = e < 64 ? (which == 0 ? p.in[31] : p.in[32]) + (size_t)e * 262144 : (which == 0 ? p.in[34] : p.in[35]);
                            tr_tile(W, 256, (tt >> 2) * 64, (tt & 3) * 64, (bf16_t*)(ws + WS_BTGU) + (size_t)e * 524288, 1024, which + 1, tile, nullptr);
                        } else {
                            const float* W = e < 64 ? p.in[33] + (size_t)e * 262144 : p.in[36];
                            tr_tile(W, 1024, (tt >> 4) * 64, (tt & 15) * 64, (bf16_t*)(ws + WS_BTDN) + (size_t)e * 262144, 256, 0, tile, nullptr);
                        }
                    } else {
                        const int i2 = it - 12800, dir = i2 >> 4, ax = (i2 >> 3) & 1, h = i2 & 7;
                        const float* W = (ax ? p.in[23] : p.in[21]) + (size_t)(dir * 8 + h) * 4096;
                        tr_tile(W, 64, 0, 0, (bf16_t*)(ws + WS_BTLRU) + (size_t)(h * 256 + dir * 128 + ax * 64) * 64, 64, 0, tile, nullptr);
                    }
                }
            }
            __syncthreads();
            for (int g = bid; g < 32; g += nb) s5_gen(p, lds, g);
        }
        SEAM(0);
        if (IN(1)) {
            {
                LAS float* tile = (LAS float*)lds;
                for (int it = bid; it < 3456; it += nb) {
                    const int bidx = it / 384, r = it % 384, kt = r / 24, nt = r % 24;
                    tr_tile(p.in[8], NWIN, kt * 64, nt * 64, BTIN + (size_t)bidx * NWIN * 1024, 1024, 0, tile, ADA + bidx * 6144 + 1024);
                }
            }
            {
                __syncthreads();
                LAS float* S = (LAS float*)lds; LAS float* red = S + 9216;
                for (int i = tid; i < 9216; i += 512) S[i] = ADA[(i >> 10) * 6144 + (i & 1023)];
                __syncthreads();
                for (int it = bid; it < 48; it += nb) gemv9_item(S, p.in[8], NWIN, it * 32, nullptr, BIASIN, NWIN, red);
            }
        }
        SEAM(1);
        if (IN(2)) {
            for (int u = bid; u < 136 * 12; u += nb) {
                const int rt = u / 12, ct = u % 12, bidx = rt < 128 ? (rt >> 4) : 8;
                const bf16_t* A = HB + (size_t)rt * 256 * 1024;
                const float* bias = BIASIN + bidx * NWIN + ct * 128;
                gemm_unit(lds, [&](int r) { return A + (size_t)r * 1024; }, BTIN + ((size_t)bidx * NWIN + ct * 128) * 1024, 1024,
                    [&](f32x4 (&acc)[4][4], int r0, int c0) {
#pragma unroll
                        for (int i = 0; i < 4; ++i) {
                            const int row = rt * 256 + r0 + 16 * i;
                            int m, s;
                            if (row < T) { const int bq = row >> 12, t = row & 4095; m = bq * 128 + (t >> 5); s = t & 31; }
                            else { const int q = row - T, bq = q >> 8, j = q & 255; m = M5LAT + bq * 8 + (j >> 5); s = j & 31; }
#pragma unroll
                            for (int j4 = 0; j4 < 4; ++j4) {
                                const int cl = c0 + 16 * j4, col = ct * 128 + cl;
                                const f32x4 v = acc[i][j4] + *(const f32x4*)(bias + cl);
                                u32x2 w; w.x = pack2(v[0], v[1]); w.y = pack2(v[2], v[3]);
                                if (col < 512) { const int g = col >> 4, cc = col & 15; *(u32x2*)(US5 + ((size_t)(g * M5PAD + m)) * KT5 + s * 16 + cc) = w; }
                                else *(u32x2*)(ULRU + (size_t)row * 1024 + (col - 512)) = w;
                            }
                        }
                    });
            }
        }
        SEAM(2);
        if (IN(3)) {
            const bf16_t* ES5 = (const bf16_t*)(ws + WS_ES5);
            for (int u = bid; u < 32 * 10; u += nb) {
                const int g = u / 10, r2 = u % 10, rt = r2 >> 1, ct = r2 & 1;
                gemm_unit(lds, [&](int r) { int m = rt * 256 + r; m = m < M5 ? m : M5 - 1; return US5 + ((size_t)(g * M5PAD + m)) * KT5; },
                    ES5 + ((size_t)g * 256 + ct * 128) * 512, 512,
                    [&](f32x4 (&acc)[4][4], int r0, int c0) {
#pragma unroll
                        for (int i = 0; i < 4; ++i) {
                            const int m = rt * 256 + r0 + 16 * i;
                            if (m < M5) {
#pragma unroll
                                for (int j4 = 0; j4 < 4; ++j4) *(f32x4*)(SLOC + ((size_t)(g * M5 + m)) * 256 + ct * 128 + c0 + 16 * j4) = acc[i][j4];
                            }
                        }
                    });
            }
            __syncthreads();
            for (int it = bid; it < NBATCH * 68 * 8; it += nb) { const int h = it & 7, q = it >> 3, ch = q % 68, b = q / 68; lru_item<false>(p, lds, b, ch, h); }
        }
        SEAM(3);
        if (IN(4)) {
            const float* ALC = (const float*)(ws + WS_ALC);
            for (int i = bid * 512 + tid; i < 32768; i += nb * 512) {
                const int pp = i & 63, dir = (i >> 6) & 1, g = (i >> 7) & 31, b = i >> 12;
                const float ar = ALC[((dir * 32 + g) * 64 + pp) * 2], ai = ALC[((dir * 32 + g) * 64 + pp) * 2 + 1];
                float xr = 0.f, xi = 0.f;
                const float* Sg = SLOC + (size_t)g * M5 * 256 + dir * 128 + pp;
                for (int s = 0; s < NCC; ++s) {
                    const int j = dir ? NCC - 1 - s : s, m = M5LAT + b * NCC + j;
                    const float sr = Sg[(size_t)m * 256], si = Sg[(size_t)m * 256 + 64];
                    const float nr = ar * xr - ai * xi + sr, ni = ar * xi + ai * xr + si; xr = nr; xi = ni;
                }
                for (int s = 0; s < NCH; ++s) {
                    const int k = dir ? NCH - 1 - s : s, m = b * NCH + k;
                    bf16_t* dst = US5 + ((size_t)(g * M5PAD + m)) * KT5 + 512 + dir * 128 + pp;
                    dst[0] = (bf16_t)f2bf(xr); dst[64] = (bf16_t)f2bf(xi);
                    const float sr = Sg[(size_t)m * 256], si = Sg[(size_t)m * 256 + 64];
                    const float nr = ar * xr - ai * xi + sr, ni = ar * xi + ai * xr + si; xr = nr; xi = ni;
                }
            }
            const float* SA = (const float*)(ws + WS_SA); const float* SB = (const float*)(ws + WS_SB); float* HIN = (float*)(ws + WS_HIN);
            for (int i = bid * 512 + tid; i < 8192; i += nb * 512) {
                const int chn = i & 511, dir = (i >> 9) & 1, b = i >> 10;
                float H = 0.f;
                for (int s = 0; s < 4; ++s) { const int c = 64 + (dir ? 3 - s : s); const size_t o = ((size_t)(b * 68 + c) * 2 + dir) * 512 + chn; H = SA[o] * H + SB[o]; }
                for (int s = 0; s < 64; ++s) {
                    const int c = dir ? 63 - s : s; const size_t o = ((size_t)(b * 68 + c) * 2 + dir) * 512 + chn;
                    HIN[((size_t)(b * 64 + c) * 2 + dir) * 512 + chn] = H;
                    H = SA[o] * H + SB[o];
                }
            }
        }
        SEAM(4);
        if (IN(5)) {
            const bf16_t* BS5 = (const bf16_t*)(ws + WS_BS5);
            for (int u = bid; u < 32 * 16; u += nb) {
                const int g = u >> 4, rt = (u >> 2) & 3, ct = u & 3;
                gemm_unit(lds, [&](int r) { return US5 + ((size_t)(g * M5PAD + rt * 256 + r)) * KT5; }, BS5 + ((size_t)g * 512 + ct * 128) * KT5, KT5,
                    [&](f32x4 (&acc)[4][4], int r0, int c0) {
#pragma unroll
                        for (int i = 0; i < 4; ++i) {
                            const int m = rt * 256 + r0 + 16 * i, bq = m >> 7, chunk = m & 127;
#pragma unroll
                            for (int j4 = 0; j4 < 4; ++j4) {
                                const int n = ct * 128 + c0 + 16 * j4, t = n >> 4, c = n & 15;
                                const size_t tok = (size_t)bq * 4096 + chunk * 32 + t;
                                const f32x4 v = acc[i][j4];
                                u32x2 w; w.x = pack2(gelu_tanh(v[0]), gelu_tanh(v[1])); w.y = pack2(gelu_tanh(v[2]), gelu_tanh(v[3]));
                                *(u32x2*)(YS5 + tok * 512 + g * 16 + c) = w;
                            }
                        }
                    });
            }
            __syncthreads();
            for (int it = bid; it < NBATCH * 64 * 8; it += nb) { const int h = it & 7, q = it >> 3, ch = q & 63, b = q >> 6; lru_item<true>(p, lds, b, ch, h); }
        }
        SEAM(5);
        if (IN(6)) {
            const bf16_t* BTGLU = (const bf16_t*)(ws + WS_BTGLU); const float* b_glu = p.in[18];
            for (int u = bid; u < 128 * 4; u += nb) {
                const int rt = u >> 2, ct = u & 3;
                const bf16_t* A = YS5 + (size_t)rt * 256 * 512;
                gemm_unit(lds, [&](int r) { return A + (size_t)r * 512; }, BTGLU + (size_t)ct * 128 * 512, 512,
                    [&](f32x4 (&acc)[4][4], int r0, int c0) {
#pragma unroll
                        for (int i = 0; i < 4; ++i) {
                            const size_t row = (size_t)rt * 256 + r0 + 16 * i;
#pragma unroll
                            for (int j4 = 0; j4 < 4; ++j4) {
                                const int col = ct * 128 + c0 + 16 * j4;
                                const f32x4 z = acc[i][j4] + *(const f32x4*)(b_glu + col);
                                const u32x2 yy = *(const u32x2*)(YS5 + row * 512 + col);
                                const float y0 = __uint_as_float(yy.x << 16), y1 = __uint_as_float(yy.x & 0xffff0000u), y2 = __uint_as_float(yy.y << 16), y3 = __uint_as_float(yy.y & 0xffff0000u);
                                u32x2 w; w.x = pack2(y0 * sigmoid_f(z[0]), y1 * sigmoid_f(z[1])); w.y = pack2(y2 * sigmoid_f(z[2]), y3 * sigmoid_f(z[3]));
                                *(u32x2*)(YCAT + row * 1024 + col) = w;
                            }
                        }
                    });
            }
        }
        SEAM(6);
        if (IN(7)) {
            const bf16_t* BTOUT = (const bf16_t*)(ws + WS_BTOUT);
            for (int u = bid; u < 128 * 8; u += nb) {
                const int rt = u >> 3, ct = u & 7;
                const bf16_t* A = YCAT + (size_t)rt * 256 * 1024;
                gemm_unit(lds, [&](int r) { return A + (size_t)r * 1024; }, BTOUT + (size_t)ct * 128 * 1024, 1024,
                    [&](f32x4 (&acc)[4][4], int r0, int c0) {
#pragma unroll
                        for (int i = 0; i < 4; ++i) {
                            const size_t row = (size_t)rt * 256 + r0 + 16 * i;
#pragma unroll
                            for (int j4 = 0; j4 < 4; ++j4) *(f32x4*)(Y + row * 1024 + ct * 128 + c0 + 16 * j4) = acc[i][j4];
                        }
                    });
            }
        }
        SEAM(7);
        if (IN(8)) {
            LAS float* Vs = (LAS float*)lds;
            LAS float* RWs = (LAS float*)(lds + 131584);
            LAS float* SEL = RWs; LAS float* SCO = RWs + 2048;
            LAS int* lcnt = (LAS int*)(lds + 147968); LAS int* gbase = lcnt + 64;
            const float* router_w = p.in[29]; const float* router_bias = p.in[30];
            for (int it = bid; it < T / 32; it += nb) {
                const int t0 = it * 32;
                if (tid < 64) lcnt[tid] = 0;
#pragma unroll 1
                for (int i = 0; i < 4; ++i) {
                    const int tl = wid * 4 + i; const size_t tok = (size_t)t0 + tl; const int b = (int)(tok >> 12);
                    const float* ada = ADA + b * 6144;
                    f32x4 z[4]; float s = 0.f;
#pragma unroll
                    for (int q = 0; q < 4; ++q) {
                        const int col = q * 256 + lane * 4;
                        const u32x2 hh = *(const u32x2*)(HB + tok * 1024 + col);
                        const f32x4 yv = *(const f32x4*)(Y + tok * 1024 + col);
                        const f32x4 g1 = *(const f32x4*)(ada + 2048 + col);
                        f32x4 hv; hv[0] = __uint_as_float(hh.x << 16); hv[1] = __uint_as_float(hh.x & 0xffff0000u); hv[2] = __uint_as_float(hh.y << 16); hv[3] = __uint_as_float(hh.y & 0xffff0000u);
                        z[q] = hv * ALPHA_F + g1 * yv;
                        s += (z[q][0] + z[q][1]) + (z[q][2] + z[q][3]);
                    }
                    const float mean = wave_sum(s) * (1.f / 1024.f); float qq = 0.f;
#pragma unroll
                    for (int q = 0; q < 4; ++q) { const f32x4 d = z[q] - mean; qq += (d[0] * d[0] + d[1] * d[1]) + (d[2] * d[2] + d[3] * d[3]); }
                    const float rstd = rsqrtf(wave_sum(qq) * (1.f / 1024.f) + LN_EPS_F);
#pragma unroll
                    for (int q = 0; q < 4; ++q) {
                        const int col = q * 256 + lane * 4;
                        const f32x4 gg = *(const f32x4*)(p.in[27] + col), bbv = *(const f32x4*)(p.in[28] + col);
                        const f32x4 h1 = (z[q] - mean) * rstd * gg + bbv;
                        *(f32x4*)(Y + tok * 1024 + col) = h1;
                        const f32x4 sc2 = *(const f32x4*)(ada + 4096 + col), sh2 = *(const f32x4*)(ada + 3072 + col);
                        const f32x4 v = h1 * (sc2 + 1.f) + sh2;
                        u32x2 w; w.x = pack2(v[0], v[1]); w.y = pack2(v[2], v[3]);
                        *(u32x2*)(VB + tok * 1024 + col) = w;
                        *(LAS f32x4*)(Vs + tl * 1028 + col) = v;
                        *(f32x4*)(p.out + tok * 1024 + col) = (f32x4){0.f, 0.f, 0.f, 0.f};
                    }
                }
                __syncthreads();
                const int tt = tid >> 4, q16 = tid & 15;
                f32x4 lg = (f32x4){0.f, 0.f, 0.f, 0.f};
                for (int k0 = 0; k0 < 1024; k0 += 64) {
#pragma unroll
                    for (int i = 0; i < 2; ++i) { const int idx = tid + i * 512, kk = idx >> 4, e4 = (idx & 15) * 4; *(LAS f32x4*)(RWs + kk * 64 + e4) = *(const f32x4*)(router_w + (size_t)(k0 + kk) * 64 + e4); }
                    __syncthreads();
#pragma unroll 2
                    for (int kk = 0; kk < 64; kk += 4) {
                        const f32x4 v = *(LAS const f32x4*)(Vs + tt * 1028 + k0 + kk);
#pragma unroll
                        for (int u = 0; u < 4; ++u) { const f32x4 w = *(LAS const f32x4*)(RWs + (kk + u) * 64 + q16 * 4); lg += w * v[u]; }
                    }
                    __syncthreads();
                }
#pragma unroll
                for (int i = 0; i < 4; ++i) { const int e = q16 * 4 + i; const float sc = sigmoid_f(lg[i]); SCO[tt * 64 + e] = sc; SEL[tt * 64 + e] = sc + router_bias[e]; }
                __syncthreads();
                float gs[8];
#pragma unroll
                for (int gi = 0; gi < 8; ++gi) {
                    float m1 = -INFINITY, m2 = -INFINITY;
#pragma unroll
                    for (int j = 0; j < 8; ++j) { const float v = SEL[tt * 64 + gi * 8 + j]; if (v > m1) { m2 = m1; m1 = v; } else if (v > m2) m2 = v; }
                    gs[gi] = m1 + m2;
                }
                unsigned gmask = 0u;
#pragma unroll
                for (int gi = 0; gi < 8; ++gi) {
                    int rank = 0;
#pragma unroll
                    for (int hh = 0; hh < 8; ++hh) rank += (gs[hh] > gs[gi] || (gs[hh] == gs[gi] && hh < gi)) ? 1 : 0;
                    if (rank < 4) gmask |= 1u << gi;
                }
                bool chosen[4]; float scv[4]; float mysum = 0.f;
#pragma unroll
                for (int i = 0; i < 4; ++i) {
                    const int e = q16 * 4 + i; chosen[i] = false; scv[i] = 0.f;
                    if ((gmask >> (e >> 3)) & 1u) {
                        const float v = SEL[tt * 64 + e]; int rank = 0;
#pragma unroll 2
                        for (int j = 0; j < 64; ++j) { if ((gmask >> (j >> 3)) & 1u) { const float vj = SEL[tt * 64 + j]; rank += (vj > v || (vj == v && j < e)) ? 1 : 0; } }
                        if (rank < 8) { chosen[i] = true; scv[i] = SCO[tt * 64 + e]; mysum += scv[i]; }
                    }
                }
                float wsum = mysum;
#pragma unroll
                for (int o = 1; o < 16; o <<= 1) wsum += __shfl_xor(wsum, o);
                int lrank[4];
#pragma unroll
                for (int i = 0; i < 4; ++i) { lrank[i] = 0; if (chosen[i]) lrank[i] = __hip_atomic_fetch_add(lcnt + q16 * 4 + i, 1, __ATOMIC_RELAXED, __HIP_MEMORY_SCOPE_WORKGROUP); }
                __syncthreads();
                if (tid < 64) gbase[tid] = atomicAdd(CNT + tid, lcnt[tid]);
                __syncthreads();
#pragma unroll
                for (int i = 0; i < 4; ++i) if (chosen[i]) {
                    const int e = q16 * 4 + i; const size_t pos = (size_t)e * T + gbase[e] + lrank[i];
                    LTOK[pos] = t0 + tt; LWT[pos] = scv[i] / wsum * 2.5f;
                }
                __syncthreads();
            }
        }
        SEAM(8);
        if (IN(9)) {
            moe_tables(p, lds);
            LAS const int* tp = (LAS const int*)(lds + MOE_TAB_OFF); LAS const int* pp = tp + 72; LAS const int* cn = pp + 72;
            const bf16_t* BTGU = (const bf16_t*)(ws + WS_BTGU);
            const int nunits = tp[65] * 4;
            for (int u = bid; u < nunits; u += nb) {
                const int rt = u >> 2, ct = u & 3;
                int e = 0; while (tp[e + 1] <= rt) ++e;
                const int r0t = (rt - tp[e]) * 256, ce = cn[e]; const size_t prow = (size_t)pp[e] + r0t;
                gemm_unit(lds, [&](int r) { int idx = r0t + r; idx = idx < ce ? idx : ce - 1; const int tok = e < 64 ? LTOK[(size_t)e * T + idx] : idx; return VB + (size_t)tok * 1024; },
                    BTGU + ((size_t)e * 512 + ct * 128) * 1024, 1024,
                    [&](f32x4 (&acc)[4][4], int r0, int c0) {
                        const int wc2 = c0 >> 6, fq4 = c0 & 63;
#pragma unroll
                        for (int i = 0; i < 4; ++i) {
                            const size_t row = prow + r0 + 16 * i;
#pragma unroll
                            for (int jp = 0; jp < 2; ++jp) {
                                const f32x4 gt = acc[i][2 * jp], up = acc[i][2 * jp + 1];
                                const int unit = (ct * 4 + wc2 * 2 + jp) * 16 + fq4;
                                u32x2 w; w.x = pack2(gt[0] * sigmoid_f(gt[0]) * up[0], gt[1] * sigmoid_f(gt[1]) * up[1]); w.y = pack2(gt[2] * sigmoid_f(gt[2]) * up[2], gt[3] * sigmoid_f(gt[3]) * up[3]);
                                *(u32x2*)(HMID + row * 256 + unit) = w;
                            }
                        }
                    });
            }
        }
        SEAM(9);
        if (IN(10)) {
            moe_tables(p, lds);
            LAS const int* tp = (LAS const int*)(lds + MOE_TAB_OFF); LAS const int* pp = tp + 72; LAS const int* cn = pp + 72;
            const bf16_t* BTDN = (const bf16_t*)(ws + WS_BTDN);
            const int nunits = tp[65] * 8;
            for (int u = bid; u < nunits; u += nb) {
                const int rt = u >> 3, ct = u & 7;
                int e = 0; while (tp[e + 1] <= rt) ++e;
                const int r0t = (rt - tp[e]) * 256, ce = cn[e]; const size_t prow = (size_t)pp[e] + r0t;
                gemm_unit(lds, [&](int r) { return HMID + (prow + r) * 256; }, BTDN + ((size_t)e * 1024 + ct * 128) * 256, 256,
                    [&](f32x4 (&acc)[4][4], int r0, int c0) {
#pragma unroll
                        for (int i = 0; i < 4; ++i) {
                            const int idx = r0t + r0 + 16 * i;
                            if (idx < ce) {
                                const int tok = e < 64 ? LTOK[(size_t)e * T + idx] : idx;
                                const float wt = e < 64 ? LWT[(size_t)e * T + idx] : 1.f;
                                float* dst = p.out + (size_t)tok * 1024 + ct * 128 + c0;
#pragma unroll
                                for (int j4 = 0; j4 < 4; ++j4) {
#pragma unroll
                                    for (int rg = 0; rg < 4; ++rg) atomicAdd(dst + 16 * j4 + rg, wt * acc[i][j4][rg]);
                                }
                            }
                        }
                    });
            }
        }
        SEAM(10);
        if (IN(11)) {
            for (int it = bid; it < T / 8; it += nb) {
                const size_t tok = (size_t)it * 8 + wid; const int b = (int)(tok >> 12);
                const float* ada = ADA + b * 6144;
                f32x4 z[4]; float s = 0.f;
#pragma unroll
                for (int q = 0; q < 4; ++q) {
                    const int col = q * 256 + lane * 4;
                    const f32x4 h1 = *(const f32x4*)(Y + tok * 1024 + col), f = *(const f32x4*)(p.out + tok * 1024 + col), g2 = *(const f32x4*)(ada + 5120 + col);
                    z[q] = h1 * ALPHA_F + g2 * f;
                    s += (z[q][0] + z[q][1]) + (z[q][2] + z[q][3]);
                }
                const float mean = wave_sum(s) * (1.f / 1024.f); float qq = 0.f;
#pragma unroll
                for (int q = 0; q < 4; ++q) { const f32x4 d = z[q] - mean; qq += (d[0] * d[0] + d[1] * d[1]) + (d[2] * d[2] + d[3] * d[3]); }
                const float rstd = rsqrtf(wave_sum(qq) * (1.f / 1024.f) + LN_EPS_F);
#pragma unroll
                for (int q = 0; q < 4; ++q) {
                    const int col = q * 256 + lane * 4;
                    const f32x4 gg = *(const f32x4*)(p.in[37] + col), bbv = *(const f32x4*)(p.in[38] + col);
                    *(f32x4*)(p.out + tok * 1024 + col) = (z[q] - mean) * rstd * gg + bbv;
                }
            }
        }
    }
}

extern "C" void kernel_launch(void* const* d_in, const int* in_sizes, int n_in, void* d_out, int out_size, void* d_ws, size_t ws_size, hipStream_t stream) {
    static int grid = 0;
    if (grid == 0) {
        if (n_in != 39 || out_size != T * D || ws_size < WS_END) { fprintf(stderr, "kernel_launch: unexpected problem (n_in %d, out %d, ws %zu); nothing launched\n", n_in, out_size, ws_size); grid = -1; return; }
        int dev = 0, cus = 0;
        if (hipGetDevice(&dev) != hipSuccess || hipDeviceGetAttribute(&cus, hipDeviceAttributeMultiprocessorCount, dev) != hipSuccess) { grid = -1; return; }
        if (hipFuncSetAttribute((const void*)mk_fwd, hipFuncAttributeMaxDynamicSharedMemorySize, LDS_BYTES) != hipSuccess) { fprintf(stderr, "kernel_launch: hipFuncSetAttribute failed\n"); grid = -1; return; }
        grid = cus > 0 ? cus : 256;
    }
    if (grid < 0) return;
    (void)in_sizes;
    if (hipMemsetAsync((char*)d_ws + WS_CTL, 0, CTL_ZERO_BYTES, stream) != hipSuccess) return;
    Params p{};
    for (int i = 0; i < 39; ++i) p.in[i] = (const float*)d_in[i];
    p.out = (float*)d_out; p.ws = (unsigned char*)d_ws;
#if MK_N_LAUNCHES == 1
    p.ph_lo = 0; p.ph_hi = NPHASE;
    hipLaunchKernelGGL(mk_fwd, dim3(grid), dim3(512), LDS_BYTES, stream, p);
#else
    for (int ph = 0; ph < NPHASE; ++ph) {
        p.ph_lo = ph; p.ph_hi = ph + 1;
        hipLaunchKernelGGL(mk_fwd, dim3(grid), dim3(512), LDS_BYTES, stream, p);
    }
#endif
}
```

```cpp
#include <hip/hip_runtime.h>
#include <cstdio>
#include <cstdint>

#ifndef MK_N_LAUNCHES
#define MK_N_LAUNCHES 1
#endif

#define DEV __device__ __forceinline__
#define LAS __attribute__((address_space(3)))
typedef unsigned short bf16_t;
typedef short bf16x8 __attribute__((ext_vector_type(8)));
typedef float f32x4 __attribute__((ext_vector_type(4)));
typedef unsigned u32x2 __attribute__((ext_vector_type(2)));
typedef unsigned u32x4 __attribute__((ext_vector_type(4)));

constexpr int D = 1024, NBATCH = 8, SEQ = 4096, T = NBATCH * SEQ, CTXL = 256, TC = NBATCH * CTXL, TT = T + TC;
constexpr int NWIN = 1536;
constexpr int LC = 32, KT5 = 768, NCH = SEQ / LC  , NCC = CTXL / LC  ;
constexpr int M5LAT = NBATCH * NCH  , M5 = M5LAT + NBATCH * NCC  , M5PAD = 1280;
constexpr int NE = 64;
constexpr int NPHASE = 14;
constexpr int HALF_T = T / 2;
constexpr float ALPHA_F = 1.189207115002721f, LN_EPS_F = 1e-5f;

constexpr size_t MiB = 1u << 20;
constexpr size_t WS_CTL = 0, CTL_ZERO_BYTES = 65536;
constexpr size_t WS_CNT = 32768;
constexpr size_t WS_ADA = 65536;
constexpr size_t WS_BIASIN = 512 * 1024;
constexpr size_t WS_ALC = 640 * 1024;
constexpr size_t WS_SA = 1 * MiB, WS_SB = 4 * MiB, WS_HIN = 7 * MiB;
constexpr size_t WS_BTGLU = 10 * MiB;
constexpr size_t WS_BTOUT = 10 * MiB + 512 * 1024;
constexpr size_t WS_BTLRU = 12 * MiB + 512 * 1024;
constexpr size_t WS_BS5 = 13 * MiB;
constexpr size_t WS_ES5 = 37 * MiB;
constexpr size_t WS_BTGU = 45 * MiB;
constexpr size_t WS_BTDN = 110 * MiB;
constexpr size_t WS_HB = 143 * MiB;
constexpr size_t WS_BTIN = 211 * MiB;
constexpr size_t WS_US5 = 238 * MiB;
constexpr size_t WS_ULRU = 298 * MiB;
constexpr size_t WS_SLOC = 366 * MiB;
constexpr size_t WS_YS5 = 400 * MiB;
constexpr size_t WS_YCAT = 448 * MiB;
constexpr size_t WS_Y = 295 * MiB;
constexpr size_t WS_LTOK = 10 * MiB;
constexpr size_t WS_LWT = 18 * MiB;
constexpr size_t WS_PAIR = 26 * MiB;
constexpr size_t WS_HMID = 143 * MiB;
constexpr size_t WS_SLAB = 216 * MiB;
constexpr size_t WS_END = 512 * MiB;

constexpr int LDS_BYTES = 155648;
constexpr int MISC_OFF = LDS_BYTES - 256;

DEV float bf2f(bf16_t h) { return __uint_as_float(((unsigned)h) << 16); }
DEV unsigned f2bf(float f) { unsigned u = __float_as_uint(f); return (u + 0x7fffu + ((u >> 16) & 1u)) >> 16; }
DEV unsigned pack2(float a, float b) { return f2bf(a) | (f2bf(b) << 16); }
DEV float sigmoid_f(float x) { return 1.f / (1.f + __expf(-x)); }
DEV float gelu_tanh(float x) {
    const float z = 0.7978845608028654f * (x + 0.044715f * x * x * x);
    const float e = __expf(2.f * z);
    const float t = 1.f - 2.f / (e + 1.f);
    return 0.5f * x * (1.f + t);
}
DEV float wave_sum(float v) {
#pragma unroll
    for (int o = 1; o < 64; o <<= 1) v += __shfl_xor(v, o);
    return v;
}

struct Params { const float* in[39]; float* out; unsigned char* ws; int ph_lo, ph_hi; };

#define XB_TMO      128
#define XB_XCNT(j)  (256  + 64 * (j))
#define XB_XSUB(j)  (1280 + 64 * (j))
#define XB_XGEN(j)  (2304 + 64 * (j))
#define XB_TOP      3328
#define XB_TOPGEN   3392
#define XCD_BAR_WORDS 3456
#define XB_SPIN_CAP (1u << 20)
DEV unsigned xb_ld(unsigned* p)              { return __hip_atomic_load(p, __ATOMIC_RELAXED, __HIP_MEMORY_SCOPE_AGENT); }
DEV unsigned xb_add(unsigned* p, unsigned v) { return __hip_atomic_fetch_add(p, v, __ATOMIC_RELAXED, __HIP_MEMORY_SCOPE_AGENT); }
DEV unsigned xb_xcc_id() { return (unsigned)__builtin_amdgcn_s_getreg((3 << 11) | 20) & 0xFu; }
#define XB_SPIN(cond, bar) do { unsigned _sp = 0; while (cond) { __builtin_amdgcn_s_sleep(1); \
    if ((++_sp & 255u) == 0u) { if (xb_ld(&(bar)[XB_TMO])) break; if (_sp > XB_SPIN_CAP) { atomicAdd(&(bar)[XB_TMO], 1u); break; } } } } while (0)
struct XcdBarrier { unsigned* bar; unsigned x; volatile LAS unsigned* st; };
DEV XcdBarrier xcd_barrier_post(unsigned* bar, volatile LAS unsigned* st) {
    XcdBarrier b; b.bar = bar; b.x = xb_xcc_id(); b.st = st;
    if (threadIdx.x == 0) (void)xb_add(&bar[XB_XCNT(b.x)], 1u);
    return b;
}
DEV void xcd_barrier_complete(unsigned* bar, unsigned x, unsigned& nloc, unsigned& nx) {
    const unsigned G = gridDim.x * gridDim.y * gridDim.z;
    unsigned sum, cnt, mine, sp = 0u;
    for (;;) {
        sum = 0u; cnt = 0u; mine = 0u;
#pragma unroll
        for (unsigned j = 0; j < 16; ++j) { const unsigned c = xb_ld(&bar[XB_XCNT(j)]); sum += c; cnt += (c > 0u) ? 1u : 0u; mine = (j == x) ? c : mine; }
        if (sum == G) break;
        __builtin_amdgcn_s_sleep(1);
        if ((++sp & 255u) == 0u) { if (xb_ld(&bar[XB_TMO])) break; if (sp > XB_SPIN_CAP) { atomicAdd(&bar[XB_TMO], 1u); break; } }
    }
    nloc = mine > 0u ? mine : 1u; nx = cnt > 0u ? cnt : 1u;
}
DEV void xcd_barrier(const XcdBarrier& b) {
    asm volatile("s_waitcnt vmcnt(0)" ::: "memory");
    __syncthreads();
    if (threadIdx.x == 0) {
        unsigned* bar = b.bar;
        __builtin_amdgcn_s_waitcnt(0);
        unsigned nloc = b.st[0], nx = b.st[1];
        if (nloc == 0u) { xcd_barrier_complete(bar, b.x, nloc, nx); b.st[0] = nloc; b.st[1] = nx; }
        const unsigned old = xb_add(&bar[XB_XSUB(b.x)], 1u);
        const unsigned gen = old / nloc;
        if (old + 1u == (gen + 1u) * nloc) {
            __builtin_amdgcn_fence(__ATOMIC_RELEASE, "agent");
            asm volatile("s_waitcnt vmcnt(0)" ::: "memory");
            const unsigned og = xb_add(&bar[XB_TOP], 1u);
            const unsigned tg = og / nx;
            if (og + 1u == (tg + 1u) * nx) xb_add(&bar[XB_TOPGEN], 1u);
            else XB_SPIN(xb_ld(&bar[XB_TOPGEN]) == tg, bar);
            __builtin_amdgcn_fence(__ATOMIC_ACQUIRE, "agent");
            xb_add(&bar[XB_XGEN(b.x)], 1u);
            asm volatile("s_waitcnt vmcnt(0)" ::: "memory");
        } else {
            XB_SPIN(xb_ld(&bar[XB_XGEN(b.x)]) == gen, bar);
            __builtin_amdgcn_fence(__ATOMIC_ACQUIRE, "agent");
            asm volatile("s_waitcnt vmcnt(0)" ::: "memory");
        }
    }
    __syncthreads();
}

constexpr int GEMM_LDS = 61440;
template <class ARow, class Epi>
DEV void gemm_unit(LAS unsigned char* lds, const ARow& arow, const bf16_t* __restrict__ Bt, int K, const Epi& epi) {
    const int tid = threadIdx.x, wid = tid >> 6, lane = tid & 63, wr = wid >> 1, wc = wid & 1, fr = lane & 15, fq = lane >> 4;
    LAS unsigned char* As = lds;
    LAS unsigned char* Bs = lds + 40960;
    const u32x4* pa0 = (const u32x4*)arow(tid >> 2) + (tid & 3);
    const u32x4* pa1 = (const u32x4*)arow(128 + (tid >> 2)) + (tid & 3);
    const u32x4* pb = (const u32x4*)(Bt + (size_t)(tid >> 2) * K) + (tid & 3);
    const int sa0 = (tid >> 2) * 80 + (tid & 3) * 16, sa1 = sa0 + 128 * 80;
    f32x4 acc[4][4];
#pragma unroll
    for (int i = 0; i < 4; ++i)
#pragma unroll
        for (int j = 0; j < 4; ++j) acc[i][j] = (f32x4){0.f, 0.f, 0.f, 0.f};
    const int nk = K >> 5;
    u32x4 ra0 = pa0[0], ra1 = pa1[0], rb = pb[0];
    *(LAS u32x4*)(As + sa0) = ra0; *(LAS u32x4*)(As + sa1) = ra1; *(LAS u32x4*)(Bs + sa0) = rb;
    __syncthreads();
    for (int kt = 0; kt < nk; ++kt) {
        const int cur = kt & 1;
        if (kt + 1 < nk) { ra0 = pa0[(kt + 1) * 4]; ra1 = pa1[(kt + 1) * 4]; rb = pb[(kt + 1) * 4]; }
        LAS const unsigned char* Ac = As + cur * 20480 + (wr * 64 + fr) * 80 + fq * 16;
        LAS const unsigned char* Bc = Bs + cur * 10240 + (wc * 64 + fr) * 80 + fq * 16;
        bf16x8 af[4], bfv[4];
#pragma unroll
        for (int i = 0; i < 4; ++i) af[i] = *(LAS const bf16x8*)(Ac + i * 1280);
#pragma unroll
        for (int j = 0; j < 4; ++j) bfv[j] = *(LAS const bf16x8*)(Bc + j * 1280);
#pragma unroll
        for (int i = 0; i < 4; ++i)
#pragma unroll
            for (int j = 0; j < 4; ++j) acc[i][j] = __builtin_amdgcn_mfma_f32_16x16x32_bf16(bfv[j], af[i], acc[i][j], 0, 0, 0);
        if (kt + 1 < nk) {
            const int nx = cur ^ 1;
            *(LAS u32x4*)(As + nx * 20480 + sa0) = ra0; *(LAS u32x4*)(As + nx * 20480 + sa1) = ra1; *(LAS u32x4*)(Bs + nx * 10240 + sa0) = rb;
        }
        __syncthreads();
    }
    epi(acc, wr * 64 + fr, wc * 64 + 4 * fq);
}

namespace gp {
constexpr int BK = 64, HALF = 128, HTB = HALF * BK * 2, STAGE_BYTES = 8 * HTB;
DEV int lds_byte(int r, int c) { const int st = (r >> 4) * 2 + (c >> 5), rr = r & 15, cc = c & 31, ob = rr * 64 + cc * 2; return st * 1024 + (ob ^ (((ob >> 9) & 1) << 5)); }
DEV void stage_rc(int b, int& R, int& C) { const int st = b / 1024, sb = b % 1024, swz = sb ^ (((sb >> 9) & 1) << 5); R = (st >> 1) * 16 + swz / 64; C = (st & 1) * 32 + (swz % 64) / 2; }
DEV int perm32(int rho) { const int n = rho >> 4, i = rho & 15; return 8 * (i >> 2) + 4 * n + (i & 3); }
struct UAddr { const char* a; const char* b; unsigned ao00, ao01, ao10, ao11; };
template <class Epi, class Sched>
DEV void gemm_phase(LAS unsigned char* lds, const int K, const Sched& S, const Epi& E) {
    typedef typename Sched::Unit Unit;
    const int tid = threadIdx.x, wid = __builtin_amdgcn_readfirstlane(tid >> 6), lane = tid & 63, wr = wid >> 2, wc = wid & 3, fr = lane & 15, fq = lane >> 4;
    const int nt = K / BK;
    int R0, C0, R1, C1; stage_rc(tid * 16, R0, C0); stage_rc(tid * 16 + 8192, R1, C1);
    const int Rb0 = Epi::PERM ? ((R0 & ~31) + perm32(R0 & 31)) : R0, Rb1 = Epi::PERM ? ((R1 & ~31) + perm32(R1 & 31)) : R1;
    const unsigned vb0 = (unsigned)(Rb0 * K + C0) * 2u, vb1 = (unsigned)(Rb1 * K + C1) * 2u;
    const size_t kstep = (size_t)(BK * 2);
    const size_t hstepB = (size_t)HALF * K * 2;
    const int lda_ = S.lda();
    const unsigned va0 = (unsigned)(R0 * lda_ + C0) * 2u, va1 = (unsigned)(R1 * lda_ + C1) * 2u;
    const size_t hstepA = (size_t)HALF * lda_ * 2;
    const unsigned ldsw = (unsigned)wid * 1024u;
    const int aoff = lds_byte(wr * 64 + fr, fq * 8), boff = lds_byte(wc * 32 + fr, fq * 8);
#define GP_SA(b, h) (((b) * 2 + (h)) * HTB)
#define GP_SB(b, h) ((4 + (b) * 2 + (h)) * HTB)
#define GP_GLDS(gp_, bufoff, i_) __builtin_amdgcn_global_load_lds((const unsigned*)(gp_), (LAS unsigned*)(lds + (bufoff) + ldsw + (i_) * 8192), 16, 0, 0)
#define GP_STAGE_A(bufoff, ab, o0, o1, h, kb) do { if constexpr (Sched::GATHER) { const char* up_ = (ab) + (kb); GP_GLDS(up_ + (o0), bufoff, 0); GP_GLDS(up_ + (o1), bufoff, 1); } \
        else { const char* up_ = (ab) + (((h) ? hstepA : (size_t)0) + (kb)); GP_GLDS(up_ + va0, bufoff, 0); GP_GLDS(up_ + va1, bufoff, 1); } } while (0)
#define GP_STAGE_B(bufoff, bb, h, kb) do { const char* up_ = (bb) + (((h) ? hstepB : (size_t)0) + (kb)); GP_GLDS(up_ + vb0, bufoff, 0); GP_GLDS(up_ + vb1, bufoff, 1); } while (0)
#define GP_LDA(dst, b, h) do { _Pragma("unroll") for (int m = 0; m < 4; ++m) _Pragma("unroll") for (int k = 0; k < 2; ++k) dst[m][k] = *(const LAS bf16x8*)(lds + GP_SA(b, h) + aoff + m * 2048 + k * 1024); } while (0)
#define GP_LDB(dst, b, h) do { _Pragma("unroll") for (int n = 0; n < 2; ++n) _Pragma("unroll") for (int k = 0; k < 2; ++k) dst[n][k] = *(const LAS bf16x8*)(lds + GP_SB(b, h) + boff + n * 2048 + k * 1024); } while (0)
#define GP_MMA(ai, bj, At, Bt) do { __builtin_amdgcn_s_setprio(1); _Pragma("unroll") for (int m = 0; m < 4; ++m) _Pragma("unroll") for (int n = 0; n < 2; ++n) _Pragma("unroll") for (int k = 0; k < 2; ++k) \
        acc[ai][bj][m][n] = __builtin_amdgcn_mfma_f32_16x16x32_bf16(Bt[n][k], At[m][k], acc[ai][bj][m][n], 0, 0, 0); __builtin_amdgcn_s_setprio(0); } while (0)
#define GP_WAIT_V(n) asm volatile("s_waitcnt vmcnt(" #n ")" ::: "memory")
#define GP_WAIT_L(n) asm volatile("s_waitcnt lgkmcnt(" #n ")" ::: "memory")
#define GP_BAR __builtin_amdgcn_s_barrier()
#define GP_SCHED __builtin_amdgcn_sched_barrier(0)
    Unit cur, nxt; int ui = 0;
    if (!S.next(0, cur)) return;
    const char* cA; const char* cB; unsigned c00 = 0, c01 = 0, c10 = 0, c11 = 0;
    const char* nA; const char* nB; unsigned n00 = 0, n01 = 0, n10 = 0, n11 = 0;
    { UAddr t_; S.addr(cur, R0, C0, R1, C1, t_); cA = t_.a; cB = t_.b; if constexpr (Sched::GATHER) { c00 = t_.ao00; c01 = t_.ao01; c10 = t_.ao10; c11 = t_.ao11; } }
    f32x4 acc[2][2][4][2];
#pragma unroll
    for (int a = 0; a < 2; ++a)
#pragma unroll
        for (int b = 0; b < 2; ++b)
#pragma unroll
            for (int m = 0; m < 4; ++m)
#pragma unroll
                for (int n = 0; n < 2; ++n) acc[a][b][m][n] = (f32x4){0.f, 0.f, 0.f, 0.f};
    bf16x8 At[4][2], B0[2][2], B1[2][2];
    GP_STAGE_B(GP_SB(0, 0), cB, 0, 0); GP_STAGE_B(GP_SB(0, 1), cB, 1, 0); GP_STAGE_A(GP_SA(0, 0), cA, c00, c01, 0, 0); GP_STAGE_A(GP_SA(0, 1), cA, c10, c11, 1, 0);
    if (wr == 1) GP_BAR;
    GP_WAIT_V(2); GP_BAR;
    GP_STAGE_B(GP_SB(1, 0), cB, 0, kstep); GP_STAGE_A(GP_SA(1, 0), cA, c00, c01, 0, kstep); GP_STAGE_B(GP_SB(1, 1), cB, 1, kstep);
    GP_WAIT_V(6); GP_BAR;
    for (;;) {
        const bool has_next = S.next(ui + 1, nxt);
        if (has_next) { UAddr t_; S.addr(nxt, R0, C0, R1, C1, t_); nA = t_.a; nB = t_.b; if constexpr (Sched::GATHER) { n00 = t_.ao00; n01 = t_.ao01; n10 = t_.ao10; n11 = t_.ao11; } }
        else { nA = cA; nB = cB; n00 = c00; n01 = c01; n10 = c10; n11 = c11; }
#pragma unroll 1
        for (int t = 0; t < nt; t += 2) {
            const bool last = (t == nt - 2);
            const size_t k1 = (size_t)(t + 1) * kstep;
            const char* sA = last ? nA : cA; const char* sB = last ? nB : cB;
            const unsigned s00 = last ? n00 : c00, s01 = last ? n01 : c01, s10 = last ? n10 : c10, s11 = last ? n11 : c11;
            const size_t k2 = last ? (size_t)0 : (size_t)(t + 2) * kstep, k3 = k2 + kstep;
            GP_LDB(B0, 0, 0); GP_LDB(B1, 0, 1); GP_SCHED; GP_LDA(At, 0, 0); GP_STAGE_A(GP_SA(1, 1), cA, c10, c11, 1, k1);
            GP_WAIT_V(8); GP_WAIT_L(0); GP_BAR; GP_MMA(0, 0, At, B0); GP_MMA(0, 1, At, B1); GP_BAR; GP_SCHED;
            GP_LDA(At, 0, 1); GP_STAGE_B(GP_SB(0, 0), sB, 0, k2); GP_STAGE_B(GP_SB(0, 1), sB, 1, k2); GP_STAGE_A(GP_SA(0, 0), sA, s00, s01, 0, k2);
            GP_WAIT_V(8); GP_WAIT_L(0); GP_BAR; GP_MMA(1, 0, At, B0); GP_MMA(1, 1, At, B1); GP_BAR; GP_SCHED;
            GP_LDB(B0, 1, 0); GP_LDB(B1, 1, 1); GP_SCHED; GP_LDA(At, 1, 0); GP_STAGE_A(GP_SA(0, 1), sA, s10, s11, 1, k2);
            GP_WAIT_V(8); GP_WAIT_L(0); GP_BAR; GP_MMA(0, 0, At, B0); GP_MMA(0, 1, At, B1); GP_BAR; GP_SCHED;
            GP_LDA(At, 1, 1); GP_STAGE_B(GP_SB(1, 0), sB, 0, k3); GP_STAGE_B(GP_SB(1, 1), sB, 1, k3); GP_STAGE_A(GP_SA(1, 0), sA, s00, s01, 0, k3);
            GP_WAIT_V(8); GP_WAIT_L(0); GP_BAR; GP_MMA(1, 0, At, B0); GP_MMA(1, 1, At, B1); GP_BAR; GP_SCHED;
        }
        if (wr == 0) GP_BAR;
        E(acc, cur, wr, wc, fr, fq);
        if (!has_next) break;
#pragma unroll
        for (int a = 0; a < 2; ++a)
#pragma unroll
            for (int b = 0; b < 2; ++b)
#pragma unroll
                for (int m = 0; m < 4; ++m)
#pragma unroll
                    for (int n = 0; n < 2; ++n) acc[a][b][m][n] = (f32x4){0.f, 0.f, 0.f, 0.f};
        cur = nxt; cA = nA; cB = nB; c00 = n00; c01 = n01; c10 = n10; c11 = n11; ++ui;
        if (wr == 1) GP_BAR;
    }
    GP_WAIT_V(0);
    GP_BAR;
#undef GP_SA
#undef GP_SB
#undef GP_GLDS
#undef GP_STAGE_A
#undef GP_STAGE_B
#undef GP_LDA
#undef GP_LDB
#undef GP_MMA
#undef GP_WAIT_V
#undef GP_WAIT_L
#undef GP_BAR
#undef GP_SCHED
}
DEV bool static_order(int i, int G, int c, int nM, int nN, int& pm, int& pn) {
    const int nwg = nM * nN; const long L = (long)i * G + c; if (L >= nwg) return false;
    int wgid = (int)L; { const int q = nwg / 8, r = nwg % 8, xcd = wgid % 8, off = wgid / 8; wgid = (xcd < r ? xcd * (q + 1) : r * (q + 1) + (xcd - r) * q) + off; }
    const int nig = 8 * nN, gid = wgid / nig, fm = gid * 8, gsz = (nM - fm) < 8 ? (nM - fm) : 8;
    pm = fm + ((wgid % nig) % gsz); pn = (wgid % nig) / gsz; return true;
}
}

struct PlainSched {
    struct Unit { int pm, pn; };
    static constexpr bool GATHER = false;
    const char* A; const char* Bt; int lda_, K, nM, nN, G, c;
    DEV int lda() const { return lda_; }
    DEV bool next(int i, Unit& u) const { return gp::static_order(i, G, c, nM, nN, u.pm, u.pn); }
    DEV void addr(const Unit& u, int R0, int C0, int R1, int C1, gp::UAddr& o) const {
        o.a = A + (size_t)u.pm * 256 * lda_ * 2; o.b = Bt + (size_t)u.pn * 256 * K * 2;
    }
};
struct EpiF32 {
    static constexpr bool PERM = false;
    float* O; int ldc;
    template <class U> DEV void operator()(const f32x4 (&acc)[2][2][4][2], const U& u, int wr, int wc, int fr, int fq) const {
        const int row0 = u.pm * 256 + wr * 64 + fr, col0 = u.pn * 256 + wc * 32 + 4 * fq;
#pragma unroll
        for (int ai = 0; ai < 2; ++ai)
#pragma unroll
            for (int m = 0; m < 4; ++m) {
                float* rowp = O + (size_t)(row0 + ai * 128 + m * 16) * ldc + col0;
#pragma unroll
                for (int bj = 0; bj < 2; ++bj)
#pragma unroll
                    for (int n = 0; n < 2; ++n) *(f32x4*)(rowp + bj * 128 + n * 16) = acc[ai][bj][m][n];
            }
    }
};

DEV void bf8_unpack(const u32x4 w, float (&y)[8]) {
    y[0] = __uint_as_float(w.x << 16); y[1] = __uint_as_float(w.x & 0xffff0000u); y[2] = __uint_as_float(w.y << 16); y[3] = __uint_as_float(w.y & 0xffff0000u);
    y[4] = __uint_as_float(w.z << 16); y[5] = __uint_as_float(w.z & 0xffff0000u); y[6] = __uint_as_float(w.w << 16); y[7] = __uint_as_float(w.w & 0xffff0000u);
}
struct WinSched {
    struct Unit { int pm, pn; };
    static constexpr bool GATHER = false;
    const char* A; const char* Bt; int G, c;
    DEV int lda() const { return 1024; }
    DEV bool next(int i, Unit& u) const { return gp::static_order(i, G, c, 136, 6, u.pm, u.pn); }
    DEV void addr(const Unit& u, int R0, int C0, int R1, int C1, gp::UAddr& o) const {
        const int bidx = u.pm < 128 ? (u.pm >> 4) : 8;
        o.a = A + (size_t)u.pm * 256 * 1024 * 2; o.b = Bt + ((size_t)bidx * NWIN + u.pn * 256) * 1024 * 2;
    }
};
struct EpiWin {
    static constexpr bool PERM = true;
    const float* bias; bf16_t* US5; bf16_t* ULRU;
    template <class U> DEV void operator()(const f32x4 (&acc)[2][2][4][2], const U& u, int wr, int wc, int fr, int fq) const {
        const int bidx = u.pm < 128 ? (u.pm >> 4) : 8;
        const float* bp = bias + bidx * NWIN;
#pragma unroll
        for (int bj = 0; bj < 2; ++bj) {
            const int col8 = u.pn * 256 + bj * 128 + wc * 32 + 8 * fq;
            const f32x4 b0 = *(const f32x4*)(bp + col8), b1 = *(const f32x4*)(bp + col8 + 4);
#pragma unroll
            for (int ai = 0; ai < 2; ++ai)
#pragma unroll
                for (int m = 0; m < 4; ++m) {
                    const int row = u.pm * 256 + ai * 128 + wr * 64 + m * 16 + fr;
                    const f32x4 v0 = acc[ai][bj][m][0] + b0, v1 = acc[ai][bj][m][1] + b1;
                    u32x4 w; w.x = pack2(v0[0], v0[1]); w.y = pack2(v0[2], v0[3]); w.z = pack2(v1[0], v1[1]); w.w = pack2(v1[2], v1[3]);
                    if (col8 < 512) {
                        int mm, ss;
                        if (row < T) { const int bq = row >> 12, t = row & 4095; mm = bq * 128 + (t >> 5); ss = t & 31; }
                        else { const int q = row - T, bq = q >> 8, j = q & 255; mm = M5LAT + bq * 8 + (j >> 5); ss = j & 31; }
                        *(u32x4*)(US5 + ((size_t)((col8 >> 4) * M5PAD + mm)) * KT5 + ss * 16 + (col8 & 15)) = w;
                    } else *(u32x4*)(ULRU + (size_t)row * 1024 + (col8 - 512)) = w;
                }
        }
    }
};
struct S5Sched {
    struct Unit { int g, pm, pn; };
    static constexpr bool GATHER = false;
    const char* A; const char* Bt; int K, nPm, nPn, brows  , G, c;
    DEV int lda() const { return KT5; }
    DEV bool next(int i, Unit& u) const {
        if (i > 0) return false;
        const int per = nPm * nPn * 4;
        const int x = c & 7, j = c >> 3; if (j >= per) return false;
        const int U = x * per + j; u.g = U / (nPm * nPn); const int r = U % (nPm * nPn); u.pm = r / nPn; u.pn = r % nPn; return true;
    }
    DEV void addr(const Unit& u, int R0, int C0, int R1, int C1, gp::UAddr& o) const {
        o.a = A + ((size_t)u.g * M5PAD + u.pm * 256) * KT5 * 2; o.b = Bt + ((size_t)u.g * brows + u.pn * 256) * K * 2;
    }
};
struct EpiS5Loc {
    static constexpr bool PERM = false;
    float* SLOC;
    template <class U> DEV void operator()(const f32x4 (&acc)[2][2][4][2], const U& u, int wr, int wc, int fr, int fq) const {
#pragma unroll
        for (int ai = 0; ai < 2; ++ai)
#pragma unroll
            for (int m = 0; m < 4; ++m) {
                const int mm = u.pm * 256 + ai * 128 + wr * 64 + m * 16 + fr;
                if (mm < M5) {
                    float* rowp = SLOC + ((size_t)(u.g * M5 + mm)) * 256 + wc * 32 + 4 * fq;
#pragma unroll
                    for (int bj = 0; bj < 2; ++bj)
#pragma unroll
                        for (int n = 0; n < 2; ++n) *(f32x4*)(rowp + bj * 128 + n * 16) = acc[ai][bj][m][n];
                }
            }
    }
};
struct EpiS5Out {
    static constexpr bool PERM = true;
    bf16_t* YS5;
    template <class U> DEV void operator()(const f32x4 (&acc)[2][2][4][2], const U& u, int wr, int wc, int fr, int fq) const {
#pragma unroll
        for (int ai = 0; ai < 2; ++ai)
#pragma unroll
            for (int m = 0; m < 4; ++m) {
                const int mm = u.pm * 256 + ai * 128 + wr * 64 + m * 16 + fr, bq = mm >> 7, chunk = mm & 127;
#pragma unroll
                for (int bj = 0; bj < 2; ++bj) {
                    const int n8 = u.pn * 256 + bj * 128 + wc * 32 + 8 * fq, t = n8 >> 4, c0 = n8 & 15;
                    const size_t tok = (size_t)bq * 4096 + chunk * 32 + t;
                    const f32x4 v0 = acc[ai][bj][m][0], v1 = acc[ai][bj][m][1];
                    u32x4 w; w.x = pack2(gelu_tanh(v0[0]), gelu_tanh(v0[1])); w.y = pack2(gelu_tanh(v0[2]), gelu_tanh(v0[3]));
                    w.z = pack2(gelu_tanh(v1[0]), gelu_tanh(v1[1])); w.w = pack2(gelu_tanh(v1[2]), gelu_tanh(v1[3]));
                    *(u32x4*)(YS5 + tok * 512 + u.g * 16 + c0) = w;
                }
            }
    }
};
struct EpiGlu {
    static constexpr bool PERM = true;
    const bf16_t* YS5; const float* b_glu; bf16_t* YCAT;
    template <class U> DEV void operator()(const f32x4 (&acc)[2][2][4][2], const U& u, int wr, int wc, int fr, int fq) const {
#pragma unroll
        for (int bj = 0; bj < 2; ++bj) {
            const int col8 = u.pn * 256 + bj * 128 + wc * 32 + 8 * fq;
            const f32x4 b0 = *(const f32x4*)(b_glu + col8), b1 = *(const f32x4*)(b_glu + col8 + 4);
#pragma unroll
            for (int ai = 0; ai < 2; ++ai)
#pragma unroll
                for (int m = 0; m < 4; ++m) {
                    const size_t row = (size_t)u.pm * 256 + ai * 128 + wr * 64 + m * 16 + fr;
                    float y[8]; bf8_unpack(*(const u32x4*)(YS5 + row * 512 + col8), y);
                    const f32x4 z0 = acc[ai][bj][m][0] + b0, z1 = acc[ai][bj][m][1] + b1;
                    u32x4 w; w.x = pack2(y[0] * sigmoid_f(z0[0]), y[1] * sigmoid_f(z0[1])); w.y = pack2(y[2] * sigmoid_f(z0[2]), y[3] * sigmoid_f(z0[3]));
                    w.z = pack2(y[4] * sigmoid_f(z1[0]), y[5] * sigmoid_f(z1[1])); w.w = pack2(y[6] * sigmoid_f(z1[2]), y[7] * sigmoid_f(z1[3]));
                    *(u32x4*)(YCAT + row * 1024 + col8) = w;
                }
        }
    }
};

DEV void tr_tile(const float* __restrict__ W, int ldw, int k0, int n0, bf16_t* __restrict__ dst, int ldd, int mode, LAS float* tile, const float* __restrict__ kscale1p) {
    const int tid = threadIdx.x;
#pragma unroll
    for (int i = 0; i < 2; ++i) {
        const int idx = tid + i * 512, kk = idx >> 4, n4 = (idx & 15) * 4;
        f32x4 v = *(const f32x4*)(W + (size_t)(k0 + kk) * ldw + n0 + n4);
        if (kscale1p) { const float s = 1.f + kscale1p[k0 + kk]; v = v * s; }
        LAS float* tp = tile + kk * 65 + n4;
        tp[0] = v[0]; tp[1] = v[1]; tp[2] = v[2]; tp[3] = v[3];
    }
    __syncthreads();
    {
        const int nn = tid >> 3, kc = tid & 7;
        float e[8];
#pragma unroll
        for (int jj = 0; jj < 8; ++jj) e[jj] = tile[(kc * 8 + jj) * 65 + nn];
        const int j = n0 + nn;
        const int row = mode == 0 ? j : (((j >> 4) << 5) + (j & 15) + (mode == 2 ? 16 : 0));
        u32x4 w; w.x = pack2(e[0], e[1]); w.y = pack2(e[2], e[3]); w.z = pack2(e[4], e[5]); w.w = pack2(e[6], e[7]);
        *(u32x4*)(dst + (size_t)row * ldd + k0 + kc * 8) = w;
    }
    __syncthreads();
}

DEV void gemv9_item(LAS const float* S, const float* __restrict__ W, int ldw, int col0, const float* __restrict__ bias, float* __restrict__ out, int ldo, LAS float* red) {
    const int tid = threadIdx.x, col = tid & 31, kp = tid >> 5;
    float acc[9];
#pragma unroll
    for (int b = 0; b < 9; ++b) acc[b] = 0.f;
    for (int k = kp * 64; k < kp * 64 + 64; ++k) {
        const float w = W[(size_t)k * ldw + col0 + col];
#pragma unroll
        for (int b = 0; b < 9; ++b) acc[b] += S[b * 1024 + k] * w;
    }
#pragma unroll
    for (int b = 0; b < 9; ++b) red[(kp * 9 + b) * 32 + col] = acc[b];
    __syncthreads();
    if (tid < 288) {
        const int b = tid >> 5, c = tid & 31; float s = 0.f;
#pragma unroll
        for (int q = 0; q < 16; ++q) s += red[(q * 9 + b) * 32 + c];
        out[b * ldo + col0 + c] = s + (bias ? bias[col0 + c] : 0.f);
    }
    __syncthreads();
}

DEV void cpow_d(double lr, double li, double dt, int l, double& re, double& im) {
    const double mag = exp(lr * dt * (double)l);
    const double ang = li * dt * (double)l;
    const double kq = rint(ang * 0.63661977236758134308);
    double x = fma(-kq, 1.57079632679489655800e+00, ang);
    x = fma(-kq, 6.12323399573676603587e-17, x);
    const double x2 = x * x;
    double s = -1.0 / 6227020800.0; s = fma(s, x2, 1.0 / 39916800.0); s = fma(s, x2, -1.0 / 362880.0); s = fma(s, x2, 1.0 / 5040.0);
    s = fma(s, x2, -1.0 / 120.0); s = fma(s, x2, 1.0 / 6.0); s = fma(-s, x2, 1.0); s = s * x;
    double c = 1.0 / 479001600.0; c = fma(c, x2, -1.0 / 3628800.0); c = fma(c, x2, 1.0 / 40320.0); c = fma(c, x2, -1.0 / 720.0);
    c = fma(c, x2, 1.0 / 24.0); c = fma(c, x2, -0.5); c = fma(c, x2, 1.0);
    const int q = ((int)(long long)kq) & 3;
    const double sn = (q == 0) ? s : (q == 1) ? c : (q == 2) ? -s : -c;
    const double cs = (q == 0) ? c : (q == 1) ? -s : (q == 2) ? -c : s;
    re = mag * cs; im = mag * sn;
}

DEV void s5_gen(const Params& p, LAS unsigned char* lds, int g) {
    const int tid = threadIdx.x;
    LAS float* apr = (LAS float*)lds;
    LAS float* api = apr + 4224;
    LAS float* bbr = api + 4224;
    LAS float* bbi = bbr + 2048;
    LAS float* ccr = bbi + 2048;
    LAS float* cci = ccr + 2048;
    LAS float* Kt = cci + 2048;
    const float* lam_re = p.in[9]; const float* lam_im = p.in[10]; const float* log_dt = p.in[11];
    const float* b_re = p.in[12]; const float* b_im = p.in[13]; const float* c_re = p.in[14]; const float* c_im = p.in[15]; const float* dvec = p.in[16];
    bf16_t* BS5 = (bf16_t*)(p.ws + WS_BS5); bf16_t* ES5 = (bf16_t*)(p.ws + WS_ES5); float* ALC = (float*)(p.ws + WS_ALC);
    for (int i = tid; i < 4224; i += 512) {
        const int dir = i / 2112, rem = i % 2112, l = rem >> 6, pp = rem & 63, gi = dir * 32 + g;
        const double dt = exp((double)log_dt[gi]);
        double re, im; cpow_d((double)lam_re[gi * 64 + pp], (double)lam_im[gi * 64 + pp], dt, l, re, im);
        apr[i] = (float)re; api[i] = (float)im;
    }
    for (int i = tid; i < 2048; i += 512) {
        const int dir = i >> 10, cc = (i >> 6) & 15, pp = i & 63; const size_t src = ((size_t)((dir * 32 + g) * 16 + cc)) * 64 + pp;
        ccr[i] = c_re[src]; cci[i] = c_im[src];
    }
    for (int i = tid; i < 2048; i += 512) {
        const int dir = i >> 10, pp = (i >> 4) & 63, c = i & 15, gi = dir * 32 + g;
        const double dt = exp((double)log_dt[gi]);
        const double lr = (double)lam_re[gi * 64 + pp], li = (double)lam_im[gi * 64 + pp];
        double ar, ai; cpow_d(lr, li, dt, 1, ar, ai);
        const double nr = ar - 1.0, den = lr * lr + li * li;
        const double fr = (nr * lr + ai * li) / den, fi = (ai * lr - nr * li) / den;
        const double br = (double)b_re[((size_t)(gi * 64 + pp)) * 16 + c], bi = (double)b_im[((size_t)(gi * 64 + pp)) * 16 + c];
        bbr[i] = (float)(fr * br - fi * bi); bbi[i] = (float)(fr * bi + fi * br);
    }
    __syncthreads();
    for (int o = tid; o < 16384; o += 512) {
        const int dir = o >> 13, l = (o >> 8) & 31, c = (o >> 4) & 15, c2 = o & 15;
        float sum = 0.f;
        for (int pp = 0; pp < 64; ++pp) {
            const float ar = apr[(dir * 33 + l) * 64 + pp], ai = api[(dir * 33 + l) * 64 + pp];
            const float br = bbr[(dir * 64 + pp) * 16 + c2], bi = bbi[(dir * 64 + pp) * 16 + c2];
            const float tr = ar * br - ai * bi, ti = ar * bi + ai * br;
            sum += ccr[(dir * 16 + c) * 64 + pp] * tr - cci[(dir * 16 + c) * 64 + pp] * ti;
        }
        Kt[o] = sum;
    }
    __syncthreads();
    for (int q = tid; q < 512 * 96; q += 512) {
        const int n = q / 96, k8 = (q % 96) * 8, t = n >> 4, c = n & 15;
        float e[8];
        if (k8 < 512) {
            const int s = k8 >> 4, c0 = k8 & 15, delta = t - s;
#pragma unroll
            for (int i = 0; i < 8; ++i) {
                const int c2 = c0 + i; float v;
                if (delta > 0) v = Kt[delta * 256 + c * 16 + c2];
                else if (delta < 0) v = Kt[(32 - delta) * 256 + c * 16 + c2];
                else v = Kt[c * 16 + c2] + Kt[32 * 256 + c * 16 + c2] + (c == c2 ? dvec[g * 16 + c] : 0.f);
                e[i] = v;
            }
        } else {
            const int kk = k8 - 512, seg = kk >> 6, p0 = kk & 63, dir = seg >> 1, l = dir == 0 ? t + 1 : 32 - t;
#pragma unroll
            for (int i = 0; i < 8; ++i) {
                const int pp = p0 + i;
                const float ar = apr[(dir * 33 + l) * 64 + pp], ai = api[(dir * 33 + l) * 64 + pp];
                const float cr = ccr[(dir * 16 + c) * 64 + pp], ci = cci[(dir * 16 + c) * 64 + pp];
                e[i] = (seg & 1) ? -(cr * ai + ci * ar) : (cr * ar - ci * ai);
            }
        }
        u32x4 w; w.x = pack2(e[0], e[1]); w.y = pack2(e[2], e[3]); w.z = pack2(e[4], e[5]); w.w = pack2(e[6], e[7]);
        *(u32x4*)(BS5 + ((size_t)g * 512 + n) * 768 + k8) = w;
    }
    for (int q = tid; q < 256 * 64; q += 512) {
        const int n = q >> 6, k8 = (q & 63) * 8, s = k8 >> 4, c0 = k8 & 15, seg = n >> 6, pp = n & 63, dir = seg >> 1, l = dir == 0 ? 31 - s : s;
        const float ar = apr[(dir * 33 + l) * 64 + pp], ai = api[(dir * 33 + l) * 64 + pp];
        float e[8];
#pragma unroll
        for (int i = 0; i < 8; ++i) {
            const float br = bbr[(dir * 64 + pp) * 16 + c0 + i], bi = bbi[(dir * 64 + pp) * 16 + c0 + i];
            e[i] = (seg & 1) ? (ar * bi + ai * br) : (ar * br - ai * bi);
        }
        u32x4 w; w.x = pack2(e[0], e[1]); w.y = pack2(e[2], e[3]); w.z = pack2(e[4], e[5]); w.w = pack2(e[6], e[7]);
        *(u32x4*)(ES5 + ((size_t)g * 256 + n) * 512 + k8) = w;
    }
    if (tid < 128) {
        const int dir = tid >> 6, pp = tid & 63;
        ALC[((dir * 32 + g) * 64 + pp) * 2 + 0] = apr[(dir * 33 + 32) * 64 + pp];
        ALC[((dir * 32 + g) * 64 + pp) * 2 + 1] = api[(dir * 33 + 32) * 64 + pp];
    }
    __syncthreads();
}

template <bool APPLY>
DEV void lru_item(const Params& p, LAS unsigned char* lds, int b, int ch, int h) {
    int tid_ = threadIdx.x; asm volatile("" : "+v"(tid_));
    const int tid = tid_, wid = tid >> 6, lane = tid & 63, fr = lane & 15, fq = lane >> 4;
    LAS float* xin = (LAS float*)lds;
    LAS float* xs = (LAS float*)(lds + 17408);
    LAS unsigned short* xsb = (LAS unsigned short*)(lds + 33792);
    LAS float* aa = (LAS float*)(lds + 43008);
    LAS float* bb = (LAS float*)(lds + 75776);
    LAS float* cAs = (LAS float*)(lds + 108544);
    const bf16_t* ULRU = (const bf16_t*)(p.ws + WS_ULRU);
    const bf16_t* BTLRU = (const bf16_t*)(p.ws + WS_BTLRU);
    const float* conv_w = p.in[19]; const float* conv_b = p.in[20];
    if (tid < 128) {
        const int dir = tid >> 6, j = tid & 63, o = dir * 512 + h * 64 + j;
        cAs[tid] = -8.f * log1pf(__expf(-p.in[25][o])); cAs[128 + tid] = p.in[22][o]; cAs[256 + tid] = p.in[24][o];
    }
#pragma unroll 1
    for (int idx = tid; idx < 67 * 64; idx += 512) {
        const int rr = idx >> 6, cc = idx & 63, pos = rr - 2;
        float v = 0.f;
        if (ch < 64) { if (pos >= 0 && pos < 64) v = bf2f(ULRU[((size_t)b * 4096 + pos * 64 + ch) * 1024 + h * 64 + cc]); }
        else { const int jt = (ch - 64) * 64 + pos; if (jt >= 0 && jt < 256) v = bf2f(ULRU[((size_t)T + b * 256 + jt) * 1024 + h * 64 + cc]); }
        xin[idx] = v;
    }
    __syncthreads();
    {
        const int cc = tid & 63, chn = h * 64 + cc;
        const float w0 = conv_w[chn], w1 = conv_w[512 + chn], w2 = conv_w[1024 + chn], w3 = conv_w[1536 + chn], cb = conv_b[chn];
#pragma unroll 2
        for (int r = tid >> 6; r < 64; r += 8) {
            const float v = cb + w0 * xin[r * 64 + cc] + w1 * xin[(r + 1) * 64 + cc] + w2 * xin[(r + 2) * 64 + cc] + w3 * xin[(r + 3) * 64 + cc];
            xs[r * 64 + cc] = v; xsb[r * 72 + cc] = (unsigned short)f2bf(v);
        }
    }
    __syncthreads();
    {
        const int mt = wid & 3, dir = wid >> 2;
        bf16x8 af[2];
#pragma unroll
        for (int ks = 0; ks < 2; ++ks) af[ks] = *(LAS const bf16x8*)((LAS const unsigned char*)xsb + (mt * 16 + fr) * 144 + ks * 64 + fq * 16);
        const int r = mt * 16 + fr;
#pragma unroll
        for (int jt = 0; jt < 8; ++jt) {
            const int n = dir * 128 + jt * 16 + fr;
            const bf16_t* bp = BTLRU + ((size_t)(h * 256 + n)) * 64 + fq * 8;
            const bf16x8 b0 = *(const bf16x8*)bp, b1 = *(const bf16x8*)(bp + 32);
            f32x4 a = (f32x4){0.f, 0.f, 0.f, 0.f};
            a = __builtin_amdgcn_mfma_f32_16x16x32_bf16(b0, af[0], a, 0, 0, 0);
            a = __builtin_amdgcn_mfma_f32_16x16x32_bf16(b1, af[1], a, 0, 0, 0);
            LAS float* dst = (jt < 4 ? aa : bb) + (dir * 64 + r) * 64 + (jt & 3) * 16 + 4 * fq;
            *(LAS f32x4*)dst = a;
        }
    }
    __syncthreads();
#pragma unroll 2
    for (int idx = tid; idx < 8192; idx += 512) {
        const int dir = idx >> 12, j = idx & 63, r = (idx >> 6) & 63;
        const float za = aa[idx] + cAs[128 + dir * 64 + j], zx = bb[idx] + cAs[256 + dir * 64 + j];
        const float la = cAs[dir * 64 + j] * sigmoid_f(za);
        const float a = __expf(la);
        const float x2 = 2.f * la;
        const float em = -x2 * (1.f + x2 * (0.5f + x2 * (0.16666667f + x2 * (0.041666668f + x2 * (0.0083333338f + x2 * 0.0013888889f)))));
        aa[idx] = a; bb[idx] = sqrtf(em) * sigmoid_f(zx) * xs[r * 64 + j];
    }
    __syncthreads();
    if (tid < 128) {
        const int dir = tid >> 6, j = tid & 63, chn = h * 64 + j;
        if (!APPLY) {
            float H = 0.f, P = 1.f;
#pragma unroll 4
            for (int s = 0; s < 64; ++s) { const int r = dir ? 63 - s : s; const float a = aa[(dir * 64 + r) * 64 + j]; H = a * H + bb[(dir * 64 + r) * 64 + j]; P *= a; }
            float* SA = (float*)(p.ws + WS_SA); float* SB = (float*)(p.ws + WS_SB);
            const size_t o = ((size_t)(b * 68 + ch) * 2 + dir) * 512 + chn;
            SA[o] = P; SB[o] = H;
        } else {
            const float* HIN = (const float*)(p.ws + WS_HIN);
            float H = HIN[((size_t)(b * 64 + ch) * 2 + dir) * 512 + chn];
#pragma unroll 4
            for (int s = 0; s < 64; ++s) { const int r = dir ? 63 - s : s; H = aa[(dir * 64 + r) * 64 + j] * H + bb[(dir * 64 + r) * 64 + j]; bb[(dir * 64 + r) * 64 + j] = H; }
        }
    }
    __syncthreads();
    if (APPLY) {
        bf16_t* YCAT = (bf16_t*)(p.ws + WS_YCAT);
#pragma unroll 2
        for (int idx = tid; idx < 4096; idx += 512) {
            const int r = idx >> 6, j = idx & 63;
            const size_t row = (size_t)b * 4096 + r * 64 + ch;
            const float gate = bf2f(ULRU[row * 1024 + 512 + h * 64 + j]);
            const float hs = bb[r * 64 + j] + bb[(64 + r) * 64 + j];
            YCAT[row * 1024 + 512 + h * 64 + j] = (bf16_t)f2bf(hs * gelu_tanh(gate));
        }
        __syncthreads();
    }
}

constexpr int MOE_TAB_OFF = 132096;
DEV void moe_tables(const Params& p, LAS unsigned char* lds, int h) {
    LAS int* tp = (LAS int*)(lds + MOE_TAB_OFF); LAS int* pc = tp + 72; LAS int* cn = pc + 72;
    if (threadIdx.x == 0) {
        const int* cnt = (const int*)(p.ws + WS_CNT) + h * 64;
        int t = 0, q = 0;
        for (int e = 0; e < 65; ++e) { const int c = e < 64 ? cnt[e] : HALF_T; cn[e] = c; tp[e] = t; pc[e] = q; t += (c + 255) >> 8; q += c; }
        tp[65] = t; pc[65] = q;
    }
    __syncthreads();
}
template <bool GU>
struct MoeSched {
    struct Unit { int e, r0t, pn; };
    static constexpr bool GATHER = GU;
    LAS const int* tp; LAS const int* pc; LAS const int* cn;
    const char* Abase; const char* Bt; const int* ltok; int h, nN, nunits, G, c;
    DEV int lda() const { return 256; }
    DEV bool next(int i, Unit& u) const {
        const long L = (long)i * G + c; if (L >= nunits) return false;
        int w = (int)L; { const int q = nunits / 8, r = nunits % 8, xcd = w % 8, off = w / 8; w = (xcd < r ? xcd * (q + 1) : r * (q + 1) + (xcd - r) * q) + off; }
        const int rt = w / nN; u.pn = w % nN;
        int e = 0; while (tp[e + 1] <= rt) ++e;
        u.e = e; u.r0t = (rt - tp[e]) * 256; return true;
    }
    DEV unsigned tokoff(int e, int ce, int idx, int C) const {
        idx = idx < ce ? idx : ce - 1;
        const int tok = e < 64 ? ltok[(size_t)(h * 64 + e) * HALF_T + idx] : h * HALF_T + idx;
        return (unsigned)tok * 4096u + 2048u + (unsigned)C * 2u;
    }
    DEV void addr(const Unit& u, int R0, int C0, int R1, int C1, gp::UAddr& o) const {
        if constexpr (GU) {
            const int ce = cn[u.e];
            o.a = Abase; o.b = Bt + ((size_t)u.e * 512 + u.pn * 256) * 2048;
            o.ao00 = tokoff(u.e, ce, u.r0t + R0, C0); o.ao01 = tokoff(u.e, ce, u.r0t + R1, C1);
            o.ao10 = tokoff(u.e, ce, u.r0t + 128 + R0, C0); o.ao11 = tokoff(u.e, ce, u.r0t + 128 + R1, C1);
        } else {
            o.a = Abase + ((size_t)pc[u.e] + u.r0t) * 512; o.b = Bt + ((size_t)u.e * 1024 + u.pn * 256) * 512;
        }
    }
};
struct EpiMoeGU {
    static constexpr bool PERM = false;
    LAS const int* pc; LAS const int* cn; const float* lwt; bf16_t* HMID; int h;
    template <class U> DEV void operator()(const f32x4 (&acc)[2][2][4][2], const U& u, int wr, int wc, int fr, int fq) const {
        const int ce = cn[u.e]; const size_t prow = (size_t)pc[u.e];
#pragma unroll
        for (int ai = 0; ai < 2; ++ai)
#pragma unroll
            for (int m = 0; m < 4; ++m) {
                const int idx = u.r0t + ai * 128 + wr * 64 + m * 16 + fr;
                if (idx < ce) {
                    const float wt = u.e < 64 ? lwt[(size_t)(h * 64 + u.e) * HALF_T + idx] : 1.f;
                    bf16_t* rowp = HMID + (prow + idx) * 256 + u.pn * 128 + wc * 16 + 4 * fq;
#pragma unroll
                    for (int bj = 0; bj < 2; ++bj) {
                        const f32x4 gt = acc[ai][bj][m][0], up = acc[ai][bj][m][1];
                        u32x2 w; w.x = pack2(wt * gt[0] * sigmoid_f(gt[0]) * up[0], wt * gt[1] * sigmoid_f(gt[1]) * up[1]);
                        w.y = pack2(wt * gt[2] * sigmoid_f(gt[2]) * up[2], wt * gt[3] * sigmoid_f(gt[3]) * up[3]);
                        *(u32x2*)(rowp + bj * 64) = w;
                    }
                }
            }
    }
};
struct EpiMoeDN {
    static constexpr bool PERM = true;
    LAS const int* pc; LAS const int* cn; bf16_t* SLAB;
    template <class U> DEV void operator()(const f32x4 (&acc)[2][2][4][2], const U& u, int wr, int wc, int fr, int fq) const {
        const int ce = cn[u.e]; const size_t prow = (size_t)pc[u.e];
#pragma unroll
        for (int ai = 0; ai < 2; ++ai)
#pragma unroll
            for (int m = 0; m < 4; ++m) {
                const int idx = u.r0t + ai * 128 + wr * 64 + m * 16 + fr;
                if (idx < ce) {
                    bf16_t* rowp = SLAB + (prow + idx) * 1024 + u.pn * 256 + wc * 32 + 8 * fq;
#pragma unroll
                    for (int bj = 0; bj < 2; ++bj) {
                        const f32x4 v0 = acc[ai][bj][m][0], v1 = acc[ai][bj][m][1];
                        u32x4 w; w.x = pack2(v0[0], v0[1]); w.y = pack2(v0[2], v0[3]); w.z = pack2(v1[0], v1[1]); w.w = pack2(v1[2], v1[3]);
                        *(u32x4*)(rowp + bj * 128) = w;
                    }
                }
            }
    }
};
DEV void moe_reduce(const Params& p, LAS unsigned char* lds, int h, int bid, int nb) {
    int tid = threadIdx.x; asm volatile("" : "+v"(tid));
    const int wid = tid >> 6, lane = tid & 63;
    LAS const int* pc = (LAS const int*)(lds + MOE_TAB_OFF) + 72;
    const bf16_t* SLAB = (const bf16_t*)(p.ws + WS_SLAB); const int* PAIR = (const int*)(p.ws + WS_PAIR); const float* ADA = (const float*)(p.ws + WS_ADA);
    for (int it = bid; it < HALF_T / 8; it += nb) {
        const int tokl = it * 8 + wid; const size_t tok = (size_t)h * HALF_T + tokl; const int b = (int)(tok >> 12), col = lane * 16;
        float f[16];
        { const bf16_t* r = SLAB + ((size_t)pc[64] + tokl) * 1024 + col; float y[8]; bf8_unpack(*(const u32x4*)r, y);
#pragma unroll
          for (int j = 0; j < 8; ++j) f[j] = y[j];
          bf8_unpack(*(const u32x4*)(r + 8), y);
#pragma unroll
          for (int j = 0; j < 8; ++j) f[8 + j] = y[j]; }
#pragma unroll
        for (int k = 0; k < 8; ++k) {
            const int pr = PAIR[tok * 8 + k], e = pr >> 16, rank = pr & 0xffff;
            const bf16_t* r = SLAB + ((size_t)pc[e] + rank) * 1024 + col; float y[8];
            bf8_unpack(*(const u32x4*)r, y);
#pragma unroll
            for (int j = 0; j < 8; ++j) f[j] += y[j];
            bf8_unpack(*(const u32x4*)(r + 8), y);
#pragma unroll
            for (int j = 0; j < 8; ++j) f[8 + j] += y[j];
        }
        float z[16]; float s = 0.f;
        { const bf16_t* hr = (const bf16_t*)p.out + tok * 2048 + col; float y0[8], y1[8]; bf8_unpack(*(const u32x4*)hr, y0); bf8_unpack(*(const u32x4*)(hr + 8), y1);
          const float* g2 = ADA + b * 6144 + 5120 + col;
#pragma unroll
          for (int j = 0; j < 8; ++j) { z[j] = y0[j] * ALPHA_F + g2[j] * f[j]; z[8 + j] = y1[j] * ALPHA_F + g2[8 + j] * f[8 + j]; }
#pragma unroll
          for (int j = 0; j < 16; ++j) s += z[j]; }
        const float mean = wave_sum(s) * (1.f / 1024.f); float qq = 0.f;
#pragma unroll
        for (int j = 0; j < 16; ++j) { const float d = z[j] - mean; qq += d * d; }
        const float rstd = rsqrtf(wave_sum(qq) * (1.f / 1024.f) + LN_EPS_F);
        const float* gg = p.in[37] + col; const float* bbv = p.in[38] + col;
#pragma unroll
        for (int q = 0; q < 4; ++q) {
            f32x4 o;
#pragma unroll
            for (int j = 0; j < 4; ++j) o[j] = (z[q * 4 + j] - mean) * rstd * gg[q * 4 + j] + bbv[q * 4 + j];
            *(f32x4*)(p.out + tok * 1024 + col + q * 4) = o;
        }
    }
}

#define ADA ((float*)(p.ws + WS_ADA))
#define BIASIN ((float*)(p.ws + WS_BIASIN))
#define HB ((bf16_t*)(p.ws + WS_HB))
#define BTIN ((bf16_t*)(p.ws + WS_BTIN))
#define US5 ((bf16_t*)(p.ws + WS_US5))
#define ULRU ((bf16_t*)(p.ws + WS_ULRU))
#define SLOC ((float*)(p.ws + WS_SLOC))
#define YS5 ((bf16_t*)(p.ws + WS_YS5))
#define YCAT ((bf16_t*)(p.ws + WS_YCAT))
#define Y ((float*)(p.ws + WS_Y))
#define LTOK ((int*)(p.ws + WS_LTOK))
#define LWT ((float*)(p.ws + WS_LWT))
#define HMID ((bf16_t*)(p.ws + WS_HMID))
#define SLAB ((bf16_t*)(p.ws + WS_SLAB))
#define PAIR ((int*)(p.ws + WS_PAIR))
#define CNT ((int*)(p.ws + WS_CNT))
__global__ void __launch_bounds__(512) mk_fwd(Params p) {
    extern __shared__ __attribute__((aligned(16))) unsigned char lds_raw[];
    LAS unsigned char* lds = (LAS unsigned char*)lds_raw;
    const int bid = blockIdx.x, nb = gridDim.x;
    volatile LAS unsigned* MISC = (volatile LAS unsigned*)(lds + MISC_OFF);
    if (threadIdx.x < 64) MISC[threadIdx.x] = 0u;
    __syncthreads();
    unsigned char* const ws = p.ws;
    XcdBarrier bar; bar.bar = (unsigned*)(ws + WS_CTL); bar.x = 0; bar.st = nullptr;
    const bool fused = (p.ph_hi - p.ph_lo) > 1;
    if (fused) bar = xcd_barrier_post((unsigned*)(ws + WS_CTL), MISC + 8);

    const int lo = p.ph_lo, hi = p.ph_hi;
#ifndef PROBE_REP_PH
#define PROBE_REP_PH -1
#endif
#define IN(k) (lo <= (k) && (k) < hi)
#define TIDS int tid = threadIdx.x; asm volatile("" : "+v"(tid)); const int wid = tid >> 6, lane = tid & 63; (void)wid; (void)lane
#define REPS(k) (((k) == PROBE_REP_PH) ? 2 : 1)
#define SEAM(k) do { if (IN(k) && IN((k) + 1)) xcd_barrier(bar); else __syncthreads(); } while (0)
    {
        for (int rep_ = 0; rep_ < REPS(0); ++rep_) if (IN(0)) { if (rep_) xcd_barrier(bar); TIDS;
            {
                LAS float* S = (LAS float*)lds; LAS float* red = S + 9216;
                for (int i = tid; i < 9216; i += 512) { const float c = i < 8192 ? p.in[1][i] : p.in[3][i - 8192]; S[i] = c * sigmoid_f(c); }
                __syncthreads();
                for (int it = bid; it < 192; it += nb) gemv9_item(S, p.in[6], 6144, it * 32, p.in[7], ADA, 6144, red);
                __syncthreads();
            }
            for (int it = bid; it < TT / 8; it += nb) {
                const int row = it * 8 + wid;
                const float* src = row < T ? p.in[0] + (size_t)row * 1024 : p.in[2] + (size_t)(row - T) * 1024;
                f32x4 v[4]; float s = 0.f;
#pragma unroll
                for (int q = 0; q < 4; ++q) { v[q] = *(const f32x4*)(src + q * 256 + lane * 4); s += (v[q][0] + v[q][1]) + (v[q][2] + v[q][3]); }
                const float mean = wave_sum(s) * (1.f / 1024.f); float qq = 0.f;
#pragma unroll
                for (int q = 0; q < 4; ++q) { const f32x4 d = v[q] - mean; qq += (d[0] * d[0] + d[1] * d[1]) + (d[2] * d[2] + d[3] * d[3]); }
                const float rstd = rsqrtf(wave_sum(qq) * (1.f / 1024.f) + LN_EPS_F);
#pragma unroll
                for (int q = 0; q < 4; ++q) {
                    const f32x4 gg = *(const f32x4*)(p.in[4] + q * 256 + lane * 4), bbv = *(const f32x4*)(p.in[5] + q * 256 + lane * 4);
                    const f32x4 o = (v[q] - mean) * rstd * gg + bbv;
                    u32x2 w; w.x = pack2(o[0], o[1]); w.y = pack2(o[2], o[3]);
                    *(u32x2*)(HB + (size_t)row * 1024 + q * 256 + lane * 4) = w;
                }
            }
            {
                LAS float* tile = (LAS float*)lds;
                __syncthreads();
                for (int it = bid; it < 12832; it += nb) {
                    if (it < 64) { tr_tile(p.in[17], 512, (it >> 3) * 64, (it & 7) * 64, (bf16_t*)(ws + WS_BTGLU), 512, 0, tile, nullptr); }
                    else if (it < 320) { const int i2 = it - 64; tr_tile(p.in[26], 1024, (i2 >> 4) * 64, (i2 & 15) * 64, (bf16_t*)(ws + WS_BTOUT), 1024, 0, tile, nullptr); }
                    else if (it < 12800) {
                        const int i2 = it - 320, e = i2 / 192, r = i2 % 192, which = r >> 6, tt = r & 63;
                        if (which < 2) {
                            const float* W = e < 64 ? (which == 0 ? p.in[31] : p.in[32]) + (size_t)e * 262144 : (which == 0 ? p.in[34] : p.in[35]);
                            tr_tile(W, 256, (tt >> 2) * 64, (tt & 3) * 64, (bf16_t*)(ws + WS_BTGU) + (size_t)e * 524288, 1024, which + 1, tile, nullptr);
                        } else {
                            const float* W = e < 64 ? p.in[33] + (size_t)e * 262144 : p.in[36];
                            tr_tile(W, 1024, (tt >> 4) * 64, (tt & 15) * 64, (bf16_t*)(ws + WS_BTDN) + (size_t)e * 262144, 256, 0, tile, nullptr);
                        }
                    } else {
                        const int i2 = it - 12800, dir = i2 >> 4, ax = (i2 >> 3) & 1, h = i2 & 7;
                        const float* W = (ax ? p.in[23] : p.in[21]) + (size_t)(dir * 8 + h) * 4096;
                        tr_tile(W, 64, 0, 0, (bf16_t*)(ws + WS_BTLRU) + (size_t)(h * 256 + dir * 128 + ax * 64) * 64, 64, 0, tile, nullptr);
                    }
                }
            }
            __syncthreads();
            for (int g = bid; g < 32; g += nb) s5_gen(p, lds, g);
        }
        SEAM(0);
        if (IN(1)) { TIDS;
            {
                LAS float* tile = (LAS float*)lds;
                for (int it = bid; it < 3456; it += nb) {
                    const int bidx = it / 384, r = it % 384, kt = r / 24, nt = r % 24;
                    tr_tile(p.in[8], NWIN, kt * 64, nt * 64, BTIN + (size_t)bidx * NWIN * 1024, 1024, 0, tile, ADA + bidx * 6144 + 1024);
                }
            }
            {
                __syncthreads();
                LAS float* S = (LAS float*)lds; LAS float* red = S + 9216;
                for (int i = tid; i < 9216; i += 512) S[i] = ADA[(i >> 10) * 6144 + (i & 1023)];
                __syncthreads();
                for (int it = bid; it < 48; it += nb) gemv9_item(S, p.in[8], NWIN, it * 32, nullptr, BIASIN, NWIN, red);
            }
        }
        SEAM(1);
        if (IN(2)) { TIDS;
            WinSched S{(const char*)HB, (const char*)BTIN, nb, bid};
            EpiWin E{BIASIN, US5, ULRU};
            gp::gemm_phase(lds, 1024, S, E);
        }
        SEAM(2);
        for (int rep_ = 0; rep_ < REPS(3); ++rep_) if (IN(3)) { if (rep_) xcd_barrier(bar); TIDS;
            const bf16_t* ES5 = (const bf16_t*)(ws + WS_ES5);
            { S5Sched S{(const char*)US5, (const char*)ES5, 512, 5, 1, 256, nb, bid}; EpiS5Loc E{SLOC}; gp::gemm_phase(lds, 512, S, E); }
            __syncthreads();
            int bid_ = bid; asm volatile("" : "+s"(bid_));
            for (int it = bid_; it < NBATCH * 68 * 8; it += nb) { const int h = it & 7, q = it >> 3, ch = q % 68, b = q / 68; lru_item<false>(p, lds, b, ch, h); }
        }
        SEAM(3);
        for (int rep_ = 0; rep_ < REPS(4); ++rep_) if (IN(4)) { if (rep_) xcd_barrier(bar); TIDS;
            const float* ALC = (const float*)(ws + WS_ALC);
            for (int i = bid * 512 + tid; i < 32768; i += nb * 512) {
                const int pp = i & 63, dir = (i >> 6) & 1, g = (i >> 7) & 31, b = i >> 12;
                const float ar = ALC[((dir * 32 + g) * 64 + pp) * 2], ai = ALC[((dir * 32 + g) * 64 + pp) * 2 + 1];
                float xr = 0.f, xi = 0.f;
                const float* Sg = SLOC + (size_t)g * M5 * 256 + dir * 128 + pp;
                for (int s = 0; s < NCC; ++s) {
                    const int j = dir ? NCC - 1 - s : s, m = M5LAT + b * NCC + j;
                    const float sr = Sg[(size_t)m * 256], si = Sg[(size_t)m * 256 + 64];
                    const float nr = ar * xr - ai * xi + sr, ni = ar * xi + ai * xr + si; xr = nr; xi = ni;
                }
                for (int s = 0; s < NCH; ++s) {
                    const int k = dir ? NCH - 1 - s : s, m = b * NCH + k;
                    bf16_t* dst = US5 + ((size_t)(g * M5PAD + m)) * KT5 + 512 + dir * 128 + pp;
                    dst[0] = (bf16_t)f2bf(xr); dst[64] = (bf16_t)f2bf(xi);
                    const float sr = Sg[(size_t)m * 256], si = Sg[(size_t)m * 256 + 64];
                    const float nr = ar * xr - ai * xi + sr, ni = ar * xi + ai * xr + si; xr = nr; xi = ni;
                }
            }
            const float* SA = (const float*)(ws + WS_SA); const float* SB = (const float*)(ws + WS_SB); float* HIN = (float*)(ws + WS_HIN);
            for (int i = bid * 512 + tid; i < 8192; i += nb * 512) {
                const int chn = i & 511, dir = (i >> 9) & 1, b = i >> 10;
                float H = 0.f;
                for (int s = 0; s < 4; ++s) { const int c = 64 + (dir ? 3 - s : s); const size_t o = ((size_t)(b * 68 + c) * 2 + dir) * 512 + chn; H = SA[o] * H + SB[o]; }
                for (int s = 0; s < 64; ++s) {
                    const int c = dir ? 63 - s : s; const size_t o = ((size_t)(b * 68 + c) * 2 + dir) * 512 + chn;
                    HIN[((size_t)(b * 64 + c) * 2 + dir) * 512 + chn] = H;
                    H = SA[o] * H + SB[o];
                }
            }
        }
        SEAM(4);
        for (int rep_ = 0; rep_ < REPS(5); ++rep_) if (IN(5)) { if (rep_) xcd_barrier(bar); TIDS;
            const bf16_t* BS5 = (const bf16_t*)(ws + WS_BS5);
            { S5Sched S{(const char*)US5, (const char*)BS5, KT5, 4, 2, 512, nb, bid}; EpiS5Out E{YS5}; gp::gemm_phase(lds, KT5, S, E); }
            __syncthreads();
            int bid_ = bid; asm volatile("" : "+s"(bid_));
            for (int it = bid_; it < NBATCH * 64 * 8; it += nb) { const int h = it & 7, q = it >> 3, ch = q & 63, b = q >> 6; lru_item<true>(p, lds, b, ch, h); }
        }
        SEAM(5);
        if (IN(6)) { TIDS;
            const bf16_t* BTGLU = (const bf16_t*)(ws + WS_BTGLU); const float* b_glu = p.in[18];
            PlainSched S{(const char*)YS5, (const char*)BTGLU, 512, 512, 128, 2, nb, bid};
            EpiGlu E{YS5, b_glu, YCAT};
            gp::gemm_phase(lds, 512, S, E);
        }
        SEAM(6);
        for (int rep_ = 0; rep_ < REPS(7); ++rep_) if (IN(7)) { if (rep_) xcd_barrier(bar); TIDS;
            const bf16_t* BTOUT = (const bf16_t*)(ws + WS_BTOUT);
            PlainSched S{(const char*)YCAT, (const char*)BTOUT, 1024, 1024, 128, 4, nb, bid};
            EpiF32 E{Y, 1024};
            gp::gemm_phase(lds, 1024, S, E);
        }
        SEAM(7);
        if (IN(8)) { TIDS;
            LAS float* Vs = (LAS float*)lds;
            LAS float* RWs = (LAS float*)(lds + 131584);
            LAS float* SEL = RWs; LAS float* SCO = RWs + 2048;
            LAS int* lcnt = (LAS int*)(lds + 147968); LAS int* gbase = lcnt + 64;
            const float* router_w = p.in[29]; const float* router_bias = p.in[30];
            for (int it = bid; it < T / 32; it += nb) {
                const int t0 = it * 32;
                if (tid < 64) lcnt[tid] = 0;
#pragma unroll 1
                for (int i = 0; i < 4; ++i) {
                    const int tl = wid * 4 + i; const size_t tok = (size_t)t0 + tl; const int b = (int)(tok >> 12);
                    const float* ada = ADA + b * 6144;
                    f32x4 z[4]; float s = 0.f;
#pragma unroll
                    for (int q = 0; q < 4; ++q) {
                        const int col = q * 256 + lane * 4;
                        const u32x2 hh = *(const u32x2*)(HB + tok * 1024 + col);
                        const f32x4 yv = *(const f32x4*)(Y + tok * 1024 + col);
                        const f32x4 g1 = *(const f32x4*)(ada + 2048 + col);
                        f32x4 hv; hv[0] = __uint_as_float(hh.x << 16); hv[1] = __uint_as_float(hh.x & 0xffff0000u); hv[2] = __uint_as_float(hh.y << 16); hv[3] = __uint_as_float(hh.y & 0xffff0000u);
                        z[q] = hv * ALPHA_F + g1 * yv;
                        s += (z[q][0] + z[q][1]) + (z[q][2] + z[q][3]);
                    }
                    const float mean = wave_sum(s) * (1.f / 1024.f); float qq = 0.f;
#pragma unroll
                    for (int q = 0; q < 4; ++q) { const f32x4 d = z[q] - mean; qq += (d[0] * d[0] + d[1] * d[1]) + (d[2] * d[2] + d[3] * d[3]); }
                    const float rstd = rsqrtf(wave_sum(qq) * (1.f / 1024.f) + LN_EPS_F);
#pragma unroll
                    for (int q = 0; q < 4; ++q) {
                        const int col = q * 256 + lane * 4;
                        const f32x4 gg = *(const f32x4*)(p.in[27] + col), bbv = *(const f32x4*)(p.in[28] + col);
                        const f32x4 h1 = (z[q] - mean) * rstd * gg + bbv;
                        { u32x2 wh; wh.x = pack2(h1[0], h1[1]); wh.y = pack2(h1[2], h1[3]); *(u32x2*)((bf16_t*)p.out + tok * 2048 + col) = wh; }
                        const f32x4 sc2 = *(const f32x4*)(ada + 4096 + col), sh2 = *(const f32x4*)(ada + 3072 + col);
                        const f32x4 v = h1 * (sc2 + 1.f) + sh2;
                        u32x2 w; w.x = pack2(v[0], v[1]); w.y = pack2(v[2], v[3]);
                        *(u32x2*)((bf16_t*)p.out + tok * 2048 + 1024 + col) = w;
                        *(LAS f32x4*)(Vs + tl * 1028 + col) = v;
                    }
                }
                __syncthreads();
                const int tt = tid >> 4, q16 = tid & 15;
                f32x4 lg = (f32x4){0.f, 0.f, 0.f, 0.f};
                for (int k0 = 0; k0 < 1024; k0 += 64) {
#pragma unroll
                    for (int i = 0; i < 2; ++i) { const int idx = tid + i * 512, kk = idx >> 4, e4 = (idx & 15) * 4; *(LAS f32x4*)(RWs + kk * 64 + e4) = *(const f32x4*)(router_w + (size_t)(k0 + kk) * 64 + e4); }
                    __syncthreads();
#pragma unroll 2
                    for (int kk = 0; kk < 64; kk += 4) {
                        const f32x4 v = *(LAS const f32x4*)(Vs + tt * 1028 + k0 + kk);
#pragma unroll
                        for (int u = 0; u < 4; ++u) { const f32x4 w = *(LAS const f32x4*)(RWs + (kk + u) * 64 + q16 * 4); lg += w * v[u]; }
                    }
                    __syncthreads();
                }
#pragma unroll
                for (int i = 0; i < 4; ++i) { const int e = q16 * 4 + i; const float sc = sigmoid_f(lg[i]); SCO[tt * 64 + e] = sc; SEL[tt * 64 + e] = sc + router_bias[e]; }
                __syncthreads();
                float gs[8];
#pragma unroll
                for (int gi = 0; gi < 8; ++gi) {
                    float m1 = -INFINITY, m2 = -INFINITY;
#pragma unroll
                    for (int j = 0; j < 8; ++j) { const float v = SEL[tt * 64 + gi * 8 + j]; if (v > m1) { m2 = m1; m1 = v; } else if (v > m2) m2 = v; }
                    gs[gi] = m1 + m2;
                }
                unsigned gmask = 0u;
#pragma unroll
                for (int gi = 0; gi < 8; ++gi) {
                    int rank = 0;
#pragma unroll
                    for (int hh = 0; hh < 8; ++hh) rank += (gs[hh] > gs[gi] || (gs[hh] == gs[gi] && hh < gi)) ? 1 : 0;
                    if (rank < 4) gmask |= 1u << gi;
                }
                bool chosen[4]; float scv[4]; int slot[4]; float mysum = 0.f;
#pragma unroll
                for (int i = 0; i < 4; ++i) {
                    const int e = q16 * 4 + i; chosen[i] = false; scv[i] = 0.f; slot[i] = 0;
                    if ((gmask >> (e >> 3)) & 1u) {
                        const float v = SEL[tt * 64 + e]; int rank = 0;
#pragma unroll 2
                        for (int j = 0; j < 64; ++j) { if ((gmask >> (j >> 3)) & 1u) { const float vj = SEL[tt * 64 + j]; rank += (vj > v || (vj == v && j < e)) ? 1 : 0; } }
                        if (rank < 8) { chosen[i] = true; slot[i] = rank; scv[i] = SCO[tt * 64 + e]; mysum += scv[i]; }
                    }
                }
                float wsum = mysum;
#pragma unroll
                for (int o = 1; o < 16; o <<= 1) wsum += __shfl_xor(wsum, o);
                int lrank[4];
#pragma unroll
                for (int i = 0; i < 4; ++i) { lrank[i] = 0; if (chosen[i]) lrank[i] = __hip_atomic_fetch_add(lcnt + q16 * 4 + i, 1, __ATOMIC_RELAXED, __HIP_MEMORY_SCOPE_WORKGROUP); }
                __syncthreads();
                const int hh = t0 >> 14;
                if (tid < 64) gbase[tid] = atomicAdd(CNT + hh * 64 + tid, lcnt[tid]);
                __syncthreads();
#pragma unroll
                for (int i = 0; i < 4; ++i) if (chosen[i]) {
                    const int e = q16 * 4 + i, rk = gbase[e] + lrank[i]; const size_t pos = (size_t)(hh * 64 + e) * HALF_T + rk;
                    LTOK[pos] = t0 + tt; LWT[pos] = scv[i] / wsum * 2.5f; PAIR[(size_t)(t0 + tt) * 8 + slot[i]] = (e << 16) | rk;
                }
                __syncthreads();
            }
        }
        SEAM(8);
        if (IN(9)) { TIDS;
            moe_tables(p, lds, 0);
            LAS const int* tp = (LAS const int*)(lds + MOE_TAB_OFF); LAS const int* pc = tp + 72; LAS const int* cn = pc + 72;
            MoeSched<true> S{tp, pc, cn, (const char*)p.out, (const char*)(ws + WS_BTGU), LTOK, 0, 2, tp[65] * 2, nb, bid};
            EpiMoeGU E{pc, cn, LWT, HMID, 0};
            gp::gemm_phase(lds, 1024, S, E);
        }
        SEAM(9);
        if (IN(10)) { TIDS;
            moe_tables(p, lds, 0);
            LAS const int* tp = (LAS const int*)(lds + MOE_TAB_OFF); LAS const int* pc = tp + 72; LAS const int* cn = pc + 72;
            MoeSched<false> S{tp, pc, cn, (const char*)HMID, (const char*)(ws + WS_BTDN), LTOK, 0, 4, tp[65] * 4, nb, bid};
            EpiMoeDN E{pc, cn, SLAB};
            gp::gemm_phase(lds, 256, S, E);
        }
        SEAM(10);
        if (IN(11)) { TIDS;
            {
                moe_tables(p, lds, 1);
                LAS const int* tp = (LAS const int*)(lds + MOE_TAB_OFF); LAS const int* pc = tp + 72; LAS const int* cn = pc + 72;
                MoeSched<true> S{tp, pc, cn, (const char*)p.out, (const char*)(ws + WS_BTGU), LTOK, 1, 2, tp[65] * 2, nb, bid};
                EpiMoeGU E{pc, cn, LWT, HMID, 1};
                gp::gemm_phase(lds, 1024, S, E);
            }
            __syncthreads();
            int bid_ = bid; asm volatile("" : "+s"(bid_));
            moe_tables(p, lds, 0);
            moe_reduce(p, lds, 0, bid_, nb);
        }
        SEAM(11);
        if (IN(12)) { TIDS;
            moe_tables(p, lds, 1);
            LAS const int* tp = (LAS const int*)(lds + MOE_TAB_OFF); LAS const int* pc = tp + 72; LAS const int* cn = pc + 72;
            MoeSched<false> S{tp, pc, cn, (const char*)HMID, (const char*)(ws + WS_BTDN), LTOK, 1, 4, tp[65] * 4, nb, bid};
            EpiMoeDN E{pc, cn, SLAB};
            gp::gemm_phase(lds, 256, S, E);
        }
        SEAM(12);
        if (IN(13)) { TIDS;
            moe_tables(p, lds, 1);
            moe_reduce(p, lds, 1, bid, nb);
        }
    }
}

extern "C" void kernel_launch(void* const* d_in, const int* in_sizes, int n_in, void* d_out, int out_size, void* d_ws, size_t ws_size, hipStream_t stream) {
    static int grid = 0;
    if (grid == 0) {
        if (n_in != 39 || out_size != T * D || ws_size < WS_END) { fprintf(stderr, "kernel_launch: unexpected problem (n_in %d, out %d, ws %zu); nothing launched\n", n_in, out_size, ws_size); grid = -1; return; }
        int dev = 0, cus = 0;
        if (hipGetDevice(&dev) != hipSuccess || hipDeviceGetAttribute(&cus, hipDeviceAttributeMultiprocessorCount, dev) != hipSuccess) { grid = -1; return; }
        if (hipFuncSetAttribute((const void*)mk_fwd, hipFuncAttributeMaxDynamicSharedMemorySize, LDS_BYTES) != hipSuccess) { fprintf(stderr, "kernel_launch: hipFuncSetAttribute failed\n"); grid = -1; return; }
        grid = cus > 0 ? cus : 256;
    }
    if (grid < 0) return;
    (void)in_sizes;
    if (hipMemsetAsync((char*)d_ws + WS_CTL, 0, CTL_ZERO_BYTES, stream) != hipSuccess) return;
    Params p{};
    for (int i = 0; i < 39; ++i) p.in[i] = (const float*)d_in[i];
    p.out = (float*)d_out; p.ws = (unsigned char*)d_ws;
#if MK_N_LAUNCHES == 1
    p.ph_lo = 0; p.ph_hi = NPHASE;
    hipLaunchKernelGGL(mk_fwd, dim3(grid), dim3(512), LDS_BYTES, stream, p);
#else
    for (int ph = 0; ph < NPHASE; ++ph) {
        p.ph_lo = ph; p.ph_hi = ph + 1;
        hipLaunchKernelGGL(mk_fwd, dim3(grid), dim3(512), LDS_BYTES, stream, p);
    }
#endif
}
```

```cpp
#include <hip/hip_runtime.h>
#include <cstdio>
#include <cstdint>

#ifndef MK_N_LAUNCHES
#define MK_N_LAUNCHES 1
#endif

#define DEV __device__ __forceinline__
#define LAS __attribute__((address_space(3)))
typedef unsigned short bf16_t;
typedef short bf16x8 __attribute__((ext_vector_type(8)));
typedef float f32x4 __attribute__((ext_vector_type(4)));
typedef unsigned u32x2 __attribute__((ext_vector_type(2)));
typedef unsigned u32x4 __attribute__((ext_vector_type(4)));

constexpr int D = 1024, NBATCH = 8, SEQ = 4096, T = NBATCH * SEQ, CTXL = 256, TC = NBATCH * CTXL, TT = T + TC;
constexpr int NWIN = 1536;
constexpr int LC = 32, KT5 = 768, NCH = SEQ / LC  , NCC = CTXL / LC  ;
constexpr int M5LAT = NBATCH * NCH  , M5 = M5LAT + NBATCH * NCC  , M5PAD = 1280;
constexpr int NE = 64;
constexpr int NPHASE = 14;
constexpr int HALF_T = T / 2;
constexpr float ALPHA_F = 1.189207115002721f, LN_EPS_F = 1e-5f;

constexpr size_t MiB = 1u << 20;
constexpr size_t WS_CTL = 0, CTL_ZERO_BYTES = 65536;
constexpr size_t WS_CNT = 32768;
constexpr size_t WS_ADA = 65536;
constexpr size_t WS_BIASIN = 512 * 1024;
constexpr size_t WS_ALC = 640 * 1024;
constexpr size_t WS_SA = 1 * MiB, WS_SB = 4 * MiB, WS_HIN = 7 * MiB;
constexpr size_t WS_BTGLU = 10 * MiB;
constexpr size_t WS_BTOUT = 10 * MiB + 512 * 1024;
constexpr size_t WS_BTLRU = 12 * MiB + 512 * 1024;
constexpr size_t WS_BS5 = 13 * MiB;
constexpr size_t WS_ES5 = 37 * MiB;
constexpr size_t WS_BTGU = 45 * MiB;
constexpr size_t WS_BTDN = 110 * MiB;
constexpr size_t WS_HB = 143 * MiB;
constexpr size_t WS_BTIN = 211 * MiB;
constexpr size_t WS_HM = 366 * MiB;
constexpr size_t WS_US5 = 238 * MiB;
constexpr size_t WS_ULRU = 298 * MiB;
constexpr size_t WS_SLOC = 366 * MiB;
constexpr size_t WS_YS5 = 400 * MiB;
constexpr size_t WS_YCAT = 448 * MiB;
constexpr size_t WS_Y = 295 * MiB;
constexpr size_t WS_LTOK = 10 * MiB;
constexpr size_t WS_LWT = 18 * MiB;
constexpr size_t WS_PAIR = 26 * MiB;
constexpr size_t WS_HMID = 143 * MiB;
constexpr size_t WS_SLAB = 216 * MiB;
constexpr size_t WS_END = 512 * MiB;

constexpr int LDS_BYTES = 155648;
constexpr int MISC_OFF = LDS_BYTES - 256;

DEV float bf2f(bf16_t h) { return __uint_as_float(((unsigned)h) << 16); }
DEV unsigned f2bf(float f) { unsigned u = __float_as_uint(f); return (u + 0x7fffu + ((u >> 16) & 1u)) >> 16; }
DEV unsigned pack2(float a, float b) { return f2bf(a) | (f2bf(b) << 16); }
DEV float sigmoid_f(float x) { return 1.f / (1.f + __expf(-x)); }
DEV float gelu_tanh(float x) {
    const float z = 0.7978845608028654f * (x + 0.044715f * x * x * x);
    const float e = __expf(2.f * z);
    const float t = 1.f - 2.f / (e + 1.f);
    return 0.5f * x * (1.f + t);
}
DEV float wave_sum(float v) {
#pragma unroll
    for (int o = 1; o < 64; o <<= 1) v += __shfl_xor(v, o);
    return v;
}

struct Params { const float* in[39]; float* out; unsigned char* ws; int ph_lo, ph_hi; };

#define XB_TMO      128
#define XB_XCNT(j)  (256  + 64 * (j))
#define XB_XSUB(j)  (1280 + 64 * (j))
#define XB_XGEN(j)  (2304 + 64 * (j))
#define XB_TOP      3328
#define XB_TOPGEN   3392
#define XCD_BAR_WORDS 3456
#define XB_SPIN_CAP (1u << 20)
DEV unsigned xb_ld(unsigned* p)              { return __hip_atomic_load(p, __ATOMIC_RELAXED, __HIP_MEMORY_SCOPE_AGENT); }
DEV unsigned xb_add(unsigned* p, unsigned v) { return __hip_atomic_fetch_add(p, v, __ATOMIC_RELAXED, __HIP_MEMORY_SCOPE_AGENT); }
DEV unsigned xb_xcc_id() { return (unsigned)__builtin_amdgcn_s_getreg((3 << 11) | 20) & 0xFu; }
#define XB_SPIN(cond, bar) do { unsigned _sp = 0; while (cond) { __builtin_amdgcn_s_sleep(1); \
    if ((++_sp & 255u) == 0u) { if (xb_ld(&(bar)[XB_TMO])) break; if (_sp > XB_SPIN_CAP) { atomicAdd(&(bar)[XB_TMO], 1u); break; } } } } while (0)
struct XcdBarrier { unsigned* bar; unsigned x; volatile LAS unsigned* st; };
DEV XcdBarrier xcd_barrier_post(unsigned* bar, volatile LAS unsigned* st) {
    XcdBarrier b; b.bar = bar; b.x = xb_xcc_id(); b.st = st;
    if (threadIdx.x == 0) (void)xb_add(&bar[XB_XCNT(b.x)], 1u);
    return b;
}
DEV void xcd_barrier_complete(unsigned* bar, unsigned x, unsigned& nloc, unsigned& nx) {
    const unsigned G = gridDim.x * gridDim.y * gridDim.z;
    unsigned sum, cnt, mine, sp = 0u;
    for (;;) {
        sum = 0u; cnt = 0u; mine = 0u;
#pragma unroll
        for (unsigned j = 0; j < 16; ++j) { const unsigned c = xb_ld(&bar[XB_XCNT(j)]); sum += c; cnt += (c > 0u) ? 1u : 0u; mine = (j == x) ? c : mine; }
        if (sum == G) break;
        __builtin_amdgcn_s_sleep(1);
        if ((++sp & 255u) == 0u) { if (xb_ld(&bar[XB_TMO])) break; if (sp > XB_SPIN_CAP) { atomicAdd(&bar[XB_TMO], 1u); break; } }
    }
    nloc = mine > 0u ? mine : 1u; nx = cnt > 0u ? cnt : 1u;
}
DEV void xcd_barrier(const XcdBarrier& b) {
    asm volatile("s_waitcnt vmcnt(0)" ::: "memory");
    __syncthreads();
    if (threadIdx.x == 0) {
        unsigned* bar = b.bar;
        __builtin_amdgcn_s_waitcnt(0);
        unsigned nloc = b.st[0], nx = b.st[1];
        if (nloc == 0u) { xcd_barrier_complete(bar, b.x, nloc, nx); b.st[0] = nloc; b.st[1] = nx; }
        const unsigned old = xb_add(&bar[XB_XSUB(b.x)], 1u);
        const unsigned gen = old / nloc;
        if (old + 1u == (gen + 1u) * nloc) {
            __builtin_amdgcn_fence(__ATOMIC_RELEASE, "agent");
            asm volatile("s_waitcnt vmcnt(0)" ::: "memory");
            const unsigned og = xb_add(&bar[XB_TOP], 1u);
            const unsigned tg = og / nx;
            if (og + 1u == (tg + 1u) * nx) xb_add(&bar[XB_TOPGEN], 1u);
            else XB_SPIN(xb_ld(&bar[XB_TOPGEN]) == tg, bar);
            __builtin_amdgcn_fence(__ATOMIC_ACQUIRE, "agent");
            xb_add(&bar[XB_XGEN(b.x)], 1u);
            asm volatile("s_waitcnt vmcnt(0)" ::: "memory");
        } else {
            XB_SPIN(xb_ld(&bar[XB_XGEN(b.x)]) == gen, bar);
            __builtin_amdgcn_fence(__ATOMIC_ACQUIRE, "agent");
            asm volatile("s_waitcnt vmcnt(0)" ::: "memory");
        }
    }
    __syncthreads();
}

constexpr int GEMM_LDS = 61440;
template <class ARow, class Epi>
DEV void gemm_unit(LAS unsigned char* lds, const ARow& arow, const bf16_t* __restrict__ Bt, int K, const Epi& epi) {
    const int tid = threadIdx.x, wid = tid >> 6, lane = tid & 63, wr = wid >> 1, wc = wid & 1, fr = lane & 15, fq = lane >> 4;
    LAS unsigned char* As = lds;
    LAS unsigned char* Bs = lds + 40960;
    const u32x4* pa0 = (const u32x4*)arow(tid >> 2) + (tid & 3);
    const u32x4* pa1 = (const u32x4*)arow(128 + (tid >> 2)) + (tid & 3);
    const u32x4* pb = (const u32x4*)(Bt + (size_t)(tid >> 2) * K) + (tid & 3);
    const int sa0 = (tid >> 2) * 80 + (tid & 3) * 16, sa1 = sa0 + 128 * 80;
    f32x4 acc[4][4];
#pragma unroll
    for (int i = 0; i < 4; ++i)
#pragma unroll
        for (int j = 0; j < 4; ++j) acc[i][j] = (f32x4){0.f, 0.f, 0.f, 0.f};
    const int nk = K >> 5;
    u32x4 ra0 = pa0[0], ra1 = pa1[0], rb = pb[0];
    *(LAS u32x4*)(As + sa0) = ra0; *(LAS u32x4*)(As + sa1) = ra1; *(LAS u32x4*)(Bs + sa0) = rb;
    __syncthreads();
    for (int kt = 0; kt < nk; ++kt) {
        const int cur = kt & 1;
        if (kt + 1 < nk) { ra0 = pa0[(kt + 1) * 4]; ra1 = pa1[(kt + 1) * 4]; rb = pb[(kt + 1) * 4]; }
        LAS const unsigned char* Ac = As + cur * 20480 + (wr * 64 + fr) * 80 + fq * 16;
        LAS const unsigned char* Bc = Bs + cur * 10240 + (wc * 64 + fr) * 80 + fq * 16;
        bf16x8 af[4], bfv[4];
#pragma unroll
        for (int i = 0; i < 4; ++i) af[i] = *(LAS const bf16x8*)(Ac + i * 1280);
#pragma unroll
        for (int j = 0; j < 4; ++j) bfv[j] = *(LAS const bf16x8*)(Bc + j * 1280);
#pragma unroll
        for (int i = 0; i < 4; ++i)
#pragma unroll
            for (int j = 0; j < 4; ++j) acc[i][j] = __builtin_amdgcn_mfma_f32_16x16x32_bf16(bfv[j], af[i], acc[i][j], 0, 0, 0);
        if (kt + 1 < nk) {
            const int nx = cur ^ 1;
            *(LAS u32x4*)(As + nx * 20480 + sa0) = ra0; *(LAS u32x4*)(As + nx * 20480 + sa1) = ra1; *(LAS u32x4*)(Bs + nx * 10240 + sa0) = rb;
        }
        __syncthreads();
    }
    epi(acc, wr * 64 + fr, wc * 64 + 4 * fq);
}

namespace gp {
constexpr int BK = 64, HALF = 128, HTB = HALF * BK * 2, STAGE_BYTES = 8 * HTB;
DEV int lds_byte(int r, int c) { const int st = (r >> 4) * 2 + (c >> 5), rr = r & 15, cc = c & 31, ob = rr * 64 + cc * 2; return st * 1024 + (ob ^ (((ob >> 9) & 1) << 5)); }
DEV void stage_rc(int b, int& R, int& C) { const int st = b / 1024, sb = b % 1024, swz = sb ^ (((sb >> 9) & 1) << 5); R = (st >> 1) * 16 + swz / 64; C = (st & 1) * 32 + (swz % 64) / 2; }
DEV int perm32(int rho) { const int n = rho >> 4, i = rho & 15; return 8 * (i >> 2) + 4 * n + (i & 3); }
struct UAddr { const char* a; const char* b; unsigned ao00, ao01, ao10, ao11; };
template <class Epi, class Sched>
DEV void gemm_phase(LAS unsigned char* lds, const int K, const Sched& S, const Epi& E) {
    typedef typename Sched::Unit Unit;
    const int tid = threadIdx.x, wid = __builtin_amdgcn_readfirstlane(tid >> 6), lane = tid & 63, wr = wid >> 2, wc = wid & 3, fr = lane & 15, fq = lane >> 4;
    const int nt = K / BK;
    int R0, C0, R1, C1; stage_rc(tid * 16, R0, C0); stage_rc(tid * 16 + 8192, R1, C1);
    const int Rb0 = Epi::PERM ? ((R0 & ~31) + perm32(R0 & 31)) : R0, Rb1 = Epi::PERM ? ((R1 & ~31) + perm32(R1 & 31)) : R1;
    const unsigned vb0 = (unsigned)(Rb0 * K + C0) * 2u, vb1 = (unsigned)(Rb1 * K + C1) * 2u;
    const size_t kstep = (size_t)(BK * 2);
    const size_t hstepB = (size_t)HALF * K * 2;
    const int lda_ = S.lda();
    const unsigned va0 = (unsigned)(R0 * lda_ + C0) * 2u, va1 = (unsigned)(R1 * lda_ + C1) * 2u;
    const size_t hstepA = (size_t)HALF * lda_ * 2;
    const unsigned ldsw = (unsigned)wid * 1024u;
    const int aoff = lds_byte(wr * 64 + fr, fq * 8), boff = lds_byte(wc * 32 + fr, fq * 8);
#define GP_SA(b, h) (((b) * 2 + (h)) * HTB)
#define GP_SB(b, h) ((4 + (b) * 2 + (h)) * HTB)
#define GP_GLDS(gp_, bufoff, i_) __builtin_amdgcn_global_load_lds((const unsigned*)(gp_), (LAS unsigned*)(lds + (bufoff) + ldsw + (i_) * 8192), 16, 0, 0)
#define GP_STAGE_A(bufoff, ab, o0, o1, h, kb) do { if constexpr (Sched::GATHER) { const char* up_ = (ab) + (kb); GP_GLDS(up_ + (o0), bufoff, 0); GP_GLDS(up_ + (o1), bufoff, 1); } \
        else { const char* up_ = (ab) + (((h) ? hstepA : (size_t)0) + (kb)); GP_GLDS(up_ + va0, bufoff, 0); GP_GLDS(up_ + va1, bufoff, 1); } } while (0)
#define GP_STAGE_B(bufoff, bb, h, kb) do { const char* up_ = (bb) + (((h) ? hstepB : (size_t)0) + (kb)); GP_GLDS(up_ + vb0, bufoff, 0); GP_GLDS(up_ + vb1, bufoff, 1); } while (0)
#define GP_LDA(dst, b, h) do { _Pragma("unroll") for (int m = 0; m < 4; ++m) _Pragma("unroll") for (int k = 0; k < 2; ++k) dst[m][k] = *(const LAS bf16x8*)(lds + GP_SA(b, h) + aoff + m * 2048 + k * 1024); } while (0)
#define GP_LDB(dst, b, h) do { _Pragma("unroll") for (int n = 0; n < 2; ++n) _Pragma("unroll") for (int k = 0; k < 2; ++k) dst[n][k] = *(const LAS bf16x8*)(lds + GP_SB(b, h) + boff + n * 2048 + k * 1024); } while (0)
#define GP_MMA(ai, bj, At, Bt) do { __builtin_amdgcn_s_setprio(1); _Pragma("unroll") for (int m = 0; m < 4; ++m) _Pragma("unroll") for (int n = 0; n < 2; ++n) _Pragma("unroll") for (int k = 0; k < 2; ++k) \
        acc[ai][bj][m][n] = __builtin_amdgcn_mfma_f32_16x16x32_bf16(Bt[n][k], At[m][k], acc[ai][bj][m][n], 0, 0, 0); __builtin_amdgcn_s_setprio(0); } while (0)
#define GP_WAIT_V(n) asm volatile("s_waitcnt vmcnt(" #n ")" ::: "memory")
#define GP_WAIT_L(n) asm volatile("s_waitcnt lgkmcnt(" #n ")" ::: "memory")
#define GP_BAR __builtin_amdgcn_s_barrier()
#define GP_SCHED __builtin_amdgcn_sched_barrier(0)
    Unit cur, nxt; int ui = 0;
    if (!S.next(0, cur)) return;
    const char* cA; const char* cB; unsigned c00 = 0, c01 = 0, c10 = 0, c11 = 0;
    const char* nA; const char* nB; unsigned n00 = 0, n01 = 0, n10 = 0, n11 = 0;
    { UAddr t_; S.addr(cur, R0, C0, R1, C1, t_); cA = t_.a; cB = t_.b; if constexpr (Sched::GATHER) { c00 = t_.ao00; c01 = t_.ao01; c10 = t_.ao10; c11 = t_.ao11; } }
    f32x4 acc[2][2][4][2];
#pragma unroll
    for (int a = 0; a < 2; ++a)
#pragma unroll
        for (int b = 0; b < 2; ++b)
#pragma unroll
            for (int m = 0; m < 4; ++m)
#pragma unroll
                for (int n = 0; n < 2; ++n) acc[a][b][m][n] = (f32x4){0.f, 0.f, 0.f, 0.f};
    bf16x8 At[4][2], B0[2][2], B1[2][2];
    GP_STAGE_B(GP_SB(0, 0), cB, 0, 0); GP_STAGE_B(GP_SB(0, 1), cB, 1, 0); GP_STAGE_A(GP_SA(0, 0), cA, c00, c01, 0, 0); GP_STAGE_A(GP_SA(0, 1), cA, c10, c11, 1, 0);
    if (wr == 1) GP_BAR;
    GP_WAIT_V(2); GP_BAR;
    GP_STAGE_B(GP_SB(1, 0), cB, 0, kstep); GP_STAGE_A(GP_SA(1, 0), cA, c00, c01, 0, kstep); GP_STAGE_B(GP_SB(1, 1), cB, 1, kstep);
    GP_WAIT_V(6); GP_BAR;
    for (;;) {
        const bool has_next = S.next(ui + 1, nxt);
        if (has_next) { UAddr t_; S.addr(nxt, R0, C0, R1, C1, t_); nA = t_.a; nB = t_.b; if constexpr (Sched::GATHER) { n00 = t_.ao00; n01 = t_.ao01; n10 = t_.ao10; n11 = t_.ao11; } }
        else { nA = cA; nB = cB; n00 = c00; n01 = c01; n10 = c10; n11 = c11; }
#pragma unroll 1
        for (int t = 0; t < nt; t += 2) {
            const bool last = (t == nt - 2);
            const size_t k1 = (size_t)(t + 1) * kstep;
            const char* sA = last ? nA : cA; const char* sB = last ? nB : cB;
            const unsigned s00 = last ? n00 : c00, s01 = last ? n01 : c01, s10 = last ? n10 : c10, s11 = last ? n11 : c11;
            const size_t k2 = last ? (size_t)0 : (size_t)(t + 2) * kstep, k3 = k2 + kstep;
            GP_LDB(B0, 0, 0); GP_LDB(B1, 0, 1); GP_SCHED; GP_LDA(At, 0, 0); GP_STAGE_A(GP_SA(1, 1), cA, c10, c11, 1, k1);
            GP_WAIT_V(8); GP_WAIT_L(0); GP_BAR; GP_MMA(0, 0, At, B0); GP_MMA(0, 1, At, B1); GP_BAR; GP_SCHED;
            GP_LDA(At, 0, 1); GP_STAGE_B(GP_SB(0, 0), sB, 0, k2); GP_STAGE_B(GP_SB(0, 1), sB, 1, k2); GP_STAGE_A(GP_SA(0, 0), sA, s00, s01, 0, k2);
            GP_WAIT_V(8); GP_WAIT_L(0); GP_BAR; GP_MMA(1, 0, At, B0); GP_MMA(1, 1, At, B1); GP_BAR; GP_SCHED;
            GP_LDB(B0, 1, 0); GP_LDB(B1, 1, 1); GP_SCHED; GP_LDA(At, 1, 0); GP_STAGE_A(GP_SA(0, 1), sA, s10, s11, 1, k2);
            GP_WAIT_V(8); GP_WAIT_L(0); GP_BAR; GP_MMA(0, 0, At, B0); GP_MMA(0, 1, At, B1); GP_BAR; GP_SCHED;
            GP_LDA(At, 1, 1); GP_STAGE_B(GP_SB(1, 0), sB, 0, k3); GP_STAGE_B(GP_SB(1, 1), sB, 1, k3); GP_STAGE_A(GP_SA(1, 0), sA, s00, s01, 0, k3);
            GP_WAIT_V(8); GP_WAIT_L(0); GP_BAR; GP_MMA(1, 0, At, B0); GP_MMA(1, 1, At, B1); GP_BAR; GP_SCHED;
        }
        if (wr == 0) GP_BAR;
        E(acc, cur, wr, wc, fr, fq);
        if (!has_next) break;
#pragma unroll
        for (int a = 0; a < 2; ++a)
#pragma unroll
            for (int b = 0; b < 2; ++b)
#pragma unroll
                for (int m = 0; m < 4; ++m)
#pragma unroll
                    for (int n = 0; n < 2; ++n) acc[a][b][m][n] = (f32x4){0.f, 0.f, 0.f, 0.f};
        cur = nxt; cA = nA; cB = nB; c00 = n00; c01 = n01; c10 = n10; c11 = n11; ++ui;
        if (wr == 1) GP_BAR;
    }
    GP_WAIT_V(0);
    GP_BAR;
#undef GP_SA
#undef GP_SB
#undef GP_GLDS
#undef GP_STAGE_A
#undef GP_STAGE_B
#undef GP_LDA
#undef GP_LDB
#undef GP_MMA
#undef GP_WAIT_V
#undef GP_WAIT_L
#undef GP_BAR
#undef GP_SCHED
}
DEV bool static_order(int i, int G, int c, int nM, int nN, int& pm, int& pn) {
    const int nwg = nM * nN; const long L = (long)i * G + c; if (L >= nwg) return false;
    int wgid = (int)L; { const int q = nwg / 8, r = nwg % 8, xcd = wgid % 8, off = wgid / 8; wgid = (xcd < r ? xcd * (q + 1) : r * (q + 1) + (xcd - r) * q) + off; }
    const int nig = 8 * nN, gid = wgid / nig, fm = gid * 8, gsz = (nM - fm) < 8 ? (nM - fm) : 8;
    pm = fm + ((wgid % nig) % gsz); pn = (wgid % nig) / gsz; return true;
}
}

struct PlainSched {
    struct Unit { int pm, pn; };
    static constexpr bool GATHER = false;
    const char* A; const char* Bt; int lda_, K, nM, nN, G, c;
    DEV int lda() const { return lda_; }
    DEV bool next(int i, Unit& u) const { return gp::static_order(i, G, c, nM, nN, u.pm, u.pn); }
    DEV void addr(const Unit& u, int R0, int C0, int R1, int C1, gp::UAddr& o) const {
        o.a = A + (size_t)u.pm * 256 * lda_ * 2; o.b = Bt + (size_t)u.pn * 256 * K * 2;
    }
};
struct EpiF32 {
    static constexpr bool PERM = false;
    float* O; int ldc;
    template <class U> DEV void operator()(const f32x4 (&acc)[2][2][4][2], const U& u, int wr, int wc, int fr, int fq) const {
        const int row0 = u.pm * 256 + wr * 64 + fr, col0 = u.pn * 256 + wc * 32 + 4 * fq;
#pragma unroll
        for (int ai = 0; ai < 2; ++ai)
#pragma unroll
            for (int m = 0; m < 4; ++m) {
                float* rowp = O + (size_t)(row0 + ai * 128 + m * 16) * ldc + col0;
#pragma unroll
                for (int bj = 0; bj < 2; ++bj)
#pragma unroll
                    for (int n = 0; n < 2; ++n) *(f32x4*)(rowp + bj * 128 + n * 16) = acc[ai][bj][m][n];
            }
    }
};

DEV void bf8_unpack(const u32x4 w, float (&y)[8]) {
    y[0] = __uint_as_float(w.x << 16); y[1] = __uint_as_float(w.x & 0xffff0000u); y[2] = __uint_as_float(w.y << 16); y[3] = __uint_as_float(w.y & 0xffff0000u);
    y[4] = __uint_as_float(w.z << 16); y[5] = __uint_as_float(w.z & 0xffff0000u); y[6] = __uint_as_float(w.w << 16); y[7] = __uint_as_float(w.w & 0xffff0000u);
}
struct WinSched {
    struct Unit { int pm, pn; };
    static constexpr bool GATHER = false;
    const char* A; const char* Bt; int G, c;
    DEV int lda() const { return 1024; }
    DEV bool next(int i, Unit& u) const { return gp::static_order(i, G, c, 136, 6, u.pm, u.pn); }
    DEV void addr(const Unit& u, int R0, int C0, int R1, int C1, gp::UAddr& o) const {
        o.a = A + (size_t)u.pm * 256 * 1024 * 2; o.b = Bt + ((size_t)u.pn * 256) * 1024 * 2;
    }
};
struct EpiWin {
    static constexpr bool PERM = true;
    bf16_t* US5; bf16_t* ULRU;
    template <class U> DEV void operator()(const f32x4 (&acc)[2][2][4][2], const U& u, int wr, int wc, int fr, int fq) const {
#pragma unroll
        for (int bj = 0; bj < 2; ++bj) {
            const int col8 = u.pn * 256 + bj * 128 + wc * 32 + 8 * fq;
#pragma unroll
            for (int ai = 0; ai < 2; ++ai)
#pragma unroll
                for (int m = 0; m < 4; ++m) {
                    const int row = u.pm * 256 + ai * 128 + wr * 64 + m * 16 + fr;
                    const f32x4 v0 = acc[ai][bj][m][0], v1 = acc[ai][bj][m][1];
                    u32x4 w; w.x = pack2(v0[0], v0[1]); w.y = pack2(v0[2], v0[3]); w.z = pack2(v1[0], v1[1]); w.w = pack2(v1[2], v1[3]);
                    if (col8 < 512) {
                        int mm, ss;
                        if (row < T) { const int bq = row >> 12, t = row & 4095; mm = bq * 128 + (t >> 5); ss = t & 31; }
                        else { const int q = row - T, bq = q >> 8, j = q & 255; mm = M5LAT + bq * 8 + (j >> 5); ss = j & 31; }
                        *(u32x4*)(US5 + ((size_t)((col8 >> 4) * M5PAD + mm)) * KT5 + ss * 16 + (col8 & 15)) = w;
                    } else *(u32x4*)(ULRU + (size_t)row * 1024 + (col8 - 512)) = w;
                }
        }
    }
};
struct S5Sched {
    struct Unit { int g, pm, pn; };
    static constexpr bool GATHER = false;
    const char* A; const char* Bt; int K, nPm, nPn, brows  , G, c;
    DEV int lda() const { return KT5; }
    DEV bool next(int i, Unit& u) const {
        if (i > 0) return false;
        const int per = nPm * nPn * 4;
        const int x = c & 7, j = c >> 3; if (j >= per) return false;
        const int U = x * per + j; u.g = U / (nPm * nPn); const int r = U % (nPm * nPn); u.pm = r / nPn; u.pn = r % nPn; return true;
    }
    DEV void addr(const Unit& u, int R0, int C0, int R1, int C1, gp::UAddr& o) const {
        o.a = A + ((size_t)u.g * M5PAD + u.pm * 256) * KT5 * 2; o.b = Bt + ((size_t)u.g * brows + u.pn * 256) * K * 2;
    }
};
struct EpiS5Loc {
    static constexpr bool PERM = false;
    float* SLOC;
    template <class U> DEV void operator()(const f32x4 (&acc)[2][2][4][2], const U& u, int wr, int wc, int fr, int fq) const {
#pragma unroll
        for (int ai = 0; ai < 2; ++ai)
#pragma unroll
            for (int m = 0; m < 4; ++m) {
                const int mm = u.pm * 256 + ai * 128 + wr * 64 + m * 16 + fr;
                if (mm < M5) {
                    float* rowp = SLOC + ((size_t)(u.g * M5 + mm)) * 256 + wc * 32 + 4 * fq;
#pragma unroll
                    for (int bj = 0; bj < 2; ++bj)
#pragma unroll
                        for (int n = 0; n < 2; ++n) *(f32x4*)(rowp + bj * 128 + n * 16) = acc[ai][bj][m][n];
                }
            }
    }
};
struct EpiS5Out {
    static constexpr bool PERM = true;
    bf16_t* YS5;
    template <class U> DEV void operator()(const f32x4 (&acc)[2][2][4][2], const U& u, int wr, int wc, int fr, int fq) const {
#pragma unroll
        for (int ai = 0; ai < 2; ++ai)
#pragma unroll
            for (int m = 0; m < 4; ++m) {
                const int mm = u.pm * 256 + ai * 128 + wr * 64 + m * 16 + fr, bq = mm >> 7, chunk = mm & 127;
#pragma unroll
                for (int bj = 0; bj < 2; ++bj) {
                    const int n8 = u.pn * 256 + bj * 128 + wc * 32 + 8 * fq, t = n8 >> 4, c0 = n8 & 15;
                    const size_t tok = (size_t)bq * 4096 + chunk * 32 + t;
                    const f32x4 v0 = acc[ai][bj][m][0], v1 = acc[ai][bj][m][1];
                    u32x4 w; w.x = pack2(gelu_tanh(v0[0]), gelu_tanh(v0[1])); w.y = pack2(gelu_tanh(v0[2]), gelu_tanh(v0[3]));
                    w.z = pack2(gelu_tanh(v1[0]), gelu_tanh(v1[1])); w.w = pack2(gelu_tanh(v1[2]), gelu_tanh(v1[3]));
                    *(u32x4*)(YS5 + tok * 512 + u.g * 16 + c0) = w;
                }
            }
    }
};
struct EpiGlu {
    static constexpr bool PERM = true;
    const bf16_t* YS5; const float* b_glu; bf16_t* YCAT;
    template <class U> DEV void operator()(const f32x4 (&acc)[2][2][4][2], const U& u, int wr, int wc, int fr, int fq) const {
#pragma unroll
        for (int bj = 0; bj < 2; ++bj) {
            const int col8 = u.pn * 256 + bj * 128 + wc * 32 + 8 * fq;
            const f32x4 b0 = *(const f32x4*)(b_glu + col8), b1 = *(const f32x4*)(b_glu + col8 + 4);
#pragma unroll
            for (int ai = 0; ai < 2; ++ai)
#pragma unroll
                for (int m = 0; m < 4; ++m) {
                    const size_t row = (size_t)u.pm * 256 + ai * 128 + wr * 64 + m * 16 + fr;
                    float y[8]; bf8_unpack(*(const u32x4*)(YS5 + row * 512 + col8), y);
                    const f32x4 z0 = acc[ai][bj][m][0] + b0, z1 = acc[ai][bj][m][1] + b1;
                    u32x4 w; w.x = pack2(y[0] * sigmoid_f(z0[0]), y[1] * sigmoid_f(z0[1])); w.y = pack2(y[2] * sigmoid_f(z0[2]), y[3] * sigmoid_f(z0[3]));
                    w.z = pack2(y[4] * sigmoid_f(z1[0]), y[5] * sigmoid_f(z1[1])); w.w = pack2(y[6] * sigmoid_f(z1[2]), y[7] * sigmoid_f(z1[3]));
                    *(u32x4*)(YCAT + row * 1024 + col8) = w;
                }
        }
    }
};

DEV void tr_tile_wave(const float* __restrict__ W, int ldw, int k0, int n0, bf16_t* __restrict__ dst, int ldd, int mode, LAS float* tile, int lane) {
    f32x4 v[16];
#pragma unroll
    for (int i = 0; i < 16; ++i) v[i] = *(const f32x4*)(W + (size_t)(k0 + i * 4 + (lane >> 4)) * ldw + n0 + (lane & 15) * 4);
#pragma unroll
    for (int i = 0; i < 16; ++i) { LAS float* tp = tile + (i * 4 + (lane >> 4)) * 65 + (lane & 15) * 4; tp[0] = v[i][0]; tp[1] = v[i][1]; tp[2] = v[i][2]; tp[3] = v[i][3]; }
    __builtin_amdgcn_fence(__ATOMIC_RELEASE, "wavefront"); __builtin_amdgcn_wave_barrier(); __builtin_amdgcn_fence(__ATOMIC_ACQUIRE, "wavefront");
    const int kc = lane & 7;
#pragma unroll
    for (int jn = 0; jn < 8; ++jn) {
        const int nn = (lane >> 3) + 8 * jn;
        float e[8];
#pragma unroll
        for (int jj = 0; jj < 8; ++jj) e[jj] = tile[(kc * 8 + jj) * 65 + nn];
        const int j = n0 + nn;
        const int row = mode == 0 ? j : (((j >> 4) << 5) + (j & 15) + (mode == 2 ? 16 : 0));
        u32x4 w; w.x = pack2(e[0], e[1]); w.y = pack2(e[2], e[3]); w.z = pack2(e[4], e[5]); w.w = pack2(e[6], e[7]);
        *(u32x4*)(dst + (size_t)row * ldd + k0 + kc * 8) = w;
    }
    __builtin_amdgcn_fence(__ATOMIC_RELEASE, "wavefront"); __builtin_amdgcn_wave_barrier(); __builtin_amdgcn_fence(__ATOMIC_ACQUIRE, "wavefront");
}

DEV void gemv9_item(LAS const float* S, const float* __restrict__ W, int ldw, int col0, const float* __restrict__ bias, float* __restrict__ out, int ldo, LAS float* red) {
    const int tid = threadIdx.x, col = tid & 31, kp = tid >> 5;
    float acc[9];
#pragma unroll
    for (int b = 0; b < 9; ++b) acc[b] = 0.f;
    for (int k = kp * 64; k < kp * 64 + 64; ++k) {
        const float w = W[(size_t)k * ldw + col0 + col];
#pragma unroll
        for (int b = 0; b < 9; ++b) acc[b] += S[b * 1024 + k] * w;
    }
#pragma unroll
    for (int b = 0; b < 9; ++b) red[(kp * 9 + b) * 32 + col] = acc[b];
    __syncthreads();
    if (tid < 288) {
        const int b = tid >> 5, c = tid & 31; float s = 0.f;
#pragma unroll
        for (int q = 0; q < 16; ++q) s += red[(q * 9 + b) * 32 + c];
        out[b * ldo + col0 + c] = s + (bias ? bias[col0 + c] : 0.f);
    }
    __syncthreads();
}

DEV void cpow_d(double lr, double li, double dt, int l, double& re, double& im) {
    const double mag = exp(lr * dt * (double)l);
    const double ang = li * dt * (double)l;
    const double kq = rint(ang * 0.63661977236758134308);
    double x = fma(-kq, 1.57079632679489655800e+00, ang);
    x = fma(-kq, 6.12323399573676603587e-17, x);
    const double x2 = x * x;
    double s = -1.0 / 6227020800.0; s = fma(s, x2, 1.0 / 39916800.0); s = fma(s, x2, -1.0 / 362880.0); s = fma(s, x2, 1.0 / 5040.0);
    s = fma(s, x2, -1.0 / 120.0); s = fma(s, x2, 1.0 / 6.0); s = fma(-s, x2, 1.0); s = s * x;
    double c = 1.0 / 479001600.0; c = fma(c, x2, -1.0 / 3628800.0); c = fma(c, x2, 1.0 / 40320.0); c = fma(c, x2, -1.0 / 720.0);
    c = fma(c, x2, 1.0 / 24.0); c = fma(c, x2, -0.5); c = fma(c, x2, 1.0);
    const int q = ((int)(long long)kq) & 3;
    const double sn = (q == 0) ? s : (q == 1) ? c : (q == 2) ? -s : -c;
    const double cs = (q == 0) ? c : (q == 1) ? -s : (q == 2) ? -c : s;
    re = mag * cs; im = mag * sn;
}

DEV void s5_gen(const Params& p, LAS unsigned char* lds, int g, int part) {
    int tid = threadIdx.x; asm volatile("" : "+v"(tid));
    LAS float* apr = (LAS float*)lds;
    LAS float* api = apr + 4224;
    LAS float* bbr = api + 4224;
    LAS float* bbi = bbr + 2048;
    LAS float* ccr = bbi + 2048;
    LAS float* cci = ccr + 2048;
    LAS float* Kt = cci + 2048;
    const float* lam_re = p.in[9]; const float* lam_im = p.in[10]; const float* log_dt = p.in[11];
    const float* b_re = p.in[12]; const float* b_im = p.in[13]; const float* c_re = p.in[14]; const float* c_im = p.in[15]; const float* dvec = p.in[16];
    bf16_t* BS5 = (bf16_t*)(p.ws + WS_BS5); bf16_t* ES5 = (bf16_t*)(p.ws + WS_ES5); float* ALC = (float*)(p.ws + WS_ALC);
    for (int i = tid; i < 4224; i += 512) {
        const int dir = i / 2112, rem = i % 2112, l = rem >> 6, pp = rem & 63, gi = dir * 32 + g;
        const double dt = exp((double)log_dt[gi]);
        double re, im; cpow_d((double)lam_re[gi * 64 + pp], (double)lam_im[gi * 64 + pp], dt, l, re, im);
        apr[i] = (float)re; api[i] = (float)im;
    }
    for (int i = tid; i < 2048; i += 512) {
        const int dir = i >> 10, cc = (i >> 6) & 15, pp = i & 63; const size_t src = ((size_t)((dir * 32 + g) * 16 + cc)) * 64 + pp;
        ccr[i] = c_re[src]; cci[i] = c_im[src];
    }
    for (int i = tid; i < 2048; i += 512) {
        const int dir = i >> 10, pp = (i >> 4) & 63, c = i & 15, gi = dir * 32 + g;
        const double dt = exp((double)log_dt[gi]);
        const double lr = (double)lam_re[gi * 64 + pp], li = (double)lam_im[gi * 64 + pp];
        double ar, ai; cpow_d(lr, li, dt, 1, ar, ai);
        const double nr = ar - 1.0, den = lr * lr + li * li;
        const double fr = (nr * lr + ai * li) / den, fi = (ai * lr - nr * li) / den;
        const double br = (double)b_re[((size_t)(gi * 64 + pp)) * 16 + c], bi = (double)b_im[((size_t)(gi * 64 + pp)) * 16 + c];
        bbr[i] = (float)(fr * br - fi * bi); bbi[i] = (float)(fr * bi + fi * br);
    }
    __syncthreads();
    for (int o = tid; o < 1024; o += 512) {
        const int dir = o >> 9, l = (o >> 4) & 31, c = o & 15;
        f32x4 s0 = (f32x4){0.f, 0.f, 0.f, 0.f}, s1 = s0, s2 = s0, s3 = s0;
#pragma unroll 2
        for (int pp = 0; pp < 64; ++pp) {
            const float ar = apr[(dir * 33 + l) * 64 + pp], ai = api[(dir * 33 + l) * 64 + pp];
            const float cr = ccr[(dir * 16 + c) * 64 + pp], ci = cci[(dir * 16 + c) * 64 + pp];
            const float qr = cr * ar - ci * ai, qi = cr * ai + ci * ar;
            LAS const f32x4* br = (LAS const f32x4*)(bbr + (dir * 64 + pp) * 16); LAS const f32x4* bi = (LAS const f32x4*)(bbi + (dir * 64 + pp) * 16);
            s0 += br[0] * qr - bi[0] * qi; s1 += br[1] * qr - bi[1] * qi; s2 += br[2] * qr - bi[2] * qi; s3 += br[3] * qr - bi[3] * qi;
        }
        LAS f32x4* kd = (LAS f32x4*)(Kt + ((dir * 32 + l) * 16 + c) * 16);
        kd[0] = s0; kd[1] = s1; kd[2] = s2; kd[3] = s3;
    }
    __syncthreads();
    for (int q = tid; q < 64 * 96; q += 512) {
        const int n = part * 64 + q / 96, k8 = (q % 96) * 8, t = n >> 4, c = n & 15;
        float e[8];
        if (k8 < 512) {
            const int s = k8 >> 4, c0 = k8 & 15, delta = t - s;
#pragma unroll
            for (int i = 0; i < 8; ++i) {
                const int c2 = c0 + i; float v;
                if (delta > 0) v = Kt[delta * 256 + c * 16 + c2];
                else if (delta < 0) v = Kt[(32 - delta) * 256 + c * 16 + c2];
                else v = Kt[c * 16 + c2] + Kt[32 * 256 + c * 16 + c2] + (c == c2 ? dvec[g * 16 + c] : 0.f);
                e[i] = v;
            }
        } else {
            const int kk = k8 - 512, seg = kk >> 6, p0 = kk & 63, dir = seg >> 1, l = dir == 0 ? t + 1 : 32 - t;
#pragma unroll
            for (int i = 0; i < 8; ++i) {
                const int pp = p0 + i;
                const float ar = apr[(dir * 33 + l) * 64 + pp], ai = api[(dir * 33 + l) * 64 + pp];
                const float cr = ccr[(dir * 16 + c) * 64 + pp], ci = cci[(dir * 16 + c) * 64 + pp];
                e[i] = (seg & 1) ? -(cr * ai + ci * ar) : (cr * ar - ci * ai);
            }
        }
        u32x4 w; w.x = pack2(e[0], e[1]); w.y = pack2(e[2], e[3]); w.z = pack2(e[4], e[5]); w.w = pack2(e[6], e[7]);
        *(u32x4*)(BS5 + ((size_t)g * 512 + n) * 768 + k8) = w;
    }
    for (int q = tid; q < 32 * 64; q += 512) {
        const int n = part * 32 + (q >> 6), k8 = (q & 63) * 8, s = k8 >> 4, c0 = k8 & 15, seg = n >> 6, pp = n & 63, dir = seg >> 1, l = dir == 0 ? 31 - s : s;
        const float ar = apr[(dir * 33 + l) * 64 + pp], ai = api[(dir * 33 + l) * 64 + pp];
        float e[8];
#pragma unroll
        for (int i = 0; i < 8; ++i) {
            const float br = bbr[(dir * 64 + pp) * 16 + c0 + i], bi = bbi[(dir * 64 + pp) * 16 + c0 + i];
            e[i] = (seg & 1) ? (ar * bi + ai * br) : (ar * br - ai * bi);
        }
        u32x4 w; w.x = pack2(e[0], e[1]); w.y = pack2(e[2], e[3]); w.z = pack2(e[4], e[5]); w.w = pack2(e[6], e[7]);
        *(u32x4*)(ES5 + ((size_t)g * 256 + n) * 512 + k8) = w;
    }
    if (part == 0 && tid < 128) {
        const int dir = tid >> 6, pp = tid & 63;
        ALC[((dir * 32 + g) * 64 + pp) * 2 + 0] = apr[(dir * 33 + 32) * 64 + pp];
        ALC[((dir * 32 + g) * 64 + pp) * 2 + 1] = api[(dir * 33 + 32) * 64 + pp];
    }
    __syncthreads();
}

template <bool APPLY>
DEV void lru_item(const Params& p, LAS unsigned char* lds, int b, int ch, int h) {
    int tid_ = threadIdx.x; asm volatile("" : "+v"(tid_));
    const int tid = tid_, wid = tid >> 6, lane = tid & 63, fr = lane & 15, fq = lane >> 4;
    LAS float* xin = (LAS float*)lds;
    LAS float* xs = (LAS float*)(lds + 17408);
    LAS unsigned short* xsb = (LAS unsigned short*)(lds + 33792);
    LAS float* aa = (LAS float*)(lds + 43008);
    LAS float* bb = (LAS float*)(lds + 75776);
    LAS float* cAs = (LAS float*)(lds + 108544);
    const bf16_t* ULRU = (const bf16_t*)(p.ws + WS_ULRU);
    const bf16_t* BTLRU = (const bf16_t*)(p.ws + WS_BTLRU);
    const float* conv_w = p.in[19]; const float* conv_b = p.in[20];
    if (tid < 128) {
        const int dir = tid >> 6, j = tid & 63, o = dir * 512 + h * 64 + j;
        cAs[tid] = -8.f * log1pf(__expf(-p.in[25][o])); cAs[128 + tid] = p.in[22][o]; cAs[256 + tid] = p.in[24][o];
    }
    for (int c = tid; c < 67 * 8; c += 512) {
        const int rr = c >> 3, c8 = (c & 7) * 8, pos = rr - 2;
        u32x4 w = (u32x4){0u, 0u, 0u, 0u};
        if (ch < 64) { if (pos >= 0 && pos < 64) w = *(const u32x4*)(ULRU + ((size_t)b * 4096 + pos * 64 + ch) * 1024 + h * 64 + c8); }
        else { const int jt = (ch - 64) * 64 + pos; if (jt >= 0 && jt < 256) w = *(const u32x4*)(ULRU + ((size_t)T + b * 256 + jt) * 1024 + h * 64 + c8); }
        float y[8]; bf8_unpack(w, y);
        *(LAS f32x4*)(xin + rr * 64 + c8) = (f32x4){y[0], y[1], y[2], y[3]}; *(LAS f32x4*)(xin + rr * 64 + c8 + 4) = (f32x4){y[4], y[5], y[6], y[7]};
    }
    __syncthreads();
    {
        const int cc = tid & 63, chn = h * 64 + cc;
        const float w0 = conv_w[chn], w1 = conv_w[512 + chn], w2 = conv_w[1024 + chn], w3 = conv_w[1536 + chn], cb = conv_b[chn];
#pragma unroll 2
        for (int r = tid >> 6; r < 64; r += 8) {
            const float v = cb + w0 * xin[r * 64 + cc] + w1 * xin[(r + 1) * 64 + cc] + w2 * xin[(r + 2) * 64 + cc] + w3 * xin[(r + 3) * 64 + cc];
            xs[r * 64 + cc] = v; xsb[r * 72 + cc] = (unsigned short)f2bf(v);
        }
    }
    __syncthreads();
    {
        const int mt = wid & 3, dir = wid >> 2;
        bf16x8 af[2];
#pragma unroll
        for (int ks = 0; ks < 2; ++ks) af[ks] = *(LAS const bf16x8*)((LAS const unsigned char*)xsb + (mt * 16 + fr) * 144 + ks * 64 + fq * 16);
        const int r = mt * 16 + fr;
#pragma unroll
        for (int jt = 0; jt < 8; ++jt) {
            const int n = dir * 128 + jt * 16 + fr;
            const bf16_t* bp = BTLRU + ((size_t)(h * 256 + n)) * 64 + fq * 8;
            const bf16x8 b0 = *(const bf16x8*)bp, b1 = *(const bf16x8*)(bp + 32);
            f32x4 a = (f32x4){0.f, 0.f, 0.f, 0.f};
            a = __builtin_amdgcn_mfma_f32_16x16x32_bf16(b0, af[0], a, 0, 0, 0);
            a = __builtin_amdgcn_mfma_f32_16x16x32_bf16(b1, af[1], a, 0, 0, 0);
            LAS float* dst = (jt < 4 ? aa : bb) + (dir * 64 + r) * 64 + (jt & 3) * 16 + 4 * fq;
            *(LAS f32x4*)dst = a;
        }
    }
    __syncthreads();
#pragma unroll 2
    for (int idx = tid; idx < 8192; idx += 512) {
        const int dir = idx >> 12, j = idx & 63, r = (idx >> 6) & 63;
        const float za = aa[idx] + cAs[128 + dir * 64 + j], zx = bb[idx] + cAs[256 + dir * 64 + j];
        const float la = cAs[dir * 64 + j] * sigmoid_f(za);
        const float a = __expf(la);
        const float x2 = 2.f * la;
        const float em = -x2 * (1.f + x2 * (0.5f + x2 * (0.16666667f + x2 * (0.041666668f + x2 * (0.0083333338f + x2 * 0.0013888889f)))));
        aa[idx] = a; bb[idx] = sqrtf(em) * sigmoid_f(zx) * xs[r * 64 + j];
    }
    __syncthreads();
    if (tid < 128) {
        const int dir = tid >> 6, j = tid & 63, chn = h * 64 + j;
        LAS float* ap = aa + dir * 4096 + j; LAS float* bp = bb + dir * 4096 + j;
        if (!APPLY) {
            float H = 0.f, P = 1.f;
#pragma unroll 1
            for (int s0 = 0; s0 < 64; s0 += 16) {
                float av[16], bv[16];
#pragma unroll
                for (int q = 0; q < 16; ++q) { const int r = dir ? 63 - (s0 + q) : s0 + q; av[q] = ap[r * 64]; bv[q] = bp[r * 64]; }
#pragma unroll
                for (int q = 0; q < 16; ++q) { H = av[q] * H + bv[q]; P *= av[q]; }
            }
            float* SA = (float*)(p.ws + WS_SA); float* SB = (float*)(p.ws + WS_SB);
            const size_t o = ((size_t)(b * 68 + ch) * 2 + dir) * 512 + chn;
            SA[o] = P; SB[o] = H;
        } else {
            const float* HIN = (const float*)(p.ws + WS_HIN);
            float H = HIN[((size_t)(b * 64 + ch) * 2 + dir) * 512 + chn];
#pragma unroll 1
            for (int s0 = 0; s0 < 64; s0 += 16) {
                float av[16], bv[16];
#pragma unroll
                for (int q = 0; q < 16; ++q) { const int r = dir ? 63 - (s0 + q) : s0 + q; av[q] = ap[r * 64]; bv[q] = bp[r * 64]; }
#pragma unroll
                for (int q = 0; q < 16; ++q) { const int r = dir ? 63 - (s0 + q) : s0 + q; H = av[q] * H + bv[q]; bp[r * 64] = H; }
            }
        }
    }
    __syncthreads();
    if (APPLY) {
        bf16_t* YCAT = (bf16_t*)(p.ws + WS_YCAT);
        {
            const int r = tid >> 3, j8 = (tid & 7) * 8;
            const size_t row = (size_t)b * 4096 + r * 64 + ch;
            float gt[8]; bf8_unpack(*(const u32x4*)(ULRU + row * 1024 + 512 + h * 64 + j8), gt);
            float o[8];
#pragma unroll
            for (int q = 0; q < 8; ++q) o[q] = (bb[r * 64 + j8 + q] + bb[(64 + r) * 64 + j8 + q]) * gelu_tanh(gt[q]);
            u32x4 w; w.x = pack2(o[0], o[1]); w.y = pack2(o[2], o[3]); w.z = pack2(o[4], o[5]); w.w = pack2(o[6], o[7]);
            *(u32x4*)(YCAT + row * 1024 + 512 + h * 64 + j8) = w;
        }
        __syncthreads();
    }
}

constexpr int MOE_TAB_OFF = 132096;
DEV void moe_tables(const Params& p, LAS unsigned char* lds, int h) {
    LAS int* tp = (LAS int*)(lds + MOE_TAB_OFF); LAS int* pc = tp + 72; LAS int* cn = pc + 72;
    if (threadIdx.x == 0) {
        const int* cnt = (const int*)(p.ws + WS_CNT) + h * 64;
        int t = 0, q = 0;
        for (int e = 0; e < 65; ++e) { const int c = e < 64 ? cnt[e] : HALF_T; cn[e] = c; tp[e] = t; pc[e] = q; t += (c + 255) >> 8; q += c; }
        tp[65] = t; pc[65] = q;
    }
    __syncthreads();
}
template <bool GU>
struct MoeSched {
    struct Unit { int e, r0t, pn; };
    static constexpr bool GATHER = GU;
    LAS const int* tp; LAS const int* pc; LAS const int* cn;
    const char* Abase; const char* Bt; const int* ltok; int h, nN, nunits, G, c;
    DEV int lda() const { return 256; }
    DEV bool next(int i, Unit& u) const {
        const long L = (long)i * G + c; if (L >= nunits) return false;
        int w = (int)L; { const int q = nunits / 8, r = nunits % 8, xcd = w % 8, off = w / 8; w = (xcd < r ? xcd * (q + 1) : r * (q + 1) + (xcd - r) * q) + off; }
        const int rt = w / nN; u.pn = w % nN;
        int e = 0; while (tp[e + 1] <= rt) ++e;
        u.e = e; u.r0t = (rt - tp[e]) * 256; return true;
    }
    DEV unsigned tokoff(int e, int ce, int idx, int C) const {
        idx = idx < ce ? idx : ce - 1;
        const int tok = e < 64 ? ltok[(size_t)(h * 64 + e) * HALF_T + idx] : h * HALF_T + idx;
        return (unsigned)tok * 4096u + 2048u + (unsigned)C * 2u;
    }
    DEV void addr(const Unit& u, int R0, int C0, int R1, int C1, gp::UAddr& o) const {
        if constexpr (GU) {
            const int ce = cn[u.e];
            o.a = Abase; o.b = Bt + ((size_t)u.e * 512 + u.pn * 256) * 2048;
            o.ao00 = tokoff(u.e, ce, u.r0t + R0, C0); o.ao01 = tokoff(u.e, ce, u.r0t + R1, C1);
            o.ao10 = tokoff(u.e, ce, u.r0t + 128 + R0, C0); o.ao11 = tokoff(u.e, ce, u.r0t + 128 + R1, C1);
        } else {
            o.a = Abase + ((size_t)pc[u.e] + u.r0t) * 512; o.b = Bt + ((size_t)u.e * 1024 + u.pn * 256) * 512;
        }
    }
};
struct EpiMoeGU {
    static constexpr bool PERM = false;
    LAS const int* pc; LAS const int* cn; const float* lwt; bf16_t* HMID; int h;
    template <class U> DEV void operator()(const f32x4 (&acc)[2][2][4][2], const U& u, int wr, int wc, int fr, int fq) const {
        const int ce = cn[u.e]; const size_t prow = (size_t)pc[u.e];
#pragma unroll
        for (int ai = 0; ai < 2; ++ai)
#pragma unroll
            for (int m = 0; m < 4; ++m) {
                const int idx = u.r0t + ai * 128 + wr * 64 + m * 16 + fr;
                if (idx < ce) {
                    const float wt = u.e < 64 ? lwt[(size_t)(h * 64 + u.e) * HALF_T + idx] : 1.f;
                    bf16_t* rowp = HMID + (prow + idx) * 256 + u.pn * 128 + wc * 16 + 4 * fq;
#pragma unroll
                    for (int bj = 0; bj < 2; ++bj) {
                        const f32x4 gt = acc[ai][bj][m][0], up = acc[ai][bj][m][1];
                        u32x2 w; w.x = pack2(wt * gt[0] * sigmoid_f(gt[0]) * up[0], wt * gt[1] * sigmoid_f(gt[1]) * up[1]);
                        w.y = pack2(wt * gt[2] * sigmoid_f(gt[2]) * up[2], wt * gt[3] * sigmoid_f(gt[3]) * up[3]);
                        *(u32x2*)(rowp + bj * 64) = w;
                    }
                }
            }
    }
};
struct EpiMoeDN {
    static constexpr bool PERM = true;
    LAS const int* pc; LAS const int* cn; bf16_t* SLAB;
    template <class U> DEV void operator()(const f32x4 (&acc)[2][2][4][2], const U& u, int wr, int wc, int fr, int fq) const {
        const int ce = cn[u.e]; const size_t prow = (size_t)pc[u.e];
#pragma unroll
        for (int ai = 0; ai < 2; ++ai)
#pragma unroll
            for (int m = 0; m < 4; ++m) {
                const int idx = u.r0t + ai * 128 + wr * 64 + m * 16 + fr;
                if (idx < ce) {
                    bf16_t* rowp = SLAB + (prow + idx) * 1024 + u.pn * 256 + wc * 32 + 8 * fq;
#pragma unroll
                    for (int bj = 0; bj < 2; ++bj) {
                        const f32x4 v0 = acc[ai][bj][m][0], v1 = acc[ai][bj][m][1];
                        u32x4 w; w.x = pack2(v0[0], v0[1]); w.y = pack2(v0[2], v0[3]); w.z = pack2(v1[0], v1[1]); w.w = pack2(v1[2], v1[3]);
                        *(u32x4*)(rowp + bj * 128) = w;
                    }
                }
            }
    }
};
DEV void moe_reduce(const Params& p, LAS unsigned char* lds, int h, int bid, int nb) {
    int tid = threadIdx.x; asm volatile("" : "+v"(tid));
    const int wid = tid >> 6, lane = tid & 63;
    LAS const int* pc = (LAS const int*)(lds + MOE_TAB_OFF) + 72;
    const bf16_t* SLAB = (const bf16_t*)(p.ws + WS_SLAB); const int* PAIR = (const int*)(p.ws + WS_PAIR); const float* ADA = (const float*)(p.ws + WS_ADA);
    for (int it = bid; it < HALF_T / 8; it += nb) {
        const int tokl = it * 8 + wid; const size_t tok = (size_t)h * HALF_T + tokl; const int b = (int)(tok >> 12), col = lane * 16;
        float f[16];
        { const bf16_t* r = SLAB + ((size_t)pc[64] + tokl) * 1024 + col; float y[8]; bf8_unpack(*(const u32x4*)r, y);
#pragma unroll
          for (int j = 0; j < 8; ++j) f[j] = y[j];
          bf8_unpack(*(const u32x4*)(r + 8), y);
#pragma unroll
          for (int j = 0; j < 8; ++j) f[8 + j] = y[j]; }
#pragma unroll
        for (int k = 0; k < 8; ++k) {
            const int pr = PAIR[tok * 8 + k], e = pr >> 16, rank = pr & 0xffff;
            const bf16_t* r = SLAB + ((size_t)pc[e] + rank) * 1024 + col; float y[8];
            bf8_unpack(*(const u32x4*)r, y);
#pragma unroll
            for (int j = 0; j < 8; ++j) f[j] += y[j];
            bf8_unpack(*(const u32x4*)(r + 8), y);
#pragma unroll
            for (int j = 0; j < 8; ++j) f[8 + j] += y[j];
        }
        float z[16]; float s = 0.f;
        { const bf16_t* hr = (const bf16_t*)p.out + tok * 2048 + col; float y0[8], y1[8]; bf8_unpack(*(const u32x4*)hr, y0); bf8_unpack(*(const u32x4*)(hr + 8), y1);
          const float* g2 = ADA + b * 6144 + 5120 + col;
#pragma unroll
          for (int j = 0; j < 8; ++j) { z[j] = y0[j] * ALPHA_F + g2[j] * f[j]; z[8 + j] = y1[j] * ALPHA_F + g2[8 + j] * f[8 + j]; }
#pragma unroll
          for (int j = 0; j < 16; ++j) s += z[j]; }
        const float mean = wave_sum(s) * (1.f / 1024.f); float qq = 0.f;
#pragma unroll
        for (int j = 0; j < 16; ++j) { const float d = z[j] - mean; qq += d * d; }
        const float rstd = rsqrtf(wave_sum(qq) * (1.f / 1024.f) + LN_EPS_F);
        const float* gg = p.in[37] + col; const float* bbv = p.in[38] + col;
#pragma unroll
        for (int q = 0; q < 4; ++q) {
            f32x4 o;
#pragma unroll
            for (int j = 0; j < 4; ++j) o[j] = (z[q * 4 + j] - mean) * rstd * gg[q * 4 + j] + bbv[q * 4 + j];
            *(f32x4*)(p.out + tok * 1024 + col + q * 4) = o;
        }
    }
}

#define ADA ((float*)(p.ws + WS_ADA))
#define BIASIN ((float*)(p.ws + WS_BIASIN))
#define HB ((bf16_t*)(p.ws + WS_HB))
#define BTIN ((bf16_t*)(p.ws + WS_BTIN))
#define HM ((bf16_t*)(p.ws + WS_HM))
#define US5 ((bf16_t*)(p.ws + WS_US5))
#define ULRU ((bf16_t*)(p.ws + WS_ULRU))
#define SLOC ((float*)(p.ws + WS_SLOC))
#define YS5 ((bf16_t*)(p.ws + WS_YS5))
#define YCAT ((bf16_t*)(p.ws + WS_YCAT))
#define Y ((float*)(p.ws + WS_Y))
#define LTOK ((int*)(p.ws + WS_LTOK))
#define LWT ((float*)(p.ws + WS_LWT))
#define HMID ((bf16_t*)(p.ws + WS_HMID))
#define SLAB ((bf16_t*)(p.ws + WS_SLAB))
#define PAIR ((int*)(p.ws + WS_PAIR))
#define CNT ((int*)(p.ws + WS_CNT))
__global__ void __launch_bounds__(512) mk_fwd(Params p) {
    extern __shared__ __attribute__((aligned(16))) unsigned char lds_raw[];
    LAS unsigned char* lds = (LAS unsigned char*)lds_raw;
    const int bid = blockIdx.x, nb = gridDim.x;
    volatile LAS unsigned* MISC = (volatile LAS unsigned*)(lds + MISC_OFF);
    if (threadIdx.x < 64) MISC[threadIdx.x] = 0u;
    __syncthreads();
    unsigned char* const ws = p.ws;
    XcdBarrier bar; bar.bar = (unsigned*)(ws + WS_CTL); bar.x = 0; bar.st = nullptr;
    const bool fused = (p.ph_hi - p.ph_lo) > 1;
    if (fused) bar = xcd_barrier_post((unsigned*)(ws + WS_CTL), MISC + 8);

    const int lo = p.ph_lo, hi = p.ph_hi;
#ifndef PROBE_REP_PH
#define PROBE_REP_PH -1
#endif
#define IN(k) (lo <= (k) && (k) < hi)
#define TIDS int tid = threadIdx.x; asm volatile("" : "+v"(tid)); const int wid = tid >> 6, lane = tid & 63; (void)wid; (void)lane
#define REPS(k) (((k) == PROBE_REP_PH) ? 2 : 1)
#define SEAM(k) do { if (IN(k) && IN((k) + 1)) xcd_barrier(bar); else __syncthreads(); } while (0)
    {
        for (int rep_ = 0; rep_ < REPS(0); ++rep_) if (IN(0)) { if (rep_) xcd_barrier(bar); TIDS;
            for (int it = bid; it < 256; it += nb) s5_gen(p, lds, it >> 3, it & 7);
            {
                LAS float* S = (LAS float*)lds; LAS float* red = S + 9216;
                __syncthreads();
                for (int i = tid; i < 9216; i += 512) { const float c = i < 8192 ? p.in[1][i] : p.in[3][i - 8192]; S[i] = c * sigmoid_f(c); }
                __syncthreads();
                for (int it = bid; it < 192; it += nb) gemv9_item(S, p.in[6], 6144, it * 32, p.in[7], ADA, 6144, red);
                __syncthreads();
            }
            {
                LAS float* tile = (LAS float*)lds + wid * (64 * 65);
                for (int it = bid * 8 + wid; it < 13216; it += nb * 8) {
                    if (it < 64) { tr_tile_wave(p.in[17], 512, (it >> 3) * 64, (it & 7) * 64, (bf16_t*)(ws + WS_BTGLU), 512, 0, tile, lane); }
                    else if (it < 320) { const int i2 = it - 64; tr_tile_wave(p.in[26], 1024, (i2 >> 4) * 64, (i2 & 15) * 64, (bf16_t*)(ws + WS_BTOUT), 1024, 0, tile, lane); }
                    else if (it < 12800) {
                        const int i2 = it - 320, e = i2 / 192, r = i2 % 192, which = r >> 6, tt = r & 63;
                        if (which < 2) {
                            const float* W = e < 64 ? (which == 0 ? p.in[31] : p.in[32]) + (size_t)e * 262144 : (which == 0 ? p.in[34] : p.in[35]);
                            tr_tile_wave(W, 256, (tt >> 2) * 64, (tt & 3) * 64, (bf16_t*)(ws + WS_BTGU) + (size_t)e * 524288, 1024, which + 1, tile, lane);
                        } else {
                            const float* W = e < 64 ? p.in[33] + (size_t)e * 262144 : p.in[36];
                            tr_tile_wave(W, 1024, (tt >> 4) * 64, (tt & 15) * 64, (bf16_t*)(ws + WS_BTDN) + (size_t)e * 262144, 256, 0, tile, lane);
                        }
                    } else if (it < 12832) {
                        const int i2 = it - 12800, dir = i2 >> 4, ax = (i2 >> 3) & 1, h = i2 & 7;
                        const float* W = (ax ? p.in[23] : p.in[21]) + (size_t)(dir * 8 + h) * 4096;
                        tr_tile_wave(W, 64, 0, 0, (bf16_t*)(ws + WS_BTLRU) + (size_t)(h * 256 + dir * 128 + ax * 64) * 64, 64, 0, tile, lane);
                    } else {
                        const int i2 = it - 12832;
                        tr_tile_wave(p.in[8], NWIN, (i2 / 24) * 64, (i2 % 24) * 64, BTIN, 1024, 0, tile, lane);
                    }
                }
            }
        }
        SEAM(0);
        if (IN(1)) { TIDS;
            for (int it = bid; it < TT / 8; it += nb) {
                const int row = it * 8 + wid;
                const float* src = row < T ? p.in[0] + (size_t)row * 1024 : p.in[2] + (size_t)(row - T) * 1024;
                const float* ada = ADA + (row < T ? (row >> 12) : 8) * 6144;
                f32x4 v[4]; float s = 0.f;
#pragma unroll
                for (int q = 0; q < 4; ++q) { v[q] = *(const f32x4*)(src + q * 256 + lane * 4); s += (v[q][0] + v[q][1]) + (v[q][2] + v[q][3]); }
                const float mean = wave_sum(s) * (1.f / 1024.f); float qq = 0.f;
#pragma unroll
                for (int q = 0; q < 4; ++q) { const f32x4 d = v[q] - mean; qq += (d[0] * d[0] + d[1] * d[1]) + (d[2] * d[2] + d[3] * d[3]); }
                const float rstd = rsqrtf(wave_sum(qq) * (1.f / 1024.f) + LN_EPS_F);
#pragma unroll
                for (int q = 0; q < 4; ++q) {
                    const int col = q * 256 + lane * 4;
                    const f32x4 gg = *(const f32x4*)(p.in[4] + col), bbv = *(const f32x4*)(p.in[5] + col);
                    const f32x4 o = (v[q] - mean) * rstd * gg + bbv;
                    u32x2 w; w.x = pack2(o[0], o[1]); w.y = pack2(o[2], o[3]);
                    *(u32x2*)(HB + (size_t)row * 1024 + col) = w;
                    const f32x4 sh1 = *(const f32x4*)(ada + col), sc1 = *(const f32x4*)(ada + 1024 + col);
                    const f32x4 om = o * (sc1 + 1.f) + sh1;
                    u32x2 wm; wm.x = pack2(om[0], om[1]); wm.y = pack2(om[2], om[3]);
                    *(u32x2*)(HM + (size_t)row * 1024 + col) = wm;
                }
            }
        }
        SEAM(1);
        if (IN(2)) { TIDS;
            WinSched S{(const char*)HM, (const char*)BTIN, nb, bid};
            EpiWin E{US5, ULRU};
            gp::gemm_phase(lds, 1024, S, E);
        }
        SEAM(2);
        for (int rep_ = 0; rep_ < REPS(3); ++rep_) if (IN(3)) { if (rep_) xcd_barrier(bar); TIDS;
            const bf16_t* ES5 = (const bf16_t*)(ws + WS_ES5);
            { S5Sched S{(const char*)US5, (const char*)ES5, 512, 5, 1, 256, nb, bid}; EpiS5Loc E{SLOC}; gp::gemm_phase(lds, 512, S, E); }
            __syncthreads();
            int bid_ = bid; asm volatile("" : "+s"(bid_));
            for (int it = bid_; it < NBATCH * 68 * 8; it += nb) { const int h = it & 7, q = it >> 3, ch = q % 68, b = q / 68; lru_item<false>(p, lds, b, ch, h); }
        }
        SEAM(3);
        for (int rep_ = 0; rep_ < REPS(4); ++rep_) if (IN(4)) { if (rep_) xcd_barrier(bar); TIDS;
            const float* ALC = (const float*)(ws + WS_ALC);
            if (tid < 128) for (int i = bid * 128 + tid; i < 32768; i += nb * 128) {
                const int pp = i & 63, dir = (i >> 6) & 1, g = (i >> 7) & 31, b = i >> 12;
                const float ar = ALC[((dir * 32 + g) * 64 + pp) * 2], ai = ALC[((dir * 32 + g) * 64 + pp) * 2 + 1];
                float xr = 0.f, xi = 0.f;
                const float* Sg = SLOC + (size_t)g * M5 * 256 + dir * 128 + pp;
                {
                    float sr[NCC], si[NCC];
#pragma unroll
                    for (int s = 0; s < NCC; ++s) { const int j = dir ? NCC - 1 - s : s, m = M5LAT + b * NCC + j; sr[s] = Sg[(size_t)m * 256]; si[s] = Sg[(size_t)m * 256 + 64]; }
#pragma unroll
                    for (int s = 0; s < NCC; ++s) { const float nr = ar * xr - ai * xi + sr[s], ni = ar * xi + ai * xr + si[s]; xr = nr; xi = ni; }
                }
#pragma unroll 1
                for (int s0 = 0; s0 < NCH; s0 += 32) {
                    float sr[32], si[32];
#pragma unroll
                    for (int q = 0; q < 32; ++q) { const int k = dir ? NCH - 1 - (s0 + q) : s0 + q, m = b * NCH + k; sr[q] = Sg[(size_t)m * 256]; si[q] = Sg[(size_t)m * 256 + 64]; }
#pragma unroll
                    for (int q = 0; q < 32; ++q) {
                        const int k = dir ? NCH - 1 - (s0 + q) : s0 + q, m = b * NCH + k;
                        bf16_t* dst = US5 + ((size_t)(g * M5PAD + m)) * KT5 + 512 + dir * 128 + pp;
                        dst[0] = (bf16_t)f2bf(xr); dst[64] = (bf16_t)f2bf(xi);
                        const float nr = ar * xr - ai * xi + sr[q], ni = ar * xi + ai * xr + si[q]; xr = nr; xi = ni;
                    }
                }
            }
            const float* SA = (const float*)(ws + WS_SA); const float* SB = (const float*)(ws + WS_SB); float* HIN = (float*)(ws + WS_HIN);
            if (tid >= 128 && tid < 160) for (int i = bid * 32 + (tid - 128); i < 8192; i += nb * 32) {
                const int chn = i & 511, dir = (i >> 9) & 1, b = i >> 10;
                float H = 0.f;
                {
                    float av[4], bv[4];
#pragma unroll
                    for (int s = 0; s < 4; ++s) { const int c = 64 + (dir ? 3 - s : s); const size_t o = ((size_t)(b * 68 + c) * 2 + dir) * 512 + chn; av[s] = SA[o]; bv[s] = SB[o]; }
#pragma unroll
                    for (int s = 0; s < 4; ++s) H = av[s] * H + bv[s];
                }
#pragma unroll 1
                for (int s0 = 0; s0 < 64; s0 += 32) {
                    float av[32], bv[32];
#pragma unroll
                    for (int q = 0; q < 32; ++q) { const int c = dir ? 63 - (s0 + q) : s0 + q; const size_t o = ((size_t)(b * 68 + c) * 2 + dir) * 512 + chn; av[q] = SA[o]; bv[q] = SB[o]; }
#pragma unroll
                    for (int q = 0; q < 32; ++q) {
                        const int c = dir ? 63 - (s0 + q) : s0 + q;
                        HIN[((size_t)(b * 64 + c) * 2 + dir) * 512 + chn] = H;
                        H = av[q] * H + bv[q];
                    }
                }
            }
        }
        SEAM(4);
        for (int rep_ = 0; rep_ < REPS(5); ++rep_) if (IN(5)) { if (rep_) xcd_barrier(bar); TIDS;
            const bf16_t* BS5 = (const bf16_t*)(ws + WS_BS5);
            { S5Sched S{(const char*)US5, (const char*)BS5, KT5, 4, 2, 512, nb, bid}; EpiS5Out E{YS5}; gp::gemm_phase(lds, KT5, S, E); }
            __syncthreads();
            int bid_ = bid; asm volatile("" : "+s"(bid_));
            for (int it = bid_; it < NBATCH * 64 * 8; it += nb) { const int h = it & 7, q = it >> 3, ch = q & 63, b = q >> 6; lru_item<true>(p, lds, b, ch, h); }
        }
        SEAM(5);
        if (IN(6)) { TIDS;
            const bf16_t* BTGLU = (const bf16_t*)(ws + WS_BTGLU); const float* b_glu = p.in[18];
            PlainSched S{(const char*)YS5, (const char*)BTGLU, 512, 512, 128, 2, nb, bid};
            EpiGlu E{YS5, b_glu, YCAT};
            gp::gemm_phase(lds, 512, S, E);
        }
        SEAM(6);
        for (int rep_ = 0; rep_ < REPS(7); ++rep_) if (IN(7)) { if (rep_) xcd_barrier(bar); TIDS;
            const bf16_t* BTOUT = (const bf16_t*)(ws + WS_BTOUT);
            PlainSched S{(const char*)YCAT, (const char*)BTOUT, 1024, 1024, 128, 4, nb, bid};
            EpiF32 E{Y, 1024};
            gp::gemm_phase(lds, 1024, S, E);
        }
        SEAM(7);
        if (IN(8)) { TIDS;
            LAS float* Vs = (LAS float*)lds;
            LAS float* RWs = (LAS float*)(lds + 131584);
            LAS float* SEL = RWs; LAS float* SCO = RWs + 2048;
            LAS int* lcnt = (LAS int*)(lds + 147968); LAS int* gbase = lcnt + 64;
            const float* router_w = p.in[29]; const float* router_bias = p.in[30];
            for (int it = bid; it < T / 32; it += nb) {
                const int t0 = it * 32;
                if (tid < 64) lcnt[tid] = 0;
#pragma unroll 1
                for (int i = 0; i < 4; ++i) {
                    const int tl = wid * 4 + i; const size_t tok = (size_t)t0 + tl; const int b = (int)(tok >> 12);
                    const float* ada = ADA + b * 6144;
                    f32x4 z[4]; float s = 0.f;
#pragma unroll
                    for (int q = 0; q < 4; ++q) {
                        const int col = q * 256 + lane * 4;
                        const u32x2 hh = *(const u32x2*)(HB + tok * 1024 + col);
                        const f32x4 yv = *(const f32x4*)(Y + tok * 1024 + col);
                        const f32x4 g1 = *(const f32x4*)(ada + 2048 + col);
                        f32x4 hv; hv[0] = __uint_as_float(hh.x << 16); hv[1] = __uint_as_float(hh.x & 0xffff0000u); hv[2] = __uint_as_float(hh.y << 16); hv[3] = __uint_as_float(hh.y & 0xffff0000u);
                        z[q] = hv * ALPHA_F + g1 * yv;
                        s += (z[q][0] + z[q][1]) + (z[q][2] + z[q][3]);
                    }
                    const float mean = wave_sum(s) * (1.f / 1024.f); float qq = 0.f;
#pragma unroll
                    for (int q = 0; q < 4; ++q) { const f32x4 d = z[q] - mean; qq += (d[0] * d[0] + d[1] * d[1]) + (d[2] * d[2] + d[3] * d[3]); }
                    const float rstd = rsqrtf(wave_sum(qq) * (1.f / 1024.f) + LN_EPS_F);
#pragma unroll
                    for (int q = 0; q < 4; ++q) {
                        const int col = q * 256 + lane * 4;
                        const f32x4 gg = *(const f32x4*)(p.in[27] + col), bbv = *(const f32x4*)(p.in[28] + col);
                        const f32x4 h1 = (z[q] - mean) * rstd * gg + bbv;
                        { u32x2 wh; wh.x = pack2(h1[0], h1[1]); wh.y = pack2(h1[2], h1[3]); *(u32x2*)((bf16_t*)p.out + tok * 2048 + col) = wh; }
                        const f32x4 sc2 = *(const f32x4*)(ada + 4096 + col), sh2 = *(const f32x4*)(ada + 3072 + col);
                        const f32x4 v = h1 * (sc2 + 1.f) + sh2;
                        u32x2 w; w.x = pack2(v[0], v[1]); w.y = pack2(v[2], v[3]);
                        *(u32x2*)((bf16_t*)p.out + tok * 2048 + 1024 + col) = w;
                        *(LAS f32x4*)(Vs + tl * 1028 + col) = v;
                    }
                }
                __syncthreads();
                const int tt = tid >> 4, q16 = tid & 15;
                f32x4 lg = (f32x4){0.f, 0.f, 0.f, 0.f};
                for (int k0 = 0; k0 < 1024; k0 += 64) {
#pragma unroll
                    for (int i = 0; i < 2; ++i) { const int idx = tid + i * 512, kk = idx >> 4, e4 = (idx & 15) * 4; *(LAS f32x4*)(RWs + kk * 64 + e4) = *(const f32x4*)(router_w + (size_t)(k0 + kk) * 64 + e4); }
                    __syncthreads();
#pragma unroll 2
                    for (int kk = 0; kk < 64; kk += 4) {
                        const f32x4 v = *(LAS const f32x4*)(Vs + tt * 1028 + k0 + kk);
#pragma unroll
                        for (int u = 0; u < 4; ++u) { const f32x4 w = *(LAS const f32x4*)(RWs + (kk + u) * 64 + q16 * 4); lg += w * v[u]; }
                    }
                    __syncthreads();
                }
#pragma unroll
                for (int i = 0; i < 4; ++i) { const int e = q16 * 4 + i; const float sc = sigmoid_f(lg[i]); SCO[tt * 64 + e] = sc; SEL[tt * 64 + e] = sc + router_bias[e]; }
                __syncthreads();
                float gs[8];
#pragma unroll
                for (int gi = 0; gi < 8; ++gi) {
                    float m1 = -INFINITY, m2 = -INFINITY;
#pragma unroll
                    for (int j = 0; j < 8; ++j) { const float v = SEL[tt * 64 + gi * 8 + j]; if (v > m1) { m2 = m1; m1 = v; } else if (v > m2) m2 = v; }
                    gs[gi] = m1 + m2;
                }
                unsigned gmask = 0u;
#pragma unroll
                for (int gi = 0; gi < 8; ++gi) {
                    int rank = 0;
#pragma unroll
                    for (int hh = 0; hh < 8; ++hh) rank += (gs[hh] > gs[gi] || (gs[hh] == gs[gi] && hh < gi)) ? 1 : 0;
                    if (rank < 4) gmask |= 1u << gi;
                }
                bool chosen[4]; float scv[4]; int slot[4]; float mysum = 0.f;
#pragma unroll
                for (int i = 0; i < 4; ++i) {
                    const int e = q16 * 4 + i; chosen[i] = false; scv[i] = 0.f; slot[i] = 0;
                    if ((gmask >> (e >> 3)) & 1u) {
                        const float v = SEL[tt * 64 + e]; int rank = 0;
#pragma unroll 2
                        for (int j = 0; j < 64; ++j) { if ((gmask >> (j >> 3)) & 1u) { const float vj = SEL[tt * 64 + j]; rank += (vj > v || (vj == v && j < e)) ? 1 : 0; } }
                        if (rank < 8) { chosen[i] = true; slot[i] = rank; scv[i] = SCO[tt * 64 + e]; mysum += scv[i]; }
                    }
                }
                float wsum = mysum;
#pragma unroll
                for (int o = 1; o < 16; o <<= 1) wsum += __shfl_xor(wsum, o);
                int lrank[4];
#pragma unroll
                for (int i = 0; i < 4; ++i) { lrank[i] = 0; if (chosen[i]) lrank[i] = __hip_atomic_fetch_add(lcnt + q16 * 4 + i, 1, __ATOMIC_RELAXED, __HIP_MEMORY_SCOPE_WORKGROUP); }
                __syncthreads();
                const int hh = t0 >> 14;
                if (tid < 64) gbase[tid] = atomicAdd(CNT + hh * 64 + tid, lcnt[tid]);
                __syncthreads();
#pragma unroll
                for (int i = 0; i < 4; ++i) if (chosen[i]) {
                    const int e = q16 * 4 + i, rk = gbase[e] + lrank[i]; const size_t pos = (size_t)(hh * 64 + e) * HALF_T + rk;
                    LTOK[pos] = t0 + tt; LWT[pos] = scv[i] / wsum * 2.5f; PAIR[(size_t)(t0 + tt) * 8 + slot[i]] = (e << 16) | rk;
                }
                __syncthreads();
            }
        }
        SEAM(8);
        if (IN(9)) { TIDS;
            moe_tables(p, lds, 0);
            LAS const int* tp = (LAS const int*)(lds + MOE_TAB_OFF); LAS const int* pc = tp + 72; LAS const int* cn = pc + 72;
            MoeSched<true> S{tp, pc, cn, (const char*)p.out, (const char*)(ws + WS_BTGU), LTOK, 0, 2, tp[65] * 2, nb, bid};
            EpiMoeGU E{pc, cn, LWT, HMID, 0};
            gp::gemm_phase(lds, 1024, S, E);
        }
        SEAM(9);
        if (IN(10)) { TIDS;
            moe_tables(p, lds, 0);
            LAS const int* tp = (LAS const int*)(lds + MOE_TAB_OFF); LAS const int* pc = tp + 72; LAS const int* cn = pc + 72;
            MoeSched<false> S{tp, pc, cn, (const char*)HMID, (const char*)(ws + WS_BTDN), LTOK, 0, 4, tp[65] * 4, nb, bid};
            EpiMoeDN E{pc, cn, SLAB};
            gp::gemm_phase(lds, 256, S, E);
        }
        SEAM(10);
        if (IN(11)) { TIDS;
            {
                moe_tables(p, lds, 1);
                LAS const int* tp = (LAS const int*)(lds + MOE_TAB_OFF); LAS const int* pc = tp + 72; LAS const int* cn = pc + 72;
                MoeSched<true> S{tp, pc, cn, (const char*)p.out, (const char*)(ws + WS_BTGU), LTOK, 1, 2, tp[65] * 2, nb, bid};
                EpiMoeGU E{pc, cn, LWT, HMID, 1};
                gp::gemm_phase(lds, 1024, S, E);
            }
            __syncthreads();
            int bid_ = bid; asm volatile("" : "+s"(bid_));
            moe_tables(p, lds, 0);
            moe_reduce(p, lds, 0, bid_, nb);
        }
        SEAM(11);
        if (IN(12)) { TIDS;
            moe_tables(p, lds, 1);
            LAS const int* tp = (LAS const int*)(lds + MOE_TAB_OFF); LAS const int* pc = tp + 72; LAS const int* cn = pc + 72;
            MoeSched<false> S{tp, pc, cn, (const char*)HMID, (const char*)(ws + WS_BTDN), LTOK, 1, 4, tp[65] * 4, nb, bid};
            EpiMoeDN E{pc, cn, SLAB};
            gp::gemm_phase(lds, 256, S, E);
        }
        SEAM(12);
        if (IN(13)) { TIDS;
            moe_tables(p, lds, 1);
            moe_reduce(p, lds, 1, bid, nb);
        }
    }
}

extern "C" void kernel_launch(void* const* d_in, const int* in_sizes, int n_in, void* d_out, int out_size, void* d_ws, size_t ws_size, hipStream_t stream) {
    static int grid = 0;
    if (grid == 0) {
        if (n_in != 39 || out_size != T * D || ws_size < WS_END) { fprintf(stderr, "kernel_launch: unexpected problem (n_in %d, out %d, ws %zu); nothing launched\n", n_in, out_size, ws_size); grid = -1; return; }
        int dev = 0, cus = 0;
        if (hipGetDevice(&dev) != hipSuccess || hipDeviceGetAttribute(&cus, hipDeviceAttributeMultiprocessorCount, dev) != hipSuccess) { grid = -1; return; }
        if (hipFuncSetAttribute((const void*)mk_fwd, hipFuncAttributeMaxDynamicSharedMemorySize, LDS_BYTES) != hipSuccess) { fprintf(stderr, "kernel_launch: hipFuncSetAttribute failed\n"); grid = -1; return; }
        grid = cus > 0 ? cus : 256;
    }
    if (grid < 0) return;
    (void)in_sizes;
    if (hipMemsetAsync((char*)d_ws + WS_CTL, 0, CTL_ZERO_BYTES, stream) != hipSuccess) return;
    Params p{};
    for (int i = 0; i < 39; ++i) p.in[i] = (const float*)d_in[i];
    p.out = (float*)d_out; p.ws = (unsigned char*)d_ws;
#if MK_N_LAUNCHES == 1
    p.ph_lo = 0; p.ph_hi = NPHASE;
    hipLaunchKernelGGL(mk_fwd, dim3(grid), dim3(512), LDS_BYTES, stream, p);
#else
    for (int ph = 0; ph < NPHASE; ++ph) {
        p.ph_lo = ph; p.ph_hi = ph + 1;
        hipLaunchKernelGGL(mk_fwd, dim3(grid), dim3(512), LDS_BYTES, stream, p);
    }
#endif
}
```

```cpp
#include <hip/hip_runtime.h>
#include <cstdio>
#include <cstdint>

#ifndef MK_N_LAUNCHES
#define MK_N_LAUNCHES 1
#endif

#define DEV __device__ __forceinline__
#define LAS __attribute__((address_space(3)))
typedef unsigned short bf16_t;
typedef short bf16x8 __attribute__((ext_vector_type(8)));
typedef float f32x4 __attribute__((ext_vector_type(4)));
typedef unsigned u32x2 __attribute__((ext_vector_type(2)));
typedef unsigned u32x4 __attribute__((ext_vector_type(4)));

constexpr int D = 1024, NBATCH = 8, SEQ = 4096, T = NBATCH * SEQ, CTXL = 256, TC = NBATCH * CTXL, TT = T + TC;
constexpr int NWIN = 1536;
constexpr int LC = 32, KT5 = 768, NCH = SEQ / LC  , NCC = CTXL / LC  ;
constexpr int M5LAT = NBATCH * NCH  , M5 = M5LAT + NBATCH * NCC  , M5PAD = 1280;
constexpr int NE = 64;
constexpr int NPHASE = 14;
constexpr int HALF_T = T / 2;
constexpr float ALPHA_F = 1.189207115002721f, LN_EPS_F = 1e-5f;

constexpr size_t MiB = 1u << 20;
constexpr size_t WS_CTL = 0, CTL_ZERO_BYTES = 65536;
constexpr size_t WS_CNT = 32768;
constexpr size_t WS_ADA = 65536;
constexpr size_t WS_RWH = 384 * 1024;
constexpr size_t WS_RWL = 512 * 1024;
constexpr size_t WS_ALC = 640 * 1024;
constexpr size_t WS_LCA = 768 * 1024;
constexpr size_t WS_SA = 1 * MiB, WS_SB = 4 * MiB, WS_HIN = 7 * MiB;
constexpr size_t WS_BTGLU = 10 * MiB;
constexpr size_t WS_BTOUT = 10 * MiB + 512 * 1024;
constexpr size_t WS_BTLRU = 12 * MiB + 512 * 1024;
constexpr size_t WS_BS5 = 13 * MiB;
constexpr size_t WS_ES5 = 37 * MiB;
constexpr size_t WS_BTGU = 45 * MiB;
constexpr size_t WS_BTDN = 110 * MiB;
constexpr size_t WS_HB = 143 * MiB;
constexpr size_t WS_BTIN = 211 * MiB;
constexpr size_t WS_HM = 366 * MiB;
constexpr size_t WS_US5 = 238 * MiB;
constexpr size_t WS_ULRU = 298 * MiB;
constexpr size_t WS_SLOC = 366 * MiB;
constexpr size_t WS_YS5 = 400 * MiB;
constexpr size_t WS_YCAT = 448 * MiB;
constexpr size_t WS_Y = 295 * MiB;
constexpr size_t WS_LTOK = 10 * MiB;
constexpr size_t WS_LWT = 18 * MiB;
constexpr size_t WS_PAIR = 26 * MiB;
constexpr size_t WS_HMID = 143 * MiB;
constexpr size_t WS_SLAB = 216 * MiB;
constexpr float SLAB_SCALE = 32.f;
constexpr size_t WS_END = 512 * MiB;

constexpr int LDS_BYTES = 155648;
constexpr int MISC_OFF = LDS_BYTES - 256;

DEV float bf2f(bf16_t h) { return __uint_as_float(((unsigned)h) << 16); }
DEV unsigned f2bf(float f) { unsigned u = __float_as_uint(f); return (u + 0x7fffu + ((u >> 16) & 1u)) >> 16; }
typedef float f32x2_t __attribute__((ext_vector_type(2)));
typedef __bf16 bf16x2_t __attribute__((ext_vector_type(2)));
DEV unsigned pack2(float a, float b) { const f32x2_t v = {a, b}; return __builtin_bit_cast(unsigned, __builtin_convertvector(v, bf16x2_t)); }
DEV float sigmoid_f(float x) { return __builtin_amdgcn_rcpf(1.f + __builtin_amdgcn_exp2f(-1.4426950408889634f * x)); }
DEV float gelu_tanh(float x) {
    const float z2 = 1.5957691216057308f * (x + 0.044715f * x * x * x);
    return x * __builtin_amdgcn_rcpf(1.f + __builtin_amdgcn_exp2f(-1.4426950408889634f * z2));
}
DEV float wave_sum(float v) {
#pragma unroll
    for (int o = 1; o < 64; o <<= 1) v += __shfl_xor(v, o);
    return v;
}

struct Params { const float* in[39]; float* out; unsigned char* ws; int ph_lo, ph_hi; };

#define XB_TMO      128
#define XB_XCNT(j)  (256  + 64 * (j))
#define XB_XSUB(j)  (1280 + 64 * (j))
#define XB_XGEN(j)  (2304 + 64 * (j))
#define XB_TOP      3328
#define XB_TOPGEN   3392
#define XCD_BAR_WORDS 3456
#define XB_SPIN_CAP (1u << 20)
DEV unsigned xb_ld(unsigned* p)              { return __hip_atomic_load(p, __ATOMIC_RELAXED, __HIP_MEMORY_SCOPE_AGENT); }
DEV unsigned xb_add(unsigned* p, unsigned v) { return __hip_atomic_fetch_add(p, v, __ATOMIC_RELAXED, __HIP_MEMORY_SCOPE_AGENT); }
DEV unsigned xb_xcc_id() { return (unsigned)__builtin_amdgcn_s_getreg((3 << 11) | 20) & 0xFu; }
#define XB_SPIN(cond, bar) do { unsigned _sp = 0; while (cond) { __builtin_amdgcn_s_sleep(1); \
    if ((++_sp & 255u) == 0u) { if (xb_ld(&(bar)[XB_TMO])) break; if (_sp > XB_SPIN_CAP) { atomicAdd(&(bar)[XB_TMO], 1u); break; } } } } while (0)
struct XcdBarrier { unsigned* bar; unsigned x; volatile LAS unsigned* st; };
DEV XcdBarrier xcd_barrier_post(unsigned* bar, volatile LAS unsigned* st) {
    XcdBarrier b; b.bar = bar; b.x = xb_xcc_id(); b.st = st;
    if (threadIdx.x == 0) (void)xb_add(&bar[XB_XCNT(b.x)], 1u);
    return b;
}
DEV void xcd_barrier_complete(unsigned* bar, unsigned x, unsigned& nloc, unsigned& nx) {
    const unsigned G = gridDim.x * gridDim.y * gridDim.z;
    unsigned sum, cnt, mine, sp = 0u;
    for (;;) {
        sum = 0u; cnt = 0u; mine = 0u;
#pragma unroll
        for (unsigned j = 0; j < 16; ++j) { const unsigned c = xb_ld(&bar[XB_XCNT(j)]); sum += c; cnt += (c > 0u) ? 1u : 0u; mine = (j == x) ? c : mine; }
        if (sum == G) break;
        __builtin_amdgcn_s_sleep(1);
        if ((++sp & 255u) == 0u) { if (xb_ld(&bar[XB_TMO])) break; if (sp > XB_SPIN_CAP) { atomicAdd(&bar[XB_TMO], 1u); break; } }
    }
    nloc = mine > 0u ? mine : 1u; nx = cnt > 0u ? cnt : 1u;
}
DEV void xcd_barrier(const XcdBarrier& b) {
    asm volatile("s_waitcnt vmcnt(0)" ::: "memory");
    __syncthreads();
    if (threadIdx.x == 0) {
        unsigned* bar = b.bar;
        __builtin_amdgcn_s_waitcnt(0);
        unsigned nloc = b.st[0], nx = b.st[1];
        if (nloc == 0u) { xcd_barrier_complete(bar, b.x, nloc, nx); b.st[0] = nloc; b.st[1] = nx; }
        const unsigned old = xb_add(&bar[XB_XSUB(b.x)], 1u);
        const unsigned gen = old / nloc;
        if (old + 1u == (gen + 1u) * nloc) {
            __builtin_amdgcn_fence(__ATOMIC_RELEASE, "agent");
            asm volatile("s_waitcnt vmcnt(0)" ::: "memory");
            const unsigned og = xb_add(&bar[XB_TOP], 1u);
            const unsigned tg = og / nx;
            if (og + 1u == (tg + 1u) * nx) xb_add(&bar[XB_TOPGEN], 1u);
            else XB_SPIN(xb_ld(&bar[XB_TOPGEN]) == tg, bar);
            __builtin_amdgcn_fence(__ATOMIC_ACQUIRE, "agent");
            xb_add(&bar[XB_XGEN(b.x)], 1u);
            asm volatile("s_waitcnt vmcnt(0)" ::: "memory");
        } else {
            XB_SPIN(xb_ld(&bar[XB_XGEN(b.x)]) == gen, bar);
            __builtin_amdgcn_fence(__ATOMIC_ACQUIRE, "agent");
            asm volatile("s_waitcnt vmcnt(0)" ::: "memory");
        }
    }
    __syncthreads();
}

constexpr int GEMM_LDS = 61440;
template <class ARow, class Epi>
DEV void gemm_unit(LAS unsigned char* lds, const ARow& arow, const bf16_t* __restrict__ Bt, int K, const Epi& epi) {
    const int tid = threadIdx.x, wid = tid >> 6, lane = tid & 63, wr = wid >> 1, wc = wid & 1, fr = lane & 15, fq = lane >> 4;
    LAS unsigned char* As = lds;
    LAS unsigned char* Bs = lds + 40960;
    const u32x4* pa0 = (const u32x4*)arow(tid >> 2) + (tid & 3);
    const u32x4* pa1 = (const u32x4*)arow(128 + (tid >> 2)) + (tid & 3);
    const u32x4* pb = (const u32x4*)(Bt + (size_t)(tid >> 2) * K) + (tid & 3);
    const int sa0 = (tid >> 2) * 80 + (tid & 3) * 16, sa1 = sa0 + 128 * 80;
    f32x4 acc[4][4];
#pragma unroll
    for (int i = 0; i < 4; ++i)
#pragma unroll
        for (int j = 0; j < 4; ++j) acc[i][j] = (f32x4){0.f, 0.f, 0.f, 0.f};
    const int nk = K >> 5;
    u32x4 ra0 = pa0[0], ra1 = pa1[0], rb = pb[0];
    *(LAS u32x4*)(As + sa0) = ra0; *(LAS u32x4*)(As + sa1) = ra1; *(LAS u32x4*)(Bs + sa0) = rb;
    __syncthreads();
    for (int kt = 0; kt < nk; ++kt) {
        const int cur = kt & 1;
        if (kt + 1 < nk) { ra0 = pa0[(kt + 1) * 4]; ra1 = pa1[(kt + 1) * 4]; rb = pb[(kt + 1) * 4]; }
        LAS const unsigned char* Ac = As + cur * 20480 + (wr * 64 + fr) * 80 + fq * 16;
        LAS const unsigned char* Bc = Bs + cur * 10240 + (wc * 64 + fr) * 80 + fq * 16;
        bf16x8 af[4], bfv[4];
#pragma unroll
        for (int i = 0; i < 4; ++i) af[i] = *(LAS const bf16x8*)(Ac + i * 1280);
#pragma unroll
        for (int j = 0; j < 4; ++j) bfv[j] = *(LAS const bf16x8*)(Bc + j * 1280);
#pragma unroll
        for (int i = 0; i < 4; ++i)
#pragma unroll
            for (int j = 0; j < 4; ++j) acc[i][j] = __builtin_amdgcn_mfma_f32_16x16x32_bf16(bfv[j], af[i], acc[i][j], 0, 0, 0);
        if (kt + 1 < nk) {
            const int nx = cur ^ 1;
            *(LAS u32x4*)(As + nx * 20480 + sa0) = ra0; *(LAS u32x4*)(As + nx * 20480 + sa1) = ra1; *(LAS u32x4*)(Bs + nx * 10240 + sa0) = rb;
        }
        __syncthreads();
    }
    epi(acc, wr * 64 + fr, wc * 64 + 4 * fq);
}

namespace gp {
constexpr int BK = 64, HALF = 128, HTB = HALF * BK * 2, STAGE_BYTES = 8 * HTB;
DEV int lds_byte(int r, int c) { const int st = (r >> 4) * 2 + (c >> 5), rr = r & 15, cc = c & 31, ob = rr * 64 + cc * 2; return st * 1024 + (ob ^ (((ob >> 9) & 1) << 5)); }
DEV void stage_rc(int b, int& R, int& C) { const int st = b / 1024, sb = b % 1024, swz = sb ^ (((sb >> 9) & 1) << 5); R = (st >> 1) * 16 + swz / 64; C = (st & 1) * 32 + (swz % 64) / 2; }
DEV int perm32(int rho) { const int n = rho >> 4, i = rho & 15; return 8 * (i >> 2) + 4 * n + (i & 3); }
struct UAddr { const char* a; const char* b; unsigned ao00, ao01, ao10, ao11; };
template <class Epi, class Sched>
DEV void gemm_phase(LAS unsigned char* lds, const int K, const Sched& S, const Epi& E) {
    typedef typename Sched::Unit Unit;
    int tid_ = threadIdx.x; asm volatile("" : "+v"(tid_));
    const int tid = tid_, wid = __builtin_amdgcn_readfirstlane(tid >> 6), lane = tid & 63, wr = wid >> 2, wc = wid & 3, fr = lane & 15, fq = lane >> 4;
    const int nt = K / BK;
    int R0, C0, R1, C1; stage_rc(tid * 16, R0, C0); stage_rc(tid * 16 + 8192, R1, C1);
    const int Rb0 = Epi::PERM ? ((R0 & ~31) + perm32(R0 & 31)) : R0, Rb1 = Epi::PERM ? ((R1 & ~31) + perm32(R1 & 31)) : R1;
    const unsigned vb0 = (unsigned)(Rb0 * K + C0) * 2u, vb1 = (unsigned)(Rb1 * K + C1) * 2u;
    const size_t kstep = (size_t)(BK * 2);
    const size_t hstepB = (size_t)HALF * K * 2;
    const int lda_ = S.lda();
    const unsigned va0 = (unsigned)(R0 * lda_ + C0) * 2u, va1 = (unsigned)(R1 * lda_ + C1) * 2u;
    const size_t hstepA = (size_t)HALF * lda_ * 2;
    const unsigned ldsw = (unsigned)wid * 1024u;
    const int aoff = lds_byte(wr * 64 + fr, fq * 8), boff = lds_byte(wc * 32 + fr, fq * 8);
#define GP_SA(b, h) (((b) * 2 + (h)) * HTB)
#define GP_SB(b, h) ((4 + (b) * 2 + (h)) * HTB)
#define GP_GLDS(gp_, bufoff, i_) __builtin_amdgcn_global_load_lds((const unsigned*)(gp_), (LAS unsigned*)(lds + (bufoff) + ldsw + (i_) * 8192), 16, 0, 0)
#define GP_STAGE_A(bufoff, ab, o0, o1, h, kb) do { if constexpr (Sched::GATHER) { const char* up_ = (ab) + (kb); GP_GLDS(up_ + (o0), bufoff, 0); GP_GLDS(up_ + (o1), bufoff, 1); } \
        else { const char* up_ = (ab) + (((h) ? hstepA : (size_t)0) + (kb)); GP_GLDS(up_ + va0, bufoff, 0); GP_GLDS(up_ + va1, bufoff, 1); } } while (0)
#define GP_STAGE_B(bufoff, bb, h, kb) do { const char* up_ = (bb) + (((h) ? hstepB : (size_t)0) + (kb)); GP_GLDS(up_ + vb0, bufoff, 0); GP_GLDS(up_ + vb1, bufoff, 1); } while (0)
#define GP_LDA(dst, b, h) do { _Pragma("unroll") for (int m = 0; m < 4; ++m) _Pragma("unroll") for (int k = 0; k < 2; ++k) dst[m][k] = *(const LAS bf16x8*)(lds + GP_SA(b, h) + aoff + m * 2048 + k * 1024); } while (0)
#define GP_LDB(dst, b, h) do { _Pragma("unroll") for (int n = 0; n < 2; ++n) _Pragma("unroll") for (int k = 0; k < 2; ++k) dst[n][k] = *(const LAS bf16x8*)(lds + GP_SB(b, h) + boff + n * 2048 + k * 1024); } while (0)
#define GP_MMA(ai, bj, At, Bt) do { __builtin_amdgcn_s_setprio(1); _Pragma("unroll") for (int m = 0; m < 4; ++m) _Pragma("unroll") for (int n = 0; n < 2; ++n) _Pragma("unroll") for (int k = 0; k < 2; ++k) \
        acc[ai][bj][m][n] = __builtin_amdgcn_mfma_f32_16x16x32_bf16(Bt[n][k], At[m][k], acc[ai][bj][m][n], 0, 0, 0); __builtin_amdgcn_s_setprio(0); } while (0)
#define GP_WAIT_V(n) asm volatile("s_waitcnt vmcnt(" #n ")" ::: "memory")
#define GP_WAIT_L(n) asm volatile("s_waitcnt lgkmcnt(" #n ")" ::: "memory")
#define GP_BAR __builtin_amdgcn_s_barrier()
#define GP_SCHED __builtin_amdgcn_sched_barrier(0)
    Unit cur, nxt; int ui = 0;
    if (!S.next(0, cur)) return;
    const char* cA; const char* cB; unsigned c00 = 0, c01 = 0, c10 = 0, c11 = 0;
    const char* nA; const char* nB; unsigned n00 = 0, n01 = 0, n10 = 0, n11 = 0;
    { UAddr t_; S.addr(cur, R0, C0, R1, C1, t_); cA = t_.a; cB = t_.b; if constexpr (Sched::GATHER) { c00 = t_.ao00; c01 = t_.ao01; c10 = t_.ao10; c11 = t_.ao11; } }
    f32x4 acc[2][2][4][2];
#pragma unroll
    for (int a = 0; a < 2; ++a)
#pragma unroll
        for (int b = 0; b < 2; ++b)
#pragma unroll
            for (int m = 0; m < 4; ++m)
#pragma unroll
                for (int n = 0; n < 2; ++n) acc[a][b][m][n] = (f32x4){0.f, 0.f, 0.f, 0.f};
    bf16x8 At[4][2], B0[2][2], B1[2][2];
    GP_STAGE_B(GP_SB(0, 0), cB, 0, 0); GP_STAGE_B(GP_SB(0, 1), cB, 1, 0); GP_STAGE_A(GP_SA(0, 0), cA, c00, c01, 0, 0); GP_STAGE_A(GP_SA(0, 1), cA, c10, c11, 1, 0);
    if (wr == 1) GP_BAR;
    GP_WAIT_V(2); GP_BAR;
    GP_STAGE_B(GP_SB(1, 0), cB, 0, kstep); GP_STAGE_A(GP_SA(1, 0), cA, c00, c01, 0, kstep); GP_STAGE_B(GP_SB(1, 1), cB, 1, kstep);
    GP_WAIT_V(6); GP_BAR;
    for (;;) {
        const bool has_next = S.next(ui + 1, nxt);
        if (has_next) { UAddr t_; S.addr(nxt, R0, C0, R1, C1, t_); nA = t_.a; nB = t_.b; if constexpr (Sched::GATHER) { n00 = t_.ao00; n01 = t_.ao01; n10 = t_.ao10; n11 = t_.ao11; } }
        else { nA = cA; nB = cB; n00 = c00; n01 = c01; n10 = c10; n11 = c11; }
#pragma unroll 1
        for (int t = 0; t < nt; t += 2) {
            const bool last = (t == nt - 2);
            const size_t k1 = (size_t)(t + 1) * kstep;
            const char* sA = last ? nA : cA; const char* sB = last ? nB : cB;
            const unsigned s00 = last ? n00 : c00, s01 = last ? n01 : c01, s10 = last ? n10 : c10, s11 = last ? n11 : c11;
            const size_t k2 = last ? (size_t)0 : (size_t)(t + 2) * kstep, k3 = k2 + kstep;
            GP_LDB(B0, 0, 0); GP_LDB(B1, 0, 1); GP_SCHED; GP_LDA(At, 0, 0); GP_STAGE_A(GP_SA(1, 1), cA, c10, c11, 1, k1);
            GP_WAIT_V(8); GP_WAIT_L(0); GP_BAR; GP_MMA(0, 0, At, B0); GP_MMA(0, 1, At, B1); GP_BAR; GP_SCHED;
            GP_LDA(At, 0, 1); GP_STAGE_B(GP_SB(0, 0), sB, 0, k2); GP_STAGE_B(GP_SB(0, 1), sB, 1, k2); GP_STAGE_A(GP_SA(0, 0), sA, s00, s01, 0, k2);
            GP_WAIT_V(8); GP_WAIT_L(0); GP_BAR; GP_MMA(1, 0, At, B0); GP_MMA(1, 1, At, B1); GP_BAR; GP_SCHED;
            GP_LDB(B0, 1, 0); GP_LDB(B1, 1, 1); GP_SCHED; GP_LDA(At, 1, 0); GP_STAGE_A(GP_SA(0, 1), sA, s10, s11, 1, k2);
            GP_WAIT_V(8); GP_WAIT_L(0); GP_BAR; GP_MMA(0, 0, At, B0); GP_MMA(0, 1, At, B1); GP_BAR; GP_SCHED;
            GP_LDA(At, 1, 1); GP_STAGE_B(GP_SB(1, 0), sB, 0, k3); GP_STAGE_B(GP_SB(1, 1), sB, 1, k3); GP_STAGE_A(GP_SA(1, 0), sA, s00, s01, 0, k3);
            GP_WAIT_V(8); GP_WAIT_L(0); GP_BAR; GP_MMA(1, 0, At, B0); GP_MMA(1, 1, At, B1); GP_BAR; GP_SCHED;
        }
        if (wr == 0) GP_BAR;
        E(acc, cur, wr, wc, fr, fq);
        if (!has_next) break;
#pragma unroll
        for (int a = 0; a < 2; ++a)
#pragma unroll
            for (int b = 0; b < 2; ++b)
#pragma unroll
                for (int m = 0; m < 4; ++m)
#pragma unroll
                    for (int n = 0; n < 2; ++n) acc[a][b][m][n] = (f32x4){0.f, 0.f, 0.f, 0.f};
        cur = nxt; cA = nA; cB = nB; c00 = n00; c01 = n01; c10 = n10; c11 = n11; ++ui;
        if (wr == 1) GP_BAR;
    }
    GP_WAIT_V(0);
    GP_BAR;
#undef GP_SA
#undef GP_SB
#undef GP_GLDS
#undef GP_STAGE_A
#undef GP_STAGE_B
#undef GP_LDA
#undef GP_LDB
#undef GP_MMA
#undef GP_WAIT_V
#undef GP_WAIT_L
#undef GP_BAR
#undef GP_SCHED
}
DEV bool static_order(int i, int G, int c, int nM, int nN, int& pm, int& pn) {
    const int nwg = nM * nN; const long L = (long)i * G + c; if (L >= nwg) return false;
    int wgid = (int)L; { const int q = nwg / 8, r = nwg % 8, xcd = wgid % 8, off = wgid / 8; wgid = (xcd < r ? xcd * (q + 1) : r * (q + 1) + (xcd - r) * q) + off; }
    const int nig = 8 * nN, gid = wgid / nig, fm = gid * 8, gsz = (nM - fm) < 8 ? (nM - fm) : 8;
    pm = fm + ((wgid % nig) % gsz); pn = (wgid % nig) / gsz; return true;
}
}

struct PlainSched {
    struct Unit { int pm, pn; };
    static constexpr bool GATHER = false;
    const char* A; const char* Bt; int lda_, K, nM, nN, G, c;
    DEV int lda() const { return lda_; }
    DEV bool next(int i, Unit& u) const { return gp::static_order(i, G, c, nM, nN, u.pm, u.pn); }
    DEV void addr(const Unit& u, int R0, int C0, int R1, int C1, gp::UAddr& o) const {
        o.a = A + (size_t)u.pm * 256 * lda_ * 2; o.b = Bt + (size_t)u.pn * 256 * K * 2;
    }
};
struct EpiF32 {
    static constexpr bool PERM = false;
    float* O; int ldc;
    template <class U> DEV void operator()(const f32x4 (&acc)[2][2][4][2], const U& u, int wr, int wc, int fr, int fq) const {
        const int row0 = u.pm * 256 + wr * 64 + fr, col0 = u.pn * 256 + wc * 32 + 4 * fq;
#pragma unroll
        for (int ai = 0; ai < 2; ++ai)
#pragma unroll
            for (int m = 0; m < 4; ++m) {
                float* rowp = O + (size_t)(row0 + ai * 128 + m * 16) * ldc + col0;
#pragma unroll
                for (int bj = 0; bj < 2; ++bj)
#pragma unroll
                    for (int n = 0; n < 2; ++n) *(f32x4*)(rowp + bj * 128 + n * 16) = acc[ai][bj][m][n];
            }
    }
};

DEV void bf8_unpack(const u32x4 w, float (&y)[8]) {
    y[0] = __uint_as_float(w.x << 16); y[1] = __uint_as_float(w.x & 0xffff0000u); y[2] = __uint_as_float(w.y << 16); y[3] = __uint_as_float(w.y & 0xffff0000u);
    y[4] = __uint_as_float(w.z << 16); y[5] = __uint_as_float(w.z & 0xffff0000u); y[6] = __uint_as_float(w.w << 16); y[7] = __uint_as_float(w.w & 0xffff0000u);
}
struct WinSched {
    struct Unit { int pm, pn; };
    static constexpr bool GATHER = false;
    const char* A; const char* Bt; int G, c;
    DEV int lda() const { return 1024; }
    DEV bool next(int i, Unit& u) const { return gp::static_order(i, G, c, 136, 6, u.pm, u.pn); }
    DEV void addr(const Unit& u, int R0, int C0, int R1, int C1, gp::UAddr& o) const {
        o.a = A + (size_t)u.pm * 256 * 1024 * 2; o.b = Bt + ((size_t)u.pn * 256) * 1024 * 2;
    }
};
struct EpiWin {
    static constexpr bool PERM = true;
    bf16_t* US5; bf16_t* ULRU;
    template <class U> DEV void operator()(const f32x4 (&acc)[2][2][4][2], const U& u, int wr, int wc, int fr, int fq) const {
#pragma unroll
        for (int bj = 0; bj < 2; ++bj) {
            const int col8 = u.pn * 256 + bj * 128 + wc * 32 + 8 * fq;
#pragma unroll
            for (int ai = 0; ai < 2; ++ai)
#pragma unroll
                for (int m = 0; m < 4; ++m) {
                    const int row = u.pm * 256 + ai * 128 + wr * 64 + m * 16 + fr;
                    const f32x4 v0 = acc[ai][bj][m][0], v1 = acc[ai][bj][m][1];
                    u32x4 w; w.x = pack2(v0[0], v0[1]); w.y = pack2(v0[2], v0[3]); w.z = pack2(v1[0], v1[1]); w.w = pack2(v1[2], v1[3]);
                    if (col8 < 512) {
                        int mm, ss;
                        if (row < T) { const int bq = row >> 12, t = row & 4095; mm = bq * 128 + (t >> 5); ss = t & 31; }
                        else { const int q = row - T, bq = q >> 8, j = q & 255; mm = M5LAT + bq * 8 + (j >> 5); ss = j & 31; }
                        *(u32x4*)(US5 + ((size_t)((col8 >> 4) * M5PAD + mm)) * KT5 + ss * 16 + (col8 & 15)) = w;
                    } else *(u32x4*)(ULRU + (size_t)row * 1024 + (col8 - 512)) = w;
                }
        }
    }
};
struct S5Sched {
    struct Unit { int g, pm, pn; };
    static constexpr bool GATHER = false;
    const char* A; const char* Bt; int K, nPm, nPn, brows  , G, c;
    DEV int lda() const { return KT5; }
    DEV bool next(int i, Unit& u) const {
        if (i > 0) return false;
        const int per = nPm * nPn * 4;
        const int x = c & 7, j = c >> 3; if (j >= per) return false;
        const int U = x * per + j; u.g = U / (nPm * nPn); const int r = U % (nPm * nPn); u.pm = r / nPn; u.pn = r % nPn; return true;
    }
    DEV void addr(const Unit& u, int R0, int C0, int R1, int C1, gp::UAddr& o) const {
        o.a = A + ((size_t)u.g * M5PAD + u.pm * 256) * KT5 * 2; o.b = Bt + ((size_t)u.g * brows + u.pn * 256) * K * 2;
    }
};
struct EpiS5Loc {
    static constexpr bool PERM = false;
    float* SLOC;
    template <class U> DEV void operator()(const f32x4 (&acc)[2][2][4][2], const U& u, int wr, int wc, int fr, int fq) const {
#pragma unroll
        for (int ai = 0; ai < 2; ++ai)
#pragma unroll
            for (int m = 0; m < 4; ++m) {
                const int mm = u.pm * 256 + ai * 128 + wr * 64 + m * 16 + fr;
                if (mm < M5) {
                    float* rowp = SLOC + ((size_t)(u.g * M5 + mm)) * 256 + wc * 32 + 4 * fq;
#pragma unroll
                    for (int bj = 0; bj < 2; ++bj)
#pragma unroll
                        for (int n = 0; n < 2; ++n) *(f32x4*)(rowp + bj * 128 + n * 16) = acc[ai][bj][m][n];
                }
            }
    }
};
struct EpiS5Out {
    static constexpr bool PERM = true;
    bf16_t* YS5;
    template <class U> DEV void operator()(const f32x4 (&acc)[2][2][4][2], const U& u, int wr, int wc, int fr, int fq) const {
#pragma unroll
        for (int ai = 0; ai < 2; ++ai)
#pragma unroll
            for (int m = 0; m < 4; ++m) {
                const int mm = u.pm * 256 + ai * 128 + wr * 64 + m * 16 + fr, bq = mm >> 7, chunk = mm & 127;
#pragma unroll
                for (int bj = 0; bj < 2; ++bj) {
                    const int n8 = u.pn * 256 + bj * 128 + wc * 32 + 8 * fq, t = n8 >> 4, c0 = n8 & 15;
                    const size_t tok = (size_t)bq * 4096 + chunk * 32 + t;
                    const f32x4 v0 = acc[ai][bj][m][0], v1 = acc[ai][bj][m][1];
                    u32x4 w; w.x = pack2(gelu_tanh(v0[0]), gelu_tanh(v0[1])); w.y = pack2(gelu_tanh(v0[2]), gelu_tanh(v0[3]));
                    w.z = pack2(gelu_tanh(v1[0]), gelu_tanh(v1[1])); w.w = pack2(gelu_tanh(v1[2]), gelu_tanh(v1[3]));
                    *(u32x4*)(YS5 + tok * 512 + u.g * 16 + c0) = w;
                }
            }
    }
};
struct EpiGlu {
    static constexpr bool PERM = true;
    const bf16_t* YS5; const float* b_glu; bf16_t* YCAT;
    template <class U> DEV void operator()(const f32x4 (&acc)[2][2][4][2], const U& u, int wr, int wc, int fr, int fq) const {
        const int col0 = u.pn * 256 + wc * 32 + 8 * fq; const size_t row0 = (size_t)u.pm * 256 + wr * 64 + fr;
        f32x4 bv[2][2];
#pragma unroll
        for (int bj = 0; bj < 2; ++bj) { bv[bj][0] = *(const f32x4*)(b_glu + col0 + bj * 128); bv[bj][1] = *(const f32x4*)(b_glu + col0 + bj * 128 + 4); }
        u32x4 yv[2][4][2];
#pragma unroll
        for (int ai = 0; ai < 2; ++ai)
#pragma unroll
            for (int m = 0; m < 4; ++m)
#pragma unroll
                for (int bj = 0; bj < 2; ++bj) yv[ai][m][bj] = *(const u32x4*)(YS5 + (row0 + ai * 128 + m * 16) * 512 + col0 + bj * 128);
#pragma unroll
        for (int ai = 0; ai < 2; ++ai)
#pragma unroll
            for (int m = 0; m < 4; ++m)
#pragma unroll
                for (int bj = 0; bj < 2; ++bj) {
                    float y[8]; bf8_unpack(yv[ai][m][bj], y);
                    const f32x4 z0 = acc[ai][bj][m][0] + bv[bj][0], z1 = acc[ai][bj][m][1] + bv[bj][1];
                    u32x4 w; w.x = pack2(y[0] * sigmoid_f(z0[0]), y[1] * sigmoid_f(z0[1])); w.y = pack2(y[2] * sigmoid_f(z0[2]), y[3] * sigmoid_f(z0[3]));
                    w.z = pack2(y[4] * sigmoid_f(z1[0]), y[5] * sigmoid_f(z1[1])); w.w = pack2(y[6] * sigmoid_f(z1[2]), y[7] * sigmoid_f(z1[3]));
                    *(u32x4*)(YCAT + (row0 + ai * 128 + m * 16) * 1024 + col0 + bj * 128) = w;
                }
    }
};

DEV void tr_tile_wave(const float* __restrict__ W, int ldw, int k0, int n0, bf16_t* __restrict__ dst, int ldd, int mode, LAS float* tile, int lane) {
    f32x4 v[16];
#pragma unroll
    for (int i = 0; i < 16; ++i) v[i] = *(const f32x4*)(W + (size_t)(k0 + i * 4 + (lane >> 4)) * ldw + n0 + (lane & 15) * 4);
#pragma unroll
    for (int i = 0; i < 16; ++i) { LAS float* tp = tile + (i * 4 + (lane >> 4)) * 65 + (lane & 15) * 4; tp[0] = v[i][0]; tp[1] = v[i][1]; tp[2] = v[i][2]; tp[3] = v[i][3]; }
    __builtin_amdgcn_fence(__ATOMIC_RELEASE, "wavefront"); __builtin_amdgcn_wave_barrier(); __builtin_amdgcn_fence(__ATOMIC_ACQUIRE, "wavefront");
    const int kc = lane & 7;
#pragma unroll
    for (int jn = 0; jn < 8; ++jn) {
        const int nn = (lane >> 3) + 8 * jn;
        float e[8];
#pragma unroll
        for (int jj = 0; jj < 8; ++jj) e[jj] = tile[(kc * 8 + jj) * 65 + nn];
        const int j = n0 + nn;
        const int row = mode == 0 ? j : (((j >> 4) << 5) + (j & 15) + (mode == 2 ? 16 : 0));
        u32x4 w; w.x = pack2(e[0], e[1]); w.y = pack2(e[2], e[3]); w.z = pack2(e[4], e[5]); w.w = pack2(e[6], e[7]);
        *(u32x4*)(dst + (size_t)row * ldd + k0 + kc * 8) = w;
    }
    __builtin_amdgcn_fence(__ATOMIC_RELEASE, "wavefront"); __builtin_amdgcn_wave_barrier(); __builtin_amdgcn_fence(__ATOMIC_ACQUIRE, "wavefront");
}

DEV void gemv9_item(LAS const float* S, const float* __restrict__ W, int ldw, int col0, const float* __restrict__ bias, float* __restrict__ out, int ldo, LAS float* red) {
    const int tid = threadIdx.x, col = tid & 31, kp = tid >> 5;
    float acc[9];
#pragma unroll
    for (int b = 0; b < 9; ++b) acc[b] = 0.f;
    for (int k = kp * 64; k < kp * 64 + 64; ++k) {
        const float w = W[(size_t)k * ldw + col0 + col];
#pragma unroll
        for (int b = 0; b < 9; ++b) acc[b] += S[b * 1024 + k] * w;
    }
#pragma unroll
    for (int b = 0; b < 9; ++b) red[(kp * 9 + b) * 32 + col] = acc[b];
    __syncthreads();
    if (tid < 288) {
        const int b = tid >> 5, c = tid & 31; float s = 0.f;
#pragma unroll
        for (int q = 0; q < 16; ++q) s += red[(q * 9 + b) * 32 + c];
        out[b * ldo + col0 + c] = s + (bias ? bias[col0 + c] : 0.f);
    }
    __syncthreads();
}

DEV void cpow_d(double lr, double li, double dt, int l, double& re, double& im) {
    const double mag = exp(lr * dt * (double)l);
    const double ang = li * dt * (double)l;
    const double kq = rint(ang * 0.63661977236758134308);
    double x = fma(-kq, 1.57079632679489655800e+00, ang);
    x = fma(-kq, 6.12323399573676603587e-17, x);
    const double x2 = x * x;
    double s = -1.0 / 6227020800.0; s = fma(s, x2, 1.0 / 39916800.0); s = fma(s, x2, -1.0 / 362880.0); s = fma(s, x2, 1.0 / 5040.0);
    s = fma(s, x2, -1.0 / 120.0); s = fma(s, x2, 1.0 / 6.0); s = fma(-s, x2, 1.0); s = s * x;
    double c = 1.0 / 479001600.0; c = fma(c, x2, -1.0 / 3628800.0); c = fma(c, x2, 1.0 / 40320.0); c = fma(c, x2, -1.0 / 720.0);
    c = fma(c, x2, 1.0 / 24.0); c = fma(c, x2, -0.5); c = fma(c, x2, 1.0);
    const int q = ((int)(long long)kq) & 3;
    const double sn = (q == 0) ? s : (q == 1) ? c : (q == 2) ? -s : -c;
    const double cs = (q == 0) ? c : (q == 1) ? -s : (q == 2) ? -c : s;
    re = mag * cs; im = mag * sn;
}

DEV void s5_gen(const Params& p, LAS unsigned char* lds, int g, int part) {
    int tid = threadIdx.x; asm volatile("" : "+v"(tid));
    LAS float* apr = (LAS float*)lds;
    LAS float* api = apr + 4224;
    LAS float* bbr = api + 4224;
    LAS float* bbi = bbr + 2048;
    LAS float* ccr = bbi + 2048;
    LAS float* cci = ccr + 2048;
    LAS float* Kt = cci + 2048;
    const float* lam_re = p.in[9]; const float* lam_im = p.in[10]; const float* log_dt = p.in[11];
    const float* b_re = p.in[12]; const float* b_im = p.in[13]; const float* c_re = p.in[14]; const float* c_im = p.in[15]; const float* dvec = p.in[16];
    bf16_t* BS5 = (bf16_t*)(p.ws + WS_BS5); bf16_t* ES5 = (bf16_t*)(p.ws + WS_ES5); float* ALC = (float*)(p.ws + WS_ALC);
    for (int i = tid; i < 4224; i += 512) {
        const int dir = i / 2112, rem = i % 2112, l = rem >> 6, pp = rem & 63, gi = dir * 32 + g;
        const double dt = exp((double)log_dt[gi]);
        double re, im; cpow_d((double)lam_re[gi * 64 + pp], (double)lam_im[gi * 64 + pp], dt, l, re, im);
        apr[i] = (float)re; api[i] = (float)im;
    }
    for (int i = tid; i < 2048; i += 512) {
        const int dir = i >> 10, cc = (i >> 6) & 15, pp = i & 63; const size_t src = ((size_t)((dir * 32 + g) * 16 + cc)) * 64 + pp;
        ccr[i] = c_re[src]; cci[i] = c_im[src];
    }
    for (int i = tid; i < 2048; i += 512) {
        const int dir = i >> 10, pp = (i >> 4) & 63, c = i & 15, gi = dir * 32 + g;
        const double dt = exp((double)log_dt[gi]);
        const double lr = (double)lam_re[gi * 64 + pp], li = (double)lam_im[gi * 64 + pp];
        double ar, ai; cpow_d(lr, li, dt, 1, ar, ai);
        const double nr = ar - 1.0, den = lr * lr + li * li;
        const double fr = (nr * lr + ai * li) / den, fi = (ai * lr - nr * li) / den;
        const double br = (double)b_re[((size_t)(gi * 64 + pp)) * 16 + c], bi = (double)b_im[((size_t)(gi * 64 + pp)) * 16 + c];
        bbr[i] = (float)(fr * br - fi * bi); bbi[i] = (float)(fr * bi + fi * br);
    }
    __syncthreads();
    for (int o = tid; o < 1024; o += 512) {
        const int dir = o >> 9, l = (o >> 4) & 31, c = o & 15;
        f32x4 s0 = (f32x4){0.f, 0.f, 0.f, 0.f}, s1 = s0, s2 = s0, s3 = s0;
#pragma unroll 2
        for (int pp = 0; pp < 64; ++pp) {
            const float ar = apr[(dir * 33 + l) * 64 + pp], ai = api[(dir * 33 + l) * 64 + pp];
            const float cr = ccr[(dir * 16 + c) * 64 + pp], ci = cci[(dir * 16 + c) * 64 + pp];
            const float qr = cr * ar - ci * ai, qi = cr * ai + ci * ar;
            LAS const f32x4* br = (LAS const f32x4*)(bbr + (dir * 64 + pp) * 16); LAS const f32x4* bi = (LAS const f32x4*)(bbi + (dir * 64 + pp) * 16);
            s0 += br[0] * qr - bi[0] * qi; s1 += br[1] * qr - bi[1] * qi; s2 += br[2] * qr - bi[2] * qi; s3 += br[3] * qr - bi[3] * qi;
        }
        LAS f32x4* kd = (LAS f32x4*)(Kt + ((dir * 32 + l) * 16 + c) * 16);
        kd[0] = s0; kd[1] = s1; kd[2] = s2; kd[3] = s3;
    }
    __syncthreads();
    for (int q = tid; q < 64 * 96; q += 512) {
        const int n = part * 64 + q / 96, k8 = (q % 96) * 8, t = n >> 4, c = n & 15;
        float e[8];
        if (k8 < 512) {
            const int s = k8 >> 4, c0 = k8 & 15, delta = t - s;
#pragma unroll
            for (int i = 0; i < 8; ++i) {
                const int c2 = c0 + i; float v;
                if (delta > 0) v = Kt[delta * 256 + c * 16 + c2];
                else if (delta < 0) v = Kt[(32 - delta) * 256 + c * 16 + c2];
                else v = Kt[c * 16 + c2] + Kt[32 * 256 + c * 16 + c2] + (c == c2 ? dvec[g * 16 + c] : 0.f);
                e[i] = v;
            }
        } else {
            const int kk = k8 - 512, seg = kk >> 6, p0 = kk & 63, dir = seg >> 1, l = dir == 0 ? t + 1 : 32 - t;
#pragma unroll
            for (int i = 0; i < 8; ++i) {
                const int pp = p0 + i;
                const float ar = apr[(dir * 33 + l) * 64 + pp], ai = api[(dir * 33 + l) * 64 + pp];
                const float cr = ccr[(dir * 16 + c) * 64 + pp], ci = cci[(dir * 16 + c) * 64 + pp];
                e[i] = (seg & 1) ? -(cr * ai + ci * ar) : (cr * ar - ci * ai);
            }
        }
        u32x4 w; w.x = pack2(e[0], e[1]); w.y = pack2(e[2], e[3]); w.z = pack2(e[4], e[5]); w.w = pack2(e[6], e[7]);
        *(u32x4*)(BS5 + ((size_t)g * 512 + n) * 768 + k8) = w;
    }
    for (int q = tid; q < 32 * 64; q += 512) {
        const int n = part * 32 + (q >> 6), k8 = (q & 63) * 8, s = k8 >> 4, c0 = k8 & 15, seg = n >> 6, pp = n & 63, dir = seg >> 1, l = dir == 0 ? 31 - s : s;
        const float ar = apr[(dir * 33 + l) * 64 + pp], ai = api[(dir * 33 + l) * 64 + pp];
        float e[8];
#pragma unroll
        for (int i = 0; i < 8; ++i) {
            const float br = bbr[(dir * 64 + pp) * 16 + c0 + i], bi = bbi[(dir * 64 + pp) * 16 + c0 + i];
            e[i] = (seg & 1) ? (ar * bi + ai * br) : (ar * br - ai * bi);
        }
        u32x4 w; w.x = pack2(e[0], e[1]); w.y = pack2(e[2], e[3]); w.z = pack2(e[4], e[5]); w.w = pack2(e[6], e[7]);
        *(u32x4*)(ES5 + ((size_t)g * 256 + n) * 512 + k8) = w;
    }
    if (part == 0 && tid < 128) {
        const int dir = tid >> 6, pp = tid & 63;
        ALC[((dir * 32 + g) * 64 + pp) * 2 + 0] = apr[(dir * 33 + 32) * 64 + pp];
        ALC[((dir * 32 + g) * 64 + pp) * 2 + 1] = api[(dir * 33 + 32) * 64 + pp];
    }
    __syncthreads();
}

template <bool APPLY>
DEV void lru_item(const Params& p, LAS unsigned char* lds, int b, int ch, int h) {
    int tid_ = threadIdx.x; asm volatile("" : "+v"(tid_));
    const int tid = tid_, wid = tid >> 6, lane = tid & 63, fr = lane & 15, fq = lane >> 4;
    LAS float* xin = (LAS float*)lds;
    LAS float* xs = (LAS float*)(lds + 17408);
    LAS unsigned short* xsb = (LAS unsigned short*)(lds + 33792);
    LAS float* aa = (LAS float*)(lds + 43008);
    LAS float* bb = (LAS float*)(lds + 75776);
    LAS float* cAs = (LAS float*)(lds + 108544);
    const bf16_t* ULRU = (const bf16_t*)(p.ws + WS_ULRU);
    const bf16_t* BTLRU = (const bf16_t*)(p.ws + WS_BTLRU);
    const float* conv_w = p.in[19]; const float* conv_b = p.in[20];
    if (tid < 128) {
        const int dir = tid >> 6, j = tid & 63, o = dir * 512 + h * 64 + j;
        cAs[tid] = -8.f * log1pf(__expf(-p.in[25][o])); cAs[128 + tid] = p.in[22][o]; cAs[256 + tid] = p.in[24][o];
    }
    for (int c = tid; c < 67 * 8; c += 512) {
        const int rr = c >> 3, c8 = (c & 7) * 8, pos = rr - 2;
        u32x4 w = (u32x4){0u, 0u, 0u, 0u};
        if (ch < 64) { if (pos >= 0 && pos < 64) w = *(const u32x4*)(ULRU + ((size_t)b * 4096 + pos * 64 + ch) * 1024 + h * 64 + c8); }
        else { const int jt = (ch - 64) * 64 + pos; if (jt >= 0 && jt < 256) w = *(const u32x4*)(ULRU + ((size_t)T + b * 256 + jt) * 1024 + h * 64 + c8); }
        float y[8]; bf8_unpack(w, y);
        *(LAS f32x4*)(xin + rr * 64 + c8) = (f32x4){y[0], y[1], y[2], y[3]}; *(LAS f32x4*)(xin + rr * 64 + c8 + 4) = (f32x4){y[4], y[5], y[6], y[7]};
    }
    __syncthreads();
    {
        const int cc = tid & 63, chn = h * 64 + cc;
        const float w0 = conv_w[chn], w1 = conv_w[512 + chn], w2 = conv_w[1024 + chn], w3 = conv_w[1536 + chn], cb = conv_b[chn];
#pragma unroll 2
        for (int r = tid >> 6; r < 64; r += 8) {
            const float v = cb + w0 * xin[r * 64 + cc] + w1 * xin[(r + 1) * 64 + cc] + w2 * xin[(r + 2) * 64 + cc] + w3 * xin[(r + 3) * 64 + cc];
            xs[r * 64 + cc] = v; xsb[r * 72 + cc] = (unsigned short)f2bf(v);
        }
    }
    __syncthreads();
    {
        const int mt = wid & 3, dir = wid >> 2;
        bf16x8 af[2];
#pragma unroll
        for (int ks = 0; ks < 2; ++ks) af[ks] = *(LAS const bf16x8*)((LAS const unsigned char*)xsb + (mt * 16 + fr) * 144 + ks * 64 + fq * 16);
        const int r = mt * 16 + fr;
#pragma unroll
        for (int jt = 0; jt < 8; ++jt) {
            const int n = dir * 128 + jt * 16 + fr;
            const bf16_t* bp = BTLRU + ((size_t)(h * 256 + n)) * 64 + fq * 8;
            const bf16x8 b0 = *(const bf16x8*)bp, b1 = *(const bf16x8*)(bp + 32);
            f32x4 a = (f32x4){0.f, 0.f, 0.f, 0.f};
            a = __builtin_amdgcn_mfma_f32_16x16x32_bf16(b0, af[0], a, 0, 0, 0);
            a = __builtin_amdgcn_mfma_f32_16x16x32_bf16(b1, af[1], a, 0, 0, 0);
            LAS float* dst = (jt < 4 ? aa : bb) + (dir * 64 + r) * 64 + (jt & 3) * 16 + 4 * fq;
            *(LAS f32x4*)dst = a;
        }
    }
    __syncthreads();
#pragma unroll 2
    for (int idx = tid; idx < 8192; idx += 512) {
        const int dir = idx >> 12, j = idx & 63, r = (idx >> 6) & 63;
        const float za = aa[idx] + cAs[128 + dir * 64 + j], zx = bb[idx] + cAs[256 + dir * 64 + j];
        const float la = cAs[dir * 64 + j] * sigmoid_f(za);
        const float a = __expf(la);
        const float x2 = 2.f * la;
        const float em = -x2 * (1.f + x2 * (0.5f + x2 * (0.16666667f + x2 * (0.041666668f + x2 * (0.0083333338f + x2 * 0.0013888889f)))));
        aa[idx] = a; bb[idx] = sqrtf(em) * sigmoid_f(zx) * xs[r * 64 + j];
    }
    __syncthreads();
    if (tid < 128) {
        const int dir = tid >> 6, j = tid & 63, chn = h * 64 + j;
        LAS float* ap = aa + dir * 4096 + j; LAS float* bp = bb + dir * 4096 + j;
        if (!APPLY) {
            float H = 0.f, P = 1.f;
#pragma unroll 1
            for (int s0 = 0; s0 < 64; s0 += 16) {
                float av[16], bv[16];
#pragma unroll
                for (int q = 0; q < 16; ++q) { const int r = dir ? 63 - (s0 + q) : s0 + q; av[q] = ap[r * 64]; bv[q] = bp[r * 64]; }
#pragma unroll
                for (int q = 0; q < 16; ++q) { H = av[q] * H + bv[q]; P *= av[q]; }
            }
            float* SA = (float*)(p.ws + WS_SA); float* SB = (float*)(p.ws + WS_SB);
            const size_t o = ((size_t)(b * 68 + ch) * 2 + dir) * 512 + chn;
            SA[o] = P; SB[o] = H;
        } else {
            const float* HIN = (const float*)(p.ws + WS_HIN);
            float H = HIN[((size_t)(b * 64 + ch) * 2 + dir) * 512 + chn];
#pragma unroll 1
            for (int s0 = 0; s0 < 64; s0 += 16) {
                float av[16], bv[16];
#pragma unroll
                for (int q = 0; q < 16; ++q) { const int r = dir ? 63 - (s0 + q) : s0 + q; av[q] = ap[r * 64]; bv[q] = bp[r * 64]; }
#pragma unroll
                for (int q = 0; q < 16; ++q) { const int r = dir ? 63 - (s0 + q) : s0 + q; H = av[q] * H + bv[q]; bp[r * 64] = H; }
            }
        }
    }
    __syncthreads();
    if (APPLY) {
        bf16_t* YCAT = (bf16_t*)(p.ws + WS_YCAT);
        {
            const int r = tid >> 3, j8 = (tid & 7) * 8;
            const size_t row = (size_t)b * 4096 + r * 64 + ch;
            float gt[8]; bf8_unpack(*(const u32x4*)(ULRU + row * 1024 + 512 + h * 64 + j8), gt);
            float o[8];
#pragma unroll
            for (int q = 0; q < 8; ++q) o[q] = (bb[r * 64 + j8 + q] + bb[(64 + r) * 64 + j8 + q]) * gelu_tanh(gt[q]);
            u32x4 w; w.x = pack2(o[0], o[1]); w.y = pack2(o[2], o[3]); w.z = pack2(o[4], o[5]); w.w = pack2(o[6], o[7]);
            *(u32x4*)(YCAT + row * 1024 + 512 + h * 64 + j8) = w;
        }
        __syncthreads();
    }
}

template <int CTRL> DEV float dpp_f(float oldv, float src) {
    return __builtin_bit_cast(float, __builtin_amdgcn_update_dpp(__builtin_bit_cast(int, oldv), __builtin_bit_cast(int, src), CTRL, 0xf, 0xf, false));
}
template <bool REV> DEV void row_scan(float& a, float& b) {
#define LRU_STEP(D) { const float ap = dpp_f<(REV ? 0x100 : 0x110) + D>(1.f, a), bp = dpp_f<(REV ? 0x100 : 0x110) + D>(0.f, b); b = a * bp + b; a = a * ap; }
    LRU_STEP(1) LRU_STEP(2) LRU_STEP(4) LRU_STEP(8)
#undef LRU_STEP
}
template <bool APPLY>
DEV void lru_phase(const Params& p, int bid, int nb) {
    int tid = threadIdx.x; asm volatile("" : "+v"(tid));
    const int wid = tid >> 6, lane = tid & 63, fr = lane & 15, fq = lane >> 4;
    const int w = bid * 8 + wid, h = (w & 31) >> 2, q = w & 3;
    const bf16_t* ULRU = (const bf16_t*)(p.ws + WS_ULRU);
    const bf16_t* BTLRU = (const bf16_t*)(p.ws + WS_BTLRU);
    const float* conv_w = p.in[19]; const float* conv_b = p.in[20];
    const int c4 = h * 64 + q * 16 + 4 * fq;
    const int nch = APPLY ? 64 : 68, npairs = NBATCH * nch;
#pragma unroll 1
    for (int j = w >> 5; j < npairs; j += 64) {
        const int b = j / nch, ch = j % nch;
        int zo = 0; asm volatile("" : "+v"(zo));
        const bool lat = ch < 64;
        const unsigned base0 = (lat ? (unsigned)(b * 4096 + ch) * 2048u : (unsigned)(T + b * 256 + (ch - 64) * 64) * 2048u) + (unsigned)h * 128u;
        const unsigned pstride = lat ? 64u * 2048u : 2048u;
        const int plo = lat ? 0 : -(ch - 64) * 64, phi = lat ? 64 : 256 - (ch - 64) * 64;
        const char* UB = (const char*)ULRU;
        f32x4 acc[4][4];
#pragma unroll
        for (int mt = 0; mt < 4; ++mt)
#pragma unroll
            for (int nt = 0; nt < 4; ++nt) acc[mt][nt] = (f32x4){0.f, 0.f, 0.f, 0.f};
#pragma unroll
        for (int ks = 0; ks < 2; ++ks) {
            const int ci = h * 64 + ks * 32 + fq * 8 + zo;
            bf16x8 bfr[4];
#pragma unroll
            for (int nt = 0; nt < 4; ++nt) bfr[nt] = *(const bf16x8*)(BTLRU + ((size_t)(h * 256 + (nt >> 1) * 128 + (nt & 1) * 64 + q * 16 + fr)) * 64 + ks * 32 + fq * 8 + zo);
            f32x4 cw[4][2]; f32x4 cb[2];
#pragma unroll
            for (int k = 0; k < 4; ++k) { cw[k][0] = *(const f32x4*)(conv_w + k * 512 + ci); cw[k][1] = *(const f32x4*)(conv_w + k * 512 + ci + 4); }
            cb[0] = *(const f32x4*)(conv_b + ci); cb[1] = *(const f32x4*)(conv_b + ci + 4);
#pragma unroll
            for (int mt = 0; mt < 4; ++mt) {
                u32x4 xv[4];
#pragma unroll
                for (int k = 0; k < 4; ++k) {
                    const int pos = mt * 16 + fr + k - 2;
                    const int pc_ = pos < plo ? plo : (pos >= phi ? phi - 1 : pos);
                    const u32x4 ld_ = *(const u32x4*)(UB + (base0 + (unsigned)pc_ * pstride + (unsigned)(ks * 64 + fq * 16)));
                    const unsigned mk_ = (pos >= plo && pos < phi) ? 0xffffffffu : 0u;
                    xv[k] = (u32x4){ld_.x & mk_, ld_.y & mk_, ld_.z & mk_, ld_.w & mk_};
                }
                f32x4 s0 = cb[0], s1 = cb[1];
#pragma unroll
                for (int k = 0; k < 4; ++k) {
                    float y[8]; bf8_unpack(xv[k], y);
                    s0 += cw[k][0] * (f32x4){y[0], y[1], y[2], y[3]}; s1 += cw[k][1] * (f32x4){y[4], y[5], y[6], y[7]};
                }
                u32x4 aw; aw.x = pack2(s0[0], s0[1]); aw.y = pack2(s0[2], s0[3]); aw.z = pack2(s1[0], s1[1]); aw.w = pack2(s1[2], s1[3]);
                const bf16x8 af = __builtin_bit_cast(bf16x8, aw);
#pragma unroll
                for (int nt = 0; nt < 4; ++nt) acc[mt][nt] = __builtin_amdgcn_mfma_f32_16x16x32_bf16(bfr[nt], af, acc[mt][nt], 0, 0, 0);
                if (mt & 1) asm volatile("" ::: "memory");
            }
            asm volatile("" ::: "memory");
        }
        f32x4 cA[2], ba[2], bx[2];
#pragma unroll
        for (int dir = 0; dir < 2; ++dir) {
            cA[dir] = *(const f32x4*)((const float*)(p.ws + WS_LCA) + dir * 512 + c4 + zo);
            ba[dir] = *(const f32x4*)(p.in[22] + dir * 512 + c4 + zo); bx[dir] = *(const f32x4*)(p.in[24] + dir * 512 + c4 + zo);
        }
        f32x4 cwo[4];
#pragma unroll
        for (int k = 0; k < 4; ++k) cwo[k] = *(const f32x4*)(conv_w + k * 512 + c4 + zo);
        const f32x4 cbo = *(const f32x4*)(conv_b + c4 + zo);
#pragma unroll
        for (int mt = 0; mt < 4; ++mt) {
            f32x4 xo = cbo;
#pragma unroll
            for (int k = 0; k < 4; ++k) {
                const int pos = mt * 16 + fr + k - 2;
                {
                    const int pc_ = pos < plo ? plo : (pos >= phi ? phi - 1 : pos);
                    u32x2 xw = *(const u32x2*)(UB + (base0 + (unsigned)pc_ * pstride + (unsigned)(q * 32 + fq * 8)));
                    const unsigned mk_ = (pos >= plo && pos < phi) ? 0xffffffffu : 0u; xw.x &= mk_; xw.y &= mk_;
                    xo += cwo[k] * (f32x4){__uint_as_float(xw.x << 16), __uint_as_float(xw.x & 0xffff0000u), __uint_as_float(xw.y << 16), __uint_as_float(xw.y & 0xffff0000u)};
                }
            }
#pragma unroll
            for (int dir = 0; dir < 2; ++dir)
#pragma unroll
                for (int r = 0; r < 4; ++r) {
                    const float za = acc[mt][2 * dir][r] + ba[dir][r], zx = acc[mt][2 * dir + 1][r] + bx[dir][r];
                    const float a = __builtin_amdgcn_exp2f(cA[dir][r] * sigmoid_f(za));
                    acc[mt][2 * dir][r] = a;
                    acc[mt][2 * dir + 1][r] = __builtin_amdgcn_sqrtf(fmaf(-a, a, 1.f)) * sigmoid_f(zx) * xo[r];
                }
            asm volatile("" ::: "memory");
        }
        const int bsel15 = ((lane & 48) | 15) << 2, bsel0 = (lane & 48) << 2;
        if (!APPLY) {
            f32x4 PA[2], PH[2];
#pragma unroll
            for (int r = 0; r < 4; ++r) {
                float cAf = 1.f, cHf = 0.f, cAr = 1.f, cHr = 0.f;
#pragma unroll
                for (int mt = 0; mt < 4; ++mt) {
                    float a = acc[mt][0][r], bq = acc[mt][1][r]; row_scan<false>(a, bq);
                    const float At = __builtin_bit_cast(float, __builtin_amdgcn_ds_bpermute(bsel15, __builtin_bit_cast(int, a)));
                    const float Ht = __builtin_bit_cast(float, __builtin_amdgcn_ds_bpermute(bsel15, __builtin_bit_cast(int, bq)));
                    cHf = At * cHf + Ht; cAf *= At;
                }
#pragma unroll
                for (int mt = 3; mt >= 0; --mt) {
                    float a = acc[mt][2][r], bq = acc[mt][3][r]; row_scan<true>(a, bq);
                    const float At = __builtin_bit_cast(float, __builtin_amdgcn_ds_bpermute(bsel0, __builtin_bit_cast(int, a)));
                    const float Ht = __builtin_bit_cast(float, __builtin_amdgcn_ds_bpermute(bsel0, __builtin_bit_cast(int, bq)));
                    cHr = At * cHr + Ht; cAr *= At;
                }
                PA[0][r] = cAf; PH[0][r] = cHf; PA[1][r] = cAr; PH[1][r] = cHr;
            }
            if (fr == 0) {
                float* SA = (float*)(p.ws + WS_SA); float* SB = (float*)(p.ws + WS_SB);
#pragma unroll
                for (int dir = 0; dir < 2; ++dir) { const size_t o = ((size_t)(b * 68 + ch) * 2 + dir) * 512 + c4; *(f32x4*)(SA + o) = PA[dir]; *(f32x4*)(SB + o) = PH[dir]; }
            }
        } else {
            const float* HIN = (const float*)(p.ws + WS_HIN);
            const f32x4 hf = *(const f32x4*)(HIN + ((size_t)(b * 64 + ch) * 2 + 0) * 512 + c4), hr = *(const f32x4*)(HIN + ((size_t)(b * 64 + ch) * 2 + 1) * 512 + c4);
            f32x4 Ho[4];
#pragma unroll
            for (int r = 0; r < 4; ++r) {
                float carry = hf[r];
#pragma unroll
                for (int mt = 0; mt < 4; ++mt) {
                    float a = acc[mt][0][r], bq = acc[mt][1][r]; row_scan<false>(a, bq);
                    const float hv = bq + a * carry; Ho[mt][r] = hv;
                    carry = __builtin_bit_cast(float, __builtin_amdgcn_ds_bpermute(bsel15, __builtin_bit_cast(int, hv)));
                }
                carry = hr[r];
#pragma unroll
                for (int mt = 3; mt >= 0; --mt) {
                    float a = acc[mt][2][r], bq = acc[mt][3][r]; row_scan<true>(a, bq);
                    const float hv = bq + a * carry; Ho[mt][r] += hv;
                    carry = __builtin_bit_cast(float, __builtin_amdgcn_ds_bpermute(bsel0, __builtin_bit_cast(int, hv)));
                }
            }
            bf16_t* YCAT = (bf16_t*)(p.ws + WS_YCAT);
#pragma unroll
            for (int mt = 0; mt < 4; ++mt) {
                const size_t row = (size_t)b * 4096 + (size_t)(mt * 16 + fr) * 64 + ch;
                const u32x2 gw = *(const u32x2*)(ULRU + row * 1024 + 512 + c4);
                const float g0 = __uint_as_float(gw.x << 16), g1 = __uint_as_float(gw.x & 0xffff0000u), g2 = __uint_as_float(gw.y << 16), g3 = __uint_as_float(gw.y & 0xffff0000u);
                u32x2 ow; ow.x = pack2(Ho[mt][0] * gelu_tanh(g0), Ho[mt][1] * gelu_tanh(g1)); ow.y = pack2(Ho[mt][2] * gelu_tanh(g2), Ho[mt][3] * gelu_tanh(g3));
                *(u32x2*)(YCAT + row * 1024 + 512 + c4) = ow;
            }
        }
    }
}

#if PROBE_SUB == 6 || PROBE_SUB == 7
DEV void lru_load_probe(const Params& p, int bid, int nb) {
    int tid = threadIdx.x; asm volatile("" : "+v"(tid));
    const int wid = tid >> 6, lane = tid & 63, fr = lane & 15, fq = lane >> 4;
    const int w = bid * 8 + wid, h = (w & 31) >> 2, q = w & 3;
    const bf16_t* ULRU = (const bf16_t*)(p.ws + WS_ULRU);
    unsigned sink = 0;
    for (int j = w >> 5; j < NBATCH * 68; j += 64) {
        const int b = j / 68, ch = j % 68;
        const bool lat = ch < 64;
        const size_t base0 = lat ? ((size_t)b * 4096 + ch) * 1024 : ((size_t)T + b * 256 + (ch - 64) * 64) * 1024;
        const size_t pstride = lat ? (size_t)64 * 1024 : (size_t)1024;
#if PROBE_SUB == 6
        if (q == 0)
#endif
#pragma unroll
        for (int mt = 0; mt < 4; ++mt) { const int pos = mt * 16 + fr; const u32x4 v = *(const u32x4*)(ULRU + base0 + (size_t)pos * pstride + fq * 8 + h * 64); sink += v.x ^ v.y ^ v.z ^ v.w; }
    }
    asm volatile("" :: "v"(sink));
}
#endif
constexpr int MOE_TAB_OFF = 132096;
DEV void moe_tables(const Params& p, LAS unsigned char* lds, int h) {
    LAS int* tp = (LAS int*)(lds + MOE_TAB_OFF); LAS int* pc = tp + 72; LAS int* cn = pc + 72;
    if (threadIdx.x == 0) {
        const int* cnt = (const int*)(p.ws + WS_CNT) + h * 64;
        int t = 0, q = 0;
        for (int e = 0; e < 65; ++e) { const int c = e < 64 ? cnt[e] : HALF_T; cn[e] = c; tp[e] = t; pc[e] = q; t += (c + 255) >> 8; q += c; }
        tp[65] = t; pc[65] = q;
    }
    __syncthreads();
}
template <bool GU>
struct MoeSched {
    struct Unit { int e, r0t, pn; };
    static constexpr bool GATHER = GU;
    LAS const int* tp; LAS const int* pc; LAS const int* cn;
    const char* Abase; const char* Bt; const int* ltok; int h, nN, nunits, G, c;
    DEV int lda() const { return 256; }
    DEV bool next(int i, Unit& u) const {
        const long L = (long)i * G + c; if (L >= nunits) return false;
        int w = (int)L; { const int q = nunits / 8, r = nunits % 8, xcd = w % 8, off = w / 8; w = (xcd < r ? xcd * (q + 1) : r * (q + 1) + (xcd - r) * q) + off; }
        const int rt = w / nN; u.pn = w % nN;
        int e = 0; while (tp[e + 1] <= rt) ++e;
        u.e = e; u.r0t = (rt - tp[e]) * 256; return true;
    }
    DEV unsigned tokoff(int e, int ce, int idx, int C) const {
        idx = idx < ce ? idx : ce - 1;
        const int tok = e < 64 ? ltok[(size_t)(h * 64 + e) * HALF_T + idx] : h * HALF_T + idx;
        return (unsigned)tok * 4096u + 2048u + (unsigned)C * 2u;
    }
    DEV void addr(const Unit& u, int R0, int C0, int R1, int C1, gp::UAddr& o) const {
        if constexpr (GU) {
            const int ce = cn[u.e];
            o.a = Abase; o.b = Bt + ((size_t)u.e * 512 + u.pn * 256) * 2048;
            o.ao00 = tokoff(u.e, ce, u.r0t + R0, C0); o.ao01 = tokoff(u.e, ce, u.r0t + R1, C1);
            o.ao10 = tokoff(u.e, ce, u.r0t + 128 + R0, C0); o.ao11 = tokoff(u.e, ce, u.r0t + 128 + R1, C1);
        } else {
            o.a = Abase + ((size_t)pc[u.e] + u.r0t) * 512; o.b = Bt + ((size_t)u.e * 1024 + u.pn * 256) * 512;
        }
    }
};
struct EpiMoeGU {
    static constexpr bool PERM = false;
    LAS const int* pc; LAS const int* cn; const float* lwt; bf16_t* HMID; int h;
    template <class U> DEV void operator()(const f32x4 (&acc)[2][2][4][2], const U& u, int wr, int wc, int fr, int fq) const {
        const int ce = cn[u.e]; const size_t prow = (size_t)pc[u.e];
        float wt[2][4];
#pragma unroll
        for (int ai = 0; ai < 2; ++ai)
#pragma unroll
            for (int m = 0; m < 4; ++m) {
                int idx = u.r0t + ai * 128 + wr * 64 + m * 16 + fr; idx = idx < ce ? idx : ce - 1;
                wt[ai][m] = u.e < 64 ? lwt[(size_t)(h * 64 + u.e) * HALF_T + idx] : 1.f;
            }
#pragma unroll
        for (int ai = 0; ai < 2; ++ai)
#pragma unroll
            for (int m = 0; m < 4; ++m) {
                const int idx = u.r0t + ai * 128 + wr * 64 + m * 16 + fr;
                if (idx < ce) {
                    const float w_ = wt[ai][m];
                    bf16_t* rowp = HMID + (prow + idx) * 256 + u.pn * 128 + wc * 16 + 4 * fq;
#pragma unroll
                    for (int bj = 0; bj < 2; ++bj) {
                        const f32x4 gt = acc[ai][bj][m][0], up = acc[ai][bj][m][1];
                        u32x2 w; w.x = pack2(w_ * gt[0] * sigmoid_f(gt[0]) * up[0], w_ * gt[1] * sigmoid_f(gt[1]) * up[1]);
                        w.y = pack2(w_ * gt[2] * sigmoid_f(gt[2]) * up[2], w_ * gt[3] * sigmoid_f(gt[3]) * up[3]);
                        *(u32x2*)(rowp + bj * 64) = w;
                    }
                }
            }
    }
};
struct EpiMoeDN {
    static constexpr bool PERM = true;
    LAS const int* pc; LAS const int* cn; unsigned char* SLAB;
    template <class U> DEV void operator()(const f32x4 (&acc)[2][2][4][2], const U& u, int wr, int wc, int fr, int fq) const {
        const int ce = cn[u.e]; const size_t prow = (size_t)pc[u.e];
#pragma unroll
        for (int ai = 0; ai < 2; ++ai)
#pragma unroll
            for (int m = 0; m < 4; ++m) {
                const int idx = u.r0t + ai * 128 + wr * 64 + m * 16 + fr;
                if (idx < ce) {
                    unsigned char* rowp = SLAB + (prow + idx) * 1024 + u.pn * 256 + wc * 32 + 8 * fq;
#pragma unroll
                    for (int bj = 0; bj < 2; ++bj) {
                        const f32x4 v0 = acc[ai][bj][m][0] * SLAB_SCALE, v1 = acc[ai][bj][m][1] * SLAB_SCALE;
                        int w0 = 0, w1 = 0;
                        w0 = __builtin_amdgcn_cvt_pk_fp8_f32(v0[0], v0[1], w0, false); w0 = __builtin_amdgcn_cvt_pk_fp8_f32(v0[2], v0[3], w0, true);
                        w1 = __builtin_amdgcn_cvt_pk_fp8_f32(v1[0], v1[1], w1, false); w1 = __builtin_amdgcn_cvt_pk_fp8_f32(v1[2], v1[3], w1, true);
                        *(u32x2*)(rowp + bj * 128) = (u32x2){(unsigned)w0, (unsigned)w1};
                    }
                }
            }
    }
};
DEV void fp8x16_add(const u32x4 w, float (&f)[16]) {
    typedef float f2 __attribute__((ext_vector_type(2)));
    const unsigned ww[4] = {w.x, w.y, w.z, w.w};
#pragma unroll
    for (int j = 0; j < 4; ++j) {
        const f2 a = __builtin_amdgcn_cvt_pk_f32_fp8((int)ww[j], false), b = __builtin_amdgcn_cvt_pk_f32_fp8((int)ww[j], true);
        f[4 * j] += a.x; f[4 * j + 1] += a.y; f[4 * j + 2] += b.x; f[4 * j + 3] += b.y;
    }
}
DEV void moe_reduce(const Params& p, LAS unsigned char* lds, int h, int bid, int nb) {
    int tid = threadIdx.x; asm volatile("" : "+v"(tid));
    const int wid = tid >> 6, lane = tid & 63;
    LAS const int* pc = (LAS const int*)(lds + MOE_TAB_OFF) + 72;
    const unsigned char* SLAB = (const unsigned char*)(p.ws + WS_SLAB); const int* PAIR = (const int*)(p.ws + WS_PAIR); const float* ADA = (const float*)(p.ws + WS_ADA);
    for (int it = bid; it < HALF_T / 8; it += nb) {
        const int tokl = it * 8 + wid; const size_t tok = (size_t)h * HALF_T + tokl; const int b = (int)(tok >> 12), col = lane * 16;
        int pr[8];
#pragma unroll
        for (int k = 0; k < 8; ++k) pr[k] = PAIR[tok * 8 + k];
        u32x4 rows[9];
        rows[8] = *(const u32x4*)(SLAB + ((size_t)pc[64] + tokl) * 1024 + col);
#pragma unroll
        for (int k = 0; k < 8; ++k) rows[k] = *(const u32x4*)(SLAB + ((size_t)pc[pr[k] >> 16] + (pr[k] & 0xffff)) * 1024 + col);
        const u32x4 hr0 = *(const u32x4*)((const bf16_t*)p.out + tok * 2048 + col), hr1 = *(const u32x4*)((const bf16_t*)p.out + tok * 2048 + col + 8);
        f32x4 g2v[4], ggv[4], bbv[4];
#pragma unroll
        for (int q = 0; q < 4; ++q) { g2v[q] = *(const f32x4*)(ADA + b * 6144 + 5120 + col + q * 4); ggv[q] = *(const f32x4*)(p.in[37] + col + q * 4); bbv[q] = *(const f32x4*)(p.in[38] + col + q * 4); }
        float f[16];
#pragma unroll
        for (int j = 0; j < 16; ++j) f[j] = 0.f;
#pragma unroll
        for (int k = 0; k < 9; ++k) fp8x16_add(rows[k], f);
        float z[16]; float s = 0.f;
        { float y0[8], y1[8]; bf8_unpack(hr0, y0); bf8_unpack(hr1, y1);
#pragma unroll
          for (int j = 0; j < 8; ++j) { z[j] = y0[j] * ALPHA_F + g2v[j >> 2][j & 3] * (f[j] * (1.f / SLAB_SCALE)); z[8 + j] = y1[j] * ALPHA_F + g2v[2 + (j >> 2)][j & 3] * (f[8 + j] * (1.f / SLAB_SCALE)); }
#pragma unroll
          for (int j = 0; j < 16; ++j) s += z[j]; }
        const float mean = wave_sum(s) * (1.f / 1024.f); float qq = 0.f;
#pragma unroll
        for (int j = 0; j < 16; ++j) { const float d = z[j] - mean; qq += d * d; }
        const float rstd = rsqrtf(wave_sum(qq) * (1.f / 1024.f) + LN_EPS_F);
#pragma unroll
        for (int q = 0; q < 4; ++q) {
            f32x4 o;
#pragma unroll
            for (int j = 0; j < 4; ++j) o[j] = (z[q * 4 + j] - mean) * rstd * ggv[q][j] + bbv[q][j];
            *(f32x4*)(p.out + tok * 1024 + col + q * 4) = o;
        }
    }
}

#define ADA ((float*)(p.ws + WS_ADA))
#define HB ((bf16_t*)(p.ws + WS_HB))
#define BTIN ((bf16_t*)(p.ws + WS_BTIN))
#define HM ((bf16_t*)(p.ws + WS_HM))
#define US5 ((bf16_t*)(p.ws + WS_US5))
#define ULRU ((bf16_t*)(p.ws + WS_ULRU))
#define SLOC ((float*)(p.ws + WS_SLOC))
#define YS5 ((bf16_t*)(p.ws + WS_YS5))
#define YCAT ((bf16_t*)(p.ws + WS_YCAT))
#define Y ((float*)(p.ws + WS_Y))
#define LTOK ((int*)(p.ws + WS_LTOK))
#define LWT ((float*)(p.ws + WS_LWT))
#define HMID ((bf16_t*)(p.ws + WS_HMID))
#define SLAB ((unsigned char*)(p.ws + WS_SLAB))
#define PAIR ((int*)(p.ws + WS_PAIR))
#define CNT ((int*)(p.ws + WS_CNT))
__global__ void __launch_bounds__(512) mk_fwd(Params p) {
    extern __shared__ __attribute__((aligned(16))) unsigned char lds_raw[];
    LAS unsigned char* lds = (LAS unsigned char*)lds_raw;
    const int bid = blockIdx.x, nb = gridDim.x;
    volatile LAS unsigned* MISC = (volatile LAS unsigned*)(lds + MISC_OFF);
    if (threadIdx.x < 64) MISC[threadIdx.x] = 0u;
    __syncthreads();
    unsigned char* const ws = p.ws;
    XcdBarrier bar; bar.bar = (unsigned*)(ws + WS_CTL); bar.x = 0; bar.st = nullptr;
    const bool fused = (p.ph_hi - p.ph_lo) > 1;
    if (fused) bar = xcd_barrier_post((unsigned*)(ws + WS_CTL), MISC + 8);

    const int lo = p.ph_lo, hi = p.ph_hi;
#ifndef PROBE_REP_PH
#define PROBE_REP_PH -1
#endif
#define IN(k) (lo <= (k) && (k) < hi)
#ifndef PROBE_TIME
#define PROBE_TIME -1
#endif
    unsigned long long tprobe0_ = 0, tprobe1_ = 0;
#ifndef PROBE_SEC
#define PROBE_SEC -1
#endif
    unsigned long long tsec_acc_ = 0, tsec_t0_ = 0;
#define SEC_BEGIN(id) do { if (PROBE_SEC == (id)) { __builtin_amdgcn_s_waitcnt(0); tsec_t0_ = __builtin_amdgcn_s_memrealtime(); } } while (0)
#define SEC_END(id) do { if (PROBE_SEC == (id)) { __builtin_amdgcn_s_waitcnt(0); tsec_acc_ += __builtin_amdgcn_s_memrealtime() - tsec_t0_; } } while (0)
#define TSTAMP(k) do { if (PROBE_TIME >= 0) { if ((k) == PROBE_TIME) tprobe0_ = __builtin_amdgcn_s_memrealtime(); if ((k) == PROBE_TIME + 1) tprobe1_ = __builtin_amdgcn_s_memrealtime(); } } while (0)
#define TIDS int tid = threadIdx.x; asm volatile("" : "+v"(tid)); const int wid = tid >> 6, lane = tid & 63; (void)wid; (void)lane
#define REPS(k) (((k) == PROBE_REP_PH) ? 2 : 1)
#ifndef PROBE_SUB
#define PROBE_SUB -1
#endif
#define SUBREPS(k) (((k) == PROBE_SUB) ? 2 : 1)
#define SEAM(k) do { if (IN(k) && IN((k) + 1)) xcd_barrier(bar); else __syncthreads(); TSTAMP((k) + 1); } while (0)
    {
        TSTAMP(0);
        for (int rep_ = 0; rep_ < REPS(0); ++rep_) if (IN(0)) { if (rep_) xcd_barrier(bar); TIDS;
            for (int sr_ = 0; sr_ < SUBREPS(1); ++sr_)
            for (int it = bid; it < 256; it += nb) s5_gen(p, lds, it >> 3, it & 7);
            {
                LAS float* S = (LAS float*)lds; LAS float* red = S + 9216;
                __syncthreads();
                for (int i = tid; i < 9216; i += 512) { const float c = i < 8192 ? p.in[1][i] : p.in[3][i - 8192]; S[i] = c * sigmoid_f(c); }
                if (bid == nb - 1) for (int i = tid; i < 1024; i += 512) ((float*)(ws + WS_LCA))[i] = -8.f * 1.4426950408889634f * log1pf(__expf(-p.in[25][i]));
                if (bid >= nb - 9 && bid < nb - 1) for (int i = (bid - (nb - 9)) * 8192 + tid; i < (bid - (nb - 9) + 1) * 8192; i += 512) {
                    const int e = i & 63, k = i >> 6; const float wv = p.in[29][i]; const unsigned hi = f2bf(wv); const float rem = wv - __uint_as_float(hi << 16);
                    ((bf16_t*)(ws + WS_RWH))[e * 1024 + k] = (bf16_t)hi; ((bf16_t*)(ws + WS_RWL))[e * 1024 + k] = (bf16_t)f2bf(rem);
                }
                __syncthreads();
                for (int sr_ = 0; sr_ < SUBREPS(2); ++sr_)
                for (int it = bid; it < 192; it += nb) gemv9_item(S, p.in[6], 6144, it * 32, p.in[7], ADA, 6144, red);
                __syncthreads();
            }
            {
                LAS float* tile = (LAS float*)lds + wid * (64 * 65);
                for (int sr_ = 0; sr_ < SUBREPS(3); ++sr_)
                for (int it = bid * 8 + wid; it < 13216; it += nb * 8) {
                    if (it < 64) { tr_tile_wave(p.in[17], 512, (it >> 3) * 64, (it & 7) * 64, (bf16_t*)(ws + WS_BTGLU), 512, 0, tile, lane); }
                    else if (it < 320) { const int i2 = it - 64; tr_tile_wave(p.in[26], 1024, (i2 >> 4) * 64, (i2 & 15) * 64, (bf16_t*)(ws + WS_BTOUT), 1024, 0, tile, lane); }
                    else if (it < 12800) {
                        const int i2 = it - 320, e = i2 / 192, r = i2 % 192, which = r >> 6, tt = r & 63;
                        if (which < 2) {
                            const float* W = e < 64 ? (which == 0 ? p.in[31] : p.in[32]) + (size_t)e * 262144 : (which == 0 ? p.in[34] : p.in[35]);
                            tr_tile_wave(W, 256, (tt >> 2) * 64, (tt & 3) * 64, (bf16_t*)(ws + WS_BTGU) + (size_t)e * 524288, 1024, which + 1, tile, lane);
                        } else {
                            const float* W = e < 64 ? p.in[33] + (size_t)e * 262144 : p.in[36];
                            tr_tile_wave(W, 1024, (tt >> 4) * 64, (tt & 15) * 64, (bf16_t*)(ws + WS_BTDN) + (size_t)e * 262144, 256, 0, tile, lane);
                        }
                    } else if (it < 12832) {
                        const int i2 = it - 12800, dir = i2 >> 4, ax = (i2 >> 3) & 1, h = i2 & 7;
                        const float* W = (ax ? p.in[23] : p.in[21]) + (size_t)(dir * 8 + h) * 4096;
                        tr_tile_wave(W, 64, 0, 0, (bf16_t*)(ws + WS_BTLRU) + (size_t)(h * 256 + dir * 128 + ax * 64) * 64, 64, 0, tile, lane);
                    } else {
                        const int i2 = it - 12832;
                        tr_tile_wave(p.in[8], NWIN, (i2 / 24) * 64, (i2 % 24) * 64, BTIN, 1024, 0, tile, lane);
                    }
                }
            }
        }
        SEAM(0);
        for (int rep_ = 0; rep_ < REPS(1); ++rep_) if (IN(1)) { if (rep_) xcd_barrier(bar); TIDS;
            for (int it = bid; it < TT / 32; it += nb) {
                const int row0 = it * 32 + wid * 4;
                f32x4 v[4][4]; float s[4];
#pragma unroll
                for (int rr = 0; rr < 4; ++rr) {
                    const int row = row0 + rr;
                    const float* src = row < T ? p.in[0] + (size_t)row * 1024 : p.in[2] + (size_t)(row - T) * 1024;
#pragma unroll
                    for (int q = 0; q < 4; ++q) v[rr][q] = *(const f32x4*)(src + q * 256 + lane * 4);
                }
                f32x4 gg[4], bbv[4], sh1[4], sc1[4];
                { const float* ada = ADA + (row0 < T ? (row0 >> 12) : 8) * 6144;
#pragma unroll
                  for (int q = 0; q < 4; ++q) { const int col = q * 256 + lane * 4; gg[q] = *(const f32x4*)(p.in[4] + col); bbv[q] = *(const f32x4*)(p.in[5] + col); sh1[q] = *(const f32x4*)(ada + col); sc1[q] = *(const f32x4*)(ada + 1024 + col); } }
#pragma unroll
                for (int rr = 0; rr < 4; ++rr) { float a = 0.f;
#pragma unroll
                    for (int q = 0; q < 4; ++q) a += (v[rr][q][0] + v[rr][q][1]) + (v[rr][q][2] + v[rr][q][3]);
                    s[rr] = a; }
#pragma unroll
                for (int o = 1; o < 64; o <<= 1) {
#pragma unroll
                    for (int rr = 0; rr < 4; ++rr) s[rr] += __shfl_xor(s[rr], o); }
                float mean[4], qq[4];
#pragma unroll
                for (int rr = 0; rr < 4; ++rr) { mean[rr] = s[rr] * (1.f / 1024.f); float a = 0.f;
#pragma unroll
                    for (int q = 0; q < 4; ++q) { const f32x4 d = v[rr][q] - mean[rr]; a += (d[0] * d[0] + d[1] * d[1]) + (d[2] * d[2] + d[3] * d[3]); }
                    qq[rr] = a; }
#pragma unroll
                for (int o = 1; o < 64; o <<= 1) {
#pragma unroll
                    for (int rr = 0; rr < 4; ++rr) qq[rr] += __shfl_xor(qq[rr], o); }
                float rstd[4];
#pragma unroll
                for (int rr = 0; rr < 4; ++rr) rstd[rr] = rsqrtf(qq[rr] * (1.f / 1024.f) + LN_EPS_F);
#pragma unroll
                for (int q = 0; q < 4; ++q) {
                    const int col = q * 256 + lane * 4;
#pragma unroll
                    for (int rr = 0; rr < 4; ++rr) {
                        const int row = row0 + rr;
                        const f32x4 o = (v[rr][q] - mean[rr]) * rstd[rr] * gg[q] + bbv[q];
                        u32x2 w; w.x = pack2(o[0], o[1]); w.y = pack2(o[2], o[3]);
                        *(u32x2*)(HB + (size_t)row * 1024 + col) = w;
                        const f32x4 om = o * (sc1[q] + 1.f) + sh1[q];
                        u32x2 wm; wm.x = pack2(om[0], om[1]); wm.y = pack2(om[2], om[3]);
                        *(u32x2*)(HM + (size_t)row * 1024 + col) = wm;
                    }
                }
            }
        }
        SEAM(1);
        for (int rep_ = 0; rep_ < REPS(2); ++rep_) if (IN(2)) { if (rep_) xcd_barrier(bar); TIDS;
            WinSched S{(const char*)HM, (const char*)BTIN, nb, bid};
            EpiWin E{US5, ULRU};
            gp::gemm_phase(lds, 1024, S, E);
        }
        SEAM(2);
        for (int rep_ = 0; rep_ < REPS(3); ++rep_) if (IN(3)) { if (rep_) xcd_barrier(bar); TIDS;
            const bf16_t* ES5 = (const bf16_t*)(ws + WS_ES5);
            { S5Sched S{(const char*)US5, (const char*)ES5, 512, 5, 1, 256, nb, bid}; EpiS5Loc E{SLOC}; gp::gemm_phase(lds, 512, S, E); }
            __syncthreads();
            int bid_ = bid; asm volatile("" : "+s"(bid_));
#if PROBE_SUB == 6 || PROBE_SUB == 7
            lru_load_probe(p, bid_, nb);
#endif
            for (int sr_ = 0; sr_ < SUBREPS(4); ++sr_) lru_phase<false>(p, bid_, nb);
        }
        SEAM(3);
#if PROBE_SUB == 8
        for (int xb_ = 0; xb_ < 10; ++xb_) xcd_barrier(bar);
#endif
        for (int rep_ = 0; rep_ < REPS(4); ++rep_) if (IN(4)) { if (rep_) xcd_barrier(bar); TIDS;
            const float* ALC = (const float*)(ws + WS_ALC);
            if (tid < 128) for (int i = bid * 128 + tid; i < 32768; i += nb * 128) {
                const int pp = i & 63, dir = (i >> 6) & 1, g = (i >> 7) & 31, b = i >> 12;
                const float ar = ALC[((dir * 32 + g) * 64 + pp) * 2], ai = ALC[((dir * 32 + g) * 64 + pp) * 2 + 1];
                float xr = 0.f, xi = 0.f;
                const float* Sg = SLOC + (size_t)g * M5 * 256 + dir * 128 + pp;
                {
                    float sr[NCC], si[NCC];
#pragma unroll
                    for (int s = 0; s < NCC; ++s) { const int j = dir ? NCC - 1 - s : s, m = M5LAT + b * NCC + j; sr[s] = Sg[(size_t)m * 256]; si[s] = Sg[(size_t)m * 256 + 64]; }
#pragma unroll
                    for (int s = 0; s < NCC; ++s) { const float nr = ar * xr - ai * xi + sr[s], ni = ar * xi + ai * xr + si[s]; xr = nr; xi = ni; }
                }
#pragma unroll 1
                for (int s0 = 0; s0 < NCH; s0 += 32) {
                    float sr[32], si[32];
#pragma unroll
                    for (int q = 0; q < 32; ++q) { const int k = dir ? NCH - 1 - (s0 + q) : s0 + q, m = b * NCH + k; sr[q] = Sg[(size_t)m * 256]; si[q] = Sg[(size_t)m * 256 + 64]; }
#pragma unroll
                    for (int q = 0; q < 32; ++q) {
                        const int k = dir ? NCH - 1 - (s0 + q) : s0 + q, m = b * NCH + k;
                        bf16_t* dst = US5 + ((size_t)(g * M5PAD + m)) * KT5 + 512 + dir * 128 + pp;
                        dst[0] = (bf16_t)f2bf(xr); dst[64] = (bf16_t)f2bf(xi);
                        const float nr = ar * xr - ai * xi + sr[q], ni = ar * xi + ai * xr + si[q]; xr = nr; xi = ni;
                    }
                }
            }
            const float* SA = (const float*)(ws + WS_SA); const float* SB = (const float*)(ws + WS_SB); float* HIN = (float*)(ws + WS_HIN);
            if (tid >= 128 && tid < 160) for (int i = bid * 32 + (tid - 128); i < 8192; i += nb * 32) {
                const int chn = i & 511, dir = (i >> 9) & 1, b = i >> 10;
                float H = 0.f;
                {
                    float av[4], bv[4];
#pragma unroll
                    for (int s = 0; s < 4; ++s) { const int c = 64 + (dir ? 3 - s : s); const size_t o = ((size_t)(b * 68 + c) * 2 + dir) * 512 + chn; av[s] = SA[o]; bv[s] = SB[o]; }
#pragma unroll
                    for (int s = 0; s < 4; ++s) H = av[s] * H + bv[s];
                }
#pragma unroll 1
                for (int s0 = 0; s0 < 64; s0 += 32) {
                    float av[32], bv[32];
#pragma unroll
                    for (int q = 0; q < 32; ++q) { const int c = dir ? 63 - (s0 + q) : s0 + q; const size_t o = ((size_t)(b * 68 + c) * 2 + dir) * 512 + chn; av[q] = SA[o]; bv[q] = SB[o]; }
#pragma unroll
                    for (int q = 0; q < 32; ++q) {
                        const int c = dir ? 63 - (s0 + q) : s0 + q;
                        HIN[((size_t)(b * 64 + c) * 2 + dir) * 512 + chn] = H;
                        H = av[q] * H + bv[q];
                    }
                }
            }
        }
        SEAM(4);
        for (int rep_ = 0; rep_ < REPS(5); ++rep_) if (IN(5)) { if (rep_) xcd_barrier(bar); TIDS;
            const bf16_t* BS5 = (const bf16_t*)(ws + WS_BS5);
            { S5Sched S{(const char*)US5, (const char*)BS5, KT5, 4, 2, 512, nb, bid}; EpiS5Out E{YS5}; gp::gemm_phase(lds, KT5, S, E); }
            __syncthreads();
            int bid_ = bid; asm volatile("" : "+s"(bid_));
            for (int sr_ = 0; sr_ < SUBREPS(5); ++sr_) lru_phase<true>(p, bid_, nb);
        }
        SEAM(5);
        for (int rep_ = 0; rep_ < REPS(6); ++rep_) if (IN(6)) { if (rep_) xcd_barrier(bar); TIDS;
            const bf16_t* BTGLU = (const bf16_t*)(ws + WS_BTGLU); const float* b_glu = p.in[18];
            PlainSched S{(const char*)YS5, (const char*)BTGLU, 512, 512, 128, 2, nb, bid};
            EpiGlu E{YS5, b_glu, YCAT};
            gp::gemm_phase(lds, 512, S, E);
        }
        SEAM(6);
        for (int rep_ = 0; rep_ < REPS(7); ++rep_) if (IN(7)) { if (rep_) xcd_barrier(bar); TIDS;
            const bf16_t* BTOUT = (const bf16_t*)(ws + WS_BTOUT);
            PlainSched S{(const char*)YCAT, (const char*)BTOUT, 1024, 1024, 128, 4, nb, bid};
            EpiF32 E{Y, 1024};
            gp::gemm_phase(lds, 1024, S, E);
        }
        SEAM(7);
        if (IN(8)) { TIDS;
            LAS unsigned char* VH = lds;
            LAS float* PART = (LAS float*)lds;
            LAS int* DEC = (LAS int*)(lds + 132096);
            LAS float* DECW = (LAS float*)(lds + 132096 + 4096);
            LAS int* lcnt = (LAS int*)(lds + 148480); LAS int* gbase = lcnt + 128;
            const int fr = lane & 15, fq = lane >> 4;
            const float rbias = p.in[30][lane];
            if (tid < 128) lcnt[tid] = 0;
            bf16x8 bw[4][4];
#pragma unroll
            for (int kk = 0; kk < 4; ++kk)
#pragma unroll
                for (int nt = 0; nt < 4; ++nt) bw[kk][nt] = *(const bf16x8*)((const bf16_t*)(ws + WS_RWH) + (size_t)(nt * 16 + fr) * 1024 + (wid * 4 + kk) * 32 + fq * 8);
            int nit = 0, it_first = bid;
            for (int it = bid; it < T / 64; it += nb) {
                const int t0 = it * 64;
                SEC_BEGIN(1);
#pragma unroll 1
                for (int rnd = 0; rnd < 4; ++rnd) {
                    const size_t tok0 = (size_t)t0 + wid * 8 + rnd * 2; const int b = (int)(tok0 >> 12);
                    const float* ada = ADA + b * 6144;
                    f32x4 z[2][4]; float s4[2];
                    {
                        u32x2 hh[2][4]; f32x4 yv[2][4], g1[4];
#pragma unroll
                        for (int q = 0; q < 4; ++q) g1[q] = *(const f32x4*)(ada + 2048 + q * 256 + lane * 4);
#pragma unroll
                        for (int rr = 0; rr < 2; ++rr)
#pragma unroll
                            for (int q = 0; q < 4; ++q) { const int col = q * 256 + lane * 4; hh[rr][q] = *(const u32x2*)(HB + (tok0 + rr) * 1024 + col); yv[rr][q] = *(const f32x4*)(Y + (tok0 + rr) * 1024 + col); }
#pragma unroll
                        for (int rr = 0; rr < 2; ++rr) { float a = 0.f;
#pragma unroll
                            for (int q = 0; q < 4; ++q) {
                                f32x4 hv; hv[0] = __uint_as_float(hh[rr][q].x << 16); hv[1] = __uint_as_float(hh[rr][q].x & 0xffff0000u); hv[2] = __uint_as_float(hh[rr][q].y << 16); hv[3] = __uint_as_float(hh[rr][q].y & 0xffff0000u);
                                z[rr][q] = hv * ALPHA_F + g1[q] * yv[rr][q];
                                a += (z[rr][q][0] + z[rr][q][1]) + (z[rr][q][2] + z[rr][q][3]);
                            }
                            s4[rr] = a; }
                    }
                    f32x4 gg[4], bbv[4], sc2[4], sh2[4];
#pragma unroll
                    for (int q = 0; q < 4; ++q) { const int col = q * 256 + lane * 4; gg[q] = *(const f32x4*)(p.in[27] + col); bbv[q] = *(const f32x4*)(p.in[28] + col); sc2[q] = *(const f32x4*)(ada + 4096 + col); sh2[q] = *(const f32x4*)(ada + 3072 + col); }
#pragma unroll
                    for (int o = 1; o < 64; o <<= 1) {
#pragma unroll
                        for (int rr = 0; rr < 2; ++rr) s4[rr] += __shfl_xor(s4[rr], o); }
                    float mean[2], q4[2];
#pragma unroll
                    for (int rr = 0; rr < 2; ++rr) { mean[rr] = s4[rr] * (1.f / 1024.f); float a = 0.f;
#pragma unroll
                        for (int q = 0; q < 4; ++q) { const f32x4 d = z[rr][q] - mean[rr]; a += (d[0] * d[0] + d[1] * d[1]) + (d[2] * d[2] + d[3] * d[3]); }
                        q4[rr] = a; }
#pragma unroll
                    for (int o = 1; o < 64; o <<= 1) {
#pragma unroll
                        for (int rr = 0; rr < 2; ++rr) q4[rr] += __shfl_xor(q4[rr], o); }
#pragma unroll
                    for (int rr = 0; rr < 2; ++rr) {
                        const float rstd = rsqrtf(q4[rr] * (1.f / 1024.f) + LN_EPS_F);
                        const size_t tok = tok0 + rr; const int tl = wid * 8 + rnd * 2 + rr;
#pragma unroll
                        for (int q = 0; q < 4; ++q) {
                            const int col = q * 256 + lane * 4;
                            const f32x4 h1 = (z[rr][q] - mean[rr]) * rstd * gg[q] + bbv[q];
                            { u32x2 wh; wh.x = pack2(h1[0], h1[1]); wh.y = pack2(h1[2], h1[3]); *(u32x2*)((bf16_t*)p.out + tok * 2048 + col) = wh; }
                            const f32x4 v = h1 * (sc2[q] + 1.f) + sh2[q];
                            u32x2 w; w.x = pack2(v[0], v[1]); w.y = pack2(v[2], v[3]);
                            *(u32x2*)((bf16_t*)p.out + tok * 2048 + 1024 + col) = w;
                            *(LAS u32x2*)(VH + tl * 2064 + col * 2) = w;
                        }
                    }
                }
                __syncthreads();
                SEC_END(1); SEC_BEGIN(2);
                {
                    f32x4 acc[4][4];
#pragma unroll
                    for (int mt = 0; mt < 4; ++mt)
#pragma unroll
                        for (int nt = 0; nt < 4; ++nt) acc[mt][nt] = (f32x4){0.f, 0.f, 0.f, 0.f};
#pragma unroll
                    for (int kk = 0; kk < 4; ++kk) {
                        const int k0 = (wid * 4 + kk) * 32 + fq * 8;
#pragma unroll
                        for (int mt = 0; mt < 4; ++mt) {
                            const bf16x8 av = *(LAS const bf16x8*)(VH + (mt * 16 + fr) * 2064 + k0 * 2);
#pragma unroll
                            for (int nt = 0; nt < 4; ++nt) acc[mt][nt] = __builtin_amdgcn_mfma_f32_16x16x32_bf16(bw[kk][nt], av, acc[mt][nt], 0, 0, 0);
                        }
                    }
                    __syncthreads();
#pragma unroll
                    for (int mt = 0; mt < 4; ++mt)
#pragma unroll
                        for (int nt = 0; nt < 4; ++nt) *(LAS f32x4*)(PART + (wid * 64 + mt * 16 + fr) * 64 + nt * 16 + 4 * fq) = acc[mt][nt];
                }
                __syncthreads();
                SEC_END(2); SEC_BEGIN(3);
                {
                    const int hh = t0 >> 14;
#pragma unroll 2
                    for (int r = 0; r < 8; ++r) {
                        const int tl = wid * 8 + r;
                        float lg = 0.f;
#pragma unroll
                        for (int w8 = 0; w8 < 8; ++w8) lg += PART[(w8 * 64 + tl) * 64 + lane];
                        const float sc = sigmoid_f(lg), sel = sc + rbias;
                        float m1 = sel; m1 = fmaxf(m1, __shfl_xor(m1, 1)); m1 = fmaxf(m1, __shfl_xor(m1, 2)); m1 = fmaxf(m1, __shfl_xor(m1, 4));
                        const unsigned long long bal = __ballot(sel == m1);
                        const unsigned gb = (unsigned)(bal >> (lane & 56)) & 0xffu;
                        const int first = __builtin_ctz(gb | 0x100u);
                        float m2 = ((lane & 7) == first) ? -INFINITY : sel; m2 = fmaxf(m2, __shfl_xor(m2, 1)); m2 = fmaxf(m2, __shfl_xor(m2, 2)); m2 = fmaxf(m2, __shfl_xor(m2, 4));
                        const float gs = m1 + m2;
                        int grank = 0; const int mygrp = lane >> 3;
#pragma unroll
                        for (int j = 0; j < 8; ++j) { const float gj = __builtin_bit_cast(float, __builtin_amdgcn_readlane(__builtin_bit_cast(int, gs), 8 * j)); grank += (gj > gs || (gj == gs && j < mygrp)) ? 1 : 0; }
                        const bool selected = grank < 4;
                        const unsigned long long gmask = __ballot(selected);
                        const float mv = selected ? sel : -INFINITY;
                        int rank = 0;
#pragma unroll
                        for (int j = 0; j < 64; ++j) {
                            if ((gmask >> j) & 1ull) { const float vj = __builtin_bit_cast(float, __builtin_amdgcn_readlane(__builtin_bit_cast(int, mv), j)); rank += (vj > mv || (vj == mv && j < lane)) ? 1 : 0; }
                        }
                        const bool chosen = selected && rank < 8;
                        const float wsum = wave_sum(chosen ? sc : 0.f);
                        if (chosen) {
                            const int lr = __hip_atomic_fetch_add(lcnt + hh * 64 + lane, 1, __ATOMIC_RELAXED, __HIP_MEMORY_SCOPE_WORKGROUP);
                            DEC[((nit & 1) * 64 + tl) * 8 + rank] = (lane << 16) | lr; DECW[((nit & 1) * 64 + tl) * 8 + rank] = sc / wsum * 2.5f;
                        }
                    }
                }
                __syncthreads();
                SEC_END(3); SEC_BEGIN(4);
                ++nit;
                const bool last = (it + nb >= T / 64);
                if ((nit & 1) == 0 || last) {
                    const int nflush = (nit & 1) == 0 ? 2 : 1;
                    if (tid < 128) { const int c = lcnt[tid]; gbase[tid] = c ? atomicAdd(CNT + tid, c) : 0; lcnt[tid] = 0; }
                    __syncthreads();
                    for (int n = tid; n < nflush * 512; n += 512) {
                        const int g2 = n >> 9, tl = (n >> 3) & 63, tok = (it_first + g2 * nb) * 64 + tl, hq = tok >> 14;
                        const int d = DEC[n], e = d >> 16, rk = gbase[hq * 64 + e] + (d & 0xffff);
                        const size_t pos = (size_t)(hq * 64 + e) * HALF_T + rk;
                        LTOK[pos] = tok; LWT[pos] = DECW[n]; PAIR[(size_t)tok * 8 + (n & 7)] = (e << 16) | rk;
                    }
                    __syncthreads();
                    it_first = it + nb;
                }
                SEC_END(4);
            }
        }
        SEAM(8);
        for (int rep_ = 0; rep_ < REPS(9); ++rep_) if (IN(9)) { if (rep_) xcd_barrier(bar); TIDS;
            moe_tables(p, lds, 0);
            LAS const int* tp = (LAS const int*)(lds + MOE_TAB_OFF); LAS const int* pc = tp + 72; LAS const int* cn = pc + 72;
            MoeSched<true> S{tp, pc, cn, (const char*)p.out, (const char*)(ws + WS_BTGU), LTOK, 0, 2, tp[65] * 2, nb, bid};
            EpiMoeGU E{pc, cn, LWT, HMID, 0};
            gp::gemm_phase(lds, 1024, S, E);
        }
        SEAM(9);
        for (int rep_ = 0; rep_ < REPS(10); ++rep_) if (IN(10)) { if (rep_) xcd_barrier(bar); TIDS;
            moe_tables(p, lds, 0);
            LAS const int* tp = (LAS const int*)(lds + MOE_TAB_OFF); LAS const int* pc = tp + 72; LAS const int* cn = pc + 72;
            MoeSched<false> S{tp, pc, cn, (const char*)HMID, (const char*)(ws + WS_BTDN), LTOK, 0, 4, tp[65] * 4, nb, bid};
            EpiMoeDN E{pc, cn, SLAB};
            gp::gemm_phase(lds, 256, S, E);
        }
        SEAM(10);
        if (IN(11)) { TIDS;
            {
                moe_tables(p, lds, 1);
                LAS const int* tp = (LAS const int*)(lds + MOE_TAB_OFF); LAS const int* pc = tp + 72; LAS const int* cn = pc + 72;
                MoeSched<true> S{tp, pc, cn, (const char*)p.out, (const char*)(ws + WS_BTGU), LTOK, 1, 2, tp[65] * 2, nb, bid};
                EpiMoeGU E{pc, cn, LWT, HMID, 1};
                gp::gemm_phase(lds, 1024, S, E);
            }
            __syncthreads();
            int bid_ = bid; asm volatile("" : "+s"(bid_));
            moe_tables(p, lds, 0);
            moe_reduce(p, lds, 0, bid_, nb);
        }
        SEAM(11);
        for (int rep_ = 0; rep_ < REPS(12); ++rep_) if (IN(12)) { if (rep_) xcd_barrier(bar); TIDS;
            moe_tables(p, lds, 1);
            LAS const int* tp = (LAS const int*)(lds + MOE_TAB_OFF); LAS const int* pc = tp + 72; LAS const int* cn = pc + 72;
            MoeSched<false> S{tp, pc, cn, (const char*)HMID, (const char*)(ws + WS_BTDN), LTOK, 1, 4, tp[65] * 4, nb, bid};
            EpiMoeDN E{pc, cn, SLAB};
            gp::gemm_phase(lds, 256, S, E);
        }
        SEAM(12);
        if (IN(13)) { TIDS;
            moe_tables(p, lds, 1);
            moe_reduce(p, lds, 1, bid, nb);
        }
        if (PROBE_SEC >= 0 && bid == 0) { const unsigned long long d_ = tsec_acc_ * 8ull, t0_ = __builtin_amdgcn_s_memrealtime(); while (__builtin_amdgcn_s_memrealtime() - t0_ < d_) __builtin_amdgcn_s_sleep(8); }
        if (PROBE_TIME >= 0) {
            if (PROBE_TIME == 13) { xcd_barrier(bar); tprobe1_ = __builtin_amdgcn_s_memrealtime(); }
            if (bid == 0) { const unsigned long long d_ = (tprobe1_ - tprobe0_) * 8ull, t0_ = __builtin_amdgcn_s_memrealtime(); while (__builtin_amdgcn_s_memrealtime() - t0_ < d_) __builtin_amdgcn_s_sleep(8); }
        }
    }
}

extern "C" void kernel_launch(void* const* d_in, const int* in_sizes, int n_in, void* d_out, int out_size, void* d_ws, size_t ws_size, hipStream_t stream) {
    static int grid = 0;
    if (grid == 0) {
        if (n_in != 39 || out_size != T * D || ws_size < WS_END) { fprintf(stderr, "kernel_launch: unexpected problem (n_in %d, out %d, ws %zu); nothing launched\n", n_in, out_size, ws_size); grid = -1; return; }
        int dev = 0, cus = 0;
        if (hipGetDevice(&dev) != hipSuccess || hipDeviceGetAttribute(&cus, hipDeviceAttributeMultiprocessorCount, dev) != hipSuccess) { grid = -1; return; }
        if (hipFuncSetAttribute((const void*)mk_fwd, hipFuncAttributeMaxDynamicSharedMemorySize, LDS_BYTES) != hipSuccess) { fprintf(stderr, "kernel_launch: hipFuncSetAttribute failed\n"); grid = -1; return; }
        grid = cus > 0 ? cus : 256;
    }
    if (grid < 0) return;
    (void)in_sizes;
    if (hipMemsetAsync((char*)d_ws + WS_CTL, 0, CTL_ZERO_BYTES, stream) != hipSuccess) return;
    Params p{};
    for (int i = 0; i < 39; ++i) p.in[i] = (const float*)d_in[i];
    p.out = (float*)d_out; p.ws = (unsigned char*)d_ws;
#if MK_N_LAUNCHES == 1
    p.ph_lo = 0; p.ph_hi = NPHASE;
    hipLaunchKernelGGL(mk_fwd, dim3(grid), dim3(512), LDS_BYTES, stream, p);
#else
    for (int ph = 0; ph < NPHASE; ++ph) {
        p.ph_lo = ph; p.ph_hi = ph + 1;
        hipLaunchKernelGGL(mk_fwd, dim3(grid), dim3(512), LDS_BYTES, stream, p);
    }
#endif
}
```

```cpp
#include <hip/hip_runtime.h>
#include <cstdio>
#include <cstdint>

#ifndef MK_N_LAUNCHES
#define MK_N_LAUNCHES 1
#endif

#define DEV __device__ __forceinline__
#define LAS __attribute__((address_space(3)))
typedef unsigned short bf16_t;
typedef short bf16x8 __attribute__((ext_vector_type(8)));
typedef float f32x4 __attribute__((ext_vector_type(4)));
typedef unsigned u32x2 __attribute__((ext_vector_type(2)));
typedef unsigned u32x4 __attribute__((ext_vector_type(4)));

constexpr int D = 1024, NBATCH = 8, SEQ = 4096, T = NBATCH * SEQ, CTXL = 256, TC = NBATCH * CTXL, TT = T + TC;
constexpr int NWIN = 1536;
constexpr int LC = 32, KT5 = 768, NCH = SEQ / LC  , NCC = CTXL / LC  ;
constexpr int M5LAT = NBATCH * NCH  , M5 = M5LAT + NBATCH * NCC  , M5PAD = 1280;
constexpr int NE = 64;
constexpr int NPHASE = 14;
constexpr int HALF_T = T / 2;
constexpr float ALPHA_F = 1.189207115002721f, LN_EPS_F = 1e-5f;

constexpr size_t MiB = 1u << 20;
constexpr size_t WS_CTL = 0, CTL_ZERO_BYTES = 65536;
constexpr size_t WS_CNT = 32768;
constexpr size_t WS_ADA = 65536;
constexpr size_t WS_RWH = 384 * 1024;
constexpr size_t WS_RWL = 512 * 1024;
constexpr size_t WS_ALC = 640 * 1024;
constexpr size_t WS_LCA = 768 * 1024;
constexpr size_t WS_SA = 1 * MiB, WS_SB = 4 * MiB, WS_HIN = 7 * MiB;
constexpr size_t WS_BTGLU = 10 * MiB;
constexpr size_t WS_BTOUT = 10 * MiB + 512 * 1024;
constexpr size_t WS_BTLRU = 12 * MiB + 512 * 1024;
constexpr size_t WS_BS5 = 13 * MiB;
constexpr size_t WS_ES5 = 37 * MiB;
constexpr size_t WS_BTGU = 45 * MiB;
constexpr size_t WS_BTDN = 110 * MiB;
constexpr size_t WS_HB = 143 * MiB;
constexpr size_t WS_BTIN = 211 * MiB;
constexpr size_t WS_KTAB = 214 * MiB;
constexpr size_t WS_APR = 216 * MiB, WS_API = 217 * MiB;
constexpr size_t WS_BBR = 218 * MiB, WS_BBI = 218 * MiB + 256 * 1024;
constexpr size_t WS_HM = 366 * MiB;
constexpr size_t WS_US5 = 238 * MiB;
constexpr size_t WS_ULRU = 298 * MiB;
constexpr size_t WS_SLOC = 366 * MiB;
constexpr size_t WS_YS5 = 400 * MiB;
constexpr size_t WS_YCAT = 448 * MiB;
constexpr size_t WS_Y = 295 * MiB;
constexpr size_t WS_LTOK = 10 * MiB;
constexpr size_t WS_LWT = 18 * MiB;
constexpr size_t WS_PAIR = 26 * MiB;
constexpr size_t WS_HMID = 143 * MiB;
constexpr size_t WS_SLAB = 216 * MiB;
constexpr float SLAB_SCALE = 32.f;
constexpr size_t WS_END = 512 * MiB;

constexpr int LDS_BYTES = 155648;
constexpr int MISC_OFF = LDS_BYTES - 256;

DEV float bf2f(bf16_t h) { return __uint_as_float(((unsigned)h) << 16); }
DEV unsigned f2bf(float f) { unsigned u = __float_as_uint(f); return (u + 0x7fffu + ((u >> 16) & 1u)) >> 16; }
typedef float f32x2_t __attribute__((ext_vector_type(2)));
typedef __bf16 bf16x2_t __attribute__((ext_vector_type(2)));
DEV unsigned pack2(float a, float b) { const f32x2_t v = {a, b}; return __builtin_bit_cast(unsigned, __builtin_convertvector(v, bf16x2_t)); }
DEV float sigmoid_f(float x) { return __builtin_amdgcn_rcpf(1.f + __builtin_amdgcn_exp2f(-1.4426950408889634f * x)); }
DEV float gelu_tanh(float x) {
    const float z2 = 1.5957691216057308f * (x + 0.044715f * x * x * x);
    return x * __builtin_amdgcn_rcpf(1.f + __builtin_amdgcn_exp2f(-1.4426950408889634f * z2));
}
DEV int cmaj(int tok) { const int t = tok & 4095; return (tok & ~4095) | ((t & 63) << 6) | (t >> 6); }
DEV float wave_sum(float v) {
#pragma unroll
    for (int o = 1; o < 64; o <<= 1) v += __shfl_xor(v, o);
    return v;
}

struct Params { const float* in[39]; float* out; unsigned char* ws; int ph_lo, ph_hi; };

#define XB_TMO      128
#define XB_XCNT(j)  (256  + 64 * (j))
#define XB_XSUB(j)  (1280 + 64 * (j))
#define XB_XGEN(j)  (2304 + 64 * (j))
#define XB_TOP      3328
#define XB_TOPGEN   3392
#define XCD_BAR_WORDS 3456
#define XB_SPIN_CAP (1u << 20)
DEV unsigned xb_ld(unsigned* p)              { return __hip_atomic_load(p, __ATOMIC_RELAXED, __HIP_MEMORY_SCOPE_AGENT); }
DEV unsigned xb_add(unsigned* p, unsigned v) { return __hip_atomic_fetch_add(p, v, __ATOMIC_RELAXED, __HIP_MEMORY_SCOPE_AGENT); }
DEV unsigned xb_xcc_id() { return (unsigned)__builtin_amdgcn_s_getreg((3 << 11) | 20) & 0xFu; }
#define XB_SPIN(cond, bar) do { unsigned _sp = 0; while (cond) { __builtin_amdgcn_s_sleep(1); \
    if ((++_sp & 255u) == 0u) { if (xb_ld(&(bar)[XB_TMO])) break; if (_sp > XB_SPIN_CAP) { atomicAdd(&(bar)[XB_TMO], 1u); break; } } } } while (0)
struct XcdBarrier { unsigned* bar; unsigned x; volatile LAS unsigned* st; };
DEV XcdBarrier xcd_barrier_post(unsigned* bar, volatile LAS unsigned* st) {
    XcdBarrier b; b.bar = bar; b.x = xb_xcc_id(); b.st = st;
    if (threadIdx.x == 0) (void)xb_add(&bar[XB_XCNT(b.x)], 1u);
    return b;
}
DEV void xcd_barrier_complete(unsigned* bar, unsigned x, unsigned& nloc, unsigned& nx) {
    const unsigned G = gridDim.x * gridDim.y * gridDim.z;
    unsigned sum, cnt, mine, sp = 0u;
    for (;;) {
        sum = 0u; cnt = 0u; mine = 0u;
#pragma unroll
        for (unsigned j = 0; j < 16; ++j) { const unsigned c = xb_ld(&bar[XB_XCNT(j)]); sum += c; cnt += (c > 0u) ? 1u : 0u; mine = (j == x) ? c : mine; }
        if (sum == G) break;
        __builtin_amdgcn_s_sleep(1);
        if ((++sp & 255u) == 0u) { if (xb_ld(&bar[XB_TMO])) break; if (sp > XB_SPIN_CAP) { atomicAdd(&bar[XB_TMO], 1u); break; } }
    }
    nloc = mine > 0u ? mine : 1u; nx = cnt > 0u ? cnt : 1u;
}
DEV void xcd_barrier(const XcdBarrier& b) {
    asm volatile("s_waitcnt vmcnt(0)" ::: "memory");
    __syncthreads();
    if (threadIdx.x == 0) {
        unsigned* bar = b.bar;
        __builtin_amdgcn_s_waitcnt(0);
        unsigned nloc = b.st[0], nx = b.st[1];
        if (nloc == 0u) { xcd_barrier_complete(bar, b.x, nloc, nx); b.st[0] = nloc; b.st[1] = nx; }
        const unsigned old = xb_add(&bar[XB_XSUB(b.x)], 1u);
        const unsigned gen = old / nloc;
        if (old + 1u == (gen + 1u) * nloc) {
            __builtin_amdgcn_fence(__ATOMIC_RELEASE, "agent");
            asm volatile("s_waitcnt vmcnt(0)" ::: "memory");
            const unsigned og = xb_add(&bar[XB_TOP], 1u);
            const unsigned tg = og / nx;
            if (og + 1u == (tg + 1u) * nx) xb_add(&bar[XB_TOPGEN], 1u);
            else XB_SPIN(xb_ld(&bar[XB_TOPGEN]) == tg, bar);
            __builtin_amdgcn_fence(__ATOMIC_ACQUIRE, "agent");
            xb_add(&bar[XB_XGEN(b.x)], 1u);
            asm volatile("s_waitcnt vmcnt(0)" ::: "memory");
        } else {
            XB_SPIN(xb_ld(&bar[XB_XGEN(b.x)]) == gen, bar);
            __builtin_amdgcn_fence(__ATOMIC_ACQUIRE, "agent");
            asm volatile("s_waitcnt vmcnt(0)" ::: "memory");
        }
    }
    __syncthreads();
}

constexpr int GEMM_LDS = 61440;
template <class ARow, class Epi>
DEV void gemm_unit(LAS unsigned char* lds, const ARow& arow, const bf16_t* __restrict__ Bt, int K, const Epi& epi) {
    const int tid = threadIdx.x, wid = tid >> 6, lane = tid & 63, wr = wid >> 1, wc = wid & 1, fr = lane & 15, fq = lane >> 4;
    LAS unsigned char* As = lds;
    LAS unsigned char* Bs = lds + 40960;
    const u32x4* pa0 = (const u32x4*)arow(tid >> 2) + (tid & 3);
    const u32x4* pa1 = (const u32x4*)arow(128 + (tid >> 2)) + (tid & 3);
    const u32x4* pb = (const u32x4*)(Bt + (size_t)(tid >> 2) * K) + (tid & 3);
    const int sa0 = (tid >> 2) * 80 + (tid & 3) * 16, sa1 = sa0 + 128 * 80;
    f32x4 acc[4][4];
#pragma unroll
    for (int i = 0; i < 4; ++i)
#pragma unroll
        for (int j = 0; j < 4; ++j) acc[i][j] = (f32x4){0.f, 0.f, 0.f, 0.f};
    const int nk = K >> 5;
    u32x4 ra0 = pa0[0], ra1 = pa1[0], rb = pb[0];
    *(LAS u32x4*)(As + sa0) = ra0; *(LAS u32x4*)(As + sa1) = ra1; *(LAS u32x4*)(Bs + sa0) = rb;
    __syncthreads();
    for (int kt = 0; kt < nk; ++kt) {
        const int cur = kt & 1;
        if (kt + 1 < nk) { ra0 = pa0[(kt + 1) * 4]; ra1 = pa1[(kt + 1) * 4]; rb = pb[(kt + 1) * 4]; }
        LAS const unsigned char* Ac = As + cur * 20480 + (wr * 64 + fr) * 80 + fq * 16;
        LAS const unsigned char* Bc = Bs + cur * 10240 + (wc * 64 + fr) * 80 + fq * 16;
        bf16x8 af[4], bfv[4];
#pragma unroll
        for (int i = 0; i < 4; ++i) af[i] = *(LAS const bf16x8*)(Ac + i * 1280);
#pragma unroll
        for (int j = 0; j < 4; ++j) bfv[j] = *(LAS const bf16x8*)(Bc + j * 1280);
#pragma unroll
        for (int i = 0; i < 4; ++i)
#pragma unroll
            for (int j = 0; j < 4; ++j) acc[i][j] = __builtin_amdgcn_mfma_f32_16x16x32_bf16(bfv[j], af[i], acc[i][j], 0, 0, 0);
        if (kt + 1 < nk) {
            const int nx = cur ^ 1;
            *(LAS u32x4*)(As + nx * 20480 + sa0) = ra0; *(LAS u32x4*)(As + nx * 20480 + sa1) = ra1; *(LAS u32x4*)(Bs + nx * 10240 + sa0) = rb;
        }
        __syncthreads();
    }
    epi(acc, wr * 64 + fr, wc * 64 + 4 * fq);
}

namespace gp {
constexpr int BK = 64, HALF = 128, HTB = HALF * BK * 2, STAGE_BYTES = 8 * HTB;
DEV int lds_byte(int r, int c) { const int st = (r >> 4) * 2 + (c >> 5), rr = r & 15, cc = c & 31, ob = rr * 64 + cc * 2; return st * 1024 + (ob ^ (((ob >> 9) & 1) << 5)); }
DEV void stage_rc(int b, int& R, int& C) { const int st = b / 1024, sb = b % 1024, swz = sb ^ (((sb >> 9) & 1) << 5); R = (st >> 1) * 16 + swz / 64; C = (st & 1) * 32 + (swz % 64) / 2; }
DEV int perm32(int rho) { const int n = rho >> 4, i = rho & 15; return 8 * (i >> 2) + 4 * n + (i & 3); }
struct UAddr { const char* a; const char* b; unsigned ao00, ao01, ao10, ao11; };
template <class Epi, class Sched>
DEV void gemm_phase(LAS unsigned char* lds, const int K, const Sched& S, const Epi& E) {
    typedef typename Sched::Unit Unit;
    int tid_ = threadIdx.x; asm volatile("" : "+v"(tid_));
    const int tid = tid_, wid = __builtin_amdgcn_readfirstlane(tid >> 6), lane = tid & 63, wr = wid >> 2, wc = wid & 3, fr = lane & 15, fq = lane >> 4;
    const int nt = K / BK;
    int R0, C0, R1, C1; stage_rc(tid * 16, R0, C0); stage_rc(tid * 16 + 8192, R1, C1);
    const int Rb0 = Epi::PERM ? ((R0 & ~31) + perm32(R0 & 31)) : R0, Rb1 = Epi::PERM ? ((R1 & ~31) + perm32(R1 & 31)) : R1;
    const unsigned vb0 = (unsigned)(Rb0 * K + C0) * 2u, vb1 = (unsigned)(Rb1 * K + C1) * 2u;
    const size_t kstep = (size_t)(BK * 2);
    const size_t hstepB = (size_t)HALF * K * 2;
    const int lda_ = S.lda();
    const unsigned va0 = (unsigned)(R0 * lda_ + C0) * 2u, va1 = (unsigned)(R1 * lda_ + C1) * 2u;
    const size_t hstepA = (size_t)HALF * lda_ * 2;
    const unsigned ldsw = (unsigned)wid * 1024u;
    const int aoff = lds_byte(wr * 64 + fr, fq * 8), boff = lds_byte(wc * 32 + fr, fq * 8);
#define GP_SA(b, h) (((b) * 2 + (h)) * HTB)
#define GP_SB(b, h) ((4 + (b) * 2 + (h)) * HTB)
#define GP_GLDS(gp_, bufoff, i_) __builtin_amdgcn_global_load_lds((const unsigned*)(gp_), (LAS unsigned*)(lds + (bufoff) + ldsw + (i_) * 8192), 16, 0, 0)
#define GP_STAGE_A(bufoff, ab, o0, o1, h, kb) do { if constexpr (Sched::GATHER) { const char* up_ = (ab) + (kb); GP_GLDS(up_ + (o0), bufoff, 0); GP_GLDS(up_ + (o1), bufoff, 1); } \
        else { const char* up_ = (ab) + (((h) ? hstepA : (size_t)0) + (kb)); GP_GLDS(up_ + va0, bufoff, 0); GP_GLDS(up_ + va1, bufoff, 1); } } while (0)
#define GP_STAGE_B(bufoff, bb, h, kb) do { const char* up_ = (bb) + (((h) ? hstepB : (size_t)0) + (kb)); GP_GLDS(up_ + vb0, bufoff, 0); GP_GLDS(up_ + vb1, bufoff, 1); } while (0)
#define GP_LDA(dst, b, h) do { _Pragma("unroll") for (int m = 0; m < 4; ++m) _Pragma("unroll") for (int k = 0; k < 2; ++k) dst[m][k] = *(const LAS bf16x8*)(lds + GP_SA(b, h) + aoff + m * 2048 + k * 1024); } while (0)
#define GP_LDB(dst, b, h) do { _Pragma("unroll") for (int n = 0; n < 2; ++n) _Pragma("unroll") for (int k = 0; k < 2; ++k) dst[n][k] = *(const LAS bf16x8*)(lds + GP_SB(b, h) + boff + n * 2048 + k * 1024); } while (0)
#define GP_MMA(ai, bj, At, Bt) do { __builtin_amdgcn_s_setprio(1); _Pragma("unroll") for (int m = 0; m < 4; ++m) _Pragma("unroll") for (int n = 0; n < 2; ++n) _Pragma("unroll") for (int k = 0; k < 2; ++k) \
        acc[ai][bj][m][n] = __builtin_amdgcn_mfma_f32_16x16x32_bf16(Bt[n][k], At[m][k], acc[ai][bj][m][n], 0, 0, 0); __builtin_amdgcn_s_setprio(0); } while (0)
#define GP_WAIT_V(n) asm volatile("s_waitcnt vmcnt(" #n ")" ::: "memory")
#define GP_WAIT_L(n) asm volatile("s_waitcnt lgkmcnt(" #n ")" ::: "memory")
#define GP_BAR __builtin_amdgcn_s_barrier()
#define GP_SCHED __builtin_amdgcn_sched_barrier(0)
    Unit cur, nxt; int ui = 0;
    if (!S.next(0, cur)) return;
    const char* cA; const char* cB; unsigned c00 = 0, c01 = 0, c10 = 0, c11 = 0;
    const char* nA; const char* nB; unsigned n00 = 0, n01 = 0, n10 = 0, n11 = 0;
    { UAddr t_; S.addr(cur, R0, C0, R1, C1, t_); cA = t_.a; cB = t_.b; if constexpr (Sched::GATHER) { c00 = t_.ao00; c01 = t_.ao01; c10 = t_.ao10; c11 = t_.ao11; } }
    f32x4 acc[2][2][4][2];
#pragma unroll
    for (int a = 0; a < 2; ++a)
#pragma unroll
        for (int b = 0; b < 2; ++b)
#pragma unroll
            for (int m = 0; m < 4; ++m)
#pragma unroll
                for (int n = 0; n < 2; ++n) acc[a][b][m][n] = (f32x4){0.f, 0.f, 0.f, 0.f};
    bf16x8 At[4][2], B0[2][2], B1[2][2];
    GP_STAGE_B(GP_SB(0, 0), cB, 0, 0); GP_STAGE_B(GP_SB(0, 1), cB, 1, 0); GP_STAGE_A(GP_SA(0, 0), cA, c00, c01, 0, 0); GP_STAGE_A(GP_SA(0, 1), cA, c10, c11, 1, 0);
    if (wr == 1) GP_BAR;
    GP_WAIT_V(2); GP_BAR;
    GP_STAGE_B(GP_SB(1, 0), cB, 0, kstep); GP_STAGE_A(GP_SA(1, 0), cA, c00, c01, 0, kstep); GP_STAGE_B(GP_SB(1, 1), cB, 1, kstep);
    GP_WAIT_V(6); GP_BAR;
    for (;;) {
        const bool has_next = S.next(ui + 1, nxt);
        if (has_next) { UAddr t_; S.addr(nxt, R0, C0, R1, C1, t_); nA = t_.a; nB = t_.b; if constexpr (Sched::GATHER) { n00 = t_.ao00; n01 = t_.ao01; n10 = t_.ao10; n11 = t_.ao11; } }
        else { nA = cA; nB = cB; n00 = c00; n01 = c01; n10 = c10; n11 = c11; }
#pragma unroll 1
        for (int t = 0; t < nt; t += 2) {
            const bool last = (t == nt - 2);
            const size_t k1 = (size_t)(t + 1) * kstep;
            const char* sA = last ? nA : cA; const char* sB = last ? nB : cB;
            const unsigned s00 = last ? n00 : c00, s01 = last ? n01 : c01, s10 = last ? n10 : c10, s11 = last ? n11 : c11;
            const size_t k2 = last ? (size_t)0 : (size_t)(t + 2) * kstep, k3 = k2 + kstep;
            GP_LDB(B0, 0, 0); GP_LDB(B1, 0, 1); GP_SCHED; GP_LDA(At, 0, 0); GP_STAGE_A(GP_SA(1, 1), cA, c10, c11, 1, k1);
            GP_WAIT_V(8); GP_WAIT_L(0); GP_BAR; GP_MMA(0, 0, At, B0); GP_MMA(0, 1, At, B1); GP_BAR; GP_SCHED;
            GP_LDA(At, 0, 1); GP_STAGE_B(GP_SB(0, 0), sB, 0, k2); GP_STAGE_B(GP_SB(0, 1), sB, 1, k2); GP_STAGE_A(GP_SA(0, 0), sA, s00, s01, 0, k2);
            GP_WAIT_V(8); GP_WAIT_L(0); GP_BAR; GP_MMA(1, 0, At, B0); GP_MMA(1, 1, At, B1); GP_BAR; GP_SCHED;
            GP_LDB(B0, 1, 0); GP_LDB(B1, 1, 1); GP_SCHED; GP_LDA(At, 1, 0); GP_STAGE_A(GP_SA(0, 1), sA, s10, s11, 1, k2);
            GP_WAIT_V(8); GP_WAIT_L(0); GP_BAR; GP_MMA(0, 0, At, B0); GP_MMA(0, 1, At, B1); GP_BAR; GP_SCHED;
            GP_LDA(At, 1, 1); GP_STAGE_B(GP_SB(1, 0), sB, 0, k3); GP_STAGE_B(GP_SB(1, 1), sB, 1, k3); GP_STAGE_A(GP_SA(1, 0), sA, s00, s01, 0, k3);
            GP_WAIT_V(8); GP_WAIT_L(0); GP_BAR; GP_MMA(1, 0, At, B0); GP_MMA(1, 1, At, B1); GP_BAR; GP_SCHED;
        }
        if (wr == 0) GP_BAR;
        E(acc, cur, wr, wc, fr, fq);
        if (!has_next) break;
#pragma unroll
        for (int a = 0; a < 2; ++a)
#pragma unroll
            for (int b = 0; b < 2; ++b)
#pragma unroll
                for (int m = 0; m < 4; ++m)
#pragma unroll
                    for (int n = 0; n < 2; ++n) acc[a][b][m][n] = (f32x4){0.f, 0.f, 0.f, 0.f};
        cur = nxt; cA = nA; cB = nB; c00 = n00; c01 = n01; c10 = n10; c11 = n11; ++ui;
        if (wr == 1) GP_BAR;
    }
    GP_WAIT_V(0);
    GP_BAR;
#undef GP_SA
#undef GP_SB
#undef GP_GLDS
#undef GP_STAGE_A
#undef GP_STAGE_B
#undef GP_LDA
#undef GP_LDB
#undef GP_MMA
#undef GP_WAIT_V
#undef GP_WAIT_L
#undef GP_BAR
#undef GP_SCHED
}
DEV bool static_order(int i, int G, int c, int nM, int nN, int& pm, int& pn) {
    const int nwg = nM * nN; const long L = (long)i * G + c; if (L >= nwg) return false;
    int wgid = (int)L; { const int q = nwg / 8, r = nwg % 8, xcd = wgid % 8, off = wgid / 8; wgid = (xcd < r ? xcd * (q + 1) : r * (q + 1) + (xcd - r) * q) + off; }
    const int nig = 8 * nN, gid = wgid / nig, fm = gid * 8, gsz = (nM - fm) < 8 ? (nM - fm) : 8;
    pm = fm + ((wgid % nig) % gsz); pn = (wgid % nig) / gsz; return true;
}
}

struct PlainSched {
    struct Unit { int pm, pn; };
    static constexpr bool GATHER = false;
    const char* A; const char* Bt; int lda_, K, nM, nN, G, c;
    DEV int lda() const { return lda_; }
    DEV bool next(int i, Unit& u) const { return gp::static_order(i, G, c, nM, nN, u.pm, u.pn); }
    DEV void addr(const Unit& u, int R0, int C0, int R1, int C1, gp::UAddr& o) const {
        o.a = A + (size_t)u.pm * 256 * lda_ * 2; o.b = Bt + (size_t)u.pn * 256 * K * 2;
    }
};
struct EpiF32 {
    static constexpr bool PERM = false;
    float* O; int ldc;
    template <class U> DEV void operator()(const f32x4 (&acc)[2][2][4][2], const U& u, int wr, int wc, int fr, int fq) const {
        const int row0 = u.pm * 256 + wr * 64 + fr, col0 = u.pn * 256 + wc * 32 + 4 * fq;
#pragma unroll
        for (int ai = 0; ai < 2; ++ai)
#pragma unroll
            for (int m = 0; m < 4; ++m) {
                float* rowp = O + (size_t)(row0 + ai * 128 + m * 16) * ldc + col0;
#pragma unroll
                for (int bj = 0; bj < 2; ++bj)
#pragma unroll
                    for (int n = 0; n < 2; ++n) *(f32x4*)(rowp + bj * 128 + n * 16) = acc[ai][bj][m][n];
            }
    }
};

DEV void bf8_unpack(const u32x4 w, float (&y)[8]) {
    y[0] = __uint_as_float(w.x << 16); y[1] = __uint_as_float(w.x & 0xffff0000u); y[2] = __uint_as_float(w.y << 16); y[3] = __uint_as_float(w.y & 0xffff0000u);
    y[4] = __uint_as_float(w.z << 16); y[5] = __uint_as_float(w.z & 0xffff0000u); y[6] = __uint_as_float(w.w << 16); y[7] = __uint_as_float(w.w & 0xffff0000u);
}
struct WinSched {
    struct Unit { int pm, pn; };
    static constexpr bool GATHER = false;
    const char* A; const char* Bt; int G, c;
    DEV int lda() const { return 1024; }
    DEV bool next(int i, Unit& u) const { return gp::static_order(i, G, c, 136, 6, u.pm, u.pn); }
    DEV void addr(const Unit& u, int R0, int C0, int R1, int C1, gp::UAddr& o) const {
        o.a = A + (size_t)u.pm * 256 * 1024 * 2; o.b = Bt + ((size_t)u.pn * 256) * 1024 * 2;
    }
};
struct EpiWin {
    static constexpr bool PERM = true;
    bf16_t* US5; bf16_t* ULRU;
    template <class U> DEV void operator()(const f32x4 (&acc)[2][2][4][2], const U& u, int wr, int wc, int fr, int fq) const {
#pragma unroll
        for (int bj = 0; bj < 2; ++bj) {
            const int col8 = u.pn * 256 + bj * 128 + wc * 32 + 8 * fq;
#pragma unroll
            for (int ai = 0; ai < 2; ++ai)
#pragma unroll
                for (int m = 0; m < 4; ++m) {
                    const int row = u.pm * 256 + ai * 128 + wr * 64 + m * 16 + fr;
                    const f32x4 v0 = acc[ai][bj][m][0], v1 = acc[ai][bj][m][1];
                    u32x4 w; w.x = pack2(v0[0], v0[1]); w.y = pack2(v0[2], v0[3]); w.z = pack2(v1[0], v1[1]); w.w = pack2(v1[2], v1[3]);
                    if (col8 < 512) {
                        int mm, ss;
                        if (row < T) { const int bq = row >> 12, t = row & 4095; mm = bq * 128 + (t >> 5); ss = t & 31; }
                        else { const int q = row - T, bq = q >> 8, j = q & 255; mm = M5LAT + bq * 8 + (j >> 5); ss = j & 31; }
                        *(u32x4*)(US5 + ((size_t)((col8 >> 4) * M5PAD + mm)) * KT5 + ss * 16 + (col8 & 15)) = w;
                    } else *(u32x4*)(ULRU + (size_t)(row < T ? cmaj(row) : row) * 1024 + (col8 - 512)) = w;
                }
        }
    }
};
struct S5Sched {
    struct Unit { int g, pm, pn; };
    static constexpr bool GATHER = false;
    const char* A; const char* Bt; int K, nPm, nPn, brows  , G, c;
    DEV int lda() const { return KT5; }
    DEV bool next(int i, Unit& u) const {
        if (i > 0) return false;
        const int per = nPm * nPn * 4;
        const int x = c & 7, j = c >> 3; if (j >= per) return false;
        const int U = x * per + j; u.g = U / (nPm * nPn); const int r = U % (nPm * nPn); u.pm = r / nPn; u.pn = r % nPn; return true;
    }
    DEV void addr(const Unit& u, int R0, int C0, int R1, int C1, gp::UAddr& o) const {
        o.a = A + ((size_t)u.g * M5PAD + u.pm * 256) * KT5 * 2; o.b = Bt + ((size_t)u.g * brows + u.pn * 256) * K * 2;
    }
};
struct EpiS5Loc {
    static constexpr bool PERM = false;
    float* SLOC;
    template <class U> DEV void operator()(const f32x4 (&acc)[2][2][4][2], const U& u, int wr, int wc, int fr, int fq) const {
#pragma unroll
        for (int ai = 0; ai < 2; ++ai)
#pragma unroll
            for (int m = 0; m < 4; ++m) {
                const int mm = u.pm * 256 + ai * 128 + wr * 64 + m * 16 + fr;
                if (mm < M5) {
                    float* rowp = SLOC + ((size_t)(u.g * M5 + mm)) * 256 + wc * 32 + 4 * fq;
#pragma unroll
                    for (int bj = 0; bj < 2; ++bj)
#pragma unroll
                        for (int n = 0; n < 2; ++n) *(f32x4*)(rowp + bj * 128 + n * 16) = acc[ai][bj][m][n];
                }
            }
    }
};
struct EpiS5Out {
    static constexpr bool PERM = true;
    bf16_t* YS5;
    template <class U> DEV void operator()(const f32x4 (&acc)[2][2][4][2], const U& u, int wr, int wc, int fr, int fq) const {
#pragma unroll
        for (int ai = 0; ai < 2; ++ai)
#pragma unroll
            for (int m = 0; m < 4; ++m) {
                const int mm = u.pm * 256 + ai * 128 + wr * 64 + m * 16 + fr, bq = mm >> 7, chunk = mm & 127;
#pragma unroll
                for (int bj = 0; bj < 2; ++bj) {
                    const int n8 = u.pn * 256 + bj * 128 + wc * 32 + 8 * fq, t = n8 >> 4, c0 = n8 & 15;
                    const size_t tok = (size_t)bq * 4096 + chunk * 32 + t;
                    const f32x4 v0 = acc[ai][bj][m][0], v1 = acc[ai][bj][m][1];
                    u32x4 w; w.x = pack2(gelu_tanh(v0[0]), gelu_tanh(v0[1])); w.y = pack2(gelu_tanh(v0[2]), gelu_tanh(v0[3]));
                    w.z = pack2(gelu_tanh(v1[0]), gelu_tanh(v1[1])); w.w = pack2(gelu_tanh(v1[2]), gelu_tanh(v1[3]));
                    *(u32x4*)(YS5 + tok * 512 + u.g * 16 + c0) = w;
                }
            }
    }
};
struct EpiGlu {
    static constexpr bool PERM = true;
    const bf16_t* YS5; const float* b_glu; bf16_t* YCAT;
    template <class U> DEV void operator()(const f32x4 (&acc)[2][2][4][2], const U& u, int wr, int wc, int fr, int fq) const {
        const int col0 = u.pn * 256 + wc * 32 + 8 * fq; const size_t row0 = (size_t)u.pm * 256 + wr * 64 + fr;
        f32x4 bv[2][2];
#pragma unroll
        for (int bj = 0; bj < 2; ++bj) { bv[bj][0] = *(const f32x4*)(b_glu + col0 + bj * 128); bv[bj][1] = *(const f32x4*)(b_glu + col0 + bj * 128 + 4); }
        u32x4 yv[2][4][2];
#pragma unroll
        for (int ai = 0; ai < 2; ++ai)
#pragma unroll
            for (int m = 0; m < 4; ++m)
#pragma unroll
                for (int bj = 0; bj < 2; ++bj) yv[ai][m][bj] = *(const u32x4*)(YS5 + (row0 + ai * 128 + m * 16) * 512 + col0 + bj * 128);
#pragma unroll
        for (int ai = 0; ai < 2; ++ai)
#pragma unroll
            for (int m = 0; m < 4; ++m)
#pragma unroll
                for (int bj = 0; bj < 2; ++bj) {
                    float y[8]; bf8_unpack(yv[ai][m][bj], y);
                    const f32x4 z0 = acc[ai][bj][m][0] + bv[bj][0], z1 = acc[ai][bj][m][1] + bv[bj][1];
                    u32x4 w; w.x = pack2(y[0] * sigmoid_f(z0[0]), y[1] * sigmoid_f(z0[1])); w.y = pack2(y[2] * sigmoid_f(z0[2]), y[3] * sigmoid_f(z0[3]));
                    w.z = pack2(y[4] * sigmoid_f(z1[0]), y[5] * sigmoid_f(z1[1])); w.w = pack2(y[6] * sigmoid_f(z1[2]), y[7] * sigmoid_f(z1[3]));
                    *(u32x4*)(YCAT + (size_t)cmaj((int)(row0 + ai * 128 + m * 16)) * 1024 + col0 + bj * 128) = w;
                }
    }
};

struct TrTile { const float* W; bf16_t* dst; int ldw, k0, n0, ldd, mode; };
DEV void tr_load(const TrTile& t, int lane, f32x4 (&v)[16]) {
#pragma unroll
    for (int i = 0; i < 16; ++i) v[i] = *(const f32x4*)(t.W + (size_t)(t.k0 + i * 4 + (lane >> 4)) * t.ldw + t.n0 + (lane & 15) * 4);
}
DEV void tr_store(const TrTile& t, int lane, const f32x4 (&v)[16], LAS float* tile) {
#pragma unroll
    for (int i = 0; i < 16; ++i) { LAS float* tp = tile + (i * 4 + (lane >> 4)) * 65 + (lane & 15) * 4; tp[0] = v[i][0]; tp[1] = v[i][1]; tp[2] = v[i][2]; tp[3] = v[i][3]; }
    __builtin_amdgcn_fence(__ATOMIC_RELEASE, "wavefront"); __builtin_amdgcn_wave_barrier(); __builtin_amdgcn_fence(__ATOMIC_ACQUIRE, "wavefront");
    const int kc = lane & 7;
#pragma unroll
    for (int jn = 0; jn < 8; ++jn) {
        const int nn = (lane >> 3) + 8 * jn;
        float e[8];
#pragma unroll
        for (int jj = 0; jj < 8; ++jj) e[jj] = tile[(kc * 8 + jj) * 65 + nn];
        const int j = t.n0 + nn;
        const int row = t.mode == 0 ? j : (((j >> 4) << 5) + (j & 15) + (t.mode == 2 ? 16 : 0));
        u32x4 w; w.x = pack2(e[0], e[1]); w.y = pack2(e[2], e[3]); w.z = pack2(e[4], e[5]); w.w = pack2(e[6], e[7]);
        *(u32x4*)(t.dst + (size_t)row * t.ldd + t.k0 + kc * 8) = w;
    }
    __builtin_amdgcn_fence(__ATOMIC_RELEASE, "wavefront"); __builtin_amdgcn_wave_barrier(); __builtin_amdgcn_fence(__ATOMIC_ACQUIRE, "wavefront");
}
DEV void tr_tile_wave(const float* __restrict__ W, int ldw, int k0, int n0, bf16_t* __restrict__ dst, int ldd, int mode, LAS float* tile, int lane) {
    TrTile t{W, dst, ldw, k0, n0, ldd, mode}; f32x4 v[16]; tr_load(t, lane, v); tr_store(t, lane, v, tile);
}
DEV TrTile expert_tile(const Params& p, int it) {
    const int e = it / 192, r = it % 192, which = r >> 6, tt = r & 63;
    TrTile t;
    if (which < 2) {
        t.W = e < 64 ? (which == 0 ? p.in[31] : p.in[32]) + (size_t)e * 262144 : (which == 0 ? p.in[34] : p.in[35]);
        t.ldw = 256; t.k0 = (tt >> 2) * 64; t.n0 = (tt & 3) * 64; t.dst = (bf16_t*)(p.ws + WS_BTGU) + (size_t)e * 524288; t.ldd = 1024; t.mode = which + 1;
    } else {
        t.W = e < 64 ? p.in[33] + (size_t)e * 262144 : p.in[36];
        t.ldw = 1024; t.k0 = (tt >> 4) * 64; t.n0 = (tt & 15) * 64; t.dst = (bf16_t*)(p.ws + WS_BTDN) + (size_t)e * 262144; t.ldd = 256; t.mode = 0;
    }
    return t;
}

DEV void gemv9_item(LAS const float* S, const float* __restrict__ W, int ldw, int col0, const float* __restrict__ bias, float* __restrict__ out, int ldo, LAS float* red) {
    const int tid = threadIdx.x, col = tid & 31, kp = tid >> 5;
    float acc[9];
#pragma unroll
    for (int b = 0; b < 9; ++b) acc[b] = 0.f;
    for (int k = kp * 64; k < kp * 64 + 64; ++k) {
        const float w = W[(size_t)k * ldw + col0 + col];
#pragma unroll
        for (int b = 0; b < 9; ++b) acc[b] += S[b * 1024 + k] * w;
    }
#pragma unroll
    for (int b = 0; b < 9; ++b) red[(kp * 9 + b) * 32 + col] = acc[b];
    __syncthreads();
    if (tid < 288) {
        const int b = tid >> 5, c = tid & 31; float s = 0.f;
#pragma unroll
        for (int q = 0; q < 16; ++q) s += red[(q * 9 + b) * 32 + c];
        out[b * ldo + col0 + c] = s + (bias ? bias[col0 + c] : 0.f);
    }
    __syncthreads();
}

DEV void cpow_d(double lr, double li, double dt, int l, double& re, double& im) {
    const double mag = exp(lr * dt * (double)l);
    const double ang = li * dt * (double)l;
    const double kq = rint(ang * 0.63661977236758134308);
    double x = fma(-kq, 1.57079632679489655800e+00, ang);
    x = fma(-kq, 6.12323399573676603587e-17, x);
    const double x2 = x * x;
    double s = -1.0 / 6227020800.0; s = fma(s, x2, 1.0 / 39916800.0); s = fma(s, x2, -1.0 / 362880.0); s = fma(s, x2, 1.0 / 5040.0);
    s = fma(s, x2, -1.0 / 120.0); s = fma(s, x2, 1.0 / 6.0); s = fma(-s, x2, 1.0); s = s * x;
    double c = 1.0 / 479001600.0; c = fma(c, x2, -1.0 / 3628800.0); c = fma(c, x2, 1.0 / 40320.0); c = fma(c, x2, -1.0 / 720.0);
    c = fma(c, x2, 1.0 / 24.0); c = fma(c, x2, -0.5); c = fma(c, x2, 1.0);
    const int q = ((int)(long long)kq) & 3;
    const double sn = (q == 0) ? s : (q == 1) ? c : (q == 2) ? -s : -c;
    const double cs = (q == 0) ? c : (q == 1) ? -s : (q == 2) ? -c : s;
    re = mag * cs; im = mag * sn;
}

DEV void s5_tables(const Params& p, LAS unsigned char* lds, int g, int part) {
    int tid = threadIdx.x; asm volatile("" : "+v"(tid));
    LAS float* apr = (LAS float*)lds;
    LAS float* api = apr + 640;
    LAS float* bbr = api + 640;
    LAS float* bbi = bbr + 2048;
    const float* lam_re = p.in[9]; const float* lam_im = p.in[10]; const float* log_dt = p.in[11];
    const float* b_re = p.in[12]; const float* b_im = p.in[13]; const float* c_re = p.in[14]; const float* c_im = p.in[15];
    float* APR = (float*)(p.ws + WS_APR) + (size_t)g * 4224; float* API = (float*)(p.ws + WS_API) + (size_t)g * 4224;
    float* BBR = (float*)(p.ws + WS_BBR) + (size_t)g * 2048; float* BBI = (float*)(p.ws + WS_BBI) + (size_t)g * 2048;
    float* KTAB = (float*)(p.ws + WS_KTAB) + (size_t)g * 16384;
    const int nl = part == 7 ? 5 : 4;
    for (int i = tid; i < 2 * nl * 64; i += 512) {
        const int dir = i / (nl * 64), rem = i % (nl * 64), li = rem >> 6, pp = rem & 63, l = part * 4 + li, gi = dir * 32 + g;
        const double dt = exp((double)log_dt[gi]);
        double re, im; cpow_d((double)lam_re[gi * 64 + pp], (double)lam_im[gi * 64 + pp], dt, l, re, im);
        apr[(dir * 5 + li) * 64 + pp] = (float)re; api[(dir * 5 + li) * 64 + pp] = (float)im;
        APR[(dir * 33 + l) * 64 + pp] = (float)re; API[(dir * 33 + l) * 64 + pp] = (float)im;
    }
    for (int i = tid; i < 2048; i += 512) {
        const int dir = i >> 10, pp = (i >> 4) & 63, c = i & 15, gi = dir * 32 + g;
        const double dt = exp((double)log_dt[gi]);
        const double lr = (double)lam_re[gi * 64 + pp], li = (double)lam_im[gi * 64 + pp];
        double ar, ai; cpow_d(lr, li, dt, 1, ar, ai);
        const double nr = ar - 1.0, den = lr * lr + li * li;
        const double fr = (nr * lr + ai * li) / den, fi = (ai * lr - nr * li) / den;
        const double br = (double)b_re[((size_t)(gi * 64 + pp)) * 16 + c], bi = (double)b_im[((size_t)(gi * 64 + pp)) * 16 + c];
        const float vr = (float)(fr * br - fi * bi), vi = (float)(fr * bi + fi * br);
        bbr[i] = vr; bbi[i] = vi;
        if (part == 0) { BBR[i] = vr; BBI[i] = vi; }
    }
    __syncthreads();
    if (tid < 128) {
        const int dir = tid >> 6, li = (tid >> 4) & 3, c = tid & 15, l = part * 4 + li;
        const float* cr_ = c_re + ((size_t)((dir * 32 + g) * 16 + c)) * 64; const float* ci_ = c_im + ((size_t)((dir * 32 + g) * 16 + c)) * 64;
        f32x4 s0 = (f32x4){0.f, 0.f, 0.f, 0.f}, s1 = s0, s2 = s0, s3 = s0;
#pragma unroll 2
        for (int pp = 0; pp < 64; ++pp) {
            const float ar = apr[(dir * 5 + li) * 64 + pp], ai = api[(dir * 5 + li) * 64 + pp];
            const float cr = cr_[pp], ci = ci_[pp];
            const float qr = cr * ar - ci * ai, qi = cr * ai + ci * ar;
            LAS const f32x4* br = (LAS const f32x4*)(bbr + (dir * 64 + pp) * 16); LAS const f32x4* bi = (LAS const f32x4*)(bbi + (dir * 64 + pp) * 16);
            s0 += br[0] * qr - bi[0] * qi; s1 += br[1] * qr - bi[1] * qi; s2 += br[2] * qr - bi[2] * qi; s3 += br[3] * qr - bi[3] * qi;
        }
        f32x4* kd = (f32x4*)(KTAB + ((dir * 32 + l) * 16 + c) * 16);
        kd[0] = s0; kd[1] = s1; kd[2] = s2; kd[3] = s3;
    }
    __syncthreads();
}
DEV void s5_fill(const Params& p, LAS unsigned char* lds, int g, int part) {
    int tid = threadIdx.x; asm volatile("" : "+v"(tid));
    LAS float* apr = (LAS float*)lds;
    LAS float* api = apr + 4224;
    LAS float* bbr = api + 4224;
    LAS float* bbi = bbr + 2048;
    LAS float* ccr = bbi + 2048;
    LAS float* cci = ccr + 2048;
    LAS float* Kt = cci + 2048;
    const float* c_re = p.in[14]; const float* c_im = p.in[15]; const float* dvec = p.in[16];
    bf16_t* BS5 = (bf16_t*)(p.ws + WS_BS5); bf16_t* ES5 = (bf16_t*)(p.ws + WS_ES5); float* ALC = (float*)(p.ws + WS_ALC);
    {
        const f32x4* s0 = (const f32x4*)((const float*)(p.ws + WS_APR) + (size_t)g * 4224); const f32x4* s1 = (const f32x4*)((const float*)(p.ws + WS_API) + (size_t)g * 4224);
        for (int i = tid; i < 1056; i += 512) { ((LAS f32x4*)apr)[i] = s0[i]; ((LAS f32x4*)api)[i] = s1[i]; }
        const f32x4* s2 = (const f32x4*)((const float*)(p.ws + WS_BBR) + (size_t)g * 2048); const f32x4* s3 = (const f32x4*)((const float*)(p.ws + WS_BBI) + (size_t)g * 2048);
        { const int i = tid; ((LAS f32x4*)bbr)[i] = s2[i]; ((LAS f32x4*)bbi)[i] = s3[i]; }
        const f32x4* s4 = (const f32x4*)((const float*)(p.ws + WS_KTAB) + (size_t)g * 16384);
        for (int i = tid; i < 4096; i += 512) { const f32x4 kv = s4[i]; LAS float* kd = Kt + (i >> 6) * 257 + (i & 63) * 4; kd[0] = kv[0]; kd[1] = kv[1]; kd[2] = kv[2]; kd[3] = kv[3]; }
        for (int i = tid; i < 2048; i += 512) {
            const int dir = i >> 10, cc = (i >> 6) & 15, pp = i & 63; const size_t src = ((size_t)((dir * 32 + g) * 16 + cc)) * 64 + pp;
            ccr[i] = c_re[src]; cci[i] = c_im[src];
        }
    }
    __syncthreads();
    for (int q = tid; q < 64 * 96; q += 512) {
        const int n = part * 64 + q / 96, k8 = (q % 96) * 8, t = n >> 4, c = n & 15;
        float e[8];
        if (k8 < 512) {
            const int s = k8 >> 4, c0 = k8 & 15, delta = t - s;
#pragma unroll
            for (int i = 0; i < 8; ++i) {
                const int c2 = c0 + i; float v;
                if (delta > 0) v = Kt[delta * 257 + c * 16 + c2];
                else if (delta < 0) v = Kt[(32 - delta) * 257 + c * 16 + c2];
                else v = Kt[c * 16 + c2] + Kt[32 * 257 + c * 16 + c2] + (c == c2 ? dvec[g * 16 + c] : 0.f);
                e[i] = v;
            }
        } else {
            const int kk = k8 - 512, seg = kk >> 6, p0 = kk & 63, dir = seg >> 1, l = dir == 0 ? t + 1 : 32 - t;
#pragma unroll
            for (int i = 0; i < 8; ++i) {
                const int pp = p0 + i;
                const float ar = apr[(dir * 33 + l) * 64 + pp], ai = api[(dir * 33 + l) * 64 + pp];
                const float cr = ccr[(dir * 16 + c) * 64 + pp], ci = cci[(dir * 16 + c) * 64 + pp];
                e[i] = (seg & 1) ? -(cr * ai + ci * ar) : (cr * ar - ci * ai);
            }
        }
        u32x4 w; w.x = pack2(e[0], e[1]); w.y = pack2(e[2], e[3]); w.z = pack2(e[4], e[5]); w.w = pack2(e[6], e[7]);
        *(u32x4*)(BS5 + ((size_t)g * 512 + n) * 768 + k8) = w;
    }
    for (int q = tid; q < 32 * 64; q += 512) {
        const int n = part * 32 + (q >> 6), k8 = (q & 63) * 8, s = k8 >> 4, c0 = k8 & 15, seg = n >> 6, pp = n & 63, dir = seg >> 1, l = dir == 0 ? 31 - s : s;
        const float ar = apr[(dir * 33 + l) * 64 + pp], ai = api[(dir * 33 + l) * 64 + pp];
        float e[8];
#pragma unroll
        for (int i = 0; i < 8; ++i) {
            const float br = bbr[(dir * 64 + pp) * 16 + c0 + i], bi = bbi[(dir * 64 + pp) * 16 + c0 + i];
            e[i] = (seg & 1) ? (ar * bi + ai * br) : (ar * br - ai * bi);
        }
        u32x4 w; w.x = pack2(e[0], e[1]); w.y = pack2(e[2], e[3]); w.z = pack2(e[4], e[5]); w.w = pack2(e[6], e[7]);
        *(u32x4*)(ES5 + ((size_t)g * 256 + n) * 512 + k8) = w;
    }
    if (part == 0 && tid < 128) {
        const int dir = tid >> 6, pp = tid & 63;
        ALC[((dir * 32 + g) * 64 + pp) * 2 + 0] = apr[(dir * 33 + 32) * 64 + pp];
        ALC[((dir * 32 + g) * 64 + pp) * 2 + 1] = api[(dir * 33 + 32) * 64 + pp];
    }
    __syncthreads();
}

template <bool APPLY>
DEV void lru_item(const Params& p, LAS unsigned char* lds, int b, int ch, int h) {
    int tid_ = threadIdx.x; asm volatile("" : "+v"(tid_));
    const int tid = tid_, wid = tid >> 6, lane = tid & 63, fr = lane & 15, fq = lane >> 4;
    LAS float* xin = (LAS float*)lds;
    LAS float* xs = (LAS float*)(lds + 17408);
    LAS unsigned short* xsb = (LAS unsigned short*)(lds + 33792);
    LAS float* aa = (LAS float*)(lds + 43008);
    LAS float* bb = (LAS float*)(lds + 75776);
    LAS float* cAs = (LAS float*)(lds + 108544);
    const bf16_t* ULRU = (const bf16_t*)(p.ws + WS_ULRU);
    const bf16_t* BTLRU = (const bf16_t*)(p.ws + WS_BTLRU);
    const float* conv_w = p.in[19]; const float* conv_b = p.in[20];
    if (tid < 128) {
        const int dir = tid >> 6, j = tid & 63, o = dir * 512 + h * 64 + j;
        cAs[tid] = -8.f * log1pf(__expf(-p.in[25][o])); cAs[128 + tid] = p.in[22][o]; cAs[256 + tid] = p.in[24][o];
    }
    for (int c = tid; c < 67 * 8; c += 512) {
        const int rr = c >> 3, c8 = (c & 7) * 8, pos = rr - 2;
        u32x4 w = (u32x4){0u, 0u, 0u, 0u};
        if (ch < 64) { if (pos >= 0 && pos < 64) w = *(const u32x4*)(ULRU + ((size_t)b * 4096 + pos * 64 + ch) * 1024 + h * 64 + c8); }
        else { const int jt = (ch - 64) * 64 + pos; if (jt >= 0 && jt < 256) w = *(const u32x4*)(ULRU + ((size_t)T + b * 256 + jt) * 1024 + h * 64 + c8); }
        float y[8]; bf8_unpack(w, y);
        *(LAS f32x4*)(xin + rr * 64 + c8) = (f32x4){y[0], y[1], y[2], y[3]}; *(LAS f32x4*)(xin + rr * 64 + c8 + 4) = (f32x4){y[4], y[5], y[6], y[7]};
    }
    __syncthreads();
    {
        const int cc = tid & 63, chn = h * 64 + cc;
        const float w0 = conv_w[chn], w1 = conv_w[512 + chn], w2 = conv_w[1024 + chn], w3 = conv_w[1536 + chn], cb = conv_b[chn];
#pragma unroll 2
        for (int r = tid >> 6; r < 64; r += 8) {
            const float v = cb + w0 * xin[r * 64 + cc] + w1 * xin[(r + 1) * 64 + cc] + w2 * xin[(r + 2) * 64 + cc] + w3 * xin[(r + 3) * 64 + cc];
            xs[r * 64 + cc] = v; xsb[r * 72 + cc] = (unsigned short)f2bf(v);
        }
    }
    __syncthreads();
    {
        const int mt = wid & 3, dir = wid >> 2;
        bf16x8 af[2];
#pragma unroll
        for (int ks = 0; ks < 2; ++ks) af[ks] = *(LAS const bf16x8*)((LAS const unsigned char*)xsb + (mt * 16 + fr) * 144 + ks * 64 + fq * 16);
        const int r = mt * 16 + fr;
#pragma unroll
        for (int jt = 0; jt < 8; ++jt) {
            const int n = dir * 128 + jt * 16 + fr;
            const bf16_t* bp = BTLRU + ((size_t)(h * 256 + n)) * 64 + fq * 8;
            const bf16x8 b0 = *(const bf16x8*)bp, b1 = *(const bf16x8*)(bp + 32);
            f32x4 a = (f32x4){0.f, 0.f, 0.f, 0.f};
            a = __builtin_amdgcn_mfma_f32_16x16x32_bf16(b0, af[0], a, 0, 0, 0);
            a = __builtin_amdgcn_mfma_f32_16x16x32_bf16(b1, af[1], a, 0, 0, 0);
            LAS float* dst = (jt < 4 ? aa : bb) + (dir * 64 + r) * 64 + (jt & 3) * 16 + 4 * fq;
            *(LAS f32x4*)dst = a;
        }
    }
    __syncthreads();
#pragma unroll 2
    for (int idx = tid; idx < 8192; idx += 512) {
        const int dir = idx >> 12, j = idx & 63, r = (idx >> 6) & 63;
        const float za = aa[idx] + cAs[128 + dir * 64 + j], zx = bb[idx] + cAs[256 + dir * 64 + j];
        const float la = cAs[dir * 64 + j] * sigmoid_f(za);
        const float a = __expf(la);
        const float x2 = 2.f * la;
        const float em = -x2 * (1.f + x2 * (0.5f + x2 * (0.16666667f + x2 * (0.041666668f + x2 * (0.0083333338f + x2 * 0.0013888889f)))));
        aa[idx] = a; bb[idx] = sqrtf(em) * sigmoid_f(zx) * xs[r * 64 + j];
    }
    __syncthreads();
    if (tid < 128) {
        const int dir = tid >> 6, j = tid & 63, chn = h * 64 + j;
        LAS float* ap = aa + dir * 4096 + j; LAS float* bp = bb + dir * 4096 + j;
        if (!APPLY) {
            float H = 0.f, P = 1.f;
#pragma unroll 1
            for (int s0 = 0; s0 < 64; s0 += 16) {
                float av[16], bv[16];
#pragma unroll
                for (int q = 0; q < 16; ++q) { const int r = dir ? 63 - (s0 + q) : s0 + q; av[q] = ap[r * 64]; bv[q] = bp[r * 64]; }
#pragma unroll
                for (int q = 0; q < 16; ++q) { H = av[q] * H + bv[q]; P *= av[q]; }
            }
            float* SA = (float*)(p.ws + WS_SA); float* SB = (float*)(p.ws + WS_SB);
            const size_t o = ((size_t)(b * 68 + ch) * 2 + dir) * 512 + chn;
            SA[o] = P; SB[o] = H;
        } else {
            const float* HIN = (const float*)(p.ws + WS_HIN);
            float H = HIN[((size_t)(b * 64 + ch) * 2 + dir) * 512 + chn];
#pragma unroll 1
            for (int s0 = 0; s0 < 64; s0 += 16) {
                float av[16], bv[16];
#pragma unroll
                for (int q = 0; q < 16; ++q) { const int r = dir ? 63 - (s0 + q) : s0 + q; av[q] = ap[r * 64]; bv[q] = bp[r * 64]; }
#pragma unroll
                for (int q = 0; q < 16; ++q) { const int r = dir ? 63 - (s0 + q) : s0 + q; H = av[q] * H + bv[q]; bp[r * 64] = H; }
            }
        }
    }
    __syncthreads();
    if (APPLY) {
        bf16_t* YCAT = (bf16_t*)(p.ws + WS_YCAT);
        {
            const int r = tid >> 3, j8 = (tid & 7) * 8;
            const size_t row = (size_t)b * 4096 + r * 64 + ch;
            float gt[8]; bf8_unpack(*(const u32x4*)(ULRU + row * 1024 + 512 + h * 64 + j8), gt);
            float o[8];
#pragma unroll
            for (int q = 0; q < 8; ++q) o[q] = (bb[r * 64 + j8 + q] + bb[(64 + r) * 64 + j8 + q]) * gelu_tanh(gt[q]);
            u32x4 w; w.x = pack2(o[0], o[1]); w.y = pack2(o[2], o[3]); w.z = pack2(o[4], o[5]); w.w = pack2(o[6], o[7]);
            *(u32x4*)(YCAT + row * 1024 + 512 + h * 64 + j8) = w;
        }
        __syncthreads();
    }
}

template <int CTRL> DEV float dpp_f(float oldv, float src) {
    return __builtin_bit_cast(float, __builtin_amdgcn_update_dpp(__builtin_bit_cast(int, oldv), __builtin_bit_cast(int, src), CTRL, 0xf, 0xf, false));
}
template <bool REV> DEV void row_scan(float& a, float& b) {
#define LRU_STEP(D) { const float ap = dpp_f<(REV ? 0x100 : 0x110) + D>(1.f, a), bp = dpp_f<(REV ? 0x100 : 0x110) + D>(0.f, b); b = a * bp + b; a = a * ap; }
    LRU_STEP(1) LRU_STEP(2) LRU_STEP(4) LRU_STEP(8)
#undef LRU_STEP
}
#ifndef PROBE_LRU
#define PROBE_LRU -1
#endif
#define LSEC_B(id) do { if (PROBE_LRU == (id)) { __builtin_amdgcn_s_waitcnt(0); lt0_ = __builtin_amdgcn_s_memrealtime(); } } while (0)
#define LSEC_E(id) do { if (PROBE_LRU == (id)) { __builtin_amdgcn_s_waitcnt(0); lacc_ += __builtin_amdgcn_s_memrealtime() - lt0_; } } while (0)
template <bool APPLY>
DEV void lru_phase(const Params& p, int bid, int nb) {
    unsigned long long lt0_ = 0, lacc_ = 0;
    int tid = threadIdx.x; asm volatile("" : "+v"(tid));
    const int wid = tid >> 6, lane = tid & 63, fr = lane & 15, fq = lane >> 4;
    const int w = bid * 8 + wid, h = (w & 31) >> 2, q = w & 3;
    const bf16_t* ULRU = (const bf16_t*)(p.ws + WS_ULRU);
    const bf16_t* BTLRU = (const bf16_t*)(p.ws + WS_BTLRU);
    const float* conv_w = p.in[19]; const float* conv_b = p.in[20];
    const int c4 = h * 64 + q * 16 + 4 * fq;
    const int nch = APPLY ? 64 : 68, npairs = NBATCH * nch;
#pragma unroll 1
    for (int j = w >> 5; j < npairs; j += 64) {
        const int b = j / nch, ch = j % nch;
        int zo = 0; asm volatile("" : "+v"(zo));
        const bool lat = ch < 64;
        const unsigned base0 = (lat ? (unsigned)(b * 4096 + ch * 64) * 2048u : (unsigned)(T + b * 256 + (ch - 64) * 64) * 2048u) + (unsigned)h * 128u;
        const unsigned pstride = 2048u;
        const int plo = lat ? 0 : -(ch - 64) * 64, phi = lat ? 64 : 256 - (ch - 64) * 64;
        const char* UB = (const char*)ULRU;
        f32x4 acc[4][4];
#pragma unroll
        for (int mt = 0; mt < 4; ++mt)
#pragma unroll
            for (int nt = 0; nt < 4; ++nt) acc[mt][nt] = (f32x4){0.f, 0.f, 0.f, 0.f};
        LSEC_B(1);
#pragma unroll
        for (int ks = 0; ks < 2; ++ks) {
            const int ci = h * 64 + ks * 32 + fq * 8 + zo;
            bf16x8 bfr[4];
#pragma unroll
            for (int nt = 0; nt < 4; ++nt) bfr[nt] = *(const bf16x8*)(BTLRU + ((size_t)(h * 256 + (nt >> 1) * 128 + (nt & 1) * 64 + q * 16 + fr)) * 64 + ks * 32 + fq * 8 + zo);
            f32x4 cw[4][2]; f32x4 cb[2];
#pragma unroll
            for (int k = 0; k < 4; ++k) { cw[k][0] = *(const f32x4*)(conv_w + k * 512 + ci); cw[k][1] = *(const f32x4*)(conv_w + k * 512 + ci + 4); }
            cb[0] = *(const f32x4*)(conv_b + ci); cb[1] = *(const f32x4*)(conv_b + ci + 4);
            u32x4 xv[4][4];
#pragma unroll
            for (int mt = 0; mt < 4; ++mt)
#pragma unroll
                for (int k = 0; k < 4; ++k) {
                    const int pos = mt * 16 + fr + k - 2;
                    const int pc_ = pos < plo ? plo : (pos >= phi ? phi - 1 : pos);
                    xv[mt][k] = *(const u32x4*)(UB + (base0 + (unsigned)pc_ * pstride + (unsigned)(ks * 64 + fq * 16)));
                }
#pragma unroll
            for (int mt = 0; mt < 4; ++mt) {
                f32x4 s0 = cb[0], s1 = cb[1];
#pragma unroll
                for (int k = 0; k < 4; ++k) {
                    const int pos = mt * 16 + fr + k - 2;
                    const unsigned mk_ = (pos >= plo && pos < phi) ? 0xffffffffu : 0u;
                    const u32x4 xm = (u32x4){xv[mt][k].x & mk_, xv[mt][k].y & mk_, xv[mt][k].z & mk_, xv[mt][k].w & mk_};
                    float y[8]; bf8_unpack(xm, y);
                    s0 += cw[k][0] * (f32x4){y[0], y[1], y[2], y[3]}; s1 += cw[k][1] * (f32x4){y[4], y[5], y[6], y[7]};
                }
                u32x4 aw; aw.x = pack2(s0[0], s0[1]); aw.y = pack2(s0[2], s0[3]); aw.z = pack2(s1[0], s1[1]); aw.w = pack2(s1[2], s1[3]);
                const bf16x8 af = __builtin_bit_cast(bf16x8, aw);
#pragma unroll
                for (int nt = 0; nt < 4; ++nt) acc[mt][nt] = __builtin_amdgcn_mfma_f32_16x16x32_bf16(bfr[nt], af, acc[mt][nt], 0, 0, 0);
            }
            asm volatile("" ::: "memory");
        }
        LSEC_E(1); LSEC_B(2);
        f32x4 cA[2], ba[2], bx[2];
#pragma unroll
        for (int dir = 0; dir < 2; ++dir) {
            cA[dir] = *(const f32x4*)((const float*)(p.ws + WS_LCA) + dir * 512 + c4 + zo);
            ba[dir] = *(const f32x4*)(p.in[22] + dir * 512 + c4 + zo); bx[dir] = *(const f32x4*)(p.in[24] + dir * 512 + c4 + zo);
        }
        f32x4 cwo[4];
#pragma unroll
        for (int k = 0; k < 4; ++k) cwo[k] = *(const f32x4*)(conv_w + k * 512 + c4 + zo);
        const f32x4 cbo = *(const f32x4*)(conv_b + c4 + zo);
        u32x2 xw4[4][4];
#pragma unroll
        for (int mt = 0; mt < 4; ++mt)
#pragma unroll
            for (int k = 0; k < 4; ++k) {
                const int pos = mt * 16 + fr + k - 2;
                const int pc_ = pos < plo ? plo : (pos >= phi ? phi - 1 : pos);
                xw4[mt][k] = *(const u32x2*)(UB + (base0 + (unsigned)pc_ * pstride + (unsigned)(q * 32 + fq * 8)));
            }
#pragma unroll
        for (int mt = 0; mt < 4; ++mt) {
            f32x4 xo = cbo;
#pragma unroll
            for (int k = 0; k < 4; ++k) {
                const int pos = mt * 16 + fr + k - 2;
                const unsigned mk_ = (pos >= plo && pos < phi) ? 0xffffffffu : 0u;
                const unsigned x0 = xw4[mt][k].x & mk_, x1 = xw4[mt][k].y & mk_;
                xo += cwo[k] * (f32x4){__uint_as_float(x0 << 16), __uint_as_float(x0 & 0xffff0000u), __uint_as_float(x1 << 16), __uint_as_float(x1 & 0xffff0000u)};
            }
#pragma unroll
            for (int dir = 0; dir < 2; ++dir)
#pragma unroll
                for (int r = 0; r < 4; ++r) {
                    const float za = acc[mt][2 * dir][r] + ba[dir][r], zx = acc[mt][2 * dir + 1][r] + bx[dir][r];
                    const float a = __builtin_amdgcn_exp2f(cA[dir][r] * sigmoid_f(za));
                    acc[mt][2 * dir][r] = a;
                    acc[mt][2 * dir + 1][r] = __builtin_amdgcn_sqrtf(fmaf(-a, a, 1.f)) * sigmoid_f(zx) * xo[r];
                }
        }
        LSEC_E(2); LSEC_B(3);
        const int bsel15 = ((lane & 48) | 15) << 2, bsel0 = (lane & 48) << 2;
        if (!APPLY) {
            f32x4 PA[2], PH[2];
#pragma unroll
            for (int r = 0; r < 4; ++r) {
                float cAf = 1.f, cHf = 0.f, cAr = 1.f, cHr = 0.f;
#pragma unroll
                for (int mt = 0; mt < 4; ++mt) {
                    float a = acc[mt][0][r], bq = acc[mt][1][r]; row_scan<false>(a, bq);
                    const float At = __builtin_bit_cast(float, __builtin_amdgcn_ds_bpermute(bsel15, __builtin_bit_cast(int, a)));
                    const float Ht = __builtin_bit_cast(float, __builtin_amdgcn_ds_bpermute(bsel15, __builtin_bit_cast(int, bq)));
                    cHf = At * cHf + Ht; cAf *= At;
                }
#pragma unroll
                for (int mt = 3; mt >= 0; --mt) {
                    float a = acc[mt][2][r], bq = acc[mt][3][r]; row_scan<true>(a, bq);
                    const float At = __builtin_bit_cast(float, __builtin_amdgcn_ds_bpermute(bsel0, __builtin_bit_cast(int, a)));
                    const float Ht = __builtin_bit_cast(float, __builtin_amdgcn_ds_bpermute(bsel0, __builtin_bit_cast(int, bq)));
                    cHr = At * cHr + Ht; cAr *= At;
                }
                PA[0][r] = cAf; PH[0][r] = cHf; PA[1][r] = cAr; PH[1][r] = cHr;
            }
            if (fr == 0) {
                float* SA = (float*)(p.ws + WS_SA); float* SB = (float*)(p.ws + WS_SB);
#pragma unroll
                for (int dir = 0; dir < 2; ++dir) { const size_t o = ((size_t)(b * 68 + ch) * 2 + dir) * 512 + c4; *(f32x4*)(SA + o) = PA[dir]; *(f32x4*)(SB + o) = PH[dir]; }
            }
        } else {
            const float* HIN = (const float*)(p.ws + WS_HIN);
            const f32x4 hf = *(const f32x4*)(HIN + ((size_t)(b * 64 + ch) * 2 + 0) * 512 + c4), hr = *(const f32x4*)(HIN + ((size_t)(b * 64 + ch) * 2 + 1) * 512 + c4);
            f32x4 Ho[4];
#pragma unroll
            for (int r = 0; r < 4; ++r) {
                float carry = hf[r];
#pragma unroll
                for (int mt = 0; mt < 4; ++mt) {
                    float a = acc[mt][0][r], bq = acc[mt][1][r]; row_scan<false>(a, bq);
                    const float hv = bq + a * carry; Ho[mt][r] = hv;
                    carry = __builtin_bit_cast(float, __builtin_amdgcn_ds_bpermute(bsel15, __builtin_bit_cast(int, hv)));
                }
                carry = hr[r];
#pragma unroll
                for (int mt = 3; mt >= 0; --mt) {
                    float a = acc[mt][2][r], bq = acc[mt][3][r]; row_scan<true>(a, bq);
                    const float hv = bq + a * carry; Ho[mt][r] += hv;
                    carry = __builtin_bit_cast(float, __builtin_amdgcn_ds_bpermute(bsel0, __builtin_bit_cast(int, hv)));
                }
            }
            bf16_t* YCAT = (bf16_t*)(p.ws + WS_YCAT);
#pragma unroll
            for (int mt = 0; mt < 4; ++mt) {
                const size_t row = (size_t)b * 4096 + (size_t)ch * 64 + (mt * 16 + fr);
                const u32x2 gw = *(const u32x2*)(ULRU + row * 1024 + 512 + c4);
                const float g0 = __uint_as_float(gw.x << 16), g1 = __uint_as_float(gw.x & 0xffff0000u), g2 = __uint_as_float(gw.y << 16), g3 = __uint_as_float(gw.y & 0xffff0000u);
                u32x2 ow; ow.x = pack2(Ho[mt][0] * gelu_tanh(g0), Ho[mt][1] * gelu_tanh(g1)); ow.y = pack2(Ho[mt][2] * gelu_tanh(g2), Ho[mt][3] * gelu_tanh(g3));
                *(u32x2*)(YCAT + row * 1024 + 512 + c4) = ow;
            }
        }
        LSEC_E(3);
    }
    if (PROBE_LRU >= 0 && !APPLY && bid == 0) { const unsigned long long d_ = lacc_ * 8ull, t0_ = __builtin_amdgcn_s_memrealtime(); while (__builtin_amdgcn_s_memrealtime() - t0_ < d_) __builtin_amdgcn_s_sleep(8); }
}

#if PROBE_SUB == 6 || PROBE_SUB == 7
DEV void lru_load_probe(const Params& p, int bid, int nb) {
    int tid = threadIdx.x; asm volatile("" : "+v"(tid));
    const int wid = tid >> 6, lane = tid & 63, fr = lane & 15, fq = lane >> 4;
    const int w = bid * 8 + wid, h = (w & 31) >> 2, q = w & 3;
    const bf16_t* ULRU = (const bf16_t*)(p.ws + WS_ULRU);
    unsigned sink = 0;
    for (int j = w >> 5; j < NBATCH * 68; j += 64) {
        const int b = j / 68, ch = j % 68;
        const bool lat = ch < 64;
        const size_t base0 = lat ? ((size_t)b * 4096 + ch) * 1024 : ((size_t)T + b * 256 + (ch - 64) * 64) * 1024;
        const size_t pstride = lat ? (size_t)64 * 1024 : (size_t)1024;
#if PROBE_SUB == 6
        if (q == 0)
#endif
#pragma unroll
        for (int mt = 0; mt < 4; ++mt) { const int pos = mt * 16 + fr; const u32x4 v = *(const u32x4*)(ULRU + base0 + (size_t)pos * pstride + fq * 8 + h * 64); sink += v.x ^ v.y ^ v.z ^ v.w; }
    }
    asm volatile("" :: "v"(sink));
}
#endif
constexpr int MOE_TAB_OFF = 132096;
DEV void moe_tables(const Params& p, LAS unsigned char* lds, int h) {
    LAS int* tp = (LAS int*)(lds + MOE_TAB_OFF); LAS int* pc = tp + 72; LAS int* cn = pc + 72;
    if (threadIdx.x == 0) {
        const int* cnt = (const int*)(p.ws + WS_CNT) + h * 64;
        int t = 0, q = 0;
        for (int e = 0; e < 65; ++e) { const int c = e < 64 ? cnt[e] : HALF_T; cn[e] = c; tp[e] = t; pc[e] = q; t += (c + 255) >> 8; q += c; }
        tp[65] = t; pc[65] = q;
    }
    __syncthreads();
}
template <bool GU>
struct MoeSched {
    struct Unit { int e, r0t, pn; };
    static constexpr bool GATHER = GU;
    LAS const int* tp; LAS const int* pc; LAS const int* cn;
    const char* Abase; const char* Bt; const int* ltok; int h, nN, nunits, G, c;
    DEV int lda() const { return 256; }
    DEV bool next(int i, Unit& u) const {
        const long L = (long)i * G + c; if (L >= nunits) return false;
        int w = (int)L; { const int q = nunits / 8, r = nunits % 8, xcd = w % 8, off = w / 8; w = (xcd < r ? xcd * (q + 1) : r * (q + 1) + (xcd - r) * q) + off; }
        const int rt = w / nN; u.pn = w % nN;
        int e = 0; while (tp[e + 1] <= rt) ++e;
        u.e = e; u.r0t = (rt - tp[e]) * 256; return true;
    }
    DEV unsigned tokoff(int e, int ce, int idx, int C) const {
        idx = idx < ce ? idx : ce - 1;
        const int tok = e < 64 ? ltok[(size_t)(h * 64 + e) * HALF_T + idx] : h * HALF_T + idx;
        return (unsigned)tok * 4096u + 2048u + (unsigned)C * 2u;
    }
    DEV void addr(const Unit& u, int R0, int C0, int R1, int C1, gp::UAddr& o) const {
        if constexpr (GU) {
            const int ce = cn[u.e];
            o.a = Abase; o.b = Bt + ((size_t)u.e * 512 + u.pn * 256) * 2048;
            o.ao00 = tokoff(u.e, ce, u.r0t + R0, C0); o.ao01 = tokoff(u.e, ce, u.r0t + R1, C1);
            o.ao10 = tokoff(u.e, ce, u.r0t + 128 + R0, C0); o.ao11 = tokoff(u.e, ce, u.r0t + 128 + R1, C1);
        } else {
            o.a = Abase + ((size_t)pc[u.e] + u.r0t) * 512; o.b = Bt + ((size_t)u.e * 1024 + u.pn * 256) * 512;
        }
    }
};
struct EpiMoeGU {
    static constexpr bool PERM = false;
    LAS const int* pc; LAS const int* cn; const float* lwt; bf16_t* HMID; int h;
    template <class U> DEV void operator()(const f32x4 (&acc)[2][2][4][2], const U& u, int wr, int wc, int fr, int fq) const {
        const int ce = cn[u.e]; const size_t prow = (size_t)pc[u.e];
        float wt[2][4];
#pragma unroll
        for (int ai = 0; ai < 2; ++ai)
#pragma unroll
            for (int m = 0; m < 4; ++m) {
                int idx = u.r0t + ai * 128 + wr * 64 + m * 16 + fr; idx = idx < ce ? idx : ce - 1;
                wt[ai][m] = u.e < 64 ? lwt[(size_t)(h * 64 + u.e) * HALF_T + idx] : 1.f;
            }
#pragma unroll
        for (int ai = 0; ai < 2; ++ai)
#pragma unroll
            for (int m = 0; m < 4; ++m) {
                const int idx = u.r0t + ai * 128 + wr * 64 + m * 16 + fr;
                if (idx < ce) {
                    const float w_ = wt[ai][m];
                    bf16_t* rowp = HMID + (prow + idx) * 256 + u.pn * 128 + wc * 16 + 4 * fq;
#pragma unroll
                    for (int bj = 0; bj < 2; ++bj) {
                        const f32x4 gt = acc[ai][bj][m][0], up = acc[ai][bj][m][1];
                        u32x2 w; w.x = pack2(w_ * gt[0] * sigmoid_f(gt[0]) * up[0], w_ * gt[1] * sigmoid_f(gt[1]) * up[1]);
                        w.y = pack2(w_ * gt[2] * sigmoid_f(gt[2]) * up[2], w_ * gt[3] * sigmoid_f(gt[3]) * up[3]);
                        *(u32x2*)(rowp + bj * 64) = w;
                    }
                }
            }
    }
};
struct EpiMoeDN {
    static constexpr bool PERM = true;
    LAS const int* pc; LAS const int* cn; unsigned char* SLAB;
    template <class U> DEV void operator()(const f32x4 (&acc)[2][2][4][2], const U& u, int wr, int wc, int fr, int fq) const {
        const int ce = cn[u.e]; const size_t prow = (size_t)pc[u.e];
#pragma unroll
        for (int ai = 0; ai < 2; ++ai)
#pragma unroll
            for (int m = 0; m < 4; ++m) {
                const int idx = u.r0t + ai * 128 + wr * 64 + m * 16 + fr;
                if (idx < ce) {
                    unsigned char* rowp = SLAB + (prow + idx) * 1024 + u.pn * 256 + wc * 32 + 8 * fq;
#pragma unroll
                    for (int bj = 0; bj < 2; ++bj) {
                        const f32x4 v0 = acc[ai][bj][m][0] * SLAB_SCALE, v1 = acc[ai][bj][m][1] * SLAB_SCALE;
                        int w0 = 0, w1 = 0;
                        w0 = __builtin_amdgcn_cvt_pk_fp8_f32(v0[0], v0[1], w0, false); w0 = __builtin_amdgcn_cvt_pk_fp8_f32(v0[2], v0[3], w0, true);
                        w1 = __builtin_amdgcn_cvt_pk_fp8_f32(v1[0], v1[1], w1, false); w1 = __builtin_amdgcn_cvt_pk_fp8_f32(v1[2], v1[3], w1, true);
                        *(u32x2*)(rowp + bj * 128) = (u32x2){(unsigned)w0, (unsigned)w1};
                    }
                }
            }
    }
};
DEV void fp8x16_add(const u32x4 w, float (&f)[16]) {
    typedef float f2 __attribute__((ext_vector_type(2)));
    const unsigned ww[4] = {w.x, w.y, w.z, w.w};
#pragma unroll
    for (int j = 0; j < 4; ++j) {
        const f2 a = __builtin_amdgcn_cvt_pk_f32_fp8((int)ww[j], false), b = __builtin_amdgcn_cvt_pk_f32_fp8((int)ww[j], true);
        f[4 * j] += a.x; f[4 * j + 1] += a.y; f[4 * j + 2] += b.x; f[4 * j + 3] += b.y;
    }
}
DEV void moe_reduce(const Params& p, LAS unsigned char* lds, int h, int bid, int nb) {
    int tid = threadIdx.x; asm volatile("" : "+v"(tid));
    const int wid = tid >> 6, lane = tid & 63;
    LAS const int* pc = (LAS const int*)(lds + MOE_TAB_OFF) + 72;
    const unsigned char* SLAB = (const unsigned char*)(p.ws + WS_SLAB); const int* PAIR = (const int*)(p.ws + WS_PAIR); const float* ADA = (const float*)(p.ws + WS_ADA);
    for (int it = bid; it < HALF_T / 8; it += nb) {
        const int tokl = it * 8 + wid; const size_t tok = (size_t)h * HALF_T + tokl; const int b = (int)(tok >> 12), col = lane * 16;
        int pr[8];
#pragma unroll
        for (int k = 0; k < 8; ++k) pr[k] = PAIR[tok * 8 + k];
        u32x4 rows[9];
        rows[8] = *(const u32x4*)(SLAB + ((size_t)pc[64] + tokl) * 1024 + col);
#pragma unroll
        for (int k = 0; k < 8; ++k) rows[k] = *(const u32x4*)(SLAB + ((size_t)pc[pr[k] >> 16] + (pr[k] & 0xffff)) * 1024 + col);
        const u32x4 hr0 = *(const u32x4*)((const bf16_t*)p.out + tok * 2048 + col), hr1 = *(const u32x4*)((const bf16_t*)p.out + tok * 2048 + col + 8);
        f32x4 g2v[4], ggv[4], bbv[4];
#pragma unroll
        for (int q = 0; q < 4; ++q) { g2v[q] = *(const f32x4*)(ADA + b * 6144 + 5120 + col + q * 4); ggv[q] = *(const f32x4*)(p.in[37] + col + q * 4); bbv[q] = *(const f32x4*)(p.in[38] + col + q * 4); }
        float f[16];
#pragma unroll
        for (int j = 0; j < 16; ++j) f[j] = 0.f;
#pragma unroll
        for (int k = 0; k < 9; ++k) fp8x16_add(rows[k], f);
        float z[16]; float s = 0.f;
        { float y0[8], y1[8]; bf8_unpack(hr0, y0); bf8_unpack(hr1, y1);
#pragma unroll
          for (int j = 0; j < 8; ++j) { z[j] = y0[j] * ALPHA_F + g2v[j >> 2][j & 3] * (f[j] * (1.f / SLAB_SCALE)); z[8 + j] = y1[j] * ALPHA_F + g2v[2 + (j >> 2)][j & 3] * (f[8 + j] * (1.f / SLAB_SCALE)); }
#pragma unroll
          for (int j = 0; j < 16; ++j) s += z[j]; }
        const float mean = wave_sum(s) * (1.f / 1024.f); float qq = 0.f;
#pragma unroll
        for (int j = 0; j < 16; ++j) { const float d = z[j] - mean; qq += d * d; }
        const float rstd = rsqrtf(wave_sum(qq) * (1.f / 1024.f) + LN_EPS_F);
#pragma unroll
        for (int q = 0; q < 4; ++q) {
            f32x4 o;
#pragma unroll
            for (int j = 0; j < 4; ++j) o[j] = (z[q * 4 + j] - mean) * rstd * ggv[q][j] + bbv[q][j];
            *(f32x4*)(p.out + tok * 1024 + col + q * 4) = o;
        }
    }
}

#define ADA ((float*)(p.ws + WS_ADA))
#define HB ((bf16_t*)(p.ws + WS_HB))
#define BTIN ((bf16_t*)(p.ws + WS_BTIN))
#define HM ((bf16_t*)(p.ws + WS_HM))
#define US5 ((bf16_t*)(p.ws + WS_US5))
#define ULRU ((bf16_t*)(p.ws + WS_ULRU))
#define SLOC ((float*)(p.ws + WS_SLOC))
#define YS5 ((bf16_t*)(p.ws + WS_YS5))
#define YCAT ((bf16_t*)(p.ws + WS_YCAT))
#define Y ((float*)(p.ws + WS_Y))
#define LTOK ((int*)(p.ws + WS_LTOK))
#define LWT ((float*)(p.ws + WS_LWT))
#define HMID ((bf16_t*)(p.ws + WS_HMID))
#define SLAB ((unsigned char*)(p.ws + WS_SLAB))
#define PAIR ((int*)(p.ws + WS_PAIR))
#define CNT ((int*)(p.ws + WS_CNT))
__global__ void __launch_bounds__(512) mk_fwd(Params p) {
    extern __shared__ __attribute__((aligned(16))) unsigned char lds_raw[];
    LAS unsigned char* lds = (LAS unsigned char*)lds_raw;
    const int bid = blockIdx.x, nb = gridDim.x;
    volatile LAS unsigned* MISC = (volatile LAS unsigned*)(lds + MISC_OFF);
    if (threadIdx.x < 64) MISC[threadIdx.x] = 0u;
    __syncthreads();
    unsigned char* const ws = p.ws;
    XcdBarrier bar; bar.bar = (unsigned*)(ws + WS_CTL); bar.x = 0; bar.st = nullptr;
    const bool fused = (p.ph_hi - p.ph_lo) > 1;
    if (fused) bar = xcd_barrier_post((unsigned*)(ws + WS_CTL), MISC + 8);

    const int lo = p.ph_lo, hi = p.ph_hi;
#ifndef PROBE_REP_PH
#define PROBE_REP_PH -1
#endif
#define IN(k) (lo <= (k) && (k) < hi)
#ifndef PROBE_TIME
#define PROBE_TIME -1
#endif
    unsigned long long tprobe0_ = 0, tprobe1_ = 0;
#ifndef PROBE_SEC
#define PROBE_SEC -1
#endif
    unsigned long long tsec_acc_ = 0, tsec_t0_ = 0;
#define SEC_BEGIN(id) do { if (PROBE_SEC == (id)) { __builtin_amdgcn_s_waitcnt(0); tsec_t0_ = __builtin_amdgcn_s_memrealtime(); } } while (0)
#define SEC_END(id) do { if (PROBE_SEC == (id)) { __builtin_amdgcn_s_waitcnt(0); tsec_acc_ += __builtin_amdgcn_s_memrealtime() - tsec_t0_; } } while (0)
#define TSTAMP(k) do { if (PROBE_TIME >= 0) { if ((k) == PROBE_TIME) tprobe0_ = __builtin_amdgcn_s_memrealtime(); if ((k) == PROBE_TIME + 1) tprobe1_ = __builtin_amdgcn_s_memrealtime(); } } while (0)
#define TIDS int tid = threadIdx.x; asm volatile("" : "+v"(tid)); const int wid = tid >> 6, lane = tid & 63; (void)wid; (void)lane
#define REPS(k) (((k) == PROBE_REP_PH) ? 2 : 1)
#ifndef PROBE_SUB
#define PROBE_SUB -1
#endif
#define SUBREPS(k) (((k) == PROBE_SUB) ? 2 : 1)
#define SEAM(k) do { if (IN(k) && IN((k) + 1)) xcd_barrier(bar); else __syncthreads(); TSTAMP((k) + 1); } while (0)
    {
        TSTAMP(0);
        for (int rep_ = 0; rep_ < REPS(0); ++rep_) if (IN(0)) { if (rep_) xcd_barrier(bar); TIDS;
            for (int sr_ = 0; sr_ < SUBREPS(1); ++sr_)
            for (int it = bid; it < 256; it += nb) s5_tables(p, lds, it >> 3, it & 7);
            {
                LAS float* S = (LAS float*)lds; LAS float* red = S + 9216;
                __syncthreads();
                for (int i = tid; i < 9216; i += 512) { const float c = i < 8192 ? p.in[1][i] : p.in[3][i - 8192]; S[i] = c * sigmoid_f(c); }
                if (bid == nb - 1) for (int i = tid; i < 1024; i += 512) ((float*)(ws + WS_LCA))[i] = -8.f * 1.4426950408889634f * log1pf(__expf(-p.in[25][i]));
                if (bid >= nb - 9 && bid < nb - 1) for (int i = (bid - (nb - 9)) * 8192 + tid; i < (bid - (nb - 9) + 1) * 8192; i += 512) {
                    const int e = i & 63, k = i >> 6; const float wv = p.in[29][i]; const unsigned hi = f2bf(wv); const float rem = wv - __uint_as_float(hi << 16);
                    ((bf16_t*)(ws + WS_RWH))[e * 1024 + k] = (bf16_t)hi; ((bf16_t*)(ws + WS_RWL))[e * 1024 + k] = (bf16_t)f2bf(rem);
                }
                __syncthreads();
                for (int sr_ = 0; sr_ < SUBREPS(2); ++sr_)
                for (int it = bid; it < 192; it += nb) gemv9_item(S, p.in[6], 6144, it * 32, p.in[7], ADA, 6144, red);
                __syncthreads();
            }
            {
                LAS float* tile = (LAS float*)lds + wid * (64 * 65);
                for (int sr_ = 0; sr_ < SUBREPS(3); ++sr_)
                for (int it = bid * 8 + wid; it < 736; it += nb * 8) {
                    if (it < 64) { tr_tile_wave(p.in[17], 512, (it >> 3) * 64, (it & 7) * 64, (bf16_t*)(ws + WS_BTGLU), 512, 0, tile, lane); }
                    else if (it < 320) { const int i2 = it - 64; tr_tile_wave(p.in[26], 1024, (i2 >> 4) * 64, (i2 & 15) * 64, (bf16_t*)(ws + WS_BTOUT), 1024, 0, tile, lane); }
                    else if (it < 352) {
                        const int i2 = it - 320, dir = i2 >> 4, ax = (i2 >> 3) & 1, h = i2 & 7;
                        const float* W = (ax ? p.in[23] : p.in[21]) + (size_t)(dir * 8 + h) * 4096;
                        tr_tile_wave(W, 64, 0, 0, (bf16_t*)(ws + WS_BTLRU) + (size_t)(h * 256 + dir * 128 + ax * 64) * 64, 64, 0, tile, lane);
                    } else {
                        const int i2 = it - 352;
                        tr_tile_wave(p.in[8], NWIN, (i2 / 24) * 64, (i2 % 24) * 64, BTIN, 1024, 0, tile, lane);
                    }
                }
            }
        }
        SEAM(0);
        for (int rep_ = 0; rep_ < REPS(1); ++rep_) if (IN(1)) { if (rep_) xcd_barrier(bar); TIDS;
            for (int it = bid; it < 256; it += nb) s5_fill(p, lds, it >> 3, it & 7);
            for (int it = bid; it < TT / 32; it += nb) {
                const int row0 = it * 32 + wid * 4;
                f32x4 v[4][4]; float s[4];
#pragma unroll
                for (int rr = 0; rr < 4; ++rr) {
                    const int row = row0 + rr;
                    const float* src = row < T ? p.in[0] + (size_t)row * 1024 : p.in[2] + (size_t)(row - T) * 1024;
#pragma unroll
                    for (int q = 0; q < 4; ++q) v[rr][q] = *(const f32x4*)(src + q * 256 + lane * 4);
                }
                f32x4 gg[4], bbv[4], sh1[4], sc1[4];
                { const float* ada = ADA + (row0 < T ? (row0 >> 12) : 8) * 6144;
#pragma unroll
                  for (int q = 0; q < 4; ++q) { const int col = q * 256 + lane * 4; gg[q] = *(const f32x4*)(p.in[4] + col); bbv[q] = *(const f32x4*)(p.in[5] + col); sh1[q] = *(const f32x4*)(ada + col); sc1[q] = *(const f32x4*)(ada + 1024 + col); } }
#pragma unroll
                for (int rr = 0; rr < 4; ++rr) { float a = 0.f;
#pragma unroll
                    for (int q = 0; q < 4; ++q) a += (v[rr][q][0] + v[rr][q][1]) + (v[rr][q][2] + v[rr][q][3]);
                    s[rr] = a; }
#pragma unroll
                for (int o = 1; o < 64; o <<= 1) {
#pragma unroll
                    for (int rr = 0; rr < 4; ++rr) s[rr] += __shfl_xor(s[rr], o); }
                float mean[4], qq[4];
#pragma unroll
                for (int rr = 0; rr < 4; ++rr) { mean[rr] = s[rr] * (1.f / 1024.f); float a = 0.f;
#pragma unroll
                    for (int q = 0; q < 4; ++q) { const f32x4 d = v[rr][q] - mean[rr]; a += (d[0] * d[0] + d[1] * d[1]) + (d[2] * d[2] + d[3] * d[3]); }
                    qq[rr] = a; }
#pragma unroll
                for (int o = 1; o < 64; o <<= 1) {
#pragma unroll
                    for (int rr = 0; rr < 4; ++rr) qq[rr] += __shfl_xor(qq[rr], o); }
                float rstd[4];
#pragma unroll
                for (int rr = 0; rr < 4; ++rr) rstd[rr] = rsqrtf(qq[rr] * (1.f / 1024.f) + LN_EPS_F);
#pragma unroll
                for (int q = 0; q < 4; ++q) {
                    const int col = q * 256 + lane * 4;
#pragma unroll
                    for (int rr = 0; rr < 4; ++rr) {
                        const int row = row0 + rr;
                        const f32x4 o = (v[rr][q] - mean[rr]) * rstd[rr] * gg[q] + bbv[q];
                        u32x2 w; w.x = pack2(o[0], o[1]); w.y = pack2(o[2], o[3]);
                        *(u32x2*)(HB + (size_t)row * 1024 + col) = w;
                        const f32x4 om = o * (sc1[q] + 1.f) + sh1[q];
                        u32x2 wm; wm.x = pack2(om[0], om[1]); wm.y = pack2(om[2], om[3]);
                        *(u32x2*)(HM + (size_t)row * 1024 + col) = wm;
                    }
                }
            }
        }
        SEAM(1);
        for (int rep_ = 0; rep_ < REPS(2); ++rep_) if (IN(2)) { if (rep_) xcd_barrier(bar); TIDS;
            { WinSched S{(const char*)HM, (const char*)BTIN, nb, bid};
              EpiWin E{US5, ULRU};
              gp::gemm_phase(lds, 1024, S, E); }
            {
                int bid_ = bid; asm volatile("" : "+s"(bid_));
                int tid2 = threadIdx.x; asm volatile("" : "+v"(tid2));
                const int wid2 = tid2 >> 6, lane2 = tid2 & 63;
                const int nfull = (136 * 6) % nb;
                const int nlow = nfull ? nb - nfull : nb, myi = nfull ? bid_ - nfull : bid_;
                if (myi >= 0) {
                    LAS float* tile = (LAS float*)lds + wid2 * (64 * 65);
                    const int step = nlow * 8; int it = myi * 8 + wid2;
                    f32x4 va[16], vb[16];
                    TrTile ta, tb;
                    if (it < 12480) { ta = expert_tile(p, it); tr_load(ta, lane2, va); }
#pragma unroll 1
                    while (it < 12480) {
                        const int i1 = it + step, i2 = it + 2 * step;
                        if (i1 < 12480) { tb = expert_tile(p, i1); tr_load(tb, lane2, vb); }
                        tr_store(ta, lane2, va, tile);
                        if (i1 >= 12480) break;
                        if (i2 < 12480) { ta = expert_tile(p, i2); tr_load(ta, lane2, va); }
                        tr_store(tb, lane2, vb, tile);
                        it = i2;
                    }
                }
            }
        }
        SEAM(2);
        for (int rep_ = 0; rep_ < REPS(3); ++rep_) if (IN(3)) { if (rep_) xcd_barrier(bar); TIDS;
            const bf16_t* ES5 = (const bf16_t*)(ws + WS_ES5);
            { S5Sched S{(const char*)US5, (const char*)ES5, 512, 5, 1, 256, nb, bid}; EpiS5Loc E{SLOC}; gp::gemm_phase(lds, 512, S, E); }
            __syncthreads();
            int bid_ = bid; asm volatile("" : "+s"(bid_));
#if PROBE_SUB == 6 || PROBE_SUB == 7
            lru_load_probe(p, bid_, nb);
#endif
            for (int sr_ = 0; sr_ < SUBREPS(4); ++sr_) lru_phase<false>(p, bid_, nb);
        }
        SEAM(3);
#if PROBE_SUB == 8
        for (int xb_ = 0; xb_ < 10; ++xb_) xcd_barrier(bar);
#endif
        for (int rep_ = 0; rep_ < REPS(4); ++rep_) if (IN(4)) { if (rep_) xcd_barrier(bar); TIDS;
            const float* ALC = (const float*)(ws + WS_ALC);
            if (tid < 128) for (int i = bid * 128 + tid; i < 32768; i += nb * 128) {
                const int pp = i & 63, dir = (i >> 6) & 1, g = (i >> 7) & 31, b = i >> 12;
                const float ar = ALC[((dir * 32 + g) * 64 + pp) * 2], ai = ALC[((dir * 32 + g) * 64 + pp) * 2 + 1];
                float xr = 0.f, xi = 0.f;
                const float* Sg = SLOC + (size_t)g * M5 * 256 + dir * 128 + pp;
                {
                    float sr[NCC], si[NCC];
#pragma unroll
                    for (int s = 0; s < NCC; ++s) { const int j = dir ? NCC - 1 - s : s, m = M5LAT + b * NCC + j; sr[s] = Sg[(size_t)m * 256]; si[s] = Sg[(size_t)m * 256 + 64]; }
#pragma unroll
                    for (int s = 0; s < NCC; ++s) { const float nr = ar * xr - ai * xi + sr[s], ni = ar * xi + ai * xr + si[s]; xr = nr; xi = ni; }
                }
#pragma unroll 1
                for (int s0 = 0; s0 < NCH; s0 += 32) {
                    float sr[32], si[32];
#pragma unroll
                    for (int q = 0; q < 32; ++q) { const int k = dir ? NCH - 1 - (s0 + q) : s0 + q, m = b * NCH + k; sr[q] = Sg[(size_t)m * 256]; si[q] = Sg[(size_t)m * 256 + 64]; }
#pragma unroll
                    for (int q = 0; q < 32; ++q) {
                        const int k = dir ? NCH - 1 - (s0 + q) : s0 + q, m = b * NCH + k;
                        bf16_t* dst = US5 + ((size_t)(g * M5PAD + m)) * KT5 + 512 + dir * 128 + pp;
                        dst[0] = (bf16_t)f2bf(xr); dst[64] = (bf16_t)f2bf(xi);
                        const float nr = ar * xr - ai * xi + sr[q], ni = ar * xi + ai * xr + si[q]; xr = nr; xi = ni;
                    }
                }
            }
            const float* SA = (const float*)(ws + WS_SA); const float* SB = (const float*)(ws + WS_SB); float* HIN = (float*)(ws + WS_HIN);
            if (tid >= 128 && tid < 160) for (int i = bid * 32 + (tid - 128); i < 8192; i += nb * 32) {
                const int chn = i & 511, dir = (i >> 9) & 1, b = i >> 10;
                float H = 0.f;
                {
                    float av[4], bv[4];
#pragma unroll
                    for (int s = 0; s < 4; ++s) { const int c = 64 + (dir ? 3 - s : s); const size_t o = ((size_t)(b * 68 + c) * 2 + dir) * 512 + chn; av[s] = SA[o]; bv[s] = SB[o]; }
#pragma unroll
                    for (int s = 0; s < 4; ++s) H = av[s] * H + bv[s];
                }
#pragma unroll 1
                for (int s0 = 0; s0 < 64; s0 += 32) {
                    float av[32], bv[32];
#pragma unroll
                    for (int q = 0; q < 32; ++q) { const int c = dir ? 63 - (s0 + q) : s0 + q; const size_t o = ((size_t)(b * 68 + c) * 2 + dir) * 512 + chn; av[q] = SA[o]; bv[q] = SB[o]; }
#pragma unroll
                    for (int q = 0; q < 32; ++q) {
                        const int c = dir ? 63 - (s0 + q) : s0 + q;
                        HIN[((size_t)(b * 64 + c) * 2 + dir) * 512 + chn] = H;
                        H = av[q] * H + bv[q];
                    }
                }
            }
        }
        SEAM(4);
        for (int rep_ = 0; rep_ < REPS(5); ++rep_) if (IN(5)) { if (rep_) xcd_barrier(bar); TIDS;
            const bf16_t* BS5 = (const bf16_t*)(ws + WS_BS5);
            { S5Sched S{(const char*)US5, (const char*)BS5, KT5, 4, 2, 512, nb, bid}; EpiS5Out E{YS5}; gp::gemm_phase(lds, KT5, S, E); }
            __syncthreads();
            int bid_ = bid; asm volatile("" : "+s"(bid_));
            for (int sr_ = 0; sr_ < SUBREPS(5); ++sr_) lru_phase<true>(p, bid_, nb);
        }
        SEAM(5);
        for (int rep_ = 0; rep_ < REPS(6); ++rep_) if (IN(6)) { if (rep_) xcd_barrier(bar); TIDS;
            const bf16_t* BTGLU = (const bf16_t*)(ws + WS_BTGLU); const float* b_glu = p.in[18];
            PlainSched S{(const char*)YS5, (const char*)BTGLU, 512, 512, 128, 2, nb, bid};
            EpiGlu E{YS5, b_glu, YCAT};
            gp::gemm_phase(lds, 512, S, E);
        }
        SEAM(6);
        for (int rep_ = 0; rep_ < REPS(7); ++rep_) if (IN(7)) { if (rep_) xcd_barrier(bar); TIDS;
            const bf16_t* BTOUT = (const bf16_t*)(ws + WS_BTOUT);
            PlainSched S{(const char*)YCAT, (const char*)BTOUT, 1024, 1024, 128, 4, nb, bid};
            EpiF32 E{Y, 1024};
            gp::gemm_phase(lds, 1024, S, E);
        }
        SEAM(7);
        if (IN(8)) { TIDS;
            LAS unsigned char* VH = lds;
            LAS float* PART = (LAS float*)lds;
            LAS int* DEC = (LAS int*)(lds + 132096);
            LAS float* DECW = (LAS float*)(lds + 132096 + 4096);
            LAS int* lcnt = (LAS int*)(lds + 148480); LAS int* gbase = lcnt + 128;
            const int fr = lane & 15, fq = lane >> 4;
            const float rbias = p.in[30][lane];
            if (tid < 128) lcnt[tid] = 0;
            bf16x8 bw[4][4];
#pragma unroll
            for (int kk = 0; kk < 4; ++kk)
#pragma unroll
                for (int nt = 0; nt < 4; ++nt) bw[kk][nt] = *(const bf16x8*)((const bf16_t*)(ws + WS_RWH) + (size_t)(nt * 16 + fr) * 1024 + (wid * 4 + kk) * 32 + fq * 8);
            int nit = 0, it_first = bid;
            for (int it = bid; it < T / 64; it += nb) {
                const int t0 = it * 64;
                SEC_BEGIN(1);
#pragma unroll 1
                for (int rnd = 0; rnd < 4; ++rnd) {
                    const size_t tok0 = (size_t)t0 + wid * 8 + rnd * 2; const int b = (int)(tok0 >> 12);
                    const float* ada = ADA + b * 6144;
                    f32x4 z[2][4]; float s4[2];
                    {
                        u32x2 hh[2][4]; f32x4 yv[2][4], g1[4];
#pragma unroll
                        for (int q = 0; q < 4; ++q) g1[q] = *(const f32x4*)(ada + 2048 + q * 256 + lane * 4);
#pragma unroll
                        for (int rr = 0; rr < 2; ++rr)
#pragma unroll
                            for (int q = 0; q < 4; ++q) { const int col = q * 256 + lane * 4; hh[rr][q] = *(const u32x2*)(HB + (tok0 + rr) * 1024 + col); yv[rr][q] = *(const f32x4*)(Y + (size_t)cmaj((int)(tok0 + rr)) * 1024 + col); }
#pragma unroll
                        for (int rr = 0; rr < 2; ++rr) { float a = 0.f;
#pragma unroll
                            for (int q = 0; q < 4; ++q) {
                                f32x4 hv; hv[0] = __uint_as_float(hh[rr][q].x << 16); hv[1] = __uint_as_float(hh[rr][q].x & 0xffff0000u); hv[2] = __uint_as_float(hh[rr][q].y << 16); hv[3] = __uint_as_float(hh[rr][q].y & 0xffff0000u);
                                z[rr][q] = hv * ALPHA_F + g1[q] * yv[rr][q];
                                a += (z[rr][q][0] + z[rr][q][1]) + (z[rr][q][2] + z[rr][q][3]);
                            }
                            s4[rr] = a; }
                    }
                    f32x4 gg[4], bbv[4], sc2[4], sh2[4];
#pragma unroll
                    for (int q = 0; q < 4; ++q) { const int col = q * 256 + lane * 4; gg[q] = *(const f32x4*)(p.in[27] + col); bbv[q] = *(const f32x4*)(p.in[28] + col); sc2[q] = *(const f32x4*)(ada + 4096 + col); sh2[q] = *(const f32x4*)(ada + 3072 + col); }
#pragma unroll
                    for (int o = 1; o < 64; o <<= 1) {
#pragma unroll
                        for (int rr = 0; rr < 2; ++rr) s4[rr] += __shfl_xor(s4[rr], o); }
                    float mean[2], q4[2];
#pragma unroll
                    for (int rr = 0; rr < 2; ++rr) { mean[rr] = s4[rr] * (1.f / 1024.f); float a = 0.f;
#pragma unroll
                        for (int q = 0; q < 4; ++q) { const f32x4 d = z[rr][q] - mean[rr]; a += (d[0] * d[0] + d[1] * d[1]) + (d[2] * d[2] + d[3] * d[3]); }
                        q4[rr] = a; }
#pragma unroll
                    for (int o = 1; o < 64; o <<= 1) {
#pragma unroll
                        for (int rr = 0; rr < 2; ++rr) q4[rr] += __shfl_xor(q4[rr], o); }
#pragma unroll
                    for (int rr = 0; rr < 2; ++rr) {
                        const float rstd = rsqrtf(q4[rr] * (1.f / 1024.f) + LN_EPS_F);
                        const size_t tok = tok0 + rr; const int tl = wid * 8 + rnd * 2 + rr;
#pragma unroll
                        for (int q = 0; q < 4; ++q) {
                            const int col = q * 256 + lane * 4;
                            const f32x4 h1 = (z[rr][q] - mean[rr]) * rstd * gg[q] + bbv[q];
                            { u32x2 wh; wh.x = pack2(h1[0], h1[1]); wh.y = pack2(h1[2], h1[3]); *(u32x2*)((bf16_t*)p.out + tok * 2048 + col) = wh; }
                            const f32x4 v = h1 * (sc2[q] + 1.f) + sh2[q];
                            u32x2 w; w.x = pack2(v[0], v[1]); w.y = pack2(v[2], v[3]);
                            *(u32x2*)((bf16_t*)p.out + tok * 2048 + 1024 + col) = w;
                            *(LAS u32x2*)(VH + tl * 2064 + col * 2) = w;
                        }
                    }
                }
                __syncthreads();
                SEC_END(1); SEC_BEGIN(2);
                {
                    f32x4 acc[4][4];
#pragma unroll
                    for (int mt = 0; mt < 4; ++mt)
#pragma unroll
                        for (int nt = 0; nt < 4; ++nt) acc[mt][nt] = (f32x4){0.f, 0.f, 0.f, 0.f};
#pragma unroll
                    for (int kk = 0; kk < 4; ++kk) {
                        const int k0 = (wid * 4 + kk) * 32 + fq * 8;
#pragma unroll
                        for (int mt = 0; mt < 4; ++mt) {
                            const bf16x8 av = *(LAS const bf16x8*)(VH + (mt * 16 + fr) * 2064 + k0 * 2);
#pragma unroll
                            for (int nt = 0; nt < 4; ++nt) acc[mt][nt] = __builtin_amdgcn_mfma_f32_16x16x32_bf16(bw[kk][nt], av, acc[mt][nt], 0, 0, 0);
                        }
                    }
                    __syncthreads();
#pragma unroll
                    for (int mt = 0; mt < 4; ++mt)
#pragma unroll
                        for (int nt = 0; nt < 4; ++nt) *(LAS f32x4*)(PART + (wid * 64 + mt * 16 + fr) * 64 + nt * 16 + 4 * fq) = acc[mt][nt];
                }
                __syncthreads();
                SEC_END(2); SEC_BEGIN(3);
                {
                    const int hh = t0 >> 14;
#pragma unroll 2
                    for (int r = 0; r < 8; ++r) {
                        const int tl = wid * 8 + r;
                        float lg = 0.f;
#pragma unroll
                        for (int w8 = 0; w8 < 8; ++w8) lg += PART[(w8 * 64 + tl) * 64 + lane];
                        const float sc = sigmoid_f(lg), sel = sc + rbias;
                        float m1 = sel; m1 = fmaxf(m1, __shfl_xor(m1, 1)); m1 = fmaxf(m1, __shfl_xor(m1, 2)); m1 = fmaxf(m1, __shfl_xor(m1, 4));
                        const unsigned long long bal = __ballot(sel == m1);
                        const unsigned gb = (unsigned)(bal >> (lane & 56)) & 0xffu;
                        const int first = __builtin_ctz(gb | 0x100u);
                        float m2 = ((lane & 7) == first) ? -INFINITY : sel; m2 = fmaxf(m2, __shfl_xor(m2, 1)); m2 = fmaxf(m2, __shfl_xor(m2, 2)); m2 = fmaxf(m2, __shfl_xor(m2, 4));
                        const float gs = m1 + m2;
                        int grank = 0; const int mygrp = lane >> 3;
#pragma unroll
                        for (int j = 0; j < 8; ++j) { const float gj = __builtin_bit_cast(float, __builtin_amdgcn_readlane(__builtin_bit_cast(int, gs), 8 * j)); grank += (gj > gs || (gj == gs && j < mygrp)) ? 1 : 0; }
                        const bool selected = grank < 4;
                        const unsigned long long gmask = __ballot(selected);
                        const float mv = selected ? sel : -INFINITY;
                        int rank = 0;
#pragma unroll
                        for (int j = 0; j < 64; ++j) {
                            if ((gmask >> j) & 1ull) { const float vj = __builtin_bit_cast(float, __builtin_amdgcn_readlane(__builtin_bit_cast(int, mv), j)); rank += (vj > mv || (vj == mv && j < lane)) ? 1 : 0; }
                        }
                        const bool chosen = selected && rank < 8;
                        const float wsum = wave_sum(chosen ? sc : 0.f);
                        if (chosen) {
                            const int lr = __hip_atomic_fetch_add(lcnt + hh * 64 + lane, 1, __ATOMIC_RELAXED, __HIP_MEMORY_SCOPE_WORKGROUP);
                            DEC[((nit & 1) * 64 + tl) * 8 + rank] = (lane << 16) | lr; DECW[((nit & 1) * 64 + tl) * 8 + rank] = sc / wsum * 2.5f;
                        }
                    }
                }
                __syncthreads();
                SEC_END(3); SEC_BEGIN(4);
                ++nit;
                const bool last = (it + nb >= T / 64);
                if ((nit & 1) == 0 || last) {
                    const int nflush = (nit & 1) == 0 ? 2 : 1;
                    if (tid < 128) { const int c = lcnt[tid]; gbase[tid] = c ? atomicAdd(CNT + tid, c) : 0; lcnt[tid] = 0; }
                    __syncthreads();
                    for (int n = tid; n < nflush * 512; n += 512) {
                        const int g2 = n >> 9, tl = (n >> 3) & 63, tok = (it_first + g2 * nb) * 64 + tl, hq = tok >> 14;
                        const int d = DEC[n], e = d >> 16, rk = gbase[hq * 64 + e] + (d & 0xffff);
                        const size_t pos = (size_t)(hq * 64 + e) * HALF_T + rk;
                        LTOK[pos] = tok; LWT[pos] = DECW[n]; PAIR[(size_t)tok * 8 + (n & 7)] = (e << 16) | rk;
                    }
                    __syncthreads();
                    it_first = it + nb;
                }
                SEC_END(4);
            }
        }
        SEAM(8);
        for (int rep_ = 0; rep_ < REPS(9); ++rep_) if (IN(9)) { if (rep_) xcd_barrier(bar); TIDS;
            moe_tables(p, lds, 0);
            LAS const int* tp = (LAS const int*)(lds + MOE_TAB_OFF); LAS const int* pc = tp + 72; LAS const int* cn = pc + 72;
            MoeSched<true> S{tp, pc, cn, (const char*)p.out, (const char*)(ws + WS_BTGU), LTOK, 0, 2, tp[65] * 2, nb, bid};
            EpiMoeGU E{pc, cn, LWT, HMID, 0};
            gp::gemm_phase(lds, 1024, S, E);
        }
        SEAM(9);
        for (int rep_ = 0; rep_ < REPS(10); ++rep_) if (IN(10)) { if (rep_) xcd_barrier(bar); TIDS;
            moe_tables(p, lds, 0);
            LAS const int* tp = (LAS const int*)(lds + MOE_TAB_OFF); LAS const int* pc = tp + 72; LAS const int* cn = pc + 72;
            MoeSched<false> S{tp, pc, cn, (const char*)HMID, (const char*)(ws + WS_BTDN), LTOK, 0, 4, tp[65] * 4, nb, bid};
            EpiMoeDN E{pc, cn, SLAB};
            gp::gemm_phase(lds, 256, S, E);
        }
        SEAM(10);
        if (IN(11)) { TIDS;
            {
                moe_tables(p, lds, 1);
                LAS const int* tp = (LAS const int*)(lds + MOE_TAB_OFF); LAS const int* pc = tp + 72; LAS const int* cn = pc + 72;
                MoeSched<true> S{tp, pc, cn, (const char*)p.out, (const char*)(ws + WS_BTGU), LTOK, 1, 2, tp[65] * 2, nb, bid};
                EpiMoeGU E{pc, cn, LWT, HMID, 1};
                gp::gemm_phase(lds, 1024, S, E);
            }
            __syncthreads();
            int bid_ = bid; asm volatile("" : "+s"(bid_));
            moe_tables(p, lds, 0);
            moe_reduce(p, lds, 0, bid_, nb);
        }
        SEAM(11);
        for (int rep_ = 0; rep_ < REPS(12); ++rep_) if (IN(12)) { if (rep_) xcd_barrier(bar); TIDS;
            moe_tables(p, lds, 1);
            LAS const int* tp = (LAS const int*)(lds + MOE_TAB_OFF); LAS const int* pc = tp + 72; LAS const int* cn = pc + 72;
            MoeSched<false> S{tp, pc, cn, (const char*)HMID, (const char*)(ws + WS_BTDN), LTOK, 1, 4, tp[65] * 4, nb, bid};
            EpiMoeDN E{pc, cn, SLAB};
            gp::gemm_phase(lds, 256, S, E);
        }
        SEAM(12);
        if (IN(13)) { TIDS;
            moe_tables(p, lds, 1);
            moe_reduce(p, lds, 1, bid, nb);
        }
        if (PROBE_SEC >= 0 && bid == 0) { const unsigned long long d_ = tsec_acc_ * 8ull, t0_ = __builtin_amdgcn_s_memrealtime(); while (__builtin_amdgcn_s_memrealtime() - t0_ < d_) __builtin_amdgcn_s_sleep(8); }
        if (PROBE_TIME >= 0) {
            if (PROBE_TIME == 13) { xcd_barrier(bar); tprobe1_ = __builtin_amdgcn_s_memrealtime(); }
            if (bid == 0) { const unsigned long long d_ = (tprobe1_ - tprobe0_) * 8ull, t0_ = __builtin_amdgcn_s_memrealtime(); while (__builtin_amdgcn_s_memrealtime() - t0_ < d_) __builtin_amdgcn_s_sleep(8); }
        }
    }
}

extern "C" void kernel_launch(void* const* d_in, const int* in_sizes, int n_in, void* d_out, int out_size, void* d_ws, size_t ws_size, hipStream_t stream) {
    static int grid = 0;
    if (grid == 0) {
        if (n_in != 39 || out_size != T * D || ws_size < WS_END) { fprintf(stderr, "kernel_launch: unexpected problem (n_in %d, out %d, ws %zu); nothing launched\n", n_in, out_size, ws_size); grid = -1; return; }
        int dev = 0, cus = 0;
        if (hipGetDevice(&dev) != hipSuccess || hipDeviceGetAttribute(&cus, hipDeviceAttributeMultiprocessorCount, dev) != hipSuccess) { grid = -1; return; }
        if (hipFuncSetAttribute((const void*)mk_fwd, hipFuncAttributeMaxDynamicSharedMemorySize, LDS_BYTES) != hipSuccess) { fprintf(stderr, "kernel_launch: hipFuncSetAttribute failed\n"); grid = -1; return; }
        grid = cus > 0 ? cus : 256;
    }
    if (grid < 0) return;
    (void)in_sizes;
    if (hipMemsetAsync((char*)d_ws + WS_CTL, 0, CTL_ZERO_BYTES, stream) != hipSuccess) return;
    Params p{};
    for (int i = 0; i < 39; ++i) p.in[i] = (const float*)d_in[i];
    p.out = (float*)d_out; p.ws = (unsigned char*)d_ws;
#if MK_N_LAUNCHES == 1
    p.ph_lo = 0; p.ph_hi = NPHASE;
    hipLaunchKernelGGL(mk_fwd, dim3(grid), dim3(512), LDS_BYTES, stream, p);
#else
    for (int ph = 0; ph < NPHASE; ++ph) {
        p.ph_lo = ph; p.ph_hi = ph + 1;
        hipLaunchKernelGGL(mk_fwd, dim3(grid), dim3(512), LDS_BYTES, stream, p);
    }
#endif
}
```

```cpp
#include <hip/hip_runtime.h>
#include <cstdio>
#include <cstdint>

#ifndef MK_N_LAUNCHES
#define MK_N_LAUNCHES 1
#endif

#define DEV __device__ __forceinline__
#define LAS __attribute__((address_space(3)))
typedef unsigned short bf16_t;
typedef short bf16x8 __attribute__((ext_vector_type(8)));
typedef float f32x4 __attribute__((ext_vector_type(4)));
typedef unsigned u32x2 __attribute__((ext_vector_type(2)));
typedef unsigned u32x4 __attribute__((ext_vector_type(4)));

constexpr int D = 1024, NBATCH = 8, SEQ = 4096, T = NBATCH * SEQ, CTXL = 256, TC = NBATCH * CTXL, TT = T + TC;
constexpr int NWIN = 1536;
constexpr int LC = 32, KT5 = 768, NCH = SEQ / LC  , NCC = CTXL / LC  ;
constexpr int M5LAT = NBATCH * NCH  , M5 = M5LAT + NBATCH * NCC  , M5PAD = 1280;
constexpr int NE = 64;
constexpr int NPHASE = 14;
constexpr int HALF_T = T / 2;
constexpr float ALPHA_F = 1.189207115002721f, LN_EPS_F = 1e-5f;

constexpr size_t MiB = 1u << 20;
constexpr size_t WS_CTL = 0, CTL_ZERO_BYTES = 65536;
constexpr size_t WS_CNT = 32768;
constexpr size_t WS_ADA = 65536;
constexpr size_t WS_RWH = 384 * 1024;
constexpr size_t WS_RWL = 512 * 1024;
constexpr size_t WS_ALC = 640 * 1024;
constexpr size_t WS_LCA = 768 * 1024;
constexpr size_t WS_SA = 1 * MiB, WS_SB = 4 * MiB, WS_HIN = 7 * MiB;
constexpr size_t WS_BTGLU = 10 * MiB;
constexpr size_t WS_BTOUT = 10 * MiB + 512 * 1024;
constexpr size_t WS_BTLRU = 12 * MiB + 512 * 1024;
constexpr size_t WS_BS5 = 13 * MiB;
constexpr size_t WS_ES5 = 37 * MiB;
constexpr size_t WS_BTGU = 45 * MiB;
constexpr size_t WS_BTDN = 110 * MiB;
constexpr size_t WS_HB = 143 * MiB;
constexpr size_t WS_BTIN = 211 * MiB;
constexpr size_t WS_KTAB = 214 * MiB;
constexpr size_t WS_APR = 216 * MiB, WS_API = 217 * MiB;
constexpr size_t WS_BBR = 218 * MiB, WS_BBI = 218 * MiB + 256 * 1024;
constexpr size_t WS_HM = 366 * MiB;
constexpr size_t WS_US5 = 238 * MiB;
constexpr size_t WS_ULRU = 298 * MiB;
constexpr size_t WS_SLOC = 366 * MiB;
constexpr size_t WS_YS5 = 400 * MiB;
constexpr size_t WS_YCAT = 448 * MiB;
constexpr size_t WS_Y = 295 * MiB;
constexpr size_t WS_LTOK = 10 * MiB;
constexpr size_t WS_LWT = 18 * MiB;
constexpr size_t WS_PAIR = 26 * MiB;
constexpr size_t WS_HMID = 143 * MiB;
constexpr size_t WS_SLAB = 216 * MiB;
constexpr float SLAB_SCALE = 32.f;
constexpr size_t WS_END = 512 * MiB;

constexpr int LDS_BYTES = 155648;
constexpr int MISC_OFF = LDS_BYTES - 256;

DEV float bf2f(bf16_t h) { return __uint_as_float(((unsigned)h) << 16); }
DEV unsigned f2bf(float f) { unsigned u = __float_as_uint(f); return (u + 0x7fffu + ((u >> 16) & 1u)) >> 16; }
typedef float f32x2_t __attribute__((ext_vector_type(2)));
typedef __bf16 bf16x2_t __attribute__((ext_vector_type(2)));
DEV unsigned pack2(float a, float b) { const f32x2_t v = {a, b}; return __builtin_bit_cast(unsigned, __builtin_convertvector(v, bf16x2_t)); }
DEV float sigmoid_f(float x) { return __builtin_amdgcn_rcpf(1.f + __builtin_amdgcn_exp2f(-1.4426950408889634f * x)); }
DEV float gelu_tanh(float x) {
    const float z2 = 1.5957691216057308f * (x + 0.044715f * x * x * x);
    return x * __builtin_amdgcn_rcpf(1.f + __builtin_amdgcn_exp2f(-1.4426950408889634f * z2));
}
DEV int cmaj(int tok) { const int t = tok & 4095; return (tok & ~4095) | ((t & 63) << 6) | (t >> 6); }
DEV float wave_sum(float v) {
#pragma unroll
    for (int o = 1; o < 64; o <<= 1) v += __shfl_xor(v, o);
    return v;
}

struct Params { const float* in[39]; float* out; unsigned char* ws; int ph_lo, ph_hi; };

#define XB_TMO      128
#define XB_XCNT(j)  (256  + 64 * (j))
#define XB_XSUB(j)  (1280 + 64 * (j))
#define XB_XGEN(j)  (2304 + 64 * (j))
#define XB_TOP      3328
#define XB_TOPGEN   3392
#define XCD_BAR_WORDS 3456
#define XB_SPIN_CAP (1u << 20)
DEV unsigned xb_ld(unsigned* p)              { return __hip_atomic_load(p, __ATOMIC_RELAXED, __HIP_MEMORY_SCOPE_AGENT); }
DEV unsigned xb_add(unsigned* p, unsigned v) { return __hip_atomic_fetch_add(p, v, __ATOMIC_RELAXED, __HIP_MEMORY_SCOPE_AGENT); }
DEV unsigned xb_xcc_id() { return (unsigned)__builtin_amdgcn_s_getreg((3 << 11) | 20) & 0xFu; }
#define XB_SPIN(cond, bar) do { unsigned _sp = 0; while (cond) { __builtin_amdgcn_s_sleep(1); \
    if ((++_sp & 255u) == 0u) { if (xb_ld(&(bar)[XB_TMO])) break; if (_sp > XB_SPIN_CAP) { atomicAdd(&(bar)[XB_TMO], 1u); break; } } } } while (0)
struct XcdBarrier { unsigned* bar; unsigned x; volatile LAS unsigned* st; };
DEV XcdBarrier xcd_barrier_post(unsigned* bar, volatile LAS unsigned* st) {
    XcdBarrier b; b.bar = bar; b.x = xb_xcc_id(); b.st = st;
    if (threadIdx.x == 0) (void)xb_add(&bar[XB_XCNT(b.x)], 1u);
    return b;
}
DEV void xcd_barrier_complete(unsigned* bar, unsigned x, unsigned& nloc, unsigned& nx) {
    const unsigned G = gridDim.x * gridDim.y * gridDim.z;
    unsigned sum, cnt, mine, sp = 0u;
    for (;;) {
        sum = 0u; cnt = 0u; mine = 0u;
#pragma unroll
        for (unsigned j = 0; j < 16; ++j) { const unsigned c = xb_ld(&bar[XB_XCNT(j)]); sum += c; cnt += (c > 0u) ? 1u : 0u; mine = (j == x) ? c : mine; }
        if (sum == G) break;
        __builtin_amdgcn_s_sleep(1);
        if ((++sp & 255u) == 0u) { if (xb_ld(&bar[XB_TMO])) break; if (sp > XB_SPIN_CAP) { atomicAdd(&bar[XB_TMO], 1u); break; } }
    }
    nloc = mine > 0u ? mine : 1u; nx = cnt > 0u ? cnt : 1u;
}
DEV void xcd_barrier(const XcdBarrier& b) {
    asm volatile("s_waitcnt vmcnt(0)" ::: "memory");
    __syncthreads();
    if (threadIdx.x == 0) {
        unsigned* bar = b.bar;
        __builtin_amdgcn_s_waitcnt(0);
        unsigned nloc = b.st[0], nx = b.st[1];
        if (nloc == 0u) { xcd_barrier_complete(bar, b.x, nloc, nx); b.st[0] = nloc; b.st[1] = nx; }
        const unsigned old = xb_add(&bar[XB_XSUB(b.x)], 1u);
        const unsigned gen = old / nloc;
        if (old + 1u == (gen + 1u) * nloc) {
            __builtin_amdgcn_fence(__ATOMIC_RELEASE, "agent");
            asm volatile("s_waitcnt vmcnt(0)" ::: "memory");
            const unsigned og = xb_add(&bar[XB_TOP], 1u);
            const unsigned tg = og / nx;
            if (og + 1u == (tg + 1u) * nx) xb_add(&bar[XB_TOPGEN], 1u);
            else XB_SPIN(xb_ld(&bar[XB_TOPGEN]) == tg, bar);
            __builtin_amdgcn_fence(__ATOMIC_ACQUIRE, "agent");
            xb_add(&bar[XB_XGEN(b.x)], 1u);
            asm volatile("s_waitcnt vmcnt(0)" ::: "memory");
        } else {
            XB_SPIN(xb_ld(&bar[XB_XGEN(b.x)]) == gen, bar);
            __builtin_amdgcn_fence(__ATOMIC_ACQUIRE, "agent");
            asm volatile("s_waitcnt vmcnt(0)" ::: "memory");
        }
    }
    __syncthreads();
}

constexpr int GEMM_LDS = 61440;
template <class ARow, class Epi>
DEV void gemm_unit(LAS unsigned char* lds, const ARow& arow, const bf16_t* __restrict__ Bt, int K, const Epi& epi) {
    const int tid = threadIdx.x, wid = tid >> 6, lane = tid & 63, wr = wid >> 1, wc = wid & 1, fr = lane & 15, fq = lane >> 4;
    LAS unsigned char* As = lds;
    LAS unsigned char* Bs = lds + 40960;
    const u32x4* pa0 = (const u32x4*)arow(tid >> 2) + (tid & 3);
    const u32x4* pa1 = (const u32x4*)arow(128 + (tid >> 2)) + (tid & 3);
    const u32x4* pb = (const u32x4*)(Bt + (size_t)(tid >> 2) * K) + (tid & 3);
    const int sa0 = (tid >> 2) * 80 + (tid & 3) * 16, sa1 = sa0 + 128 * 80;
    f32x4 acc[4][4];
#pragma unroll
    for (int i = 0; i < 4; ++i)
#pragma unroll
        for (int j = 0; j < 4; ++j) acc[i][j] = (f32x4){0.f, 0.f, 0.f, 0.f};
    const int nk = K >> 5;
    u32x4 ra0 = pa0[0], ra1 = pa1[0], rb = pb[0];
    *(LAS u32x4*)(As + sa0) = ra0; *(LAS u32x4*)(As + sa1) = ra1; *(LAS u32x4*)(Bs + sa0) = rb;
    __syncthreads();
    for (int kt = 0; kt < nk; ++kt) {
        const int cur = kt & 1;
        if (kt + 1 < nk) { ra0 = pa0[(kt + 1) * 4]; ra1 = pa1[(kt + 1) * 4]; rb = pb[(kt + 1) * 4]; }
        LAS const unsigned char* Ac = As + cur * 20480 + (wr * 64 + fr) * 80 + fq * 16;
        LAS const unsigned char* Bc = Bs + cur * 10240 + (wc * 64 + fr) * 80 + fq * 16;
        bf16x8 af[4], bfv[4];
#pragma unroll
        for (int i = 0; i < 4; ++i) af[i] = *(LAS const bf16x8*)(Ac + i * 1280);
#pragma unroll
        for (int j = 0; j < 4; ++j) bfv[j] = *(LAS const bf16x8*)(Bc + j * 1280);
#pragma unroll
        for (int i = 0; i < 4; ++i)
#pragma unroll
            for (int j = 0; j < 4; ++j) acc[i][j] = __builtin_amdgcn_mfma_f32_16x16x32_bf16(bfv[j], af[i], acc[i][j], 0, 0, 0);
        if (kt + 1 < nk) {
            const int nx = cur ^ 1;
            *(LAS u32x4*)(As + nx * 20480 + sa0) = ra0; *(LAS u32x4*)(As + nx * 20480 + sa1) = ra1; *(LAS u32x4*)(Bs + nx * 10240 + sa0) = rb;
        }
        __syncthreads();
    }
    epi(acc, wr * 64 + fr, wc * 64 + 4 * fq);
}

namespace gp {
constexpr int BK = 64, HALF = 128, HTB = HALF * BK * 2, STAGE_BYTES = 8 * HTB;
DEV int lds_byte(int r, int c) { const int st = (r >> 4) * 2 + (c >> 5), rr = r & 15, cc = c & 31, ob = rr * 64 + cc * 2; return st * 1024 + (ob ^ (((ob >> 9) & 1) << 5)); }
DEV void stage_rc(int b, int& R, int& C) { const int st = b / 1024, sb = b % 1024, swz = sb ^ (((sb >> 9) & 1) << 5); R = (st >> 1) * 16 + swz / 64; C = (st & 1) * 32 + (swz % 64) / 2; }
DEV int perm32(int rho) { const int n = rho >> 4, i = rho & 15; return 8 * (i >> 2) + 4 * n + (i & 3); }
struct UAddr { const char* a; const char* b; unsigned ao00, ao01, ao10, ao11; };
template <class Epi, class Sched>
DEV void gemm_phase(LAS unsigned char* lds, const int K, const Sched& S, const Epi& E) {
    typedef typename Sched::Unit Unit;
    int tid_ = threadIdx.x; asm volatile("" : "+v"(tid_));
    const int tid = tid_, wid = __builtin_amdgcn_readfirstlane(tid >> 6), lane = tid & 63, wr = wid >> 2, wc = wid & 3, fr = lane & 15, fq = lane >> 4;
    const int nt = K / BK;
    int R0, C0, R1, C1; stage_rc(tid * 16, R0, C0); stage_rc(tid * 16 + 8192, R1, C1);
    const int Rb0 = Epi::PERM ? ((R0 & ~31) + perm32(R0 & 31)) : R0, Rb1 = Epi::PERM ? ((R1 & ~31) + perm32(R1 & 31)) : R1;
    const unsigned vb0 = (unsigned)(Rb0 * K + C0) * 2u, vb1 = (unsigned)(Rb1 * K + C1) * 2u;
    const size_t kstep = (size_t)(BK * 2);
    const size_t hstepB = (size_t)HALF * K * 2;
    const int lda_ = S.lda();
    const unsigned va0 = (unsigned)(R0 * lda_ + C0) * 2u, va1 = (unsigned)(R1 * lda_ + C1) * 2u;
    const size_t hstepA = (size_t)HALF * lda_ * 2;
    const unsigned ldsw = (unsigned)wid * 1024u;
    const int aoff = lds_byte(wr * 64 + fr, fq * 8), boff = lds_byte(wc * 32 + fr, fq * 8);
#define GP_SA(b, h) (((b) * 2 + (h)) * HTB)
#define GP_SB(b, h) ((4 + (b) * 2 + (h)) * HTB)
#define GP_GLDS(gp_, bufoff, i_) __builtin_amdgcn_global_load_lds((const unsigned*)(gp_), (LAS unsigned*)(lds + (bufoff) + ldsw + (i_) * 8192), 16, 0, 0)
#define GP_STAGE_A(bufoff, ab, o0, o1, h, kb) do { if constexpr (Sched::GATHER) { const char* up_ = (ab) + (kb); GP_GLDS(up_ + (o0), bufoff, 0); GP_GLDS(up_ + (o1), bufoff, 1); } \
        else { const char* up_ = (ab) + (((h) ? hstepA : (size_t)0) + (kb)); GP_GLDS(up_ + va0, bufoff, 0); GP_GLDS(up_ + va1, bufoff, 1); } } while (0)
#define GP_STAGE_B(bufoff, bb, h, kb) do { const char* up_ = (bb) + (((h) ? hstepB : (size_t)0) + (kb)); GP_GLDS(up_ + vb0, bufoff, 0); GP_GLDS(up_ + vb1, bufoff, 1); } while (0)
#define GP_LDA(dst, b, h) do { _Pragma("unroll") for (int m = 0; m < 4; ++m) _Pragma("unroll") for (int k = 0; k < 2; ++k) dst[m][k] = *(const LAS bf16x8*)(lds + GP_SA(b, h) + aoff + m * 2048 + k * 1024); } while (0)
#define GP_LDB(dst, b, h) do { _Pragma("unroll") for (int n = 0; n < 2; ++n) _Pragma("unroll") for (int k = 0; k < 2; ++k) dst[n][k] = *(const LAS bf16x8*)(lds + GP_SB(b, h) + boff + n * 2048 + k * 1024); } while (0)
#define GP_MMA(ai, bj, At, Bt) do { __builtin_amdgcn_s_setprio(1); _Pragma("unroll") for (int m = 0; m < 4; ++m) _Pragma("unroll") for (int n = 0; n < 2; ++n) _Pragma("unroll") for (int k = 0; k < 2; ++k) \
        acc[ai][bj][m][n] = __builtin_amdgcn_mfma_f32_16x16x32_bf16(Bt[n][k], At[m][k], acc[ai][bj][m][n], 0, 0, 0); __builtin_amdgcn_s_setprio(0); } while (0)
#define GP_WAIT_V(n) asm volatile("s_waitcnt vmcnt(" #n ")" ::: "memory")
#define GP_WAIT_L(n) asm volatile("s_waitcnt lgkmcnt(" #n ")" ::: "memory")
#define GP_BAR __builtin_amdgcn_s_barrier()
#define GP_SCHED __builtin_amdgcn_sched_barrier(0)
    Unit cur, nxt; int ui = 0;
    if (!S.next(0, cur)) return;
    const char* cA; const char* cB; unsigned c00 = 0, c01 = 0, c10 = 0, c11 = 0;
    const char* nA; const char* nB; unsigned n00 = 0, n01 = 0, n10 = 0, n11 = 0;
    { UAddr t_; S.addr(cur, R0, C0, R1, C1, t_); cA = t_.a; cB = t_.b; if constexpr (Sched::GATHER) { c00 = t_.ao00; c01 = t_.ao01; c10 = t_.ao10; c11 = t_.ao11; } }
    f32x4 acc[2][2][4][2];
#pragma unroll
    for (int a = 0; a < 2; ++a)
#pragma unroll
        for (int b = 0; b < 2; ++b)
#pragma unroll
            for (int m = 0; m < 4; ++m)
#pragma unroll
                for (int n = 0; n < 2; ++n) acc[a][b][m][n] = (f32x4){0.f, 0.f, 0.f, 0.f};
    bf16x8 At[4][2], B0[2][2], B1[2][2];
    GP_STAGE_B(GP_SB(0, 0), cB, 0, 0); GP_STAGE_B(GP_SB(0, 1), cB, 1, 0); GP_STAGE_A(GP_SA(0, 0), cA, c00, c01, 0, 0); GP_STAGE_A(GP_SA(0, 1), cA, c10, c11, 1, 0);
    if (wr == 1) GP_BAR;
    GP_WAIT_V(2); GP_BAR;
    GP_STAGE_B(GP_SB(1, 0), cB, 0, kstep); GP_STAGE_A(GP_SA(1, 0), cA, c00, c01, 0, kstep); GP_STAGE_B(GP_SB(1, 1), cB, 1, kstep);
    GP_WAIT_V(6); GP_BAR;
    for (;;) {
        const bool has_next = S.next(ui + 1, nxt);
        if (has_next) { UAddr t_; S.addr(nxt, R0, C0, R1, C1, t_); nA = t_.a; nB = t_.b; if constexpr (Sched::GATHER) { n00 = t_.ao00; n01 = t_.ao01; n10 = t_.ao10; n11 = t_.ao11; } }
        else { nA = cA; nB = cB; n00 = c00; n01 = c01; n10 = c10; n11 = c11; }
#pragma unroll 1
        for (int t = 0; t < nt; t += 2) {
            const bool last = (t == nt - 2);
            const size_t k1 = (size_t)(t + 1) * kstep;
            const char* sA = last ? nA : cA; const char* sB = last ? nB : cB;
            const unsigned s00 = last ? n00 : c00, s01 = last ? n01 : c01, s10 = last ? n10 : c10, s11 = last ? n11 : c11;
            const size_t k2 = last ? (size_t)0 : (size_t)(t + 2) * kstep, k3 = k2 + kstep;
            GP_LDB(B0, 0, 0); GP_LDB(B1, 0, 1); GP_SCHED; GP_LDA(At, 0, 0); GP_STAGE_A(GP_SA(1, 1), cA, c10, c11, 1, k1);
            GP_WAIT_V(8); GP_WAIT_L(0); GP_BAR; GP_MMA(0, 0, At, B0); GP_MMA(0, 1, At, B1); GP_BAR; GP_SCHED;
            GP_LDA(At, 0, 1); GP_STAGE_B(GP_SB(0, 0), sB, 0, k2); GP_STAGE_B(GP_SB(0, 1), sB, 1, k2); GP_STAGE_A(GP_SA(0, 0), sA, s00, s01, 0, k2);
            GP_WAIT_V(8); GP_WAIT_L(0); GP_BAR; GP_MMA(1, 0, At, B0); GP_MMA(1, 1, At, B1); GP_BAR; GP_SCHED;
            GP_LDB(B0, 1, 0); GP_LDB(B1, 1, 1); GP_SCHED; GP_LDA(At, 1, 0); GP_STAGE_A(GP_SA(0, 1), sA, s10, s11, 1, k2);
            GP_WAIT_V(8); GP_WAIT_L(0); GP_BAR; GP_MMA(0, 0, At, B0); GP_MMA(0, 1, At, B1); GP_BAR; GP_SCHED;
            GP_LDA(At, 1, 1); GP_STAGE_B(GP_SB(1, 0), sB, 0, k3); GP_STAGE_B(GP_SB(1, 1), sB, 1, k3); GP_STAGE_A(GP_SA(1, 0), sA, s00, s01, 0, k3);
            GP_WAIT_V(8); GP_WAIT_L(0); GP_BAR; GP_MMA(1, 0, At, B0); GP_MMA(1, 1, At, B1); GP_BAR; GP_SCHED;
        }
        if (wr == 0) GP_BAR;
        E(acc, cur, wr, wc, fr, fq);
        if (!has_next) break;
#pragma unroll
        for (int a = 0; a < 2; ++a)
#pragma unroll
            for (int b = 0; b < 2; ++b)
#pragma unroll
                for (int m = 0; m < 4; ++m)
#pragma unroll
                    for (int n = 0; n < 2; ++n) acc[a][b][m][n] = (f32x4){0.f, 0.f, 0.f, 0.f};
        cur = nxt; cA = nA; cB = nB; c00 = n00; c01 = n01; c10 = n10; c11 = n11; ++ui;
        if (wr == 1) GP_BAR;
    }
    GP_WAIT_V(0);
    GP_BAR;
#undef GP_SA
#undef GP_SB
#undef GP_GLDS
#undef GP_STAGE_A
#undef GP_STAGE_B
#undef GP_LDA
#undef GP_LDB
#undef GP_MMA
#undef GP_WAIT_V
#undef GP_WAIT_L
#undef GP_BAR
#undef GP_SCHED
}
DEV bool static_order(int i, int G, int c, int nM, int nN, int& pm, int& pn) {
    const int nwg = nM * nN; const long L = (long)i * G + c; if (L >= nwg) return false;
    int wgid = (int)L; { const int q = nwg / 8, r = nwg % 8, xcd = wgid % 8, off = wgid / 8; wgid = (xcd < r ? xcd * (q + 1) : r * (q + 1) + (xcd - r) * q) + off; }
    const int nig = 8 * nN, gid = wgid / nig, fm = gid * 8, gsz = (nM - fm) < 8 ? (nM - fm) : 8;
    pm = fm + ((wgid % nig) % gsz); pn = (wgid % nig) / gsz; return true;
}
}

struct PlainSched {
    struct Unit { int pm, pn; };
    static constexpr bool GATHER = false;
    const char* A; const char* Bt; int lda_, K, nM, nN, G, c;
    DEV int lda() const { return lda_; }
    DEV bool next(int i, Unit& u) const { return gp::static_order(i, G, c, nM, nN, u.pm, u.pn); }
    DEV void addr(const Unit& u, int R0, int C0, int R1, int C1, gp::UAddr& o) const {
        o.a = A + (size_t)u.pm * 256 * lda_ * 2; o.b = Bt + (size_t)u.pn * 256 * K * 2;
    }
};
struct EpiBf16 {
    static constexpr bool PERM = true;
    bf16_t* O; int ldc;
    template <class U> DEV void operator()(const f32x4 (&acc)[2][2][4][2], const U& u, int wr, int wc, int fr, int fq) const {
        const int row0 = u.pm * 256 + wr * 64 + fr, col0 = u.pn * 256 + wc * 32 + 8 * fq;
#pragma unroll
        for (int ai = 0; ai < 2; ++ai)
#pragma unroll
            for (int m = 0; m < 4; ++m) {
                bf16_t* rowp = O + (size_t)(row0 + ai * 128 + m * 16) * ldc + col0;
#pragma unroll
                for (int bj = 0; bj < 2; ++bj) {
                    const f32x4 v0 = acc[ai][bj][m][0], v1 = acc[ai][bj][m][1];
                    u32x4 w; w.x = pack2(v0[0], v0[1]); w.y = pack2(v0[2], v0[3]); w.z = pack2(v1[0], v1[1]); w.w = pack2(v1[2], v1[3]);
                    *(u32x4*)(rowp + bj * 128) = w;
                }
            }
    }
};
struct EpiF32 {
    static constexpr bool PERM = false;
    float* O; int ldc;
    template <class U> DEV void operator()(const f32x4 (&acc)[2][2][4][2], const U& u, int wr, int wc, int fr, int fq) const {
        const int row0 = u.pm * 256 + wr * 64 + fr, col0 = u.pn * 256 + wc * 32 + 4 * fq;
#pragma unroll
        for (int ai = 0; ai < 2; ++ai)
#pragma unroll
            for (int m = 0; m < 4; ++m) {
                float* rowp = O + (size_t)(row0 + ai * 128 + m * 16) * ldc + col0;
#pragma unroll
                for (int bj = 0; bj < 2; ++bj)
#pragma unroll
                    for (int n = 0; n < 2; ++n) *(f32x4*)(rowp + bj * 128 + n * 16) = acc[ai][bj][m][n];
            }
    }
};

DEV void bf8_unpack(const u32x4 w, float (&y)[8]) {
    y[0] = __uint_as_float(w.x << 16); y[1] = __uint_as_float(w.x & 0xffff0000u); y[2] = __uint_as_float(w.y << 16); y[3] = __uint_as_float(w.y & 0xffff0000u);
    y[4] = __uint_as_float(w.z << 16); y[5] = __uint_as_float(w.z & 0xffff0000u); y[6] = __uint_as_float(w.w << 16); y[7] = __uint_as_float(w.w & 0xffff0000u);
}
struct WinSched {
    struct Unit { int pm, pn; };
    static constexpr bool GATHER = false;
    const char* A; const char* Bt; int G, c;
    DEV int lda() const { return 1024; }
    DEV bool next(int i, Unit& u) const { return gp::static_order(i, G, c, 136, 6, u.pm, u.pn); }
    DEV void addr(const Unit& u, int R0, int C0, int R1, int C1, gp::UAddr& o) const {
        o.a = A + (size_t)u.pm * 256 * 1024 * 2; o.b = Bt + ((size_t)u.pn * 256) * 1024 * 2;
    }
};
struct EpiWin {
    static constexpr bool PERM = true;
    bf16_t* US5; bf16_t* ULRU;
    template <class U> DEV void operator()(const f32x4 (&acc)[2][2][4][2], const U& u, int wr, int wc, int fr, int fq) const {
#pragma unroll
        for (int bj = 0; bj < 2; ++bj) {
            const int col8 = u.pn * 256 + bj * 128 + wc * 32 + 8 * fq;
#pragma unroll
            for (int ai = 0; ai < 2; ++ai)
#pragma unroll
                for (int m = 0; m < 4; ++m) {
                    const int row = u.pm * 256 + ai * 128 + wr * 64 + m * 16 + fr;
                    const f32x4 v0 = acc[ai][bj][m][0], v1 = acc[ai][bj][m][1];
                    u32x4 w; w.x = pack2(v0[0], v0[1]); w.y = pack2(v0[2], v0[3]); w.z = pack2(v1[0], v1[1]); w.w = pack2(v1[2], v1[3]);
                    if (col8 < 512) {
                        int mm, ss;
                        if (row < T) { const int bq = row >> 12, t = row & 4095; mm = bq * 128 + (t >> 5); ss = t & 31; }
                        else { const int q = row - T, bq = q >> 8, j = q & 255; mm = M5LAT + bq * 8 + (j >> 5); ss = j & 31; }
                        *(u32x4*)(US5 + ((size_t)((col8 >> 4) * M5PAD + mm)) * KT5 + ss * 16 + (col8 & 15)) = w;
                    } else *(u32x4*)(ULRU + (size_t)(row < T ? cmaj(row) : row) * 1024 + (col8 - 512)) = w;
                }
        }
    }
};
struct S5Sched {
    struct Unit { int g, pm, pn; };
    static constexpr bool GATHER = false;
    const char* A; const char* Bt; int K, nPm, nPn, brows  , G, c;
    DEV int lda() const { return KT5; }
    DEV bool next(int i, Unit& u) const {
        if (i > 0) return false;
        const int per = nPm * nPn * 4;
        const int x = c & 7, j = c >> 3; if (j >= per) return false;
        const int U = x * per + j; u.g = U / (nPm * nPn); const int r = U % (nPm * nPn); u.pm = r / nPn; u.pn = r % nPn; return true;
    }
    DEV void addr(const Unit& u, int R0, int C0, int R1, int C1, gp::UAddr& o) const {
        o.a = A + ((size_t)u.g * M5PAD + u.pm * 256) * KT5 * 2; o.b = Bt + ((size_t)u.g * brows + u.pn * 256) * K * 2;
    }
};
struct EpiS5Loc {
    static constexpr bool PERM = false;
    float* SLOC;
    template <class U> DEV void operator()(const f32x4 (&acc)[2][2][4][2], const U& u, int wr, int wc, int fr, int fq) const {
#pragma unroll
        for (int ai = 0; ai < 2; ++ai)
#pragma unroll
            for (int m = 0; m < 4; ++m) {
                const int mm = u.pm * 256 + ai * 128 + wr * 64 + m * 16 + fr;
                if (mm < M5) {
                    float* rowp = SLOC + ((size_t)(u.g * M5 + mm)) * 256 + wc * 32 + 4 * fq;
#pragma unroll
                    for (int bj = 0; bj < 2; ++bj)
#pragma unroll
                        for (int n = 0; n < 2; ++n) *(f32x4*)(rowp + bj * 128 + n * 16) = acc[ai][bj][m][n];
                }
            }
    }
};
struct EpiS5Out {
    static constexpr bool PERM = true;
    bf16_t* YS5;
    template <class U> DEV void operator()(const f32x4 (&acc)[2][2][4][2], const U& u, int wr, int wc, int fr, int fq) const {
#pragma unroll
        for (int ai = 0; ai < 2; ++ai)
#pragma unroll
            for (int m = 0; m < 4; ++m) {
                const int mm = u.pm * 256 + ai * 128 + wr * 64 + m * 16 + fr, bq = mm >> 7, chunk = mm & 127;
#pragma unroll
                for (int bj = 0; bj < 2; ++bj) {
                    const int n8 = u.pn * 256 + bj * 128 + wc * 32 + 8 * fq, t = n8 >> 4, c0 = n8 & 15;
                    const size_t tok = (size_t)bq * 4096 + chunk * 32 + t;
                    const f32x4 v0 = acc[ai][bj][m][0], v1 = acc[ai][bj][m][1];
                    u32x4 w; w.x = pack2(gelu_tanh(v0[0]), gelu_tanh(v0[1])); w.y = pack2(gelu_tanh(v0[2]), gelu_tanh(v0[3]));
                    w.z = pack2(gelu_tanh(v1[0]), gelu_tanh(v1[1])); w.w = pack2(gelu_tanh(v1[2]), gelu_tanh(v1[3]));
                    *(u32x4*)(YS5 + tok * 512 + u.g * 16 + c0) = w;
                }
            }
    }
};
struct EpiGlu {
    static constexpr bool PERM = true;
    const bf16_t* YS5; const float* b_glu; bf16_t* YCAT;
    template <class U> DEV void operator()(const f32x4 (&acc)[2][2][4][2], const U& u, int wr, int wc, int fr, int fq) const {
        const int col0 = u.pn * 256 + wc * 32 + 8 * fq; const size_t row0 = (size_t)u.pm * 256 + wr * 64 + fr;
        f32x4 bv[2][2];
#pragma unroll
        for (int bj = 0; bj < 2; ++bj) { bv[bj][0] = *(const f32x4*)(b_glu + col0 + bj * 128); bv[bj][1] = *(const f32x4*)(b_glu + col0 + bj * 128 + 4); }
        u32x4 yv[2][4][2];
#pragma unroll
        for (int ai = 0; ai < 2; ++ai)
#pragma unroll
            for (int m = 0; m < 4; ++m)
#pragma unroll
                for (int bj = 0; bj < 2; ++bj) yv[ai][m][bj] = *(const u32x4*)(YS5 + (row0 + ai * 128 + m * 16) * 512 + col0 + bj * 128);
#pragma unroll
        for (int ai = 0; ai < 2; ++ai)
#pragma unroll
            for (int m = 0; m < 4; ++m)
#pragma unroll
                for (int bj = 0; bj < 2; ++bj) {
                    float y[8]; bf8_unpack(yv[ai][m][bj], y);
                    const f32x4 z0 = acc[ai][bj][m][0] + bv[bj][0], z1 = acc[ai][bj][m][1] + bv[bj][1];
                    u32x4 w; w.x = pack2(y[0] * sigmoid_f(z0[0]), y[1] * sigmoid_f(z0[1])); w.y = pack2(y[2] * sigmoid_f(z0[2]), y[3] * sigmoid_f(z0[3]));
                    w.z = pack2(y[4] * sigmoid_f(z1[0]), y[5] * sigmoid_f(z1[1])); w.w = pack2(y[6] * sigmoid_f(z1[2]), y[7] * sigmoid_f(z1[3]));
                    *(u32x4*)(YCAT + (size_t)cmaj((int)(row0 + ai * 128 + m * 16)) * 1024 + col0 + bj * 128) = w;
                }
    }
};

struct TrTile { const float* W; bf16_t* dst; int ldw, k0, n0, ldd, mode; };
DEV void tr_load(const TrTile& t, int lane, f32x4 (&v)[16]) {
#pragma unroll
    for (int i = 0; i < 16; ++i) v[i] = *(const f32x4*)(t.W + (size_t)(t.k0 + i * 4 + (lane >> 4)) * t.ldw + t.n0 + (lane & 15) * 4);
}
DEV void tr_store(const TrTile& t, int lane, const f32x4 (&v)[16], LAS float* tile) {
#pragma unroll
    for (int i = 0; i < 16; ++i) { LAS float* tp = tile + (i * 4 + (lane >> 4)) * 65 + (lane & 15) * 4; tp[0] = v[i][0]; tp[1] = v[i][1]; tp[2] = v[i][2]; tp[3] = v[i][3]; }
    __builtin_amdgcn_fence(__ATOMIC_RELEASE, "wavefront"); __builtin_amdgcn_wave_barrier(); __builtin_amdgcn_fence(__ATOMIC_ACQUIRE, "wavefront");
    const int kc = lane & 7;
#pragma unroll
    for (int jn = 0; jn < 8; ++jn) {
        const int nn = (lane >> 3) + 8 * jn;
        float e[8];
#pragma unroll
        for (int jj = 0; jj < 8; ++jj) e[jj] = tile[(kc * 8 + jj) * 65 + nn];
        const int j = t.n0 + nn;
        const int row = t.mode == 0 ? j : (((j >> 4) << 5) + (j & 15) + (t.mode == 2 ? 16 : 0));
        u32x4 w; w.x = pack2(e[0], e[1]); w.y = pack2(e[2], e[3]); w.z = pack2(e[4], e[5]); w.w = pack2(e[6], e[7]);
        *(u32x4*)(t.dst + (size_t)row * t.ldd + t.k0 + kc * 8) = w;
    }
    __builtin_amdgcn_fence(__ATOMIC_RELEASE, "wavefront"); __builtin_amdgcn_wave_barrier(); __builtin_amdgcn_fence(__ATOMIC_ACQUIRE, "wavefront");
}
DEV void tr_tile_wave(const float* __restrict__ W, int ldw, int k0, int n0, bf16_t* __restrict__ dst, int ldd, int mode, LAS float* tile, int lane) {
    TrTile t{W, dst, ldw, k0, n0, ldd, mode}; f32x4 v[16]; tr_load(t, lane, v); tr_store(t, lane, v, tile);
}
DEV TrTile expert_tile(const Params& p, int it) {
    const int e = it / 192, r = it % 192, which = r >> 6, tt = r & 63;
    TrTile t;
    if (which < 2) {
        t.W = e < 64 ? (which == 0 ? p.in[31] : p.in[32]) + (size_t)e * 262144 : (which == 0 ? p.in[34] : p.in[35]);
        t.ldw = 256; t.k0 = (tt >> 2) * 64; t.n0 = (tt & 3) * 64; t.dst = (bf16_t*)(p.ws + WS_BTGU) + (size_t)e * 524288; t.ldd = 1024; t.mode = which + 1;
    } else {
        t.W = e < 64 ? p.in[33] + (size_t)e * 262144 : p.in[36];
        t.ldw = 1024; t.k0 = (tt >> 4) * 64; t.n0 = (tt & 15) * 64; t.dst = (bf16_t*)(p.ws + WS_BTDN) + (size_t)e * 262144; t.ldd = 256; t.mode = 0;
    }
    return t;
}

DEV void gemv9_item(LAS const float* S, const float* __restrict__ W, int ldw, int col0, const float* __restrict__ bias, float* __restrict__ out, int ldo, LAS float* red) {
    const int tid = threadIdx.x, col = tid & 31, kp = tid >> 5;
    float acc[9];
#pragma unroll
    for (int b = 0; b < 9; ++b) acc[b] = 0.f;
    for (int k = kp * 64; k < kp * 64 + 64; ++k) {
        const float w = W[(size_t)k * ldw + col0 + col];
#pragma unroll
        for (int b = 0; b < 9; ++b) acc[b] += S[b * 1024 + k] * w;
    }
#pragma unroll
    for (int b = 0; b < 9; ++b) red[(kp * 9 + b) * 32 + col] = acc[b];
    __syncthreads();
    if (tid < 288) {
        const int b = tid >> 5, c = tid & 31; float s = 0.f;
#pragma unroll
        for (int q = 0; q < 16; ++q) s += red[(q * 9 + b) * 32 + c];
        out[b * ldo + col0 + c] = s + (bias ? bias[col0 + c] : 0.f);
    }
    __syncthreads();
}

DEV void cpow_d(double lr, double li, double dt, int l, double& re, double& im) {
    const double mag = exp(lr * dt * (double)l);
    const double ang = li * dt * (double)l;
    const double kq = rint(ang * 0.63661977236758134308);
    double x = fma(-kq, 1.57079632679489655800e+00, ang);
    x = fma(-kq, 6.12323399573676603587e-17, x);
    const double x2 = x * x;
    double s = -1.0 / 6227020800.0; s = fma(s, x2, 1.0 / 39916800.0); s = fma(s, x2, -1.0 / 362880.0); s = fma(s, x2, 1.0 / 5040.0);
    s = fma(s, x2, -1.0 / 120.0); s = fma(s, x2, 1.0 / 6.0); s = fma(-s, x2, 1.0); s = s * x;
    double c = 1.0 / 479001600.0; c = fma(c, x2, -1.0 / 3628800.0); c = fma(c, x2, 1.0 / 40320.0); c = fma(c, x2, -1.0 / 720.0);
    c = fma(c, x2, 1.0 / 24.0); c = fma(c, x2, -0.5); c = fma(c, x2, 1.0);
    const int q = ((int)(long long)kq) & 3;
    const double sn = (q == 0) ? s : (q == 1) ? c : (q == 2) ? -s : -c;
    const double cs = (q == 0) ? c : (q == 1) ? -s : (q == 2) ? -c : s;
    re = mag * cs; im = mag * sn;
}

DEV void s5_tables(const Params& p, LAS unsigned char* lds, int g, int part) {
    int tid = threadIdx.x; asm volatile("" : "+v"(tid));
    LAS float* apr = (LAS float*)lds;
    LAS float* api = apr + 640;
    LAS float* bbr = api + 640;
    LAS float* bbi = bbr + 2048;
    const float* lam_re = p.in[9]; const float* lam_im = p.in[10]; const float* log_dt = p.in[11];
    const float* b_re = p.in[12]; const float* b_im = p.in[13]; const float* c_re = p.in[14]; const float* c_im = p.in[15];
    float* APR = (float*)(p.ws + WS_APR) + (size_t)g * 4224; float* API = (float*)(p.ws + WS_API) + (size_t)g * 4224;
    float* BBR = (float*)(p.ws + WS_BBR) + (size_t)g * 2048; float* BBI = (float*)(p.ws + WS_BBI) + (size_t)g * 2048;
    float* KTAB = (float*)(p.ws + WS_KTAB) + (size_t)g * 16384;
    const int nl = part == 7 ? 5 : 4;
    for (int i = tid; i < 2 * nl * 64; i += 512) {
        const int dir = i / (nl * 64), rem = i % (nl * 64), li = rem >> 6, pp = rem & 63, l = part * 4 + li, gi = dir * 32 + g;
        const double dt = exp((double)log_dt[gi]);
        double re, im; cpow_d((double)lam_re[gi * 64 + pp], (double)lam_im[gi * 64 + pp], dt, l, re, im);
        apr[(dir * 5 + li) * 64 + pp] = (float)re; api[(dir * 5 + li) * 64 + pp] = (float)im;
        APR[(dir * 33 + l) * 64 + pp] = (float)re; API[(dir * 33 + l) * 64 + pp] = (float)im;
    }
    for (int i = tid; i < 2048; i += 512) {
        const int dir = i >> 10, pp = (i >> 4) & 63, c = i & 15, gi = dir * 32 + g;
        const double dt = exp((double)log_dt[gi]);
        const double lr = (double)lam_re[gi * 64 + pp], li = (double)lam_im[gi * 64 + pp];
        double ar, ai; cpow_d(lr, li, dt, 1, ar, ai);
        const double nr = ar - 1.0, den = lr * lr + li * li;
        const double fr = (nr * lr + ai * li) / den, fi = (ai * lr - nr * li) / den;
        const double br = (double)b_re[((size_t)(gi * 64 + pp)) * 16 + c], bi = (double)b_im[((size_t)(gi * 64 + pp)) * 16 + c];
        const float vr = (float)(fr * br - fi * bi), vi = (float)(fr * bi + fi * br);
        bbr[i] = vr; bbi[i] = vi;
        if (part == 0) { BBR[i] = vr; BBI[i] = vi; }
    }
    __syncthreads();
    if (tid < 128) {
        const int dir = tid >> 6, li = (tid >> 4) & 3, c = tid & 15, l = part * 4 + li;
        const float* cr_ = c_re + ((size_t)((dir * 32 + g) * 16 + c)) * 64; const float* ci_ = c_im + ((size_t)((dir * 32 + g) * 16 + c)) * 64;
        f32x4 s0 = (f32x4){0.f, 0.f, 0.f, 0.f}, s1 = s0, s2 = s0, s3 = s0;
#pragma unroll 2
        for (int pp = 0; pp < 64; ++pp) {
            const float ar = apr[(dir * 5 + li) * 64 + pp], ai = api[(dir * 5 + li) * 64 + pp];
            const float cr = cr_[pp], ci = ci_[pp];
            const float qr = cr * ar - ci * ai, qi = cr * ai + ci * ar;
            LAS const f32x4* br = (LAS const f32x4*)(bbr + (dir * 64 + pp) * 16); LAS const f32x4* bi = (LAS const f32x4*)(bbi + (dir * 64 + pp) * 16);
            s0 += br[0] * qr - bi[0] * qi; s1 += br[1] * qr - bi[1] * qi; s2 += br[2] * qr - bi[2] * qi; s3 += br[3] * qr - bi[3] * qi;
        }
        f32x4* kd = (f32x4*)(KTAB + ((dir * 32 + l) * 16 + c) * 16);
        kd[0] = s0; kd[1] = s1; kd[2] = s2; kd[3] = s3;
    }
    __syncthreads();
}
DEV void s5_fill(const Params& p, LAS unsigned char* lds, int g, int part) {
    int tid = threadIdx.x; asm volatile("" : "+v"(tid));
    LAS float* apr = (LAS float*)lds;
    LAS float* api = apr + 4224;
    LAS float* bbr = api + 4224;
    LAS float* bbi = bbr + 2048;
    LAS float* ccr = bbi + 2048;
    LAS float* cci = ccr + 2048;
    LAS float* Kt = cci + 2048;
    const float* c_re = p.in[14]; const float* c_im = p.in[15]; const float* dvec = p.in[16];
    bf16_t* BS5 = (bf16_t*)(p.ws + WS_BS5); bf16_t* ES5 = (bf16_t*)(p.ws + WS_ES5); float* ALC = (float*)(p.ws + WS_ALC);
    {
        const f32x4* s0 = (const f32x4*)((const float*)(p.ws + WS_APR) + (size_t)g * 4224); const f32x4* s1 = (const f32x4*)((const float*)(p.ws + WS_API) + (size_t)g * 4224);
        const f32x4* s2 = (const f32x4*)((const float*)(p.ws + WS_BBR) + (size_t)g * 2048); const f32x4* s3 = (const f32x4*)((const float*)(p.ws + WS_BBI) + (size_t)g * 2048);
        const f32x4* s4 = (const f32x4*)((const float*)(p.ws + WS_KTAB) + (size_t)g * 16384);
        f32x4 ra[3], ri[3], rb0, rb1, rk[8]; float rc[4], rd[4];
#pragma unroll
        for (int u = 0; u < 3; ++u) { const int i = tid + u * 512; if (i < 1056) { ra[u] = s0[i]; ri[u] = s1[i]; } }
        rb0 = s2[tid]; rb1 = s3[tid];
#pragma unroll
        for (int u = 0; u < 8; ++u) rk[u] = s4[tid + u * 512];
#pragma unroll
        for (int u = 0; u < 4; ++u) { const int i = tid + u * 512; const int dir = i >> 10, cc = (i >> 6) & 15, pp = i & 63; const size_t src = ((size_t)((dir * 32 + g) * 16 + cc)) * 64 + pp; rc[u] = c_re[src]; rd[u] = c_im[src]; }
#pragma unroll
        for (int u = 0; u < 3; ++u) { const int i = tid + u * 512; if (i < 1056) { ((LAS f32x4*)apr)[i] = ra[u]; ((LAS f32x4*)api)[i] = ri[u]; } }
        ((LAS f32x4*)bbr)[tid] = rb0; ((LAS f32x4*)bbi)[tid] = rb1;
#pragma unroll
        for (int u = 0; u < 8; ++u) { const int i = tid + u * 512; LAS float* kd = Kt + (i >> 6) * 257 + (i & 63) * 4; kd[0] = rk[u][0]; kd[1] = rk[u][1]; kd[2] = rk[u][2]; kd[3] = rk[u][3]; }
#pragma unroll
        for (int u = 0; u < 4; ++u) { const int i = tid + u * 512; ccr[i] = rc[u]; cci[i] = rd[u]; }
    }
    __syncthreads();
    for (int q = tid; q < 64 * 96; q += 512) {
        const int n = part * 64 + q / 96, k8 = (q % 96) * 8, t = n >> 4, c = n & 15;
        float e[8];
        if (k8 < 512) {
            const int s = k8 >> 4, c0 = k8 & 15, delta = t - s;
#pragma unroll
            for (int i = 0; i < 8; ++i) {
                const int c2 = c0 + i; float v;
                if (delta > 0) v = Kt[delta * 257 + c * 16 + c2];
                else if (delta < 0) v = Kt[(32 - delta) * 257 + c * 16 + c2];
                else v = Kt[c * 16 + c2] + Kt[32 * 257 + c * 16 + c2] + (c == c2 ? dvec[g * 16 + c] : 0.f);
                e[i] = v;
            }
        } else {
            const int kk = k8 - 512, seg = kk >> 6, p0 = kk & 63, dir = seg >> 1, l = dir == 0 ? t + 1 : 32 - t;
#pragma unroll
            for (int i = 0; i < 8; ++i) {
                const int pp = p0 + i;
                const float ar = apr[(dir * 33 + l) * 64 + pp], ai = api[(dir * 33 + l) * 64 + pp];
                const float cr = ccr[(dir * 16 + c) * 64 + pp], ci = cci[(dir * 16 + c) * 64 + pp];
                e[i] = (seg & 1) ? -(cr * ai + ci * ar) : (cr * ar - ci * ai);
            }
        }
        u32x4 w; w.x = pack2(e[0], e[1]); w.y = pack2(e[2], e[3]); w.z = pack2(e[4], e[5]); w.w = pack2(e[6], e[7]);
        *(u32x4*)(BS5 + ((size_t)g * 512 + n) * 768 + k8) = w;
    }
    for (int q = tid; q < 32 * 64; q += 512) {
        const int n = part * 32 + (q >> 6), k8 = (q & 63) * 8, s = k8 >> 4, c0 = k8 & 15, seg = n >> 6, pp = n & 63, dir = seg >> 1, l = dir == 0 ? 31 - s : s;
        const float ar = apr[(dir * 33 + l) * 64 + pp], ai = api[(dir * 33 + l) * 64 + pp];
        float e[8];
#pragma unroll
        for (int i = 0; i < 8; ++i) {
            const float br = bbr[(dir * 64 + pp) * 16 + c0 + i], bi = bbi[(dir * 64 + pp) * 16 + c0 + i];
            e[i] = (seg & 1) ? (ar * bi + ai * br) : (ar * br - ai * bi);
        }
        u32x4 w; w.x = pack2(e[0], e[1]); w.y = pack2(e[2], e[3]); w.z = pack2(e[4], e[5]); w.w = pack2(e[6], e[7]);
        *(u32x4*)(ES5 + ((size_t)g * 256 + n) * 512 + k8) = w;
    }
    if (part == 0 && tid < 128) {
        const int dir = tid >> 6, pp = tid & 63;
        ALC[((dir * 32 + g) * 64 + pp) * 2 + 0] = apr[(dir * 33 + 32) * 64 + pp];
        ALC[((dir * 32 + g) * 64 + pp) * 2 + 1] = api[(dir * 33 + 32) * 64 + pp];
    }
    __syncthreads();
}

template <bool APPLY>
DEV void lru_item(const Params& p, LAS unsigned char* lds, int b, int ch, int h) {
    int tid_ = threadIdx.x; asm volatile("" : "+v"(tid_));
    const int tid = tid_, wid = tid >> 6, lane = tid & 63, fr = lane & 15, fq = lane >> 4;
    LAS float* xin = (LAS float*)lds;
    LAS float* xs = (LAS float*)(lds + 17408);
    LAS unsigned short* xsb = (LAS unsigned short*)(lds + 33792);
    LAS float* aa = (LAS float*)(lds + 43008);
    LAS float* bb = (LAS float*)(lds + 75776);
    LAS float* cAs = (LAS float*)(lds + 108544);
    const bf16_t* ULRU = (const bf16_t*)(p.ws + WS_ULRU);
    const bf16_t* BTLRU = (const bf16_t*)(p.ws + WS_BTLRU);
    const float* conv_w = p.in[19]; const float* conv_b = p.in[20];
    if (tid < 128) {
        const int dir = tid >> 6, j = tid & 63, o = dir * 512 + h * 64 + j;
        cAs[tid] = -8.f * log1pf(__expf(-p.in[25][o])); cAs[128 + tid] = p.in[22][o]; cAs[256 + tid] = p.in[24][o];
    }
    for (int c = tid; c < 67 * 8; c += 512) {
        const int rr = c >> 3, c8 = (c & 7) * 8, pos = rr - 2;
        u32x4 w = (u32x4){0u, 0u, 0u, 0u};
        if (ch < 64) { if (pos >= 0 && pos < 64) w = *(const u32x4*)(ULRU + ((size_t)b * 4096 + pos * 64 + ch) * 1024 + h * 64 + c8); }
        else { const int jt = (ch - 64) * 64 + pos; if (jt >= 0 && jt < 256) w = *(const u32x4*)(ULRU + ((size_t)T + b * 256 + jt) * 1024 + h * 64 + c8); }
        float y[8]; bf8_unpack(w, y);
        *(LAS f32x4*)(xin + rr * 64 + c8) = (f32x4){y[0], y[1], y[2], y[3]}; *(LAS f32x4*)(xin + rr * 64 + c8 + 4) = (f32x4){y[4], y[5], y[6], y[7]};
    }
    __syncthreads();
    {
        const int cc = tid & 63, chn = h * 64 + cc;
        const float w0 = conv_w[chn], w1 = conv_w[512 + chn], w2 = conv_w[1024 + chn], w3 = conv_w[1536 + chn], cb = conv_b[chn];
#pragma unroll 2
        for (int r = tid >> 6; r < 64; r += 8) {
            const float v = cb + w0 * xin[r * 64 + cc] + w1 * xin[(r + 1) * 64 + cc] + w2 * xin[(r + 2) * 64 + cc] + w3 * xin[(r + 3) * 64 + cc];
            xs[r * 64 + cc] = v; xsb[r * 72 + cc] = (unsigned short)f2bf(v);
        }
    }
    __syncthreads();
    {
        const int mt = wid & 3, dir = wid >> 2;
        bf16x8 af[2];
#pragma unroll
        for (int ks = 0; ks < 2; ++ks) af[ks] = *(LAS const bf16x8*)((LAS const unsigned char*)xsb + (mt * 16 + fr) * 144 + ks * 64 + fq * 16);
        const int r = mt * 16 + fr;
#pragma unroll
        for (int jt = 0; jt < 8; ++jt) {
            const int n = dir * 128 + jt * 16 + fr;
            const bf16_t* bp = BTLRU + ((size_t)(h * 256 + n)) * 64 + fq * 8;
            const bf16x8 b0 = *(const bf16x8*)bp, b1 = *(const bf16x8*)(bp + 32);
            f32x4 a = (f32x4){0.f, 0.f, 0.f, 0.f};
            a = __builtin_amdgcn_mfma_f32_16x16x32_bf16(b0, af[0], a, 0, 0, 0);
            a = __builtin_amdgcn_mfma_f32_16x16x32_bf16(b1, af[1], a, 0, 0, 0);
            LAS float* dst = (jt < 4 ? aa : bb) + (dir * 64 + r) * 64 + (jt & 3) * 16 + 4 * fq;
            *(LAS f32x4*)dst = a;
        }
    }
    __syncthreads();
#pragma unroll 2
    for (int idx = tid; idx < 8192; idx += 512) {
        const int dir = idx >> 12, j = idx & 63, r = (idx >> 6) & 63;
        const float za = aa[idx] + cAs[128 + dir * 64 + j], zx = bb[idx] + cAs[256 + dir * 64 + j];
        const float la = cAs[dir * 64 + j] * sigmoid_f(za);
        const float a = __expf(la);
        const float x2 = 2.f * la;
        const float em = -x2 * (1.f + x2 * (0.5f + x2 * (0.16666667f + x2 * (0.041666668f + x2 * (0.0083333338f + x2 * 0.0013888889f)))));
        aa[idx] = a; bb[idx] = sqrtf(em) * sigmoid_f(zx) * xs[r * 64 + j];
    }
    __syncthreads();
    if (tid < 128) {
        const int dir = tid >> 6, j = tid & 63, chn = h * 64 + j;
        LAS float* ap = aa + dir * 4096 + j; LAS float* bp = bb + dir * 4096 + j;
        if (!APPLY) {
            float H = 0.f, P = 1.f;
#pragma unroll 1
            for (int s0 = 0; s0 < 64; s0 += 16) {
                float av[16], bv[16];
#pragma unroll
                for (int q = 0; q < 16; ++q) { const int r = dir ? 63 - (s0 + q) : s0 + q; av[q] = ap[r * 64]; bv[q] = bp[r * 64]; }
#pragma unroll
                for (int q = 0; q < 16; ++q) { H = av[q] * H + bv[q]; P *= av[q]; }
            }
            float* SA = (float*)(p.ws + WS_SA); float* SB = (float*)(p.ws + WS_SB);
            const size_t o = ((size_t)(b * 68 + ch) * 2 + dir) * 512 + chn;
            SA[o] = P; SB[o] = H;
        } else {
            const float* HIN = (const float*)(p.ws + WS_HIN);
            float H = HIN[((size_t)(b * 64 + ch) * 2 + dir) * 512 + chn];
#pragma unroll 1
            for (int s0 = 0; s0 < 64; s0 += 16) {
                float av[16], bv[16];
#pragma unroll
                for (int q = 0; q < 16; ++q) { const int r = dir ? 63 - (s0 + q) : s0 + q; av[q] = ap[r * 64]; bv[q] = bp[r * 64]; }
#pragma unroll
                for (int q = 0; q < 16; ++q) { const int r = dir ? 63 - (s0 + q) : s0 + q; H = av[q] * H + bv[q]; bp[r * 64] = H; }
            }
        }
    }
    __syncthreads();
    if (APPLY) {
        bf16_t* YCAT = (bf16_t*)(p.ws + WS_YCAT);
        {
            const int r = tid >> 3, j8 = (tid & 7) * 8;
            const size_t row = (size_t)b * 4096 + r * 64 + ch;
            float gt[8]; bf8_unpack(*(const u32x4*)(ULRU + row * 1024 + 512 + h * 64 + j8), gt);
            float o[8];
#pragma unroll
            for (int q = 0; q < 8; ++q) o[q] = (bb[r * 64 + j8 + q] + bb[(64 + r) * 64 + j8 + q]) * gelu_tanh(gt[q]);
            u32x4 w; w.x = pack2(o[0], o[1]); w.y = pack2(o[2], o[3]); w.z = pack2(o[4], o[5]); w.w = pack2(o[6], o[7]);
            *(u32x4*)(YCAT + row * 1024 + 512 + h * 64 + j8) = w;
        }
        __syncthreads();
    }
}

template <int CTRL> DEV float dpp_f(float oldv, float src) {
    return __builtin_bit_cast(float, __builtin_amdgcn_update_dpp(__builtin_bit_cast(int, oldv), __builtin_bit_cast(int, src), CTRL, 0xf, 0xf, false));
}
template <bool REV> DEV void row_scan(float& a, float& b) {
#define LRU_STEP(D) { const float ap = dpp_f<(REV ? 0x100 : 0x110) + D>(1.f, a), bp = dpp_f<(REV ? 0x100 : 0x110) + D>(0.f, b); b = a * bp + b; a = a * ap; }
    LRU_STEP(1) LRU_STEP(2) LRU_STEP(4) LRU_STEP(8)
#undef LRU_STEP
}
#ifndef PROBE_LRU
#define PROBE_LRU -1
#endif
#define LSEC_B(id) do { if (PROBE_LRU == (id)) { __builtin_amdgcn_s_waitcnt(0); lt0_ = __builtin_amdgcn_s_memrealtime(); } } while (0)
#define LSEC_E(id) do { if (PROBE_LRU == (id)) { __builtin_amdgcn_s_waitcnt(0); lacc_ += __builtin_amdgcn_s_memrealtime() - lt0_; } } while (0)
template <bool APPLY>
DEV void lru_phase(const Params& p, LAS unsigned char* lds, int bid, int nb) {
    unsigned long long lt0_ = 0, lacc_ = 0;
    int tid = threadIdx.x; asm volatile("" : "+v"(tid));
    const int wid = __builtin_amdgcn_readfirstlane(tid >> 6), lane = tid & 63, fr = lane & 15, fq = lane >> 4;
    const int w = bid * 8 + wid, h = (w & 31) >> 2, q = w & 3;
    const bf16_t* ULRU = (const bf16_t*)(p.ws + WS_ULRU);
    const bf16_t* BTLRU = (const bf16_t*)(p.ws + WS_BTLRU);
    const float* conv_w = p.in[19]; const float* conv_b = p.in[20];
    const int c4 = h * 64 + q * 16 + 4 * fq;
    const int nch = APPLY ? 64 : 68, npairs = NBATCH * nch;
    LAS unsigned char* wl = lds + wid * 19072;
    LAS float* cwl = (LAS float*)(wl + 17408);
    for (int i = lane; i < 320; i += 64) cwl[i] = i < 256 ? conv_w[(i >> 6) * 512 + h * 64 + (i & 63)] : conv_b[h * 64 + (i & 63)];
    bf16x8 bfr[2][4];
#pragma unroll
    for (int ks = 0; ks < 2; ++ks)
#pragma unroll
        for (int nt = 0; nt < 4; ++nt) bfr[ks][nt] = *(const bf16x8*)(BTLRU + ((size_t)(h * 256 + (nt >> 1) * 128 + (nt & 1) * 64 + q * 16 + fr)) * 64 + ks * 32 + fq * 8);
    for (int i = lane; i < 96; i += 64) { const int kind = i >> 5, dir = (i >> 4) & 1, c = i & 15, o = dir * 512 + h * 64 + q * 16 + c; cwl[320 + i] = kind == 0 ? ((const float*)(p.ws + WS_LCA))[o] : (kind == 1 ? p.in[22][o] : p.in[24][o]); }
    const char* UB = (const char*)ULRU;
#define LRU_GEO(jj, base0_, plo_, phi_) const int b_##jj = (jj) / nch, ch_##jj = (jj) % nch; const bool lat_##jj = ch_##jj < 64; \
        const unsigned base0_ = (lat_##jj ? (unsigned)(b_##jj * 4096 + ch_##jj * 64) * 2048u : (unsigned)(T + b_##jj * 256 + (ch_##jj - 64) * 64) * 2048u) + (unsigned)h * 128u; \
        const int plo_ = lat_##jj ? 0 : -(ch_##jj - 64) * 64, phi_ = lat_##jj ? 64 : 256 - (ch_##jj - 64) * 64;
#define LRU_DMA(base0_, plo_, phi_, buf_) _Pragma("unroll") for (int i_ = 0; i_ < 9; ++i_) { const int s_ = i_ * 64 + lane; if (s_ < 536) { const int row_ = s_ >> 3, chk_ = (s_ & 7) ^ (row_ & 7); \
        int pos_ = row_ - 2; pos_ = pos_ < (plo_) ? (plo_) : (pos_ >= (phi_) ? (phi_) - 1 : pos_); \
        __builtin_amdgcn_global_load_lds((const unsigned*)(UB + ((base0_) + (unsigned)pos_ * 2048u + (unsigned)chk_ * 16u)), (LAS unsigned*)(wl + (buf_) * 8704 + i_ * 1024), 16, 0, 0); } }
    int jcur = w >> 5, it_ = 0;
    if (jcur < npairs) { LRU_GEO(jcur, bz, pl, ph) LRU_DMA(bz, pl, ph, 0) }
#pragma unroll 1
    for (int j = w >> 5; j < npairs; j += 64, ++it_) {
        const int b = j / nch, ch = j % nch;
        LRU_GEO(j, base0, plo, phi)
        (void)base0;
        LAS const unsigned char* xb = wl + (it_ & 1) * 8704;
        asm volatile("s_waitcnt vmcnt(0)" ::: "memory");
        { const int jn = j + 64; if (jn < npairs) { LRU_GEO(jn, bz, pl, ph) LRU_DMA(bz, pl, ph, (it_ + 1) & 1) } }
        asm volatile("" ::: "memory");
        f32x4 acc[4][4];
#pragma unroll
        for (int mt = 0; mt < 4; ++mt)
#pragma unroll
            for (int nt = 0; nt < 4; ++nt) acc[mt][nt] = (f32x4){0.f, 0.f, 0.f, 0.f};
        LSEC_B(1);
#pragma unroll
        for (int ks = 0; ks < 2; ++ks) {
            f32x4 cw[4][2], cb[2];
#pragma unroll
            for (int k = 0; k < 4; ++k) { cw[k][0] = *(LAS const f32x4*)(cwl + k * 64 + ks * 32 + fq * 8); cw[k][1] = *(LAS const f32x4*)(cwl + k * 64 + ks * 32 + fq * 8 + 4); }
            cb[0] = *(LAS const f32x4*)(cwl + 256 + ks * 32 + fq * 8); cb[1] = *(LAS const f32x4*)(cwl + 256 + ks * 32 + fq * 8 + 4);
#pragma unroll
            for (int mt = 0; mt < 4; ++mt) {
                f32x4 s0 = cb[0], s1 = cb[1];
#pragma unroll
                for (int k = 0; k < 4; ++k) {
                    const int row = mt * 16 + fr + k, pos = row - 2;
                    const u32x4 xr = *(LAS const u32x4*)(xb + (row * 8 + ((ks * 4 + fq) ^ (row & 7))) * 16);
                    const unsigned mk_ = (pos >= plo && pos < phi) ? 0xffffffffu : 0u;
                    const u32x4 xm = (u32x4){xr.x & mk_, xr.y & mk_, xr.z & mk_, xr.w & mk_};
                    float y[8]; bf8_unpack(xm, y);
                    s0 += cw[k][0] * (f32x4){y[0], y[1], y[2], y[3]}; s1 += cw[k][1] * (f32x4){y[4], y[5], y[6], y[7]};
                }
                u32x4 aw; aw.x = pack2(s0[0], s0[1]); aw.y = pack2(s0[2], s0[3]); aw.z = pack2(s1[0], s1[1]); aw.w = pack2(s1[2], s1[3]);
                const bf16x8 af = __builtin_bit_cast(bf16x8, aw);
#pragma unroll
                for (int nt = 0; nt < 4; ++nt) acc[mt][nt] = __builtin_amdgcn_mfma_f32_16x16x32_bf16(bfr[ks][nt], af, acc[mt][nt], 0, 0, 0);
            }
        }
        LSEC_E(1); LSEC_B(2);
        f32x4 cwo[4], cA[2], ba[2], bx[2];
#pragma unroll
        for (int k = 0; k < 4; ++k) cwo[k] = *(LAS const f32x4*)(cwl + k * 64 + q * 16 + 4 * fq);
#pragma unroll
        for (int dir = 0; dir < 2; ++dir) { cA[dir] = *(LAS const f32x4*)(cwl + 320 + dir * 16 + 4 * fq); ba[dir] = *(LAS const f32x4*)(cwl + 352 + dir * 16 + 4 * fq); bx[dir] = *(LAS const f32x4*)(cwl + 384 + dir * 16 + 4 * fq); }
        const f32x4 cbo = *(LAS const f32x4*)(cwl + 256 + q * 16 + 4 * fq);
#pragma unroll
        for (int mt = 0; mt < 4; ++mt) {
            f32x4 xo = cbo;
#pragma unroll
            for (int k = 0; k < 4; ++k) {
                const int row = mt * 16 + fr + k, pos = row - 2;
                const u32x2 xr = *(LAS const u32x2*)(xb + (row * 8 + ((q * 2 + (fq >> 1)) ^ (row & 7))) * 16 + (fq & 1) * 8);
                const unsigned mk_ = (pos >= plo && pos < phi) ? 0xffffffffu : 0u;
                const unsigned x0 = xr.x & mk_, x1 = xr.y & mk_;
                xo += cwo[k] * (f32x4){__uint_as_float(x0 << 16), __uint_as_float(x0 & 0xffff0000u), __uint_as_float(x1 << 16), __uint_as_float(x1 & 0xffff0000u)};
            }
#pragma unroll
            for (int dir = 0; dir < 2; ++dir)
#pragma unroll
                for (int r = 0; r < 4; ++r) {
                    const float za = acc[mt][2 * dir][r] + ba[dir][r], zx = acc[mt][2 * dir + 1][r] + bx[dir][r];
                    const float a = __builtin_amdgcn_exp2f(cA[dir][r] * sigmoid_f(za));
                    acc[mt][2 * dir][r] = a;
                    acc[mt][2 * dir + 1][r] = __builtin_amdgcn_sqrtf(fmaf(-a, a, 1.f)) * sigmoid_f(zx) * xo[r];
                }
        }
        LSEC_E(2); LSEC_B(3);
        const int bsel15 = ((lane & 48) | 15) << 2, bsel0 = (lane & 48) << 2;
        if (!APPLY) {
            f32x4 PA[2], PH[2];
#pragma unroll
            for (int r = 0; r < 4; ++r) {
                float cAf = 1.f, cHf = 0.f, cAr = 1.f, cHr = 0.f;
#pragma unroll
                for (int mt = 0; mt < 4; ++mt) {
                    float a = acc[mt][0][r], bq = acc[mt][1][r]; row_scan<false>(a, bq);
                    const float At = __builtin_bit_cast(float, __builtin_amdgcn_ds_bpermute(bsel15, __builtin_bit_cast(int, a)));
                    const float Ht = __builtin_bit_cast(float, __builtin_amdgcn_ds_bpermute(bsel15, __builtin_bit_cast(int, bq)));
                    cHf = At * cHf + Ht; cAf *= At;
                }
#pragma unroll
                for (int mt = 3; mt >= 0; --mt) {
                    float a = acc[mt][2][r], bq = acc[mt][3][r]; row_scan<true>(a, bq);
                    const float At = __builtin_bit_cast(float, __builtin_amdgcn_ds_bpermute(bsel0, __builtin_bit_cast(int, a)));
                    const float Ht = __builtin_bit_cast(float, __builtin_amdgcn_ds_bpermute(bsel0, __builtin_bit_cast(int, bq)));
                    cHr = At * cHr + Ht; cAr *= At;
                }
                PA[0][r] = cAf; PH[0][r] = cHf; PA[1][r] = cAr; PH[1][r] = cHr;
            }
            if (fr == 0) {
                float* SA = (float*)(p.ws + WS_SA); float* SB = (float*)(p.ws + WS_SB);
#pragma unroll
                for (int dir = 0; dir < 2; ++dir) { const size_t o = ((size_t)(b * 68 + ch) * 2 + dir) * 512 + c4; *(f32x4*)(SA + o) = PA[dir]; *(f32x4*)(SB + o) = PH[dir]; }
            }
        } else {
            const float* HIN = (const float*)(p.ws + WS_HIN);
            const f32x4 hf = *(const f32x4*)(HIN + ((size_t)(b * 64 + ch) * 2 + 0) * 512 + c4), hr = *(const f32x4*)(HIN + ((size_t)(b * 64 + ch) * 2 + 1) * 512 + c4);
            f32x4 Ho[4];
#pragma unroll
            for (int r = 0; r < 4; ++r) {
                float carry = hf[r];
#pragma unroll
                for (int mt = 0; mt < 4; ++mt) {
                    float a = acc[mt][0][r], bq = acc[mt][1][r]; row_scan<false>(a, bq);
                    const float hv = bq + a * carry; Ho[mt][r] = hv;
                    carry = __builtin_bit_cast(float, __builtin_amdgcn_ds_bpermute(bsel15, __builtin_bit_cast(int, hv)));
                }
                carry = hr[r];
#pragma unroll
                for (int mt = 3; mt >= 0; --mt) {
                    float a = acc[mt][2][r], bq = acc[mt][3][r]; row_scan<true>(a, bq);
                    const float hv = bq + a * carry; Ho[mt][r] += hv;
                    carry = __builtin_bit_cast(float, __builtin_amdgcn_ds_bpermute(bsel0, __builtin_bit_cast(int, hv)));
                }
            }
            bf16_t* YCAT = (bf16_t*)(p.ws + WS_YCAT);
#pragma unroll
            for (int mt = 0; mt < 4; ++mt) {
                const size_t row = (size_t)b * 4096 + (size_t)ch * 64 + (mt * 16 + fr);
                const u32x2 gw = *(const u32x2*)(ULRU + row * 1024 + 512 + c4);
                const float g0 = __uint_as_float(gw.x << 16), g1 = __uint_as_float(gw.x & 0xffff0000u), g2 = __uint_as_float(gw.y << 16), g3 = __uint_as_float(gw.y & 0xffff0000u);
                u32x2 ow; ow.x = pack2(Ho[mt][0] * gelu_tanh(g0), Ho[mt][1] * gelu_tanh(g1)); ow.y = pack2(Ho[mt][2] * gelu_tanh(g2), Ho[mt][3] * gelu_tanh(g3));
                *(u32x2*)(YCAT + row * 1024 + 512 + c4) = ow;
            }
        }
        LSEC_E(3);
    }
    if (PROBE_LRU >= 0 && !APPLY && bid == 0) { const unsigned long long d_ = lacc_ * 8ull, t0_ = __builtin_amdgcn_s_memrealtime(); while (__builtin_amdgcn_s_memrealtime() - t0_ < d_) __builtin_amdgcn_s_sleep(8); }
}

#if PROBE_SUB == 6 || PROBE_SUB == 7
DEV void lru_load_probe(const Params& p, int bid, int nb) {
    int tid = threadIdx.x; asm volatile("" : "+v"(tid));
    const int wid = tid >> 6, lane = tid & 63, fr = lane & 15, fq = lane >> 4;
    const int w = bid * 8 + wid, h = (w & 31) >> 2, q = w & 3;
    const bf16_t* ULRU = (const bf16_t*)(p.ws + WS_ULRU);
    unsigned sink = 0;
    for (int j = w >> 5; j < NBATCH * 68; j += 64) {
        const int b = j / 68, ch = j % 68;
        const bool lat = ch < 64;
        const size_t base0 = lat ? ((size_t)b * 4096 + ch) * 1024 : ((size_t)T + b * 256 + (ch - 64) * 64) * 1024;
        const size_t pstride = lat ? (size_t)64 * 1024 : (size_t)1024;
#if PROBE_SUB == 6
        if (q == 0)
#endif
#pragma unroll
        for (int mt = 0; mt < 4; ++mt) { const int pos = mt * 16 + fr; const u32x4 v = *(const u32x4*)(ULRU + base0 + (size_t)pos * pstride + fq * 8 + h * 64); sink += v.x ^ v.y ^ v.z ^ v.w; }
    }
    asm volatile("" :: "v"(sink));
}
#endif
constexpr int MOE_TAB_OFF = 132096;
DEV void moe_tables(const Params& p, LAS unsigned char* lds, int h) {
    LAS int* tp = (LAS int*)(lds + MOE_TAB_OFF); LAS int* pc = tp + 72; LAS int* cn = pc + 72;
    if (threadIdx.x == 0) {
        const int* cnt = (const int*)(p.ws + WS_CNT) + h * 64;
        int t = 0, q = 0;
        for (int e = 0; e < 65; ++e) { const int c = e < 64 ? cnt[e] : HALF_T; cn[e] = c; tp[e] = t; pc[e] = q; t += (c + 255) >> 8; q += c; }
        tp[65] = t; pc[65] = q;
    }
    __syncthreads();
}
template <bool GU>
struct MoeSched {
    struct Unit { int e, r0t, pn; };
    static constexpr bool GATHER = GU;
    LAS const int* tp; LAS const int* pc; LAS const int* cn;
    const char* Abase; const char* Bt; const int* ltok; int h, nN, nunits, G, c;
    DEV int lda() const { return 256; }
    DEV bool next(int i, Unit& u) const {
        const long L = (long)i * G + c; if (L >= nunits) return false;
        int w = (int)L; { const int q = nunits / 8, r = nunits % 8, xcd = w % 8, off = w / 8; w = (xcd < r ? xcd * (q + 1) : r * (q + 1) + (xcd - r) * q) + off; }
        const int rt = w / nN; u.pn = w % nN;
        int e = 0; while (tp[e + 1] <= rt) ++e;
        u.e = e; u.r0t = (rt - tp[e]) * 256; return true;
    }
    DEV unsigned tokoff(int e, int ce, int idx, int C) const {
        idx = idx < ce ? idx : ce - 1;
        const int tok = e < 64 ? ltok[(size_t)(h * 64 + e) * HALF_T + idx] : h * HALF_T + idx;
        return (unsigned)tok * 4096u + 2048u + (unsigned)C * 2u;
    }
    DEV void addr(const Unit& u, int R0, int C0, int R1, int C1, gp::UAddr& o) const {
        if constexpr (GU) {
            const int ce = cn[u.e];
            o.a = Abase; o.b = Bt + ((size_t)u.e * 512 + u.pn * 256) * 2048;
            o.ao00 = tokoff(u.e, ce, u.r0t + R0, C0); o.ao01 = tokoff(u.e, ce, u.r0t + R1, C1);
            o.ao10 = tokoff(u.e, ce, u.r0t + 128 + R0, C0); o.ao11 = tokoff(u.e, ce, u.r0t + 128 + R1, C1);
        } else {
            o.a = Abase + ((size_t)pc[u.e] + u.r0t) * 512; o.b = Bt + ((size_t)u.e * 1024 + u.pn * 256) * 512;
        }
    }
};
struct EpiMoeGU {
    static constexpr bool PERM = false;
    LAS const int* pc; LAS const int* cn; const float* lwt; bf16_t* HMID; int h;
    template <class U> DEV void operator()(const f32x4 (&acc)[2][2][4][2], const U& u, int wr, int wc, int fr, int fq) const {
        const int ce = cn[u.e]; const size_t prow = (size_t)pc[u.e];
        float wt[2][4];
#pragma unroll
        for (int ai = 0; ai < 2; ++ai)
#pragma unroll
            for (int m = 0; m < 4; ++m) {
                int idx = u.r0t + ai * 128 + wr * 64 + m * 16 + fr; idx = idx < ce ? idx : ce - 1;
                wt[ai][m] = u.e < 64 ? lwt[(size_t)(h * 64 + u.e) * HALF_T + idx] : 1.f;
            }
#pragma unroll
        for (int ai = 0; ai < 2; ++ai)
#pragma unroll
            for (int m = 0; m < 4; ++m) {
                const int idx = u.r0t + ai * 128 + wr * 64 + m * 16 + fr;
                if (idx < ce) {
                    const float w_ = wt[ai][m];
                    bf16_t* rowp = HMID + (prow + idx) * 256 + u.pn * 128 + wc * 16 + 4 * fq;
#pragma unroll
                    for (int bj = 0; bj < 2; ++bj) {
                        const f32x4 gt = acc[ai][bj][m][0], up = acc[ai][bj][m][1];
                        u32x2 w; w.x = pack2(w_ * gt[0] * sigmoid_f(gt[0]) * up[0], w_ * gt[1] * sigmoid_f(gt[1]) * up[1]);
                        w.y = pack2(w_ * gt[2] * sigmoid_f(gt[2]) * up[2], w_ * gt[3] * sigmoid_f(gt[3]) * up[3]);
                        *(u32x2*)(rowp + bj * 64) = w;
                    }
                }
            }
    }
};
struct EpiMoeDN {
    static constexpr bool PERM = true;
    LAS const int* pc; LAS const int* cn; unsigned char* SLAB;
    template <class U> DEV void operator()(const f32x4 (&acc)[2][2][4][2], const U& u, int wr, int wc, int fr, int fq) const {
        const int ce = cn[u.e]; const size_t prow = (size_t)pc[u.e];
#pragma unroll
        for (int ai = 0; ai < 2; ++ai)
#pragma unroll
            for (int m = 0; m < 4; ++m) {
                const int idx = u.r0t + ai * 128 + wr * 64 + m * 16 + fr;
                if (idx < ce) {
                    unsigned char* rowp = SLAB + (prow + idx) * 1024 + u.pn * 256 + wc * 32 + 8 * fq;
#pragma unroll
                    for (int bj = 0; bj < 2; ++bj) {
                        const f32x4 v0 = acc[ai][bj][m][0] * SLAB_SCALE, v1 = acc[ai][bj][m][1] * SLAB_SCALE;
                        int w0 = 0, w1 = 0;
                        w0 = __builtin_amdgcn_cvt_pk_fp8_f32(v0[0], v0[1], w0, false); w0 = __builtin_amdgcn_cvt_pk_fp8_f32(v0[2], v0[3], w0, true);
                        w1 = __builtin_amdgcn_cvt_pk_fp8_f32(v1[0], v1[1], w1, false); w1 = __builtin_amdgcn_cvt_pk_fp8_f32(v1[2], v1[3], w1, true);
                        *(u32x2*)(rowp + bj * 128) = (u32x2){(unsigned)w0, (unsigned)w1};
                    }
                }
            }
    }
};
DEV void fp8x16_add(const u32x4 w, float (&f)[16]) {
    typedef float f2 __attribute__((ext_vector_type(2)));
    const unsigned ww[4] = {w.x, w.y, w.z, w.w};
#pragma unroll
    for (int j = 0; j < 4; ++j) {
        const f2 a = __builtin_amdgcn_cvt_pk_f32_fp8((int)ww[j], false), b = __builtin_amdgcn_cvt_pk_f32_fp8((int)ww[j], true);
        f[4 * j] += a.x; f[4 * j + 1] += a.y; f[4 * j + 2] += b.x; f[4 * j + 3] += b.y;
    }
}
DEV void moe_reduce(const Params& p, LAS unsigned char* lds, int h, int bid, int nb) {
    int tid = threadIdx.x; asm volatile("" : "+v"(tid));
    const int wid = tid >> 6, lane = tid & 63;
    LAS const int* pc = (LAS const int*)(lds + MOE_TAB_OFF) + 72;
    const unsigned char* SLAB = (const unsigned char*)(p.ws + WS_SLAB); const int* PAIR = (const int*)(p.ws + WS_PAIR); const float* ADA = (const float*)(p.ws + WS_ADA);
    for (int it = bid; it < HALF_T / 8; it += nb) {
        const int tokl = it * 8 + wid; const size_t tok = (size_t)h * HALF_T + tokl; const int b = (int)(tok >> 12), col = lane * 16;
        int pr[8];
#pragma unroll
        for (int k = 0; k < 8; ++k) pr[k] = PAIR[tok * 8 + k];
        u32x4 rows[9];
        rows[8] = *(const u32x4*)(SLAB + ((size_t)pc[64] + tokl) * 1024 + col);
#pragma unroll
        for (int k = 0; k < 8; ++k) rows[k] = *(const u32x4*)(SLAB + ((size_t)pc[pr[k] >> 16] + (pr[k] & 0xffff)) * 1024 + col);
        const u32x4 hr0 = *(const u32x4*)((const bf16_t*)p.out + tok * 2048 + col), hr1 = *(const u32x4*)((const bf16_t*)p.out + tok * 2048 + col + 8);
        f32x4 g2v[4], ggv[4], bbv[4];
#pragma unroll
        for (int q = 0; q < 4; ++q) { g2v[q] = *(const f32x4*)(ADA + b * 6144 + 5120 + col + q * 4); ggv[q] = *(const f32x4*)(p.in[37] + col + q * 4); bbv[q] = *(const f32x4*)(p.in[38] + col + q * 4); }
        float f[16];
#pragma unroll
        for (int j = 0; j < 16; ++j) f[j] = 0.f;
#pragma unroll
        for (int k = 0; k < 9; ++k) fp8x16_add(rows[k], f);
        float z[16]; float s = 0.f;
        { float y0[8], y1[8]; bf8_unpack(hr0, y0); bf8_unpack(hr1, y1);
#pragma unroll
          for (int j = 0; j < 8; ++j) { z[j] = y0[j] * ALPHA_F + g2v[j >> 2][j & 3] * (f[j] * (1.f / SLAB_SCALE)); z[8 + j] = y1[j] * ALPHA_F + g2v[2 + (j >> 2)][j & 3] * (f[8 + j] * (1.f / SLAB_SCALE)); }
#pragma unroll
          for (int j = 0; j < 16; ++j) s += z[j]; }
        const float mean = wave_sum(s) * (1.f / 1024.f); float qq = 0.f;
#pragma unroll
        for (int j = 0; j < 16; ++j) { const float d = z[j] - mean; qq += d * d; }
        const float rstd = rsqrtf(wave_sum(qq) * (1.f / 1024.f) + LN_EPS_F);
#pragma unroll
        for (int q = 0; q < 4; ++q) {
            f32x4 o;
#pragma unroll
            for (int j = 0; j < 4; ++j) o[j] = (z[q * 4 + j] - mean) * rstd * ggv[q][j] + bbv[q][j];
            *(f32x4*)(p.out + tok * 1024 + col + q * 4) = o;
        }
    }
}

#define ADA ((float*)(p.ws + WS_ADA))
#define HB ((bf16_t*)(p.ws + WS_HB))
#define BTIN ((bf16_t*)(p.ws + WS_BTIN))
#define HM ((bf16_t*)(p.ws + WS_HM))
#define US5 ((bf16_t*)(p.ws + WS_US5))
#define ULRU ((bf16_t*)(p.ws + WS_ULRU))
#define SLOC ((float*)(p.ws + WS_SLOC))
#define YS5 ((bf16_t*)(p.ws + WS_YS5))
#define YCAT ((bf16_t*)(p.ws + WS_YCAT))
#define Y ((bf16_t*)(p.ws + WS_Y))
#define LTOK ((int*)(p.ws + WS_LTOK))
#define LWT ((float*)(p.ws + WS_LWT))
#define HMID ((bf16_t*)(p.ws + WS_HMID))
#define SLAB ((unsigned char*)(p.ws + WS_SLAB))
#define PAIR ((int*)(p.ws + WS_PAIR))
#define CNT ((int*)(p.ws + WS_CNT))
__global__ void __launch_bounds__(512) mk_fwd(Params p) {
    extern __shared__ __attribute__((aligned(16))) unsigned char lds_raw[];
    LAS unsigned char* lds = (LAS unsigned char*)lds_raw;
    const int bid = blockIdx.x, nb = gridDim.x;
    volatile LAS unsigned* MISC = (volatile LAS unsigned*)(lds + MISC_OFF);
    if (threadIdx.x < 64) MISC[threadIdx.x] = 0u;
    __syncthreads();
    unsigned char* const ws = p.ws;
    XcdBarrier bar; bar.bar = (unsigned*)(ws + WS_CTL); bar.x = 0; bar.st = nullptr;
    const bool fused = (p.ph_hi - p.ph_lo) > 1;
    if (fused) bar = xcd_barrier_post((unsigned*)(ws + WS_CTL), MISC + 8);

    const int lo = p.ph_lo, hi = p.ph_hi;
#ifndef PROBE_REP_PH
#define PROBE_REP_PH -1
#endif
#define IN(k) (lo <= (k) && (k) < hi)
#ifndef PROBE_TIME
#define PROBE_TIME -1
#endif
    unsigned long long tprobe0_ = 0, tprobe1_ = 0;
#ifndef PROBE_SEC
#define PROBE_SEC -1
#endif
    unsigned long long tsec_acc_ = 0, tsec_t0_ = 0;
#define SEC_BEGIN(id) do { if (PROBE_SEC == (id)) { __builtin_amdgcn_s_waitcnt(0); tsec_t0_ = __builtin_amdgcn_s_memrealtime(); } } while (0)
#define SEC_END(id) do { if (PROBE_SEC == (id)) { __builtin_amdgcn_s_waitcnt(0); tsec_acc_ += __builtin_amdgcn_s_memrealtime() - tsec_t0_; } } while (0)
#define TSTAMP(k) do { if (PROBE_TIME >= 0) { if ((k) == PROBE_TIME) tprobe0_ = __builtin_amdgcn_s_memrealtime(); if ((k) == PROBE_TIME + 1) tprobe1_ = __builtin_amdgcn_s_memrealtime(); } } while (0)
#define TIDS int tid = threadIdx.x; asm volatile("" : "+v"(tid)); const int wid = tid >> 6, lane = tid & 63; (void)wid; (void)lane
#define REPS(k) (((k) == PROBE_REP_PH) ? 2 : 1)
#ifndef PROBE_SUB
#define PROBE_SUB -1
#endif
#define SUBREPS(k) (((k) == PROBE_SUB) ? 2 : 1)
#define SEAM(k) do { if (IN(k) && IN((k) + 1)) xcd_barrier(bar); else __syncthreads(); TSTAMP((k) + 1); } while (0)
    {
        TSTAMP(0);
        for (int rep_ = 0; rep_ < REPS(0); ++rep_) if (IN(0)) { if (rep_) xcd_barrier(bar); TIDS;
            for (int sr_ = 0; sr_ < SUBREPS(1); ++sr_)
            for (int it = bid; it < 256; it += nb) s5_tables(p, lds, it >> 3, it & 7);
            {
                LAS float* S = (LAS float*)lds; LAS float* red = S + 9216;
                __syncthreads();
                for (int i = tid; i < 9216; i += 512) { const float c = i < 8192 ? p.in[1][i] : p.in[3][i - 8192]; S[i] = c * sigmoid_f(c); }
                if (bid == nb - 1) for (int i = tid; i < 1024; i += 512) ((float*)(ws + WS_LCA))[i] = -8.f * 1.4426950408889634f * log1pf(__expf(-p.in[25][i]));
                if (bid >= nb - 9 && bid < nb - 1) for (int i = (bid - (nb - 9)) * 8192 + tid; i < (bid - (nb - 9) + 1) * 8192; i += 512) {
                    const int e = i & 63, k = i >> 6; const float wv = p.in[29][i]; const unsigned hi = f2bf(wv); const float rem = wv - __uint_as_float(hi << 16);
                    ((bf16_t*)(ws + WS_RWH))[e * 1024 + k] = (bf16_t)hi; ((bf16_t*)(ws + WS_RWL))[e * 1024 + k] = (bf16_t)f2bf(rem);
                }
                __syncthreads();
                for (int sr_ = 0; sr_ < SUBREPS(2); ++sr_)
                for (int it = bid; it < 192; it += nb) gemv9_item(S, p.in[6], 6144, it * 32, p.in[7], ADA, 6144, red);
                __syncthreads();
            }
            {
                LAS float* tile = (LAS float*)lds + wid * (64 * 65);
                for (int sr_ = 0; sr_ < SUBREPS(3); ++sr_)
                for (int it = bid * 8 + wid; it < 736; it += nb * 8) {
                    if (it < 64) { tr_tile_wave(p.in[17], 512, (it >> 3) * 64, (it & 7) * 64, (bf16_t*)(ws + WS_BTGLU), 512, 0, tile, lane); }
                    else if (it < 320) { const int i2 = it - 64; tr_tile_wave(p.in[26], 1024, (i2 >> 4) * 64, (i2 & 15) * 64, (bf16_t*)(ws + WS_BTOUT), 1024, 0, tile, lane); }
                    else if (it < 352) {
                        const int i2 = it - 320, dir = i2 >> 4, ax = (i2 >> 3) & 1, h = i2 & 7;
                        const float* W = (ax ? p.in[23] : p.in[21]) + (size_t)(dir * 8 + h) * 4096;
                        tr_tile_wave(W, 64, 0, 0, (bf16_t*)(ws + WS_BTLRU) + (size_t)(h * 256 + dir * 128 + ax * 64) * 64, 64, 0, tile, lane);
                    } else {
                        const int i2 = it - 352;
                        tr_tile_wave(p.in[8], NWIN, (i2 / 24) * 64, (i2 % 24) * 64, BTIN, 1024, 0, tile, lane);
                    }
                }
            }
        }
        SEAM(0);
        for (int rep_ = 0; rep_ < REPS(1); ++rep_) if (IN(1)) { if (rep_) xcd_barrier(bar); TIDS;
            SEC_BEGIN(5);
            for (int it = bid; it < 256; it += nb) s5_fill(p, lds, it >> 3, it & 7);
            SEC_END(5); SEC_BEGIN(6);
            for (int it = bid; it < TT / 32; it += nb) {
                const int row0 = it * 32 + wid * 4;
                f32x4 v[4][4]; float s[4];
#pragma unroll
                for (int rr = 0; rr < 4; ++rr) {
                    const int row = row0 + rr;
                    const float* src = row < T ? p.in[0] + (size_t)row * 1024 : p.in[2] + (size_t)(row - T) * 1024;
#pragma unroll
                    for (int q = 0; q < 4; ++q) v[rr][q] = *(const f32x4*)(src + q * 256 + lane * 4);
                }
                f32x4 gg[4], bbv[4], sh1[4], sc1[4];
                { const float* ada = ADA + (row0 < T ? (row0 >> 12) : 8) * 6144;
#pragma unroll
                  for (int q = 0; q < 4; ++q) { const int col = q * 256 + lane * 4; gg[q] = *(const f32x4*)(p.in[4] + col); bbv[q] = *(const f32x4*)(p.in[5] + col); sh1[q] = *(const f32x4*)(ada + col); sc1[q] = *(const f32x4*)(ada + 1024 + col); } }
#pragma unroll
                for (int rr = 0; rr < 4; ++rr) { float a = 0.f;
#pragma unroll
                    for (int q = 0; q < 4; ++q) a += (v[rr][q][0] + v[rr][q][1]) + (v[rr][q][2] + v[rr][q][3]);
                    s[rr] = a; }
#pragma unroll
                for (int o = 1; o < 64; o <<= 1) {
#pragma unroll
                    for (int rr = 0; rr < 4; ++rr) s[rr] += __shfl_xor(s[rr], o); }
                float mean[4], qq[4];
#pragma unroll
                for (int rr = 0; rr < 4; ++rr) { mean[rr] = s[rr] * (1.f / 1024.f); float a = 0.f;
#pragma unroll
                    for (int q = 0; q < 4; ++q) { const f32x4 d = v[rr][q] - mean[rr]; a += (d[0] * d[0] + d[1] * d[1]) + (d[2] * d[2] + d[3] * d[3]); }
                    qq[rr] = a; }
#pragma unroll
                for (int o = 1; o < 64; o <<= 1) {
#pragma unroll
                    for (int rr = 0; rr < 4; ++rr) qq[rr] += __shfl_xor(qq[rr], o); }
                float rstd[4];
#pragma unroll
                for (int rr = 0; rr < 4; ++rr) rstd[rr] = rsqrtf(qq[rr] * (1.f / 1024.f) + LN_EPS_F);
#pragma unroll
                for (int q = 0; q < 4; ++q) {
                    const int col = q * 256 + lane * 4;
#pragma unroll
                    for (int rr = 0; rr < 4; ++rr) {
                        const int row = row0 + rr;
                        const f32x4 o = (v[rr][q] - mean[rr]) * rstd[rr] * gg[q] + bbv[q];
                        u32x2 w; w.x = pack2(o[0], o[1]); w.y = pack2(o[2], o[3]);
                        *(u32x2*)(HB + (size_t)row * 1024 + col) = w;
                        const f32x4 om = o * (sc1[q] + 1.f) + sh1[q];
                        u32x2 wm; wm.x = pack2(om[0], om[1]); wm.y = pack2(om[2], om[3]);
                        *(u32x2*)(HM + (size_t)row * 1024 + col) = wm;
                    }
                }
            }
            SEC_END(6);
        }
        SEAM(1);
        for (int rep_ = 0; rep_ < REPS(2); ++rep_) if (IN(2)) { if (rep_) xcd_barrier(bar); TIDS;
            { WinSched S{(const char*)HM, (const char*)BTIN, nb, bid};
              EpiWin E{US5, ULRU};
              gp::gemm_phase(lds, 1024, S, E); }
            {
                int bid_ = bid; asm volatile("" : "+s"(bid_));
                int tid2 = threadIdx.x; asm volatile("" : "+v"(tid2));
                const int wid2 = tid2 >> 6, lane2 = tid2 & 63;
                const int nfull = (136 * 6) % nb;
                const int nlow = nfull ? nb - nfull : nb, myi = nfull ? bid_ - nfull : bid_;
                if (myi >= 0) {
                    LAS float* tile = (LAS float*)lds + wid2 * (64 * 65);
                    const int step = nlow * 8; int it = myi * 8 + wid2;
                    f32x4 va[16], vb[16];
                    TrTile ta, tb;
                    if (it < 12480) { ta = expert_tile(p, it); tr_load(ta, lane2, va); }
#pragma unroll 1
                    while (it < 12480) {
                        const int i1 = it + step, i2 = it + 2 * step;
                        if (i1 < 12480) { tb = expert_tile(p, i1); tr_load(tb, lane2, vb); }
                        tr_store(ta, lane2, va, tile);
                        if (i1 >= 12480) break;
                        if (i2 < 12480) { ta = expert_tile(p, i2); tr_load(ta, lane2, va); }
                        tr_store(tb, lane2, vb, tile);
                        it = i2;
                    }
                }
            }
        }
        SEAM(2);
        for (int rep_ = 0; rep_ < REPS(3); ++rep_) if (IN(3)) { if (rep_) xcd_barrier(bar); TIDS;
            const bf16_t* ES5 = (const bf16_t*)(ws + WS_ES5);
            { S5Sched S{(const char*)US5, (const char*)ES5, 512, 5, 1, 256, nb, bid}; EpiS5Loc E{SLOC}; gp::gemm_phase(lds, 512, S, E); }
            __syncthreads();
            int bid_ = bid; asm volatile("" : "+s"(bid_));
#if PROBE_SUB == 6 || PROBE_SUB == 7
            lru_load_probe(p, bid_, nb);
#endif
            for (int sr_ = 0; sr_ < SUBREPS(4); ++sr_) lru_phase<false>(p, lds, bid_, nb);
        }
        SEAM(3);
#if PROBE_SUB == 8
        for (int xb_ = 0; xb_ < 10; ++xb_) xcd_barrier(bar);
#endif
        for (int rep_ = 0; rep_ < REPS(4); ++rep_) if (IN(4)) { if (rep_) xcd_barrier(bar); TIDS;
            const float* ALC = (const float*)(ws + WS_ALC);
            if (tid < 128) for (int i = bid * 128 + tid; i < 32768; i += nb * 128) {
                const int pp = i & 63, dir = (i >> 6) & 1, g = (i >> 7) & 31, b = i >> 12;
                const float ar = ALC[((dir * 32 + g) * 64 + pp) * 2], ai = ALC[((dir * 32 + g) * 64 + pp) * 2 + 1];
                float xr = 0.f, xi = 0.f;
                const float* Sg = SLOC + (size_t)g * M5 * 256 + dir * 128 + pp;
                {
                    float sr[NCC], si[NCC];
#pragma unroll
                    for (int s = 0; s < NCC; ++s) { const int j = dir ? NCC - 1 - s : s, m = M5LAT + b * NCC + j; sr[s] = Sg[(size_t)m * 256]; si[s] = Sg[(size_t)m * 256 + 64]; }
#pragma unroll
                    for (int s = 0; s < NCC; ++s) { const float nr = ar * xr - ai * xi + sr[s], ni = ar * xi + ai * xr + si[s]; xr = nr; xi = ni; }
                }
#pragma unroll 1
                for (int s0 = 0; s0 < NCH; s0 += 32) {
                    float sr[32], si[32];
#pragma unroll
                    for (int q = 0; q < 32; ++q) { const int k = dir ? NCH - 1 - (s0 + q) : s0 + q, m = b * NCH + k; sr[q] = Sg[(size_t)m * 256]; si[q] = Sg[(size_t)m * 256 + 64]; }
#pragma unroll
                    for (int q = 0; q < 32; ++q) {
                        const int k = dir ? NCH - 1 - (s0 + q) : s0 + q, m = b * NCH + k;
                        bf16_t* dst = US5 + ((size_t)(g * M5PAD + m)) * KT5 + 512 + dir * 128 + pp;
                        dst[0] = (bf16_t)f2bf(xr); dst[64] = (bf16_t)f2bf(xi);
                        const float nr = ar * xr - ai * xi + sr[q], ni = ar * xi + ai * xr + si[q]; xr = nr; xi = ni;
                    }
                }
            }
            const float* SA = (const float*)(ws + WS_SA); const float* SB = (const float*)(ws + WS_SB); float* HIN = (float*)(ws + WS_HIN);
            if (tid >= 128 && tid < 160) for (int i = bid * 32 + (tid - 128); i < 8192; i += nb * 32) {
                const int chn = i & 511, dir = (i >> 9) & 1, b = i >> 10;
                float H = 0.f;
                {
                    float av[4], bv[4];
#pragma unroll
                    for (int s = 0; s < 4; ++s) { const int c = 64 + (dir ? 3 - s : s); const size_t o = ((size_t)(b * 68 + c) * 2 + dir) * 512 + chn; av[s] = SA[o]; bv[s] = SB[o]; }
#pragma unroll
                    for (int s = 0; s < 4; ++s) H = av[s] * H + bv[s];
                }
#pragma unroll 1
                for (int s0 = 0; s0 < 64; s0 += 32) {
                    float av[32], bv[32];
#pragma unroll
                    for (int q = 0; q < 32; ++q) { const int c = dir ? 63 - (s0 + q) : s0 + q; const size_t o = ((size_t)(b * 68 + c) * 2 + dir) * 512 + chn; av[q] = SA[o]; bv[q] = SB[o]; }
#pragma unroll
                    for (int q = 0; q < 32; ++q) {
                        const int c = dir ? 63 - (s0 + q) : s0 + q;
                        HIN[((size_t)(b * 64 + c) * 2 + dir) * 512 + chn] = H;
                        H = av[q] * H + bv[q];
                    }
                }
            }
        }
        SEAM(4);
        for (int rep_ = 0; rep_ < REPS(5); ++rep_) if (IN(5)) { if (rep_) xcd_barrier(bar); TIDS;
            const bf16_t* BS5 = (const bf16_t*)(ws + WS_BS5);
            { S5Sched S{(const char*)US5, (const char*)BS5, KT5, 4, 2, 512, nb, bid}; EpiS5Out E{YS5}; gp::gemm_phase(lds, KT5, S, E); }
            __syncthreads();
            int bid_ = bid; asm volatile("" : "+s"(bid_));
            for (int sr_ = 0; sr_ < SUBREPS(5); ++sr_) lru_phase<true>(p, lds, bid_, nb);
        }
        SEAM(5);
        for (int rep_ = 0; rep_ < REPS(6); ++rep_) if (IN(6)) { if (rep_) xcd_barrier(bar); TIDS;
            const bf16_t* BTGLU = (const bf16_t*)(ws + WS_BTGLU); const float* b_glu = p.in[18];
            PlainSched S{(const char*)YS5, (const char*)BTGLU, 512, 512, 128, 2, nb, bid};
            EpiGlu E{YS5, b_glu, YCAT};
            gp::gemm_phase(lds, 512, S, E);
        }
        SEAM(6);
        for (int rep_ = 0; rep_ < REPS(7); ++rep_) if (IN(7)) { if (rep_) xcd_barrier(bar); TIDS;
            const bf16_t* BTOUT = (const bf16_t*)(ws + WS_BTOUT);
            PlainSched S{(const char*)YCAT, (const char*)BTOUT, 1024, 1024, 128, 4, nb, bid};
            EpiBf16 E{Y, 1024};
            gp::gemm_phase(lds, 1024, S, E);
        }
        SEAM(7);
        if (IN(8)) { TIDS;
            LAS unsigned char* VH = lds;
            LAS float* PART = (LAS float*)lds;
            LAS int* DEC = (LAS int*)(lds + 132096);
            LAS float* DECW = (LAS float*)(lds + 132096 + 4096);
            LAS int* lcnt = (LAS int*)(lds + 148480); LAS int* gbase = lcnt + 128;
            const int fr = lane & 15, fq = lane >> 4;
            const float rbias = p.in[30][lane];
            if (tid < 128) lcnt[tid] = 0;
            bf16x8 bw[4][4];
#pragma unroll
            for (int kk = 0; kk < 4; ++kk)
#pragma unroll
                for (int nt = 0; nt < 4; ++nt) bw[kk][nt] = *(const bf16x8*)((const bf16_t*)(ws + WS_RWH) + (size_t)(nt * 16 + fr) * 1024 + (wid * 4 + kk) * 32 + fq * 8);
            int nit = 0, it_first = bid;
            for (int it = bid; it < T / 64; it += nb) {
                const int t0 = it * 64;
                SEC_BEGIN(1);
#pragma unroll 1
                for (int rnd = 0; rnd < 4; ++rnd) {
                    const size_t tok0 = (size_t)t0 + wid * 8 + rnd * 2; const int b = (int)(tok0 >> 12);
                    const float* ada = ADA + b * 6144;
                    f32x4 z[2][4]; float s4[2];
                    {
                        u32x2 hh[2][4], yv[2][4]; f32x4 g1[4];
#pragma unroll
                        for (int q = 0; q < 4; ++q) g1[q] = *(const f32x4*)(ada + 2048 + q * 256 + lane * 4);
#pragma unroll
                        for (int rr = 0; rr < 2; ++rr)
#pragma unroll
                            for (int q = 0; q < 4; ++q) { const int col = q * 256 + lane * 4; hh[rr][q] = *(const u32x2*)(HB + (tok0 + rr) * 1024 + col); yv[rr][q] = *(const u32x2*)(Y + (size_t)cmaj((int)(tok0 + rr)) * 1024 + col); }
#pragma unroll
                        for (int rr = 0; rr < 2; ++rr) { float a = 0.f;
#pragma unroll
                            for (int q = 0; q < 4; ++q) {
                                f32x4 hv; hv[0] = __uint_as_float(hh[rr][q].x << 16); hv[1] = __uint_as_float(hh[rr][q].x & 0xffff0000u); hv[2] = __uint_as_float(hh[rr][q].y << 16); hv[3] = __uint_as_float(hh[rr][q].y & 0xffff0000u);
                                f32x4 yf; yf[0] = __uint_as_float(yv[rr][q].x << 16); yf[1] = __uint_as_float(yv[rr][q].x & 0xffff0000u); yf[2] = __uint_as_float(yv[rr][q].y << 16); yf[3] = __uint_as_float(yv[rr][q].y & 0xffff0000u);
                                z[rr][q] = hv * ALPHA_F + g1[q] * yf;
                                a += (z[rr][q][0] + z[rr][q][1]) + (z[rr][q][2] + z[rr][q][3]);
                            }
                            s4[rr] = a; }
                    }
                    f32x4 gg[4], bbv[4], sc2[4], sh2[4];
#pragma unroll
                    for (int q = 0; q < 4; ++q) { const int col = q * 256 + lane * 4; gg[q] = *(const f32x4*)(p.in[27] + col); bbv[q] = *(const f32x4*)(p.in[28] + col); sc2[q] = *(const f32x4*)(ada + 4096 + col); sh2[q] = *(const f32x4*)(ada + 3072 + col); }
#pragma unroll
                    for (int o = 1; o < 64; o <<= 1) {
#pragma unroll
                        for (int rr = 0; rr < 2; ++rr) s4[rr] += __shfl_xor(s4[rr], o); }
                    float mean[2], q4[2];
#pragma unroll
                    for (int rr = 0; rr < 2; ++rr) { mean[rr] = s4[rr] * (1.f / 1024.f); float a = 0.f;
#pragma unroll
                        for (int q = 0; q < 4; ++q) { const f32x4 d = z[rr][q] - mean[rr]; a += (d[0] * d[0] + d[1] * d[1]) + (d[2] * d[2] + d[3] * d[3]); }
                        q4[rr] = a; }
#pragma unroll
                    for (int o = 1; o < 64; o <<= 1) {
#pragma unroll
                        for (int rr = 0; rr < 2; ++rr) q4[rr] += __shfl_xor(q4[rr], o); }
#pragma unroll
                    for (int rr = 0; rr < 2; ++rr) {
                        const float rstd = rsqrtf(q4[rr] * (1.f / 1024.f) + LN_EPS_F);
                        const size_t tok = tok0 + rr; const int tl = wid * 8 + rnd * 2 + rr;
#pragma unroll
                        for (int q = 0; q < 4; ++q) {
                            const int col = q * 256 + lane * 4;
                            const f32x4 h1 = (z[rr][q] - mean[rr]) * rstd * gg[q] + bbv[q];
                            { u32x2 wh; wh.x = pack2(h1[0], h1[1]); wh.y = pack2(h1[2], h1[3]); *(u32x2*)((bf16_t*)p.out + tok * 2048 + col) = wh; }
                            const f32x4 v = h1 * (sc2[q] + 1.f) + sh2[q];
                            u32x2 w; w.x = pack2(v[0], v[1]); w.y = pack2(v[2], v[3]);
                            *(u32x2*)((bf16_t*)p.out + tok * 2048 + 1024 + col) = w;
                            *(LAS u32x2*)(VH + tl * 2064 + col * 2) = w;
                        }
                    }
                }
                __syncthreads();
                SEC_END(1); SEC_BEGIN(2);
                {
                    f32x4 acc[4][4];
#pragma unroll
                    for (int mt = 0; mt < 4; ++mt)
#pragma unroll
                        for (int nt = 0; nt < 4; ++nt) acc[mt][nt] = (f32x4){0.f, 0.f, 0.f, 0.f};
#pragma unroll
                    for (int kk = 0; kk < 4; ++kk) {
                        const int k0 = (wid * 4 + kk) * 32 + fq * 8;
#pragma unroll
                        for (int mt = 0; mt < 4; ++mt) {
                            const bf16x8 av = *(LAS const bf16x8*)(VH + (mt * 16 + fr) * 2064 + k0 * 2);
#pragma unroll
                            for (int nt = 0; nt < 4; ++nt) acc[mt][nt] = __builtin_amdgcn_mfma_f32_16x16x32_bf16(bw[kk][nt], av, acc[mt][nt], 0, 0, 0);
                        }
                    }
                    __syncthreads();
#pragma unroll
                    for (int mt = 0; mt < 4; ++mt)
#pragma unroll
                        for (int nt = 0; nt < 4; ++nt) *(LAS f32x4*)(PART + (wid * 64 + mt * 16 + fr) * 64 + nt * 16 + 4 * fq) = acc[mt][nt];
                }
                __syncthreads();
                SEC_END(2); SEC_BEGIN(3);
                {
                    const int hh = t0 >> 14;
#pragma unroll 2
                    for (int r = 0; r < 8; ++r) {
                        const int tl = wid * 8 + r;
                        float lg = 0.f;
#pragma unroll
                        for (int w8 = 0; w8 < 8; ++w8) lg += PART[(w8 * 64 + tl) * 64 + lane];
                        const float sc = sigmoid_f(lg), sel = sc + rbias;
                        float m1 = sel; m1 = fmaxf(m1, __shfl_xor(m1, 1)); m1 = fmaxf(m1, __shfl_xor(m1, 2)); m1 = fmaxf(m1, __shfl_xor(m1, 4));
                        const unsigned long long bal = __ballot(sel == m1);
                        const unsigned gb = (unsigned)(bal >> (lane & 56)) & 0xffu;
                        const int first = __builtin_ctz(gb | 0x100u);
                        float m2 = ((lane & 7) == first) ? -INFINITY : sel; m2 = fmaxf(m2, __shfl_xor(m2, 1)); m2 = fmaxf(m2, __shfl_xor(m2, 2)); m2 = fmaxf(m2, __shfl_xor(m2, 4));
                        const float gs = m1 + m2;
                        int grank = 0; const int mygrp = lane >> 3;
#pragma unroll
                        for (int j = 0; j < 8; ++j) { const float gj = __builtin_bit_cast(float, __builtin_amdgcn_readlane(__builtin_bit_cast(int, gs), 8 * j)); grank += (gj > gs || (gj == gs && j < mygrp)) ? 1 : 0; }
                        const bool selected = grank < 4;
                        const unsigned long long gmask = __ballot(selected);
                        const float mv = selected ? sel : -INFINITY;
                        int rank = 0;
#pragma unroll
                        for (int j = 0; j < 64; ++j) {
                            if ((gmask >> j) & 1ull) { const float vj = __builtin_bit_cast(float, __builtin_amdgcn_readlane(__builtin_bit_cast(int, mv), j)); rank += (vj > mv || (vj == mv && j < lane)) ? 1 : 0; }
                        }
                        const bool chosen = selected && rank < 8;
                        const float wsum = wave_sum(chosen ? sc : 0.f);
                        if (chosen) {
                            const int lr = __hip_atomic_fetch_add(lcnt + hh * 64 + lane, 1, __ATOMIC_RELAXED, __HIP_MEMORY_SCOPE_WORKGROUP);
                            DEC[((nit & 1) * 64 + tl) * 8 + rank] = (lane << 16) | lr; DECW[((nit & 1) * 64 + tl) * 8 + rank] = sc / wsum * 2.5f;
                        }
                    }
                }
                __syncthreads();
                SEC_END(3); SEC_BEGIN(4);
                ++nit;
                const bool last = (it + nb >= T / 64);
                if ((nit & 1) == 0 || last) {
                    const int nflush = (nit & 1) == 0 ? 2 : 1;
                    if (tid < 128) { const int c = lcnt[tid]; gbase[tid] = c ? atomicAdd(CNT + tid, c) : 0; lcnt[tid] = 0; }
                    __syncthreads();
                    for (int n = tid; n < nflush * 512; n += 512) {
                        const int g2 = n >> 9, tl = (n >> 3) & 63, tok = (it_first + g2 * nb) * 64 + tl, hq = tok >> 14;
                        const int d = DEC[n], e = d >> 16, rk = gbase[hq * 64 + e] + (d & 0xffff);
                        const size_t pos = (size_t)(hq * 64 + e) * HALF_T + rk;
                        LTOK[pos] = tok; LWT[pos] = DECW[n]; PAIR[(size_t)tok * 8 + (n & 7)] = (e << 16) | rk;
                    }
                    __syncthreads();
                    it_first = it + nb;
                }
                SEC_END(4);
            }
        }
        SEAM(8);
        for (int rep_ = 0; rep_ < REPS(9); ++rep_) if (IN(9)) { if (rep_) xcd_barrier(bar); TIDS;
            moe_tables(p, lds, 0);
            LAS const int* tp = (LAS const int*)(lds + MOE_TAB_OFF); LAS const int* pc = tp + 72; LAS const int* cn = pc + 72;
            MoeSched<true> S{tp, pc, cn, (const char*)p.out, (const char*)(ws + WS_BTGU), LTOK, 0, 2, tp[65] * 2, nb, bid};
            EpiMoeGU E{pc, cn, LWT, HMID, 0};
            gp::gemm_phase(lds, 1024, S, E);
        }
        SEAM(9);
        for (int rep_ = 0; rep_ < REPS(10); ++rep_) if (IN(10)) { if (rep_) xcd_barrier(bar); TIDS;
            moe_tables(p, lds, 0);
            LAS const int* tp = (LAS const int*)(lds + MOE_TAB_OFF); LAS const int* pc = tp + 72; LAS const int* cn = pc + 72;
            MoeSched<false> S{tp, pc, cn, (const char*)HMID, (const char*)(ws + WS_BTDN), LTOK, 0, 4, tp[65] * 4, nb, bid};
            EpiMoeDN E{pc, cn, SLAB};
            gp::gemm_phase(lds, 256, S, E);
        }
        SEAM(10);
        if (IN(11)) { TIDS;
            {
                moe_tables(p, lds, 1);
                LAS const int* tp = (LAS const int*)(lds + MOE_TAB_OFF); LAS const int* pc = tp + 72; LAS const int* cn = pc + 72;
                MoeSched<true> S{tp, pc, cn, (const char*)p.out, (const char*)(ws + WS_BTGU), LTOK, 1, 2, tp[65] * 2, nb, bid};
                EpiMoeGU E{pc, cn, LWT, HMID, 1};
                gp::gemm_phase(lds, 1024, S, E);
            }
            __syncthreads();
            int bid_ = bid; asm volatile("" : "+s"(bid_));
            moe_tables(p, lds, 0);
            moe_reduce(p, lds, 0, bid_, nb);
        }
        SEAM(11);
        for (int rep_ = 0; rep_ < REPS(12); ++rep_) if (IN(12)) { if (rep_) xcd_barrier(bar); TIDS;
            moe_tables(p, lds, 1);
            LAS const int* tp = (LAS const int*)(lds + MOE_TAB_OFF); LAS const int* pc = tp + 72; LAS const int* cn = pc + 72;
            MoeSched<false> S{tp, pc, cn, (const char*)HMID, (const char*)(ws + WS_BTDN), LTOK, 1, 4, tp[65] * 4, nb, bid};
            EpiMoeDN E{pc, cn, SLAB};
            gp::gemm_phase(lds, 256, S, E);
        }
        SEAM(12);
        if (IN(13)) { TIDS;
            moe_tables(p, lds, 1);
            moe_reduce(p, lds, 1, bid, nb);
        }
        if (PROBE_SEC >= 0 && bid == 0) { const unsigned long long d_ = tsec_acc_ * 8ull, t0_ = __builtin_amdgcn_s_memrealtime(); while (__builtin_amdgcn_s_memrealtime() - t0_ < d_) __builtin_amdgcn_s_sleep(8); }
        if (PROBE_TIME >= 0) {
            if (PROBE_TIME == 13) { xcd_barrier(bar); tprobe1_ = __builtin_amdgcn_s_memrealtime(); }
            if (bid == 0) { const unsigned long long d_ = (tprobe1_ - tprobe0_) * 8ull, t0_ = __builtin_amdgcn_s_memrealtime(); while (__builtin_amdgcn_s_memrealtime() - t0_ < d_) __builtin_amdgcn_s_sleep(8); }
        }
    }
}

extern "C" void kernel_launch(void* const* d_in, const int* in_sizes, int n_in, void* d_out, int out_size, void* d_ws, size_t ws_size, hipStream_t stream) {
    static int grid = 0;
    if (grid == 0) {
        if (n_in != 39 || out_size != T * D || ws_size < WS_END) { fprintf(stderr, "kernel_launch: unexpected problem (n_in %d, out %d, ws %zu); nothing launched\n", n_in, out_size, ws_size); grid = -1; return; }
        int dev = 0, cus = 0;
        if (hipGetDevice(&dev) != hipSuccess || hipDeviceGetAttribute(&cus, hipDeviceAttributeMultiprocessorCount, dev) != hipSuccess) { grid = -1; return; }
        if (hipFuncSetAttribute((const void*)mk_fwd, hipFuncAttributeMaxDynamicSharedMemorySize, LDS_BYTES) != hipSuccess) { fprintf(stderr, "kernel_launch: hipFuncSetAttribute failed\n"); grid = -1; return; }
        grid = cus > 0 ? cus : 256;
    }
    if (grid < 0) return;
    (void)in_sizes;
    if (hipMemsetAsync((char*)d_ws + WS_CTL, 0, CTL_ZERO_BYTES, stream) != hipSuccess) return;
    Params p{};
    for (int i = 0; i < 39; ++i) p.in[i] = (const float*)d_in[i];
    p.out = (float*)d_out; p.ws = (unsigned char*)d_ws;
#if MK_N_LAUNCHES == 1
    p.ph_lo = 0; p.ph_hi = NPHASE;
    hipLaunchKernelGGL(mk_fwd, dim3(grid), dim3(512), LDS_BYTES, stream, p);
#else
    for (int ph = 0; ph < NPHASE; ++ph) {
        p.ph_lo = ph; p.ph_hi = ph + 1;
        hipLaunchKernelGGL(mk_fwd, dim3(grid), dim3(512), LDS_BYTES, stream, p);
    }
#endif
}
```

```cpp
#include <hip/hip_runtime.h>
#include <cstdio>
#include <cstdint>

#ifndef MK_N_LAUNCHES
#define MK_N_LAUNCHES 1
#endif

#define DEV __device__ __forceinline__
#define LAS __attribute__((address_space(3)))
typedef unsigned short bf16_t;
typedef short bf16x8 __attribute__((ext_vector_type(8)));
typedef float f32x4 __attribute__((ext_vector_type(4)));
typedef unsigned u32x2 __attribute__((ext_vector_type(2)));
typedef unsigned u32x4 __attribute__((ext_vector_type(4)));

constexpr int D = 1024, NBATCH = 8, SEQ = 4096, T = NBATCH * SEQ, CTXL = 256, TC = NBATCH * CTXL, TT = T + TC;
constexpr int NWIN = 1536;
constexpr int LC = 32, KT5 = 768, NCH = SEQ / LC  , NCC = CTXL / LC  ;
constexpr int M5LAT = NBATCH * NCH  , M5 = M5LAT + NBATCH * NCC  , M5PAD = 1280;
constexpr int NE = 64;
constexpr int NPHASE = 12;
constexpr int HALF_T = T;
constexpr float ALPHA_F = 1.189207115002721f, LN_EPS_F = 1e-5f;

constexpr size_t MiB = 1u << 20;
constexpr size_t WS_CTL = 0, CTL_ZERO_BYTES = 65536;
constexpr size_t WS_CNT = 32768;
constexpr size_t WS_ADA = 65536;
constexpr size_t WS_RWH = 384 * 1024;
constexpr size_t WS_RWL = 512 * 1024;
constexpr size_t WS_ALC = 640 * 1024;
constexpr size_t WS_LCA = 768 * 1024;
constexpr size_t WS_SA = 1 * MiB, WS_SB = 4 * MiB, WS_HIN = 7 * MiB;
constexpr size_t WS_BTGLU = 10 * MiB;
constexpr size_t WS_BTOUT = 10 * MiB + 512 * 1024;
constexpr size_t WS_BTLRU = 12 * MiB + 512 * 1024;
constexpr size_t WS_BS5 = 13 * MiB;
constexpr size_t WS_ES5 = 37 * MiB;
constexpr size_t WS_BTGU = 45 * MiB;
constexpr size_t WS_BTDN = 110 * MiB;
constexpr size_t WS_HB = 143 * MiB;
constexpr size_t WS_BTIN = 211 * MiB;
constexpr size_t WS_KTAB = 214 * MiB;
constexpr size_t WS_APR = 216 * MiB, WS_API = 217 * MiB;
constexpr size_t WS_BBR = 218 * MiB, WS_BBI = 218 * MiB + 256 * 1024;
constexpr size_t WS_HM = 366 * MiB;
constexpr size_t WS_US5 = 238 * MiB;
constexpr size_t WS_ULRU = 298 * MiB;
constexpr size_t WS_SLOC = 366 * MiB;
constexpr size_t WS_YS5 = 400 * MiB;
constexpr size_t WS_YCAT = 448 * MiB;
constexpr size_t WS_Y = 295 * MiB;
constexpr size_t WS_LIST = 1 * MiB;
constexpr size_t WS_PAIR = 9 * MiB;
constexpr size_t WS_HMID = 143 * MiB;
constexpr size_t WS_SLABA = 10 * MiB;
constexpr size_t WS_SLABB = 288 * MiB;
constexpr int SLAB_ROWS_A = 35 * 1024;
constexpr float SLAB_SCALE = 32.f;
constexpr size_t WS_END = 512 * MiB;

constexpr int LDS_BYTES = 155648;
constexpr int MISC_OFF = LDS_BYTES - 256;

DEV float bf2f(bf16_t h) { return __uint_as_float(((unsigned)h) << 16); }
DEV unsigned f2bf(float f) { unsigned u = __float_as_uint(f); return (u + 0x7fffu + ((u >> 16) & 1u)) >> 16; }
typedef float f32x2_t __attribute__((ext_vector_type(2)));
typedef __bf16 bf16x2_t __attribute__((ext_vector_type(2)));
DEV unsigned pack2(float a, float b) { const f32x2_t v = {a, b}; return __builtin_bit_cast(unsigned, __builtin_convertvector(v, bf16x2_t)); }
DEV float sigmoid_f(float x) { return __builtin_amdgcn_rcpf(1.f + __builtin_amdgcn_exp2f(-1.4426950408889634f * x)); }
DEV float gelu_tanh(float x) {
    const float z2 = 1.5957691216057308f * (x + 0.044715f * x * x * x);
    return x * __builtin_amdgcn_rcpf(1.f + __builtin_amdgcn_exp2f(-1.4426950408889634f * z2));
}
DEV int cmaj(int tok) { const int t = tok & 4095; return (tok & ~4095) | ((t & 63) << 6) | (t >> 6); }
DEV float wave_sum(float v) {
#pragma unroll
    for (int o = 1; o < 64; o <<= 1) v += __shfl_xor(v, o);
    return v;
}

struct Params { const float* in[39]; float* out; unsigned char* ws; int ph_lo, ph_hi; };

#define XB_TMO      128
#define XB_XCNT(j)  (256  + 64 * (j))
#define XB_XSUB(j)  (1280 + 64 * (j))
#define XB_XGEN(j)  (2304 + 64 * (j))
#define XB_TOP      3328
#define XB_TOPGEN   3392
#define XCD_BAR_WORDS 3456
#define XB_SPIN_CAP (1u << 20)
DEV unsigned xb_ld(unsigned* p)              { return __hip_atomic_load(p, __ATOMIC_RELAXED, __HIP_MEMORY_SCOPE_AGENT); }
DEV unsigned xb_add(unsigned* p, unsigned v) { return __hip_atomic_fetch_add(p, v, __ATOMIC_RELAXED, __HIP_MEMORY_SCOPE_AGENT); }
DEV unsigned xb_xcc_id() { return (unsigned)__builtin_amdgcn_s_getreg((3 << 11) | 20) & 0xFu; }
#define XB_SPIN(cond, bar) do { unsigned _sp = 0; while (cond) { __builtin_amdgcn_s_sleep(1); \
    if ((++_sp & 255u) == 0u) { if (xb_ld(&(bar)[XB_TMO])) break; if (_sp > XB_SPIN_CAP) { atomicAdd(&(bar)[XB_TMO], 1u); break; } } } } while (0)
struct XcdBarrier { unsigned* bar; unsigned x; volatile LAS unsigned* st; };
DEV XcdBarrier xcd_barrier_post(unsigned* bar, volatile LAS unsigned* st) {
    XcdBarrier b; b.bar = bar; b.x = xb_xcc_id(); b.st = st;
    if (threadIdx.x == 0) (void)xb_add(&bar[XB_XCNT(b.x)], 1u);
    return b;
}
DEV void xcd_barrier_complete(unsigned* bar, unsigned x, unsigned& nloc, unsigned& nx) {
    const unsigned G = gridDim.x * gridDim.y * gridDim.z;
    unsigned sum, cnt, mine, sp = 0u;
    for (;;) {
        sum = 0u; cnt = 0u; mine = 0u;
#pragma unroll
        for (unsigned j = 0; j < 16; ++j) { const unsigned c = xb_ld(&bar[XB_XCNT(j)]); sum += c; cnt += (c > 0u) ? 1u : 0u; mine = (j == x) ? c : mine; }
        if (sum == G) break;
        __builtin_amdgcn_s_sleep(1);
        if ((++sp & 255u) == 0u) { if (xb_ld(&bar[XB_TMO])) break; if (sp > XB_SPIN_CAP) { atomicAdd(&bar[XB_TMO], 1u); break; } }
    }
    nloc = mine > 0u ? mine : 1u; nx = cnt > 0u ? cnt : 1u;
}
#ifndef FLAT_BAR
#define FLAT_BAR 0
#endif
#define XB_TWO_LEVEL_RELEASE 0
DEV void flat_barrier(const XcdBarrier& b) {
    asm volatile("s_waitcnt vmcnt(0)" ::: "memory");
    __syncthreads();
    if (threadIdx.x == 0) {
        unsigned* ctr = b.bar + XB_TOP;
        const unsigned G = gridDim.x;
        __builtin_amdgcn_fence(__ATOMIC_RELEASE, "agent");
        asm volatile("s_waitcnt vmcnt(0)" ::: "memory");
        const unsigned old = xb_add(ctr, 1u);
        const unsigned target = (old / G + 1u) * G;
        unsigned sp = 0;
        while (xb_ld(ctr) < target) { __builtin_amdgcn_s_sleep(1); if (++sp > (1u << 22)) { atomicAdd(&b.bar[XB_TMO], 1u); break; } }
        __builtin_amdgcn_fence(__ATOMIC_ACQUIRE, "agent");
        asm volatile("s_waitcnt vmcnt(0)" ::: "memory");
    }
    __syncthreads();
}
DEV void xcd_barrier_impl(const XcdBarrier& b);
DEV void xcd_barrier(const XcdBarrier& b) { if (FLAT_BAR) flat_barrier(b); else xcd_barrier_impl(b); }
DEV void xcd_barrier_impl(const XcdBarrier& b) {
    asm volatile("s_waitcnt vmcnt(0)" ::: "memory");
    __syncthreads();
    if (threadIdx.x == 0) {
        unsigned* bar = b.bar;
        __builtin_amdgcn_s_waitcnt(0);
        unsigned nloc = b.st[0], nx = b.st[1];
        if (nloc == 0u) { xcd_barrier_complete(bar, b.x, nloc, nx); b.st[0] = nloc; b.st[1] = nx; }
        const unsigned old = xb_add(&bar[XB_XSUB(b.x)], 1u);
        const unsigned gen = old / nloc;
        if (old + 1u == (gen + 1u) * nloc) {
            __builtin_amdgcn_fence(__ATOMIC_RELEASE, "agent");
            asm volatile("s_waitcnt vmcnt(0)" ::: "memory");
            const unsigned og = xb_add(&bar[XB_TOP], 1u);
            if (og + 1u == (gen + 1u) * nx) xb_add(&bar[XB_TOPGEN], 1u);
        }
#if XB_TWO_LEVEL_RELEASE
#error not built
#endif
        XB_SPIN(xb_ld(&bar[XB_TOPGEN]) == gen, bar);
        __builtin_amdgcn_fence(__ATOMIC_ACQUIRE, "agent");
        asm volatile("s_waitcnt vmcnt(0)" ::: "memory");
    }
    __syncthreads();
}

constexpr int GEMM_LDS = 61440;
template <class ARow, class Epi>
DEV void gemm_unit(LAS unsigned char* lds, const ARow& arow, const bf16_t* __restrict__ Bt, int K, const Epi& epi) {
    const int tid = threadIdx.x, wid = tid >> 6, lane = tid & 63, wr = wid >> 1, wc = wid & 1, fr = lane & 15, fq = lane >> 4;
    LAS unsigned char* As = lds;
    LAS unsigned char* Bs = lds + 40960;
    const u32x4* pa0 = (const u32x4*)arow(tid >> 2) + (tid & 3);
    const u32x4* pa1 = (const u32x4*)arow(128 + (tid >> 2)) + (tid & 3);
    const u32x4* pb = (const u32x4*)(Bt + (size_t)(tid >> 2) * K) + (tid & 3);
    const int sa0 = (tid >> 2) * 80 + (tid & 3) * 16, sa1 = sa0 + 128 * 80;
    f32x4 acc[4][4];
#pragma unroll
    for (int i = 0; i < 4; ++i)
#pragma unroll
        for (int j = 0; j < 4; ++j) acc[i][j] = (f32x4){0.f, 0.f, 0.f, 0.f};
    const int nk = K >> 5;
    u32x4 ra0 = pa0[0], ra1 = pa1[0], rb = pb[0];
    *(LAS u32x4*)(As + sa0) = ra0; *(LAS u32x4*)(As + sa1) = ra1; *(LAS u32x4*)(Bs + sa0) = rb;
    __syncthreads();
    for (int kt = 0; kt < nk; ++kt) {
        const int cur = kt & 1;
        if (kt + 1 < nk) { ra0 = pa0[(kt + 1) * 4]; ra1 = pa1[(kt + 1) * 4]; rb = pb[(kt + 1) * 4]; }
        LAS const unsigned char* Ac = As + cur * 20480 + (wr * 64 + fr) * 80 + fq * 16;
        LAS const unsigned char* Bc = Bs + cur * 10240 + (wc * 64 + fr) * 80 + fq * 16;
        bf16x8 af[4], bfv[4];
#pragma unroll
        for (int i = 0; i < 4; ++i) af[i] = *(LAS const bf16x8*)(Ac + i * 1280);
#pragma unroll
        for (int j = 0; j < 4; ++j) bfv[j] = *(LAS const bf16x8*)(Bc + j * 1280);
#pragma unroll
        for (int i = 0; i < 4; ++i)
#pragma unroll
            for (int j = 0; j < 4; ++j) acc[i][j] = __builtin_amdgcn_mfma_f32_16x16x32_bf16(bfv[j], af[i], acc[i][j], 0, 0, 0);
        if (kt + 1 < nk) {
            const int nx = cur ^ 1;
            *(LAS u32x4*)(As + nx * 20480 + sa0) = ra0; *(LAS u32x4*)(As + nx * 20480 + sa1) = ra1; *(LAS u32x4*)(Bs + nx * 10240 + sa0) = rb;
        }
        __syncthreads();
    }
    epi(acc, wr * 64 + fr, wc * 64 + 4 * fq);
}

namespace gp {
constexpr int BK = 64, HALF = 128, HTB = HALF * BK * 2, STAGE_BYTES = 8 * HTB;
DEV int lds_byte(int r, int c) { const int st = (r >> 4) * 2 + (c >> 5), rr = r & 15, cc = c & 31, ob = rr * 64 + cc * 2; return st * 1024 + (ob ^ (((ob >> 9) & 1) << 5)); }
DEV void stage_rc(int b, int& R, int& C) { const int st = b / 1024, sb = b % 1024, swz = sb ^ (((sb >> 9) & 1) << 5); R = (st >> 1) * 16 + swz / 64; C = (st & 1) * 32 + (swz % 64) / 2; }
DEV int perm32(int rho) { const int n = rho >> 4, i = rho & 15; return 8 * (i >> 2) + 4 * n + (i & 3); }
struct UAddr { const char* a; const char* b; unsigned ao00, ao01, ao10, ao11; };
#ifndef PROBE_GEMM
#define PROBE_GEMM -1
#endif
#define GSEC_B(id) do { if (PROBE_GEMM == (id)) { __builtin_amdgcn_s_waitcnt(0); gt0_ = __builtin_amdgcn_s_memrealtime(); } } while (0)
#define GSEC_E(id) do { if (PROBE_GEMM == (id)) { __builtin_amdgcn_s_waitcnt(0); gacc_ += __builtin_amdgcn_s_memrealtime() - gt0_; } } while (0)
template <class Epi, class Sched>
DEV void gemm_phase(LAS unsigned char* lds, const int K, const Sched& S, const Epi& E) {
    unsigned long long gt0_ = 0, gacc_ = 0;
    typedef typename Sched::Unit Unit;
    int tid_ = threadIdx.x; asm volatile("" : "+v"(tid_));
    const int tid = tid_, wid = __builtin_amdgcn_readfirstlane(tid >> 6), lane = tid & 63, wr = wid >> 2, wc = wid & 3, fr = lane & 15, fq = lane >> 4;
    const int nt = K / BK;
    int R0, C0, R1, C1; stage_rc(tid * 16, R0, C0); stage_rc(tid * 16 + 8192, R1, C1);
    const int Rb0 = Epi::PERM ? ((R0 & ~31) + perm32(R0 & 31)) : R0, Rb1 = Epi::PERM ? ((R1 & ~31) + perm32(R1 & 31)) : R1;
    const unsigned vb0 = (unsigned)(Rb0 * K + C0) * 2u, vb1 = (unsigned)(Rb1 * K + C1) * 2u;
    const size_t kstep = (size_t)(BK * 2);
    const size_t hstepB = (size_t)HALF * K * 2;
    const int lda_ = S.lda();
    const unsigned va0 = (unsigned)(R0 * lda_ + C0) * 2u, va1 = (unsigned)(R1 * lda_ + C1) * 2u;
    const size_t hstepA = (size_t)HALF * lda_ * 2;
    const unsigned ldsw = (unsigned)wid * 1024u;
    const int aoff = lds_byte(wr * 64 + fr, fq * 8), boff = lds_byte(wc * 32 + fr, fq * 8);
#define GP_SA(b, h) (((b) * 2 + (h)) * HTB)
#define GP_SB(b, h) ((4 + (b) * 2 + (h)) * HTB)
#define GP_GLDS(gp_, bufoff, i_) __builtin_amdgcn_global_load_lds((const unsigned*)(gp_), (LAS unsigned*)(lds + (bufoff) + ldsw + (i_) * 8192), 16, 0, 0)
#define GP_STAGE_A(bufoff, ab, o0, o1, h, kb) do { if constexpr (Sched::GATHER) { const char* up_ = (ab) + (kb); GP_GLDS(up_ + (o0), bufoff, 0); GP_GLDS(up_ + (o1), bufoff, 1); } \
        else { const char* up_ = (ab) + (((h) ? hstepA : (size_t)0) + (kb)); GP_GLDS(up_ + va0, bufoff, 0); GP_GLDS(up_ + va1, bufoff, 1); } } while (0)
#define GP_STAGE_B(bufoff, bb, h, kb) do { const char* up_ = (bb) + (((h) ? hstepB : (size_t)0) + (kb)); GP_GLDS(up_ + vb0, bufoff, 0); GP_GLDS(up_ + vb1, bufoff, 1); } while (0)
#define GP_LDA(dst, b, h) do { _Pragma("unroll") for (int m = 0; m < 4; ++m) _Pragma("unroll") for (int k = 0; k < 2; ++k) dst[m][k] = *(const LAS bf16x8*)(lds + GP_SA(b, h) + aoff + m * 2048 + k * 1024); } while (0)
#define GP_LDB(dst, b, h) do { _Pragma("unroll") for (int n = 0; n < 2; ++n) _Pragma("unroll") for (int k = 0; k < 2; ++k) dst[n][k] = *(const LAS bf16x8*)(lds + GP_SB(b, h) + boff + n * 2048 + k * 1024); } while (0)
#define GP_MMA(ai, bj, At, Bt) do { __builtin_amdgcn_s_setprio(1); _Pragma("unroll") for (int m = 0; m < 4; ++m) _Pragma("unroll") for (int n = 0; n < 2; ++n) _Pragma("unroll") for (int k = 0; k < 2; ++k) \
        acc[ai][bj][m][n] = __builtin_amdgcn_mfma_f32_16x16x32_bf16(Bt[n][k], At[m][k], acc[ai][bj][m][n], 0, 0, 0); __builtin_amdgcn_s_setprio(0); } while (0)
#define GP_WAIT_V(n) asm volatile("s_waitcnt vmcnt(" #n ")" ::: "memory")
#define GP_WAIT_L(n) asm volatile("s_waitcnt lgkmcnt(" #n ")" ::: "memory")
#define GP_BAR __builtin_amdgcn_s_barrier()
#define GP_SCHED __builtin_amdgcn_sched_barrier(0)
    Unit cur, nxt; int ui = 0;
    if (!S.next(0, cur)) return;
    const char* cA; const char* cB; unsigned c00 = 0, c01 = 0, c10 = 0, c11 = 0;
    const char* nA; const char* nB; unsigned n00 = 0, n01 = 0, n10 = 0, n11 = 0;
    { UAddr t_; S.addr(cur, R0, C0, R1, C1, t_); cA = t_.a; cB = t_.b; if constexpr (Sched::GATHER) { c00 = t_.ao00; c01 = t_.ao01; c10 = t_.ao10; c11 = t_.ao11; } }
    f32x4 acc[2][2][4][2];
#pragma unroll
    for (int a = 0; a < 2; ++a)
#pragma unroll
        for (int b = 0; b < 2; ++b)
#pragma unroll
            for (int m = 0; m < 4; ++m)
#pragma unroll
                for (int n = 0; n < 2; ++n) acc[a][b][m][n] = (f32x4){0.f, 0.f, 0.f, 0.f};
    bf16x8 At[4][2], B0[2][2], B1[2][2];
    GP_STAGE_B(GP_SB(0, 0), cB, 0, 0); GP_STAGE_B(GP_SB(0, 1), cB, 1, 0); GP_STAGE_A(GP_SA(0, 0), cA, c00, c01, 0, 0); GP_STAGE_A(GP_SA(0, 1), cA, c10, c11, 1, 0);
    if (wr == 1) GP_BAR;
    GP_WAIT_V(2); GP_BAR;
    GP_STAGE_B(GP_SB(1, 0), cB, 0, kstep); GP_STAGE_A(GP_SA(1, 0), cA, c00, c01, 0, kstep); GP_STAGE_B(GP_SB(1, 1), cB, 1, kstep);
    GP_WAIT_V(6); GP_BAR;
    for (;;) {
        GSEC_B(3);
        const bool has_next = S.next(ui + 1, nxt);
        if (has_next) { UAddr t_; S.addr(nxt, R0, C0, R1, C1, t_); nA = t_.a; nB = t_.b; if constexpr (Sched::GATHER) { n00 = t_.ao00; n01 = t_.ao01; n10 = t_.ao10; n11 = t_.ao11; } }
        else { nA = cA; nB = cB; n00 = c00; n01 = c01; n10 = c10; n11 = c11; }
        GSEC_E(3); GSEC_B(2);
#pragma unroll 1
        for (int t = 0; t < nt; t += 2) {
            const bool last = (t == nt - 2);
            const size_t k1 = (size_t)(t + 1) * kstep;
            const char* sA = last ? nA : cA; const char* sB = last ? nB : cB;
            const unsigned s00 = last ? n00 : c00, s01 = last ? n01 : c01, s10 = last ? n10 : c10, s11 = last ? n11 : c11;
            const size_t k2 = last ? (size_t)0 : (size_t)(t + 2) * kstep, k3 = k2 + kstep;
            GP_LDB(B0, 0, 0); GP_LDB(B1, 0, 1); GP_SCHED; GP_LDA(At, 0, 0); GP_STAGE_A(GP_SA(1, 1), cA, c10, c11, 1, k1);
            GP_WAIT_V(8); GP_WAIT_L(0); GP_BAR; GP_MMA(0, 0, At, B0); GP_MMA(0, 1, At, B1); GP_BAR; GP_SCHED;
            GP_LDA(At, 0, 1); GP_STAGE_B(GP_SB(0, 0), sB, 0, k2); GP_STAGE_B(GP_SB(0, 1), sB, 1, k2); GP_STAGE_A(GP_SA(0, 0), sA, s00, s01, 0, k2);
            GP_WAIT_V(8); GP_WAIT_L(0); GP_BAR; GP_MMA(1, 0, At, B0); GP_MMA(1, 1, At, B1); GP_BAR; GP_SCHED;
            GP_LDB(B0, 1, 0); GP_LDB(B1, 1, 1); GP_SCHED; GP_LDA(At, 1, 0); GP_STAGE_A(GP_SA(0, 1), sA, s10, s11, 1, k2);
            GP_WAIT_V(8); GP_WAIT_L(0); GP_BAR; GP_MMA(0, 0, At, B0); GP_MMA(0, 1, At, B1); GP_BAR; GP_SCHED;
            GP_LDA(At, 1, 1); GP_STAGE_B(GP_SB(1, 0), sB, 0, k3); GP_STAGE_B(GP_SB(1, 1), sB, 1, k3); GP_STAGE_A(GP_SA(1, 0), sA, s00, s01, 0, k3);
            GP_WAIT_V(8); GP_WAIT_L(0); GP_BAR; GP_MMA(1, 0, At, B0); GP_MMA(1, 1, At, B1); GP_BAR; GP_SCHED;
        }
        GSEC_E(2);
        if (wr == 0) GP_BAR;
        GSEC_B(1);
        E(acc, cur, wr, wc, fr, fq);
        GSEC_E(1);
        if (!has_next) break;
#pragma unroll
        for (int a = 0; a < 2; ++a)
#pragma unroll
            for (int b = 0; b < 2; ++b)
#pragma unroll
                for (int m = 0; m < 4; ++m)
#pragma unroll
                    for (int n = 0; n < 2; ++n) acc[a][b][m][n] = (f32x4){0.f, 0.f, 0.f, 0.f};
        cur = nxt; cA = nA; cB = nB; c00 = n00; c01 = n01; c10 = n10; c11 = n11; ++ui;
        if (wr == 1) GP_BAR;
    }
    GP_WAIT_V(0);
    GP_BAR;
    if (PROBE_GEMM >= 0 && blockIdx.x == 0) { const unsigned long long d_ = gacc_ * 8ull, t0_ = __builtin_amdgcn_s_memrealtime(); while (__builtin_amdgcn_s_memrealtime() - t0_ < d_) __builtin_amdgcn_s_sleep(8); }
#undef GP_SA
#undef GP_SB
#undef GP_GLDS
#undef GP_STAGE_A
#undef GP_STAGE_B
#undef GP_LDA
#undef GP_LDB
#undef GP_MMA
#undef GP_WAIT_V
#undef GP_WAIT_L
#undef GP_BAR
#undef GP_SCHED
}
DEV bool static_order(int i, int G, int c, int nM, int nN, int& pm, int& pn) {
    const int nwg = nM * nN; const long L = (long)i * G + c; if (L >= nwg) return false;
    int wgid = (int)L; { const int q = nwg / 8, r = nwg % 8, xcd = wgid % 8, off = wgid / 8; wgid = (xcd < r ? xcd * (q + 1) : r * (q + 1) + (xcd - r) * q) + off; }
    const int nig = 8 * nN, gid = wgid / nig, fm = gid * 8, gsz = (nM - fm) < 8 ? (nM - fm) : 8;
    pm = fm + ((wgid % nig) % gsz); pn = (wgid % nig) / gsz; return true;
}
}

struct PlainSched {
    struct Unit { int pm, pn; };
    static constexpr bool GATHER = false;
    const char* A; const char* Bt; int lda_, K, nM, nN, G, c;
    DEV int lda() const { return lda_; }
    DEV bool next(int i, Unit& u) const { return gp::static_order(i, G, c, nM, nN, u.pm, u.pn); }
    DEV void addr(const Unit& u, int R0, int C0, int R1, int C1, gp::UAddr& o) const {
        o.a = A + (size_t)u.pm * 256 * lda_ * 2; o.b = Bt + (size_t)u.pn * 256 * K * 2;
    }
};
struct EpiBf16 {
    static constexpr bool PERM = true;
    bf16_t* O; int ldc;
    template <class U> DEV void operator()(const f32x4 (&acc)[2][2][4][2], const U& u, int wr, int wc, int fr, int fq) const {
        const int row0 = u.pm * 256 + wr * 64 + fr, col0 = u.pn * 256 + wc * 32 + 8 * fq;
#pragma unroll
        for (int ai = 0; ai < 2; ++ai)
#pragma unroll
            for (int m = 0; m < 4; ++m) {
                bf16_t* rowp = O + (size_t)(row0 + ai * 128 + m * 16) * ldc + col0;
#pragma unroll
                for (int bj = 0; bj < 2; ++bj) {
                    const f32x4 v0 = acc[ai][bj][m][0], v1 = acc[ai][bj][m][1];
                    u32x4 w; w.x = pack2(v0[0], v0[1]); w.y = pack2(v0[2], v0[3]); w.z = pack2(v1[0], v1[1]); w.w = pack2(v1[2], v1[3]);
                    *(u32x4*)(rowp + bj * 128) = w;
                }
            }
    }
};
struct EpiF32 {
    static constexpr bool PERM = false;
    float* O; int ldc;
    template <class U> DEV void operator()(const f32x4 (&acc)[2][2][4][2], const U& u, int wr, int wc, int fr, int fq) const {
        const int row0 = u.pm * 256 + wr * 64 + fr, col0 = u.pn * 256 + wc * 32 + 4 * fq;
#pragma unroll
        for (int ai = 0; ai < 2; ++ai)
#pragma unroll
            for (int m = 0; m < 4; ++m) {
                float* rowp = O + (size_t)(row0 + ai * 128 + m * 16) * ldc + col0;
#pragma unroll
                for (int bj = 0; bj < 2; ++bj)
#pragma unroll
                    for (int n = 0; n < 2; ++n) *(f32x4*)(rowp + bj * 128 + n * 16) = acc[ai][bj][m][n];
            }
    }
};

DEV void bf8_unpack(const u32x4 w, float (&y)[8]) {
    y[0] = __uint_as_float(w.x << 16); y[1] = __uint_as_float(w.x & 0xffff0000u); y[2] = __uint_as_float(w.y << 16); y[3] = __uint_as_float(w.y & 0xffff0000u);
    y[4] = __uint_as_float(w.z << 16); y[5] = __uint_as_float(w.z & 0xffff0000u); y[6] = __uint_as_float(w.w << 16); y[7] = __uint_as_float(w.w & 0xffff0000u);
}
struct WinSched {
    struct Unit { int pm, pn; };
    static constexpr bool GATHER = false;
    const char* A; const char* Bt; int G, c;
    DEV int lda() const { return 1024; }
    DEV bool next(int i, Unit& u) const { return gp::static_order(i, G, c, 136, 6, u.pm, u.pn); }
    DEV void addr(const Unit& u, int R0, int C0, int R1, int C1, gp::UAddr& o) const {
        o.a = A + (size_t)u.pm * 256 * 1024 * 2; o.b = Bt + ((size_t)u.pn * 256) * 1024 * 2;
    }
};
struct EpiWin {
    static constexpr bool PERM = true;
    bf16_t* US5; bf16_t* ULRU;
    template <class U> DEV void operator()(const f32x4 (&acc)[2][2][4][2], const U& u, int wr, int wc, int fr, int fq) const {
#pragma unroll
        for (int bj = 0; bj < 2; ++bj) {
            const int col8 = u.pn * 256 + bj * 128 + wc * 32 + 8 * fq;
#pragma unroll
            for (int ai = 0; ai < 2; ++ai)
#pragma unroll
                for (int m = 0; m < 4; ++m) {
                    const int row = u.pm * 256 + ai * 128 + wr * 64 + m * 16 + fr;
                    const f32x4 v0 = acc[ai][bj][m][0], v1 = acc[ai][bj][m][1];
                    u32x4 w; w.x = pack2(v0[0], v0[1]); w.y = pack2(v0[2], v0[3]); w.z = pack2(v1[0], v1[1]); w.w = pack2(v1[2], v1[3]);
                    if (col8 < 512) {
                        int mm, ss;
                        if (row < T) { const int bq = row >> 12, t = row & 4095; mm = bq * 128 + (t >> 5); ss = t & 31; }
                        else { const int q = row - T, bq = q >> 8, j = q & 255; mm = M5LAT + bq * 8 + (j >> 5); ss = j & 31; }
                        *(u32x4*)(US5 + ((size_t)((col8 >> 4) * M5PAD + mm)) * KT5 + ss * 16 + (col8 & 15)) = w;
                    } else *(u32x4*)(ULRU + (size_t)(row < T ? cmaj(row) : row) * 1024 + (col8 - 512)) = w;
                }
        }
    }
};
struct S5Sched {
    struct Unit { int g, pm, pn; };
    static constexpr bool GATHER = false;
    const char* A; const char* Bt; int K, nPm, nPn, brows  , G, c;
    DEV int lda() const { return KT5; }
    DEV bool next(int i, Unit& u) const {
        if (i > 0) return false;
        const int per = nPm * nPn * 4;
        const int x = c & 7, j = c >> 3; if (j >= per) return false;
        const int U = x * per + j; u.g = U / (nPm * nPn); const int r = U % (nPm * nPn); u.pm = r / nPn; u.pn = r % nPn; return true;
    }
    DEV void addr(const Unit& u, int R0, int C0, int R1, int C1, gp::UAddr& o) const {
        o.a = A + ((size_t)u.g * M5PAD + u.pm * 256) * KT5 * 2; o.b = Bt + ((size_t)u.g * brows + u.pn * 256) * K * 2;
    }
};
struct EpiS5Loc {
    static constexpr bool PERM = false;
    float* SLOC;
    template <class U> DEV void operator()(const f32x4 (&acc)[2][2][4][2], const U& u, int wr, int wc, int fr, int fq) const {
#pragma unroll
        for (int ai = 0; ai < 2; ++ai)
#pragma unroll
            for (int m = 0; m < 4; ++m) {
                const int mm = u.pm * 256 + ai * 128 + wr * 64 + m * 16 + fr;
                if (mm < M5) {
                    float* rowp = SLOC + ((size_t)(u.g * M5 + mm)) * 256 + wc * 32 + 4 * fq;
#pragma unroll
                    for (int bj = 0; bj < 2; ++bj)
#pragma unroll
                        for (int n = 0; n < 2; ++n) *(f32x4*)(rowp + bj * 128 + n * 16) = acc[ai][bj][m][n];
                }
            }
    }
};
struct EpiS5Out {
    static constexpr bool PERM = true;
    bf16_t* YS5;
    template <class U> DEV void operator()(const f32x4 (&acc)[2][2][4][2], const U& u, int wr, int wc, int fr, int fq) const {
#pragma unroll
        for (int ai = 0; ai < 2; ++ai)
#pragma unroll
            for (int m = 0; m < 4; ++m) {
                const int mm = u.pm * 256 + ai * 128 + wr * 64 + m * 16 + fr, bq = mm >> 7, chunk = mm & 127;
#pragma unroll
                for (int bj = 0; bj < 2; ++bj) {
                    const int n8 = u.pn * 256 + bj * 128 + wc * 32 + 8 * fq, t = n8 >> 4, c0 = n8 & 15;
                    const size_t tok = (size_t)bq * 4096 + chunk * 32 + t;
                    const f32x4 v0 = acc[ai][bj][m][0], v1 = acc[ai][bj][m][1];
                    u32x4 w; w.x = pack2(gelu_tanh(v0[0]), gelu_tanh(v0[1])); w.y = pack2(gelu_tanh(v0[2]), gelu_tanh(v0[3]));
                    w.z = pack2(gelu_tanh(v1[0]), gelu_tanh(v1[1])); w.w = pack2(gelu_tanh(v1[2]), gelu_tanh(v1[3]));
                    *(u32x4*)(YS5 + tok * 512 + u.g * 16 + c0) = w;
                }
            }
    }
};
struct EpiGlu {
    static constexpr bool PERM = true;
    const bf16_t* YS5; const float* b_glu; bf16_t* YCAT;
    template <class U> DEV void operator()(const f32x4 (&acc)[2][2][4][2], const U& u, int wr, int wc, int fr, int fq) const {
        const int col0 = u.pn * 256 + wc * 32 + 8 * fq; const size_t row0 = (size_t)u.pm * 256 + wr * 64 + fr;
        f32x4 bv[2][2];
#pragma unroll
        for (int bj = 0; bj < 2; ++bj) { bv[bj][0] = *(const f32x4*)(b_glu + col0 + bj * 128); bv[bj][1] = *(const f32x4*)(b_glu + col0 + bj * 128 + 4); }
        u32x4 yv[2][4][2];
#pragma unroll
        for (int ai = 0; ai < 2; ++ai)
#pragma unroll
            for (int m = 0; m < 4; ++m)
#pragma unroll
                for (int bj = 0; bj < 2; ++bj) yv[ai][m][bj] = *(const u32x4*)(YS5 + (row0 + ai * 128 + m * 16) * 512 + col0 + bj * 128);
#pragma unroll
        for (int ai = 0; ai < 2; ++ai)
#pragma unroll
            for (int m = 0; m < 4; ++m)
#pragma unroll
                for (int bj = 0; bj < 2; ++bj) {
                    float y[8]; bf8_unpack(yv[ai][m][bj], y);
                    const f32x4 z0 = acc[ai][bj][m][0] + bv[bj][0], z1 = acc[ai][bj][m][1] + bv[bj][1];
                    u32x4 w; w.x = pack2(y[0] * sigmoid_f(z0[0]), y[1] * sigmoid_f(z0[1])); w.y = pack2(y[2] * sigmoid_f(z0[2]), y[3] * sigmoid_f(z0[3]));
                    w.z = pack2(y[4] * sigmoid_f(z1[0]), y[5] * sigmoid_f(z1[1])); w.w = pack2(y[6] * sigmoid_f(z1[2]), y[7] * sigmoid_f(z1[3]));
                    *(u32x4*)(YCAT + (size_t)cmaj((int)(row0 + ai * 128 + m * 16)) * 1024 + col0 + bj * 128) = w;
                }
    }
};

struct TrTile { const float* W; bf16_t* dst; int ldw, k0, n0, ldd, mode; };
DEV void tr_load(const TrTile& t, int lane, f32x4 (&v)[16]) {
#pragma unroll
    for (int i = 0; i < 16; ++i) v[i] = *(const f32x4*)(t.W + (size_t)(t.k0 + i * 4 + (lane >> 4)) * t.ldw + t.n0 + (lane & 15) * 4);
}
DEV void tr_store(const TrTile& t, int lane, const f32x4 (&v)[16], LAS float* tile) {
#pragma unroll
    for (int i = 0; i < 16; ++i) { LAS float* tp = tile + (i * 4 + (lane >> 4)) * 65 + (lane & 15) * 4; tp[0] = v[i][0]; tp[1] = v[i][1]; tp[2] = v[i][2]; tp[3] = v[i][3]; }
    __builtin_amdgcn_fence(__ATOMIC_RELEASE, "wavefront"); __builtin_amdgcn_wave_barrier(); __builtin_amdgcn_fence(__ATOMIC_ACQUIRE, "wavefront");
    const int kc = lane & 7;
#pragma unroll
    for (int jn = 0; jn < 8; ++jn) {
        const int nn = (lane >> 3) + 8 * jn;
        float e[8];
#pragma unroll
        for (int jj = 0; jj < 8; ++jj) e[jj] = tile[(kc * 8 + jj) * 65 + nn];
        const int j = t.n0 + nn;
        const int row = t.mode == 0 ? j : (((j >> 4) << 5) + (j & 15) + (t.mode == 2 ? 16 : 0));
        u32x4 w; w.x = pack2(e[0], e[1]); w.y = pack2(e[2], e[3]); w.z = pack2(e[4], e[5]); w.w = pack2(e[6], e[7]);
        *(u32x4*)(t.dst + (size_t)row * t.ldd + t.k0 + kc * 8) = w;
    }
    __builtin_amdgcn_fence(__ATOMIC_RELEASE, "wavefront"); __builtin_amdgcn_wave_barrier(); __builtin_amdgcn_fence(__ATOMIC_ACQUIRE, "wavefront");
}
DEV void tr_tile_wave(const float* __restrict__ W, int ldw, int k0, int n0, bf16_t* __restrict__ dst, int ldd, int mode, LAS float* tile, int lane) {
    TrTile t{W, dst, ldw, k0, n0, ldd, mode}; f32x4 v[16]; tr_load(t, lane, v); tr_store(t, lane, v, tile);
}
DEV TrTile expert_tile(const Params& p, int it) {
    const int e = it / 192, r = it % 192, which = r >> 6, tt = r & 63;
    TrTile t;
    if (which < 2) {
        t.W = e < 64 ? (which == 0 ? p.in[31] : p.in[32]) + (size_t)e * 262144 : (which == 0 ? p.in[34] : p.in[35]);
        t.ldw = 256; t.k0 = (tt >> 2) * 64; t.n0 = (tt & 3) * 64; t.dst = (bf16_t*)(p.ws + WS_BTGU) + (size_t)e * 524288; t.ldd = 1024; t.mode = which + 1;
    } else {
        t.W = e < 64 ? p.in[33] + (size_t)e * 262144 : p.in[36];
        t.ldw = 1024; t.k0 = (tt >> 4) * 64; t.n0 = (tt & 15) * 64; t.dst = (bf16_t*)(p.ws + WS_BTDN) + (size_t)e * 262144; t.ldd = 256; t.mode = 0;
    }
    return t;
}

DEV void gemv9_item(LAS const float* S, const float* __restrict__ W, int ldw, int col0, const float* __restrict__ bias, float* __restrict__ out, int ldo, LAS float* red) {
    const int tid = threadIdx.x, col = tid & 31, kp = tid >> 5;
    float acc[9];
#pragma unroll
    for (int b = 0; b < 9; ++b) acc[b] = 0.f;
    for (int k = kp * 64; k < kp * 64 + 64; ++k) {
        const float w = W[(size_t)k * ldw + col0 + col];
#pragma unroll
        for (int b = 0; b < 9; ++b) acc[b] += S[b * 1024 + k] * w;
    }
#pragma unroll
    for (int b = 0; b < 9; ++b) red[(kp * 9 + b) * 32 + col] = acc[b];
    __syncthreads();
    if (tid < 288) {
        const int b = tid >> 5, c = tid & 31; float s = 0.f;
#pragma unroll
        for (int q = 0; q < 16; ++q) s += red[(q * 9 + b) * 32 + c];
        out[b * ldo + col0 + c] = s + (bias ? bias[col0 + c] : 0.f);
    }
    __syncthreads();
}

DEV void cpow_d(double lr, double li, double dt, int l, double& re, double& im) {
    const double mag = exp(lr * dt * (double)l);
    const double ang = li * dt * (double)l;
    const double kq = rint(ang * 0.63661977236758134308);
    double x = fma(-kq, 1.57079632679489655800e+00, ang);
    x = fma(-kq, 6.12323399573676603587e-17, x);
    const double x2 = x * x;
    double s = -1.0 / 6227020800.0; s = fma(s, x2, 1.0 / 39916800.0); s = fma(s, x2, -1.0 / 362880.0); s = fma(s, x2, 1.0 / 5040.0);
    s = fma(s, x2, -1.0 / 120.0); s = fma(s, x2, 1.0 / 6.0); s = fma(-s, x2, 1.0); s = s * x;
    double c = 1.0 / 479001600.0; c = fma(c, x2, -1.0 / 3628800.0); c = fma(c, x2, 1.0 / 40320.0); c = fma(c, x2, -1.0 / 720.0);
    c = fma(c, x2, 1.0 / 24.0); c = fma(c, x2, -0.5); c = fma(c, x2, 1.0);
    const int q = ((int)(long long)kq) & 3;
    const double sn = (q == 0) ? s : (q == 1) ? c : (q == 2) ? -s : -c;
    const double cs = (q == 0) ? c : (q == 1) ? -s : (q == 2) ? -c : s;
    re = mag * cs; im = mag * sn;
}

DEV void s5_tables(const Params& p, LAS unsigned char* lds, int g, int part) {
    int tid = threadIdx.x; asm volatile("" : "+v"(tid));
    LAS float* apr = (LAS float*)lds;
    LAS float* api = apr + 640;
    LAS float* bbr = api + 640;
    LAS float* bbi = bbr + 2048;
    const float* lam_re = p.in[9]; const float* lam_im = p.in[10]; const float* log_dt = p.in[11];
    const float* b_re = p.in[12]; const float* b_im = p.in[13]; const float* c_re = p.in[14]; const float* c_im = p.in[15];
    float* APR = (float*)(p.ws + WS_APR) + (size_t)g * 4224; float* API = (float*)(p.ws + WS_API) + (size_t)g * 4224;
    float* BBR = (float*)(p.ws + WS_BBR) + (size_t)g * 2048; float* BBI = (float*)(p.ws + WS_BBI) + (size_t)g * 2048;
    float* KTAB = (float*)(p.ws + WS_KTAB) + (size_t)g * 16384;
    const int nl = part == 7 ? 5 : 4;
    for (int i = tid; i < 2 * nl * 64; i += 512) {
        const int dir = i / (nl * 64), rem = i % (nl * 64), li = rem >> 6, pp = rem & 63, l = part * 4 + li, gi = dir * 32 + g;
        const double dt = exp((double)log_dt[gi]);
        double re, im; cpow_d((double)lam_re[gi * 64 + pp], (double)lam_im[gi * 64 + pp], dt, l, re, im);
        apr[(dir * 5 + li) * 64 + pp] = (float)re; api[(dir * 5 + li) * 64 + pp] = (float)im;
        APR[(dir * 33 + l) * 64 + pp] = (float)re; API[(dir * 33 + l) * 64 + pp] = (float)im;
    }
    for (int i = tid; i < 2048; i += 512) {
        const int dir = i >> 10, pp = (i >> 4) & 63, c = i & 15, gi = dir * 32 + g;
        const double dt = exp((double)log_dt[gi]);
        const double lr = (double)lam_re[gi * 64 + pp], li = (double)lam_im[gi * 64 + pp];
        double ar, ai; cpow_d(lr, li, dt, 1, ar, ai);
        const double nr = ar - 1.0, den = lr * lr + li * li;
        const double fr = (nr * lr + ai * li) / den, fi = (ai * lr - nr * li) / den;
        const double br = (double)b_re[((size_t)(gi * 64 + pp)) * 16 + c], bi = (double)b_im[((size_t)(gi * 64 + pp)) * 16 + c];
        const float vr = (float)(fr * br - fi * bi), vi = (float)(fr * bi + fi * br);
        bbr[i] = vr; bbi[i] = vi;
        if (part == 0) { BBR[i] = vr; BBI[i] = vi; }
    }
    __syncthreads();
    if (tid < 128) {
        const int dir = tid >> 6, li = (tid >> 4) & 3, c = tid & 15, l = part * 4 + li;
        const float* cr_ = c_re + ((size_t)((dir * 32 + g) * 16 + c)) * 64; const float* ci_ = c_im + ((size_t)((dir * 32 + g) * 16 + c)) * 64;
        f32x4 s0 = (f32x4){0.f, 0.f, 0.f, 0.f}, s1 = s0, s2 = s0, s3 = s0;
#pragma unroll 2
        for (int pp = 0; pp < 64; ++pp) {
            const float ar = apr[(dir * 5 + li) * 64 + pp], ai = api[(dir * 5 + li) * 64 + pp];
            const float cr = cr_[pp], ci = ci_[pp];
            const float qr = cr * ar - ci * ai, qi = cr * ai + ci * ar;
            LAS const f32x4* br = (LAS const f32x4*)(bbr + (dir * 64 + pp) * 16); LAS const f32x4* bi = (LAS const f32x4*)(bbi + (dir * 64 + pp) * 16);
            s0 += br[0] * qr - bi[0] * qi; s1 += br[1] * qr - bi[1] * qi; s2 += br[2] * qr - bi[2] * qi; s3 += br[3] * qr - bi[3] * qi;
        }
        f32x4* kd = (f32x4*)(KTAB + ((dir * 32 + l) * 16 + c) * 16);
        kd[0] = s0; kd[1] = s1; kd[2] = s2; kd[3] = s3;
    }
    __syncthreads();
}
DEV void s5_fill(const Params& p, LAS unsigned char* lds, int g, int part) {
    int tid = threadIdx.x; asm volatile("" : "+v"(tid));
    LAS float* apr = (LAS float*)lds;
    LAS float* api = apr + 4224;
    LAS float* bbr = api + 4224;
    LAS float* bbi = bbr + 2048;
    LAS float* ccr = bbi + 2048;
    LAS float* cci = ccr + 2048;
    LAS float* Kt = cci + 2048;
    const float* c_re = p.in[14]; const float* c_im = p.in[15]; const float* dvec = p.in[16];
    bf16_t* BS5 = (bf16_t*)(p.ws + WS_BS5); bf16_t* ES5 = (bf16_t*)(p.ws + WS_ES5); float* ALC = (float*)(p.ws + WS_ALC);
    {
        const f32x4* s0 = (const f32x4*)((const float*)(p.ws + WS_APR) + (size_t)g * 4224); const f32x4* s1 = (const f32x4*)((const float*)(p.ws + WS_API) + (size_t)g * 4224);
        const f32x4* s2 = (const f32x4*)((const float*)(p.ws + WS_BBR) + (size_t)g * 2048); const f32x4* s3 = (const f32x4*)((const float*)(p.ws + WS_BBI) + (size_t)g * 2048);
        const f32x4* s4 = (const f32x4*)((const float*)(p.ws + WS_KTAB) + (size_t)g * 16384);
        f32x4 ra[3], ri[3], rb0, rb1, rk[8]; float rc[4], rd[4];
#pragma unroll
        for (int u = 0; u < 3; ++u) { const int i = tid + u * 512; if (i < 1056) { ra[u] = s0[i]; ri[u] = s1[i]; } }
        rb0 = s2[tid]; rb1 = s3[tid];
#pragma unroll
        for (int u = 0; u < 8; ++u) rk[u] = s4[tid + u * 512];
#pragma unroll
        for (int u = 0; u < 4; ++u) { const int i = tid + u * 512; const int dir = i >> 10, cc = (i >> 6) & 15, pp = i & 63; const size_t src = ((size_t)((dir * 32 + g) * 16 + cc)) * 64 + pp; rc[u] = c_re[src]; rd[u] = c_im[src]; }
#pragma unroll
        for (int u = 0; u < 3; ++u) { const int i = tid + u * 512; if (i < 1056) { ((LAS f32x4*)apr)[i] = ra[u]; ((LAS f32x4*)api)[i] = ri[u]; } }
        ((LAS f32x4*)bbr)[tid] = rb0; ((LAS f32x4*)bbi)[tid] = rb1;
#pragma unroll
        for (int u = 0; u < 8; ++u) { const int i = tid + u * 512; LAS float* kd = Kt + (i >> 6) * 257 + (i & 63) * 4; kd[0] = rk[u][0]; kd[1] = rk[u][1]; kd[2] = rk[u][2]; kd[3] = rk[u][3]; }
#pragma unroll
        for (int u = 0; u < 4; ++u) { const int i = tid + u * 512; ccr[i] = rc[u]; cci[i] = rd[u]; }
    }
    __syncthreads();
    for (int q = tid; q < 64 * 96; q += 512) {
        const int n = part * 64 + q / 96, k8 = (q % 96) * 8, t = n >> 4, c = n & 15;
        float e[8];
        if (k8 < 512) {
            const int s = k8 >> 4, c0 = k8 & 15, delta = t - s;
#pragma unroll
            for (int i = 0; i < 8; ++i) {
                const int c2 = c0 + i; float v;
                if (delta > 0) v = Kt[delta * 257 + c * 16 + c2];
                else if (delta < 0) v = Kt[(32 - delta) * 257 + c * 16 + c2];
                else v = Kt[c * 16 + c2] + Kt[32 * 257 + c * 16 + c2] + (c == c2 ? dvec[g * 16 + c] : 0.f);
                e[i] = v;
            }
        } else {
            const int kk = k8 - 512, seg = kk >> 6, p0 = kk & 63, dir = seg >> 1, l = dir == 0 ? t + 1 : 32 - t;
#pragma unroll
            for (int i = 0; i < 8; ++i) {
                const int pp = p0 + i;
                const float ar = apr[(dir * 33 + l) * 64 + pp], ai = api[(dir * 33 + l) * 64 + pp];
                const float cr = ccr[(dir * 16 + c) * 64 + pp], ci = cci[(dir * 16 + c) * 64 + pp];
                e[i] = (seg & 1) ? -(cr * ai + ci * ar) : (cr * ar - ci * ai);
            }
        }
        u32x4 w; w.x = pack2(e[0], e[1]); w.y = pack2(e[2], e[3]); w.z = pack2(e[4], e[5]); w.w = pack2(e[6], e[7]);
        *(u32x4*)(BS5 + ((size_t)g * 512 + n) * 768 + k8) = w;
    }
    for (int q = tid; q < 32 * 64; q += 512) {
        const int n = part * 32 + (q >> 6), k8 = (q & 63) * 8, s = k8 >> 4, c0 = k8 & 15, seg = n >> 6, pp = n & 63, dir = seg >> 1, l = dir == 0 ? 31 - s : s;
        const float ar = apr[(dir * 33 + l) * 64 + pp], ai = api[(dir * 33 + l) * 64 + pp];
        float e[8];
#pragma unroll
        for (int i = 0; i < 8; ++i) {
            const float br = bbr[(dir * 64 + pp) * 16 + c0 + i], bi = bbi[(dir * 64 + pp) * 16 + c0 + i];
            e[i] = (seg & 1) ? (ar * bi + ai * br) : (ar * br - ai * bi);
        }
        u32x4 w; w.x = pack2(e[0], e[1]); w.y = pack2(e[2], e[3]); w.z = pack2(e[4], e[5]); w.w = pack2(e[6], e[7]);
        *(u32x4*)(ES5 + ((size_t)g * 256 + n) * 512 + k8) = w;
    }
    if (part == 0 && tid < 128) {
        const int dir = tid >> 6, pp = tid & 63;
        ALC[((dir * 32 + g) * 64 + pp) * 2 + 0] = apr[(dir * 33 + 32) * 64 + pp];
        ALC[((dir * 32 + g) * 64 + pp) * 2 + 1] = api[(dir * 33 + 32) * 64 + pp];
    }
    __syncthreads();
}

template <bool APPLY>
DEV void lru_item(const Params& p, LAS unsigned char* lds, int b, int ch, int h) {
    int tid_ = threadIdx.x; asm volatile("" : "+v"(tid_));
    const int tid = tid_, wid = tid >> 6, lane = tid & 63, fr = lane & 15, fq = lane >> 4;
    LAS float* xin = (LAS float*)lds;
    LAS float* xs = (LAS float*)(lds + 17408);
    LAS unsigned short* xsb = (LAS unsigned short*)(lds + 33792);
    LAS float* aa = (LAS float*)(lds + 43008);
    LAS float* bb = (LAS float*)(lds + 75776);
    LAS float* cAs = (LAS float*)(lds + 108544);
    const bf16_t* ULRU = (const bf16_t*)(p.ws + WS_ULRU);
    const bf16_t* BTLRU = (const bf16_t*)(p.ws + WS_BTLRU);
    const float* conv_w = p.in[19]; const float* conv_b = p.in[20];
    if (tid < 128) {
        const int dir = tid >> 6, j = tid & 63, o = dir * 512 + h * 64 + j;
        cAs[tid] = -8.f * log1pf(__expf(-p.in[25][o])); cAs[128 + tid] = p.in[22][o]; cAs[256 + tid] = p.in[24][o];
    }
    for (int c = tid; c < 67 * 8; c += 512) {
        const int rr = c >> 3, c8 = (c & 7) * 8, pos = rr - 2;
        u32x4 w = (u32x4){0u, 0u, 0u, 0u};
        if (ch < 64) { if (pos >= 0 && pos < 64) w = *(const u32x4*)(ULRU + ((size_t)b * 4096 + pos * 64 + ch) * 1024 + h * 64 + c8); }
        else { const int jt = (ch - 64) * 64 + pos; if (jt >= 0 && jt < 256) w = *(const u32x4*)(ULRU + ((size_t)T + b * 256 + jt) * 1024 + h * 64 + c8); }
        float y[8]; bf8_unpack(w, y);
        *(LAS f32x4*)(xin + rr * 64 + c8) = (f32x4){y[0], y[1], y[2], y[3]}; *(LAS f32x4*)(xin + rr * 64 + c8 + 4) = (f32x4){y[4], y[5], y[6], y[7]};
    }
    __syncthreads();
    {
        const int cc = tid & 63, chn = h * 64 + cc;
        const float w0 = conv_w[chn], w1 = conv_w[512 + chn], w2 = conv_w[1024 + chn], w3 = conv_w[1536 + chn], cb = conv_b[chn];
#pragma unroll 2
        for (int r = tid >> 6; r < 64; r += 8) {
            const float v = cb + w0 * xin[r * 64 + cc] + w1 * xin[(r + 1) * 64 + cc] + w2 * xin[(r + 2) * 64 + cc] + w3 * xin[(r + 3) * 64 + cc];
            xs[r * 64 + cc] = v; xsb[r * 72 + cc] = (unsigned short)f2bf(v);
        }
    }
    __syncthreads();
    {
        const int mt = wid & 3, dir = wid >> 2;
        bf16x8 af[2];
#pragma unroll
        for (int ks = 0; ks < 2; ++ks) af[ks] = *(LAS const bf16x8*)((LAS const unsigned char*)xsb + (mt * 16 + fr) * 144 + ks * 64 + fq * 16);
        const int r = mt * 16 + fr;
#pragma unroll
        for (int jt = 0; jt < 8; ++jt) {
            const int n = dir * 128 + jt * 16 + fr;
            const bf16_t* bp = BTLRU + ((size_t)(h * 256 + n)) * 64 + fq * 8;
            const bf16x8 b0 = *(const bf16x8*)bp, b1 = *(const bf16x8*)(bp + 32);
            f32x4 a = (f32x4){0.f, 0.f, 0.f, 0.f};
            a = __builtin_amdgcn_mfma_f32_16x16x32_bf16(b0, af[0], a, 0, 0, 0);
            a = __builtin_amdgcn_mfma_f32_16x16x32_bf16(b1, af[1], a, 0, 0, 0);
            LAS float* dst = (jt < 4 ? aa : bb) + (dir * 64 + r) * 64 + (jt & 3) * 16 + 4 * fq;
            *(LAS f32x4*)dst = a;
        }
    }
    __syncthreads();
#pragma unroll 2
    for (int idx = tid; idx < 8192; idx += 512) {
        const int dir = idx >> 12, j = idx & 63, r = (idx >> 6) & 63;
        const float za = aa[idx] + cAs[128 + dir * 64 + j], zx = bb[idx] + cAs[256 + dir * 64 + j];
        const float la = cAs[dir * 64 + j] * sigmoid_f(za);
        const float a = __expf(la);
        const float x2 = 2.f * la;
        const float em = -x2 * (1.f + x2 * (0.5f + x2 * (0.16666667f + x2 * (0.041666668f + x2 * (0.0083333338f + x2 * 0.0013888889f)))));
        aa[idx] = a; bb[idx] = sqrtf(em) * sigmoid_f(zx) * xs[r * 64 + j];
    }
    __syncthreads();
    if (tid < 128) {
        const int dir = tid >> 6, j = tid & 63, chn = h * 64 + j;
        LAS float* ap = aa + dir * 4096 + j; LAS float* bp = bb + dir * 4096 + j;
        if (!APPLY) {
            float H = 0.f, P = 1.f;
#pragma unroll 1
            for (int s0 = 0; s0 < 64; s0 += 16) {
                float av[16], bv[16];
#pragma unroll
                for (int q = 0; q < 16; ++q) { const int r = dir ? 63 - (s0 + q) : s0 + q; av[q] = ap[r * 64]; bv[q] = bp[r * 64]; }
#pragma unroll
                for (int q = 0; q < 16; ++q) { H = av[q] * H + bv[q]; P *= av[q]; }
            }
            float* SA = (float*)(p.ws + WS_SA); float* SB = (float*)(p.ws + WS_SB);
            const size_t o = ((size_t)(b * 68 + ch) * 2 + dir) * 512 + chn;
            SA[o] = P; SB[o] = H;
        } else {
            const float* HIN = (const float*)(p.ws + WS_HIN);
            float H = HIN[((size_t)(b * 64 + ch) * 2 + dir) * 512 + chn];
#pragma unroll 1
            for (int s0 = 0; s0 < 64; s0 += 16) {
                float av[16], bv[16];
#pragma unroll
                for (int q = 0; q < 16; ++q) { const int r = dir ? 63 - (s0 + q) : s0 + q; av[q] = ap[r * 64]; bv[q] = bp[r * 64]; }
#pragma unroll
                for (int q = 0; q < 16; ++q) { const int r = dir ? 63 - (s0 + q) : s0 + q; H = av[q] * H + bv[q]; bp[r * 64] = H; }
            }
        }
    }
    __syncthreads();
    if (APPLY) {
        bf16_t* YCAT = (bf16_t*)(p.ws + WS_YCAT);
        {
            const int r = tid >> 3, j8 = (tid & 7) * 8;
            const size_t row = (size_t)b * 4096 + r * 64 + ch;
            float gt[8]; bf8_unpack(*(const u32x4*)(ULRU + row * 1024 + 512 + h * 64 + j8), gt);
            float o[8];
#pragma unroll
            for (int q = 0; q < 8; ++q) o[q] = (bb[r * 64 + j8 + q] + bb[(64 + r) * 64 + j8 + q]) * gelu_tanh(gt[q]);
            u32x4 w; w.x = pack2(o[0], o[1]); w.y = pack2(o[2], o[3]); w.z = pack2(o[4], o[5]); w.w = pack2(o[6], o[7]);
            *(u32x4*)(YCAT + row * 1024 + 512 + h * 64 + j8) = w;
        }
        __syncthreads();
    }
}

template <int CTRL> DEV float dpp_f(float oldv, float src) {
    return __builtin_bit_cast(float, __builtin_amdgcn_update_dpp(__builtin_bit_cast(int, oldv), __builtin_bit_cast(int, src), CTRL, 0xf, 0xf, false));
}
#define LRU_DPP_STEP(SH) "s_nop 1\n\tv_fmac_f32_dpp %0, %0, %1 " SH " row_mask:0xf bank_mask:0xf\n\ts_nop 1\n\tv_mul_f32_dpp %1, %1, %1 " SH " row_mask:0xf bank_mask:0xf\n\t"
template <bool REV> DEV void row_scan(float& a, float& b) {
    if (!REV) asm volatile(LRU_DPP_STEP("row_shr:1") LRU_DPP_STEP("row_shr:2") LRU_DPP_STEP("row_shr:4") LRU_DPP_STEP("row_shr:8") "s_nop 1" : "+v"(b), "+v"(a));
    else      asm volatile(LRU_DPP_STEP("row_shl:1") LRU_DPP_STEP("row_shl:2") LRU_DPP_STEP("row_shl:4") LRU_DPP_STEP("row_shl:8") "s_nop 1" : "+v"(b), "+v"(a));
}
#ifndef PROBE_LRU
#define PROBE_LRU -1
#endif
#define LSEC_B(id) do { if (PROBE_LRU == (id)) { __builtin_amdgcn_sched_barrier(0); __builtin_amdgcn_s_waitcnt(0); lt0_ = __builtin_amdgcn_s_memrealtime(); __builtin_amdgcn_sched_barrier(0); } } while (0)
#define LSEC_E(id) do { if (PROBE_LRU == (id)) { __builtin_amdgcn_sched_barrier(0); __builtin_amdgcn_s_waitcnt(0); lacc_ += __builtin_amdgcn_s_memrealtime() - lt0_; __builtin_amdgcn_sched_barrier(0); } } while (0)
template <bool APPLY>
DEV void lru_phase(const Params& p, LAS unsigned char* lds, int bid, int nb) {
    unsigned long long lt0_ = 0, lacc_ = 0;
    int tid = threadIdx.x; asm volatile("" : "+v"(tid));
    const int wid = __builtin_amdgcn_readfirstlane(tid >> 6), lane = tid & 63, fr = lane & 15, fq = lane >> 4;
    const int w = bid * 8 + wid, h = (w & 31) >> 2, q = w & 3;
    const bf16_t* ULRU = (const bf16_t*)(p.ws + WS_ULRU);
    const bf16_t* BTLRU = (const bf16_t*)(p.ws + WS_BTLRU);
    const float* conv_w = p.in[19]; const float* conv_b = p.in[20];
    const int c4 = h * 64 + q * 16 + 4 * fq;
    const int nch = APPLY ? 64 : 68, npairs = NBATCH * nch;
    LAS unsigned char* wl = lds + wid * 19072;
    LAS float* cwl = (LAS float*)(wl + 17408);
    for (int i = lane; i < 320; i += 64) cwl[i] = i < 256 ? conv_w[(i >> 6) * 512 + h * 64 + (i & 63)] : conv_b[h * 64 + (i & 63)];
    bf16x8 bfr[2][4];
#pragma unroll
    for (int ks = 0; ks < 2; ++ks)
#pragma unroll
        for (int nt = 0; nt < 4; ++nt) bfr[ks][nt] = *(const bf16x8*)(BTLRU + ((size_t)(h * 256 + (nt >> 1) * 128 + (nt & 1) * 64 + q * 16 + fr)) * 64 + ks * 32 + fq * 8);
    for (int i = lane; i < 96; i += 64) { const int kind = i >> 5, dir = (i >> 4) & 1, c = i & 15, o = dir * 512 + h * 64 + q * 16 + c; cwl[320 + i] = kind == 0 ? ((const float*)(p.ws + WS_LCA))[o] : (kind == 1 ? p.in[22][o] : p.in[24][o]); }
    const char* UB = (const char*)ULRU;
#define LRU_GEO(jj, base0_, plo_, phi_) const int b_##jj = (jj) / nch, ch_##jj = (jj) % nch; const bool lat_##jj = ch_##jj < 64; \
        const unsigned base0_ = (lat_##jj ? (unsigned)(b_##jj * 4096 + ch_##jj * 64) * 2048u : (unsigned)(T + b_##jj * 256 + (ch_##jj - 64) * 64) * 2048u) + (unsigned)h * 128u; \
        const int plo_ = lat_##jj ? 0 : -(ch_##jj - 64) * 64, phi_ = lat_##jj ? 64 : 256 - (ch_##jj - 64) * 64;
#define LRU_DMA(base0_, plo_, phi_, buf_) _Pragma("unroll") for (int i_ = 0; i_ < 9; ++i_) { const int s_ = i_ * 64 + lane; if (s_ < 536) { const int row_ = s_ >> 3, chk_ = (s_ & 7) ^ (row_ & 7); \
        int pos_ = row_ - 2; pos_ = pos_ < (plo_) ? (plo_) : (pos_ >= (phi_) ? (phi_) - 1 : pos_); \
        __builtin_amdgcn_global_load_lds((const unsigned*)(UB + ((base0_) + (unsigned)pos_ * 2048u + (unsigned)chk_ * 16u)), (LAS unsigned*)(wl + (buf_) * 8704 + i_ * 1024), 16, 0, 0); } }
    int jcur = w >> 5, it_ = 0;
    if (jcur < npairs) { LRU_GEO(jcur, bz, pl, ph) LRU_DMA(bz, pl, ph, 0) }
#pragma unroll 1
    for (int j = w >> 5; j < npairs; j += 64, ++it_) {
        const int b = j / nch, ch = j % nch;
        LRU_GEO(j, base0, plo, phi)
        (void)base0;
        LAS const unsigned char* xb = wl + (it_ & 1) * 8704;
        LSEC_B(4);
        asm volatile("s_waitcnt vmcnt(0)" ::: "memory");
        LSEC_E(4);
        { const int jn = j + 64; if (jn < npairs) { LRU_GEO(jn, bz, pl, ph) LRU_DMA(bz, pl, ph, (it_ + 1) & 1) } }
        asm volatile("" ::: "memory");
        f32x4 acc[4][4];
#pragma unroll
        for (int mt = 0; mt < 4; ++mt)
#pragma unroll
            for (int nt = 0; nt < 4; ++nt) acc[mt][nt] = (f32x4){0.f, 0.f, 0.f, 0.f};
        LSEC_B(1);
#pragma unroll
        for (int ks = 0; ks < 2; ++ks) {
            f32x4 cw[4][2], cb[2];
#pragma unroll
            for (int k = 0; k < 4; ++k) { cw[k][0] = *(LAS const f32x4*)(cwl + k * 64 + ks * 32 + fq * 8); cw[k][1] = *(LAS const f32x4*)(cwl + k * 64 + ks * 32 + fq * 8 + 4); }
            cb[0] = *(LAS const f32x4*)(cwl + 256 + ks * 32 + fq * 8); cb[1] = *(LAS const f32x4*)(cwl + 256 + ks * 32 + fq * 8 + 4);
#pragma unroll
            for (int mt = 0; mt < 4; ++mt) {
                f32x4 s0 = cb[0], s1 = cb[1];
#pragma unroll
                for (int k = 0; k < 4; ++k) {
                    const int row = mt * 16 + fr + k, pos = row - 2;
                    const u32x4 xr = *(LAS const u32x4*)(xb + (row * 8 + ((ks * 4 + fq) ^ (row & 7))) * 16);
                    const unsigned mk_ = (pos >= plo && pos < phi) ? 0xffffffffu : 0u;
                    const u32x4 xm = (u32x4){xr.x & mk_, xr.y & mk_, xr.z & mk_, xr.w & mk_};
                    float y[8]; bf8_unpack(xm, y);
                    s0 += cw[k][0] * (f32x4){y[0], y[1], y[2], y[3]}; s1 += cw[k][1] * (f32x4){y[4], y[5], y[6], y[7]};
                }
                u32x4 aw; aw.x = pack2(s0[0], s0[1]); aw.y = pack2(s0[2], s0[3]); aw.z = pack2(s1[0], s1[1]); aw.w = pack2(s1[2], s1[3]);
                const bf16x8 af = __builtin_bit_cast(bf16x8, aw);
#pragma unroll
                for (int nt = 0; nt < 4; ++nt) acc[mt][nt] = __builtin_amdgcn_mfma_f32_16x16x32_bf16(bfr[ks][nt], af, acc[mt][nt], 0, 0, 0);
            }
        }
        LSEC_E(1); LSEC_B(2);
        f32x4 cwo[4], cA[2], ba[2], bx[2];
#pragma unroll
        for (int k = 0; k < 4; ++k) cwo[k] = *(LAS const f32x4*)(cwl + k * 64 + q * 16 + 4 * fq);
#pragma unroll
        for (int dir = 0; dir < 2; ++dir) { cA[dir] = *(LAS const f32x4*)(cwl + 320 + dir * 16 + 4 * fq); ba[dir] = *(LAS const f32x4*)(cwl + 352 + dir * 16 + 4 * fq); bx[dir] = *(LAS const f32x4*)(cwl + 384 + dir * 16 + 4 * fq); }
        const f32x4 cbo = *(LAS const f32x4*)(cwl + 256 + q * 16 + 4 * fq);
#pragma unroll
        for (int mt = 0; mt < 4; ++mt) {
            f32x4 xo = cbo;
#pragma unroll
            for (int k = 0; k < 4; ++k) {
                const int row = mt * 16 + fr + k, pos = row - 2;
                const u32x2 xr = *(LAS const u32x2*)(xb + (row * 8 + ((q * 2 + (fq >> 1)) ^ (row & 7))) * 16 + (fq & 1) * 8);
                const unsigned mk_ = (pos >= plo && pos < phi) ? 0xffffffffu : 0u;
                const unsigned x0 = xr.x & mk_, x1 = xr.y & mk_;
                xo += cwo[k] * (f32x4){__uint_as_float(x0 << 16), __uint_as_float(x0 & 0xffff0000u), __uint_as_float(x1 << 16), __uint_as_float(x1 & 0xffff0000u)};
            }
#pragma unroll
            for (int dir = 0; dir < 2; ++dir)
#pragma unroll
                for (int r = 0; r < 4; ++r) {
                    const float za = acc[mt][2 * dir][r] + ba[dir][r], zx = acc[mt][2 * dir + 1][r] + bx[dir][r];
                    const float a = __builtin_amdgcn_exp2f(cA[dir][r] * sigmoid_f(za));
                    acc[mt][2 * dir][r] = a;
                    acc[mt][2 * dir + 1][r] = __builtin_amdgcn_sqrtf(fmaf(-a, a, 1.f)) * sigmoid_f(zx) * xo[r];
                }
        }
        LSEC_E(2); LSEC_B(3);
        const int bsel15 = ((lane & 48) | 15) << 2, bsel0 = (lane & 48) << 2;
        if (!APPLY) {
            f32x4 PA[2], PH[2];
#pragma unroll
            for (int r = 0; r < 4; ++r) {
                float cAf = 1.f, cHf = 0.f, cAr = 1.f, cHr = 0.f;
#pragma unroll
                for (int mt = 0; mt < 4; ++mt) {
                    float a = acc[mt][0][r], bq = acc[mt][1][r]; row_scan<false>(a, bq);
                    const float At = __builtin_bit_cast(float, __builtin_amdgcn_ds_bpermute(bsel15, __builtin_bit_cast(int, a)));
                    const float Ht = __builtin_bit_cast(float, __builtin_amdgcn_ds_bpermute(bsel15, __builtin_bit_cast(int, bq)));
                    cHf = At * cHf + Ht; cAf *= At;
                }
#pragma unroll
                for (int mt = 3; mt >= 0; --mt) {
                    float a = acc[mt][2][r], bq = acc[mt][3][r]; row_scan<true>(a, bq);
                    const float At = __builtin_bit_cast(float, __builtin_amdgcn_ds_bpermute(bsel0, __builtin_bit_cast(int, a)));
                    const float Ht = __builtin_bit_cast(float, __builtin_amdgcn_ds_bpermute(bsel0, __builtin_bit_cast(int, bq)));
                    cHr = At * cHr + Ht; cAr *= At;
                }
                PA[0][r] = cAf; PH[0][r] = cHf; PA[1][r] = cAr; PH[1][r] = cHr;
            }
            if (fr == 0) {
                float* SA = (float*)(p.ws + WS_SA); float* SB = (float*)(p.ws + WS_SB);
#pragma unroll
                for (int dir = 0; dir < 2; ++dir) { const size_t o = ((size_t)(b * 68 + ch) * 2 + dir) * 512 + c4; *(f32x4*)(SA + o) = PA[dir]; *(f32x4*)(SB + o) = PH[dir]; }
            }
        } else {
            const float* HIN = (const float*)(p.ws + WS_HIN);
            const f32x4 hf = *(const f32x4*)(HIN + ((size_t)(b * 64 + ch) * 2 + 0) * 512 + c4), hr = *(const f32x4*)(HIN + ((size_t)(b * 64 + ch) * 2 + 1) * 512 + c4);
            f32x4 Ho[4];
#pragma unroll
            for (int r = 0; r < 4; ++r) {
                float carry = hf[r];
#pragma unroll
                for (int mt = 0; mt < 4; ++mt) {
                    float a = acc[mt][0][r], bq = acc[mt][1][r]; row_scan<false>(a, bq);
                    const float hv = bq + a * carry; Ho[mt][r] = hv;
                    carry = __builtin_bit_cast(float, __builtin_amdgcn_ds_bpermute(bsel15, __builtin_bit_cast(int, hv)));
                }
                carry = hr[r];
#pragma unroll
                for (int mt = 3; mt >= 0; --mt) {
                    float a = acc[mt][2][r], bq = acc[mt][3][r]; row_scan<true>(a, bq);
                    const float hv = bq + a * carry; Ho[mt][r] += hv;
                    carry = __builtin_bit_cast(float, __builtin_amdgcn_ds_bpermute(bsel0, __builtin_bit_cast(int, hv)));
                }
            }
            bf16_t* YCAT = (bf16_t*)(p.ws + WS_YCAT);
#pragma unroll
            for (int mt = 0; mt < 4; ++mt) {
                const size_t row = (size_t)b * 4096 + (size_t)ch * 64 + (mt * 16 + fr);
                const u32x2 gw = *(const u32x2*)(ULRU + row * 1024 + 512 + c4);
                const float g0 = __uint_as_float(gw.x << 16), g1 = __uint_as_float(gw.x & 0xffff0000u), g2 = __uint_as_float(gw.y << 16), g3 = __uint_as_float(gw.y & 0xffff0000u);
                u32x2 ow; ow.x = pack2(Ho[mt][0] * gelu_tanh(g0), Ho[mt][1] * gelu_tanh(g1)); ow.y = pack2(Ho[mt][2] * gelu_tanh(g2), Ho[mt][3] * gelu_tanh(g3));
                *(u32x2*)(YCAT + row * 1024 + 512 + c4) = ow;
            }
        }
        LSEC_E(3);
    }
    if (PROBE_LRU >= 0 && !APPLY && bid == 0) { const unsigned long long d_ = lacc_ * 8ull, t0_ = __builtin_amdgcn_s_memrealtime(); while (__builtin_amdgcn_s_memrealtime() - t0_ < d_) __builtin_amdgcn_s_sleep(8); }
}

#if PROBE_SUB == 6 || PROBE_SUB == 7
DEV void lru_load_probe(const Params& p, int bid, int nb) {
    int tid = threadIdx.x; asm volatile("" : "+v"(tid));
    const int wid = tid >> 6, lane = tid & 63, fr = lane & 15, fq = lane >> 4;
    const int w = bid * 8 + wid, h = (w & 31) >> 2, q = w & 3;
    const bf16_t* ULRU = (const bf16_t*)(p.ws + WS_ULRU);
    unsigned sink = 0;
    for (int j = w >> 5; j < NBATCH * 68; j += 64) {
        const int b = j / 68, ch = j % 68;
        const bool lat = ch < 64;
        const size_t base0 = lat ? ((size_t)b * 4096 + ch) * 1024 : ((size_t)T + b * 256 + (ch - 64) * 64) * 1024;
        const size_t pstride = lat ? (size_t)64 * 1024 : (size_t)1024;
#if PROBE_SUB == 6
        if (q == 0)
#endif
#pragma unroll
        for (int mt = 0; mt < 4; ++mt) { const int pos = mt * 16 + fr; const u32x4 v = *(const u32x4*)(ULRU + base0 + (size_t)pos * pstride + fq * 8 + h * 64); sink += v.x ^ v.y ^ v.z ^ v.w; }
    }
    asm volatile("" :: "v"(sink));
}
#endif
DEV unsigned char* slab_row(unsigned char* ws, size_t row) { return row < (size_t)SLAB_ROWS_A ? ws + WS_SLABA + row * 1024 : ws + WS_SLABB + (row - SLAB_ROWS_A) * 1024; }
constexpr int MOE_TAB_OFF = 132096;
DEV void moe_tables(const Params& p, LAS unsigned char* lds, int h) {
    LAS int* tp = (LAS int*)(lds + MOE_TAB_OFF); LAS int* pc = tp + 72; LAS int* cn = pc + 72; LAS int* texp = cn + 72;
    if (threadIdx.x == 0) {
        const int* cnt = (const int*)(p.ws + WS_CNT) + h * 64;
        int t = 0, q = 0;
        for (int e = 0; e < 65; ++e) { const int c = e < 64 ? cnt[e] : HALF_T; cn[e] = c; tp[e] = t; pc[e] = q; t += (c + 255) >> 8; q += c; }
        tp[65] = t; pc[65] = q;
    }
    __syncthreads();
    for (int e = threadIdx.x >> 3; e < 65; e += 64) for (int r = tp[e] + (threadIdx.x & 7); r < tp[e + 1]; r += 8) texp[r] = e;
    __syncthreads();
}
template <bool GU>
struct MoeSched {
    struct Unit { int e, r0t, pn; };
    static constexpr bool GATHER = GU;
    LAS const int* tp; LAS const int* pc; LAS const int* cn;
    const char* Abase; const char* Bt; const unsigned* list; int h, nN, nunits, G, c;
    DEV int lda() const { return 256; }
    DEV bool next(int i, Unit& u) const {
        const long L = (long)i * G + c; if (L >= nunits) return false;
        int w = (int)L; { const int q = nunits / 8, r = nunits % 8, xcd = w % 8, off = w / 8; w = (xcd < r ? xcd * (q + 1) : r * (q + 1) + (xcd - r) * q) + off; }
        const int rt = w / nN; u.pn = w % nN;
        const int e = tp[216 + rt];
        u.e = e; u.r0t = (rt - tp[e]) * 256; return true;
    }
    DEV unsigned tokoff(int e, int ce, int idx, int C) const {
        idx = idx < ce ? idx : ce - 1;
        const int tok = e < 64 ? (int)(list[(size_t)e * HALF_T + idx] >> 16) : idx;
        return (unsigned)tok * 4096u + 2048u + (unsigned)C * 2u;
    }
    DEV void addr(const Unit& u, int R0, int C0, int R1, int C1, gp::UAddr& o) const {
        if constexpr (GU) {
            const int ce = cn[u.e];
            o.a = Abase; o.b = Bt + ((size_t)u.e * 512 + u.pn * 256) * 2048;
            o.ao00 = tokoff(u.e, ce, u.r0t + R0, C0); o.ao01 = tokoff(u.e, ce, u.r0t + R1, C1);
            o.ao10 = tokoff(u.e, ce, u.r0t + 128 + R0, C0); o.ao11 = tokoff(u.e, ce, u.r0t + 128 + R1, C1);
        } else {
            o.a = Abase + ((size_t)pc[u.e] + u.r0t) * 512; o.b = Bt + ((size_t)u.e * 1024 + u.pn * 256) * 512;
        }
    }
};
struct EpiMoeGU {
    static constexpr bool PERM = false;
    LAS const int* pc; LAS const int* cn; const unsigned* list; bf16_t* HMID;
    template <class U> DEV void operator()(const f32x4 (&acc)[2][2][4][2], const U& u, int wr, int wc, int fr, int fq) const {
        const int ce = cn[u.e]; const size_t prow = (size_t)pc[u.e];
        float wt[2][4];
#pragma unroll
        for (int ai = 0; ai < 2; ++ai)
#pragma unroll
            for (int m = 0; m < 4; ++m) {
                int idx = u.r0t + ai * 128 + wr * 64 + m * 16 + fr; idx = idx < ce ? idx : ce - 1;
                wt[ai][m] = u.e < 64 ? __uint_as_float(list[(size_t)u.e * HALF_T + idx] << 16) : 1.f;
            }
#pragma unroll
        for (int ai = 0; ai < 2; ++ai)
#pragma unroll
            for (int m = 0; m < 4; ++m) {
                const int idx = u.r0t + ai * 128 + wr * 64 + m * 16 + fr;
                if (idx < ce) {
                    const float w_ = wt[ai][m];
                    bf16_t* rowp = HMID + (prow + idx) * 256 + u.pn * 128 + wc * 16 + 4 * fq;
#pragma unroll
                    for (int bj = 0; bj < 2; ++bj) {
                        const f32x4 gt = acc[ai][bj][m][0], up = acc[ai][bj][m][1];
                        u32x2 w; w.x = pack2(w_ * gt[0] * sigmoid_f(gt[0]) * up[0], w_ * gt[1] * sigmoid_f(gt[1]) * up[1]);
                        w.y = pack2(w_ * gt[2] * sigmoid_f(gt[2]) * up[2], w_ * gt[3] * sigmoid_f(gt[3]) * up[3]);
                        *(u32x2*)(rowp + bj * 64) = w;
                    }
                }
            }
    }
};
struct EpiMoeDN {
    static constexpr bool PERM = true;
    LAS const int* pc; LAS const int* cn; unsigned char* ws; bf16_t* out2;
    template <class U> DEV void operator()(const f32x4 (&acc)[2][2][4][2], const U& u, int wr, int wc, int fr, int fq) const {
        const int ce = cn[u.e]; const size_t prow = (size_t)pc[u.e];
#pragma unroll
        for (int ai = 0; ai < 2; ++ai)
#pragma unroll
            for (int m = 0; m < 4; ++m) {
                const int idx = u.r0t + ai * 128 + wr * 64 + m * 16 + fr;
                if (idx < ce) {
                    const int colb = u.pn * 256 + wc * 32 + 8 * fq;
                    if (u.e < 64) {
                        unsigned char* rowp = slab_row(ws, prow + idx) + colb;
#pragma unroll
                        for (int bj = 0; bj < 2; ++bj) {
                            const f32x4 v0 = acc[ai][bj][m][0] * SLAB_SCALE, v1 = acc[ai][bj][m][1] * SLAB_SCALE;
                            int w0 = 0, w1 = 0;
                            w0 = __builtin_amdgcn_cvt_pk_fp8_f32(v0[0], v0[1], w0, false); w0 = __builtin_amdgcn_cvt_pk_fp8_f32(v0[2], v0[3], w0, true);
                            w1 = __builtin_amdgcn_cvt_pk_fp8_f32(v1[0], v1[1], w1, false); w1 = __builtin_amdgcn_cvt_pk_fp8_f32(v1[2], v1[3], w1, true);
                            *(u32x2*)(rowp + bj * 128) = (u32x2){(unsigned)w0, (unsigned)w1};
                        }
                    } else {
                        bf16_t* rowp = out2 + (size_t)idx * 2048 + 1024 + colb;
#pragma unroll
                        for (int bj = 0; bj < 2; ++bj) {
                            const f32x4 v0 = acc[ai][bj][m][0], v1 = acc[ai][bj][m][1];
                            u32x4 w; w.x = pack2(v0[0], v0[1]); w.y = pack2(v0[2], v0[3]); w.z = pack2(v1[0], v1[1]); w.w = pack2(v1[2], v1[3]);
                            *(u32x4*)(rowp + bj * 128) = w;
                        }
                    }
                }
            }
    }
};
DEV void fp8x16_add(const u32x4 w, float (&f)[16]) {
    typedef float f2 __attribute__((ext_vector_type(2)));
    const unsigned ww[4] = {w.x, w.y, w.z, w.w};
#pragma unroll
    for (int j = 0; j < 4; ++j) {
        const f2 a = __builtin_amdgcn_cvt_pk_f32_fp8((int)ww[j], false), b = __builtin_amdgcn_cvt_pk_f32_fp8((int)ww[j], true);
        f[4 * j] += a.x; f[4 * j + 1] += a.y; f[4 * j + 2] += b.x; f[4 * j + 3] += b.y;
    }
}
DEV void moe_reduce(const Params& p, LAS unsigned char* lds, int h, int bid, int nb) {
    int tid = threadIdx.x; asm volatile("" : "+v"(tid));
    const int wid = tid >> 6, lane = tid & 63;
    LAS const int* pc = (LAS const int*)(lds + MOE_TAB_OFF) + 72;
    const int* PAIR = (const int*)(p.ws + WS_PAIR); const float* ADA = (const float*)(p.ws + WS_ADA);
    for (int it = bid; it < HALF_T / 8; it += nb) {
        const int tokl = it * 8 + wid; const size_t tok = (size_t)h * HALF_T + tokl; const int b = (int)(tok >> 12), col = lane * 16;
        int pr[8];
#pragma unroll
        for (int k = 0; k < 8; ++k) pr[k] = PAIR[tok * 8 + k];
        u32x4 rows[8];
#pragma unroll
        for (int k = 0; k < 8; ++k) rows[k] = *(const u32x4*)(slab_row(p.ws, (size_t)pc[pr[k] >> 16] + (pr[k] & 0xffff)) + col);
        const u32x4 sh0 = *(const u32x4*)((const bf16_t*)p.out + tok * 2048 + 1024 + col), sh1 = *(const u32x4*)((const bf16_t*)p.out + tok * 2048 + 1024 + col + 8);
        const u32x4 hr0 = *(const u32x4*)((const bf16_t*)p.out + tok * 2048 + col), hr1 = *(const u32x4*)((const bf16_t*)p.out + tok * 2048 + col + 8);
        f32x4 g2v[4], ggv[4], bbv[4];
#pragma unroll
        for (int q = 0; q < 4; ++q) { g2v[q] = *(const f32x4*)(ADA + b * 6144 + 5120 + col + q * 4); ggv[q] = *(const f32x4*)(p.in[37] + col + q * 4); bbv[q] = *(const f32x4*)(p.in[38] + col + q * 4); }
        float f[16];
#pragma unroll
        for (int j = 0; j < 16; ++j) f[j] = 0.f;
#pragma unroll
        for (int k = 0; k < 8; ++k) fp8x16_add(rows[k], f);
        { float y0[8], y1[8]; bf8_unpack(sh0, y0); bf8_unpack(sh1, y1);
#pragma unroll
          for (int j = 0; j < 8; ++j) { f[j] += y0[j] * SLAB_SCALE; f[8 + j] += y1[j] * SLAB_SCALE; } }
        float z[16]; float s = 0.f;
        { float y0[8], y1[8]; bf8_unpack(hr0, y0); bf8_unpack(hr1, y1);
#pragma unroll
          for (int j = 0; j < 8; ++j) { z[j] = y0[j] * ALPHA_F + g2v[j >> 2][j & 3] * (f[j] * (1.f / SLAB_SCALE)); z[8 + j] = y1[j] * ALPHA_F + g2v[2 + (j >> 2)][j & 3] * (f[8 + j] * (1.f / SLAB_SCALE)); }
#pragma unroll
          for (int j = 0; j < 16; ++j) s += z[j]; }
        const float mean = wave_sum(s) * (1.f / 1024.f); float qq = 0.f;
#pragma unroll
        for (int j = 0; j < 16; ++j) { const float d = z[j] - mean; qq += d * d; }
        const float rstd = rsqrtf(wave_sum(qq) * (1.f / 1024.f) + LN_EPS_F);
#pragma unroll
        for (int q = 0; q < 4; ++q) {
            f32x4 o;
#pragma unroll
            for (int j = 0; j < 4; ++j) o[j] = (z[q * 4 + j] - mean) * rstd * ggv[q][j] + bbv[q][j];
            *(f32x4*)(p.out + tok * 1024 + col + q * 4) = o;
        }
    }
}

#define ADA ((float*)(p.ws + WS_ADA))
#define HB ((bf16_t*)(p.ws + WS_HB))
#define BTIN ((bf16_t*)(p.ws + WS_BTIN))
#define HM ((bf16_t*)(p.ws + WS_HM))
#define US5 ((bf16_t*)(p.ws + WS_US5))
#define ULRU ((bf16_t*)(p.ws + WS_ULRU))
#define SLOC ((float*)(p.ws + WS_SLOC))
#define YS5 ((bf16_t*)(p.ws + WS_YS5))
#define YCAT ((bf16_t*)(p.ws + WS_YCAT))
#define Y ((bf16_t*)(p.ws + WS_Y))
#define LIST ((unsigned*)(p.ws + WS_LIST))
#define HMID ((bf16_t*)(p.ws + WS_HMID))
#define PAIR ((int*)(p.ws + WS_PAIR))
#define CNT ((int*)(p.ws + WS_CNT))
__global__ void __launch_bounds__(512) mk_fwd(Params p) {
    extern __shared__ __attribute__((aligned(16))) unsigned char lds_raw[];
    LAS unsigned char* lds = (LAS unsigned char*)lds_raw;
    const int bid = blockIdx.x, nb = gridDim.x;
    volatile LAS unsigned* MISC = (volatile LAS unsigned*)(lds + MISC_OFF);
    if (threadIdx.x < 64) MISC[threadIdx.x] = 0u;
    __syncthreads();
    unsigned char* const ws = p.ws;
    XcdBarrier bar; bar.bar = (unsigned*)(ws + WS_CTL); bar.x = 0; bar.st = nullptr;
    const bool fused = (p.ph_hi - p.ph_lo) > 1;
    if (fused) bar = xcd_barrier_post((unsigned*)(ws + WS_CTL), MISC + 8);

    const int lo = p.ph_lo, hi = p.ph_hi;
#ifndef PROBE_REP_PH
#define PROBE_REP_PH -1
#endif
#define IN(k) (lo <= (k) && (k) < hi)
#ifndef PROBE_TIME
#define PROBE_TIME -1
#endif
    unsigned long long tprobe0_ = 0, tprobe1_ = 0;
#ifndef PROBE_SEC
#define PROBE_SEC -1
#endif
    unsigned long long tsec_acc_ = 0, tsec_t0_ = 0;
#define SEC_BEGIN(id) do { if (PROBE_SEC == (id)) { __builtin_amdgcn_s_waitcnt(0); tsec_t0_ = __builtin_amdgcn_s_memrealtime(); } } while (0)
#define SEC_END(id) do { if (PROBE_SEC == (id)) { __builtin_amdgcn_s_waitcnt(0); tsec_acc_ += __builtin_amdgcn_s_memrealtime() - tsec_t0_; } } while (0)
#define TSTAMP(k) do { if (PROBE_TIME >= 0) { if ((k) == PROBE_TIME) tprobe0_ = __builtin_amdgcn_s_memrealtime(); if ((k) == PROBE_TIME + 1) tprobe1_ = __builtin_amdgcn_s_memrealtime(); } } while (0)
#define TIDS int tid = threadIdx.x; asm volatile("" : "+v"(tid)); const int wid = tid >> 6, lane = tid & 63; (void)wid; (void)lane
#define REPS(k) (((k) == PROBE_REP_PH) ? 2 : 1)
#ifndef PROBE_SUB
#define PROBE_SUB -1
#endif
#define SUBREPS(k) (((k) == PROBE_SUB) ? 2 : 1)
#define SEAM(k) do { if (IN(k) && IN((k) + 1)) xcd_barrier(bar); else __syncthreads(); TSTAMP((k) + 1); } while (0)
    {
        TSTAMP(0);
        for (int rep_ = 0; rep_ < REPS(0); ++rep_) if (IN(0)) { if (rep_) xcd_barrier(bar); TIDS;
            for (int sr_ = 0; sr_ < SUBREPS(1); ++sr_)
            for (int it = bid; it < 256; it += nb) s5_tables(p, lds, it >> 3, it & 7);
            {
                LAS float* S = (LAS float*)lds; LAS float* red = S + 9216;
                __syncthreads();
                for (int i = tid; i < 9216; i += 512) { const float c = i < 8192 ? p.in[1][i] : p.in[3][i - 8192]; S[i] = c * sigmoid_f(c); }
                if (bid == nb - 1) for (int i = tid; i < 1024; i += 512) ((float*)(ws + WS_LCA))[i] = -8.f * 1.4426950408889634f * log1pf(__expf(-p.in[25][i]));
                if (bid >= nb - 9 && bid < nb - 1) for (int i = (bid - (nb - 9)) * 8192 + tid; i < (bid - (nb - 9) + 1) * 8192; i += 512) {
                    const int e = i & 63, k = i >> 6; const float wv = p.in[29][i]; const unsigned hi = f2bf(wv); const float rem = wv - __uint_as_float(hi << 16);
                    ((bf16_t*)(ws + WS_RWH))[e * 1024 + k] = (bf16_t)hi; ((bf16_t*)(ws + WS_RWL))[e * 1024 + k] = (bf16_t)f2bf(rem);
                }
                __syncthreads();
                for (int sr_ = 0; sr_ < SUBREPS(2); ++sr_)
                for (int it = bid; it < 192; it += nb) gemv9_item(S, p.in[6], 6144, it * 32, p.in[7], ADA, 6144, red);
                __syncthreads();
            }
            {
                LAS float* tile = (LAS float*)lds + wid * (64 * 65);
                for (int sr_ = 0; sr_ < SUBREPS(3); ++sr_)
                for (int it = bid * 8 + wid; it < 736; it += nb * 8) {
                    if (it < 64) { tr_tile_wave(p.in[17], 512, (it >> 3) * 64, (it & 7) * 64, (bf16_t*)(ws + WS_BTGLU), 512, 0, tile, lane); }
                    else if (it < 320) { const int i2 = it - 64; tr_tile_wave(p.in[26], 1024, (i2 >> 4) * 64, (i2 & 15) * 64, (bf16_t*)(ws + WS_BTOUT), 1024, 0, tile, lane); }
                    else if (it < 352) {
                        const int i2 = it - 320, dir = i2 >> 4, ax = (i2 >> 3) & 1, h = i2 & 7;
                        const float* W = (ax ? p.in[23] : p.in[21]) + (size_t)(dir * 8 + h) * 4096;
                        tr_tile_wave(W, 64, 0, 0, (bf16_t*)(ws + WS_BTLRU) + (size_t)(h * 256 + dir * 128 + ax * 64) * 64, 64, 0, tile, lane);
                    } else {
                        const int i2 = it - 352;
                        tr_tile_wave(p.in[8], NWIN, (i2 / 24) * 64, (i2 % 24) * 64, BTIN, 1024, 0, tile, lane);
                    }
                }
            }
        }
        SEAM(0);
        for (int rep_ = 0; rep_ < REPS(1); ++rep_) if (IN(1)) { if (rep_) xcd_barrier(bar); TIDS;
            SEC_BEGIN(5);
            for (int it = bid; it < 256; it += nb) s5_fill(p, lds, it >> 3, it & 7);
            SEC_END(5); SEC_BEGIN(6);
            for (int it = bid; it < TT / 32; it += nb) {
                const int row0 = it * 32 + wid * 4;
                f32x4 v[4][4]; float s[4];
#pragma unroll
                for (int rr = 0; rr < 4; ++rr) {
                    const int row = row0 + rr;
                    const float* src = row < T ? p.in[0] + (size_t)row * 1024 : p.in[2] + (size_t)(row - T) * 1024;
#pragma unroll
                    for (int q = 0; q < 4; ++q) v[rr][q] = *(const f32x4*)(src + q * 256 + lane * 4);
                }
                f32x4 gg[4], bbv[4], sh1[4], sc1[4];
                { const float* ada = ADA + (row0 < T ? (row0 >> 12) : 8) * 6144;
#pragma unroll
                  for (int q = 0; q < 4; ++q) { const int col = q * 256 + lane * 4; gg[q] = *(const f32x4*)(p.in[4] + col); bbv[q] = *(const f32x4*)(p.in[5] + col); sh1[q] = *(const f32x4*)(ada + col); sc1[q] = *(const f32x4*)(ada + 1024 + col); } }
#pragma unroll
                for (int rr = 0; rr < 4; ++rr) { float a = 0.f;
#pragma unroll
                    for (int q = 0; q < 4; ++q) a += (v[rr][q][0] + v[rr][q][1]) + (v[rr][q][2] + v[rr][q][3]);
                    s[rr] = a; }
#pragma unroll
                for (int o = 1; o < 64; o <<= 1) {
#pragma unroll
                    for (int rr = 0; rr < 4; ++rr) s[rr] += __shfl_xor(s[rr], o); }
                float mean[4], qq[4];
#pragma unroll
                for (int rr = 0; rr < 4; ++rr) { mean[rr] = s[rr] * (1.f / 1024.f); float a = 0.f;
#pragma unroll
                    for (int q = 0; q < 4; ++q) { const f32x4 d = v[rr][q] - mean[rr]; a += (d[0] * d[0] + d[1] * d[1]) + (d[2] * d[2] + d[3] * d[3]); }
                    qq[rr] = a; }
#pragma unroll
                for (int o = 1; o < 64; o <<= 1) {
#pragma unroll
                    for (int rr = 0; rr < 4; ++rr) qq[rr] += __shfl_xor(qq[rr], o); }
                float rstd[4];
#pragma unroll
                for (int rr = 0; rr < 4; ++rr) rstd[rr] = rsqrtf(qq[rr] * (1.f / 1024.f) + LN_EPS_F);
#pragma unroll
                for (int q = 0; q < 4; ++q) {
                    const int col = q * 256 + lane * 4;
#pragma unroll
                    for (int rr = 0; rr < 4; ++rr) {
                        const int row = row0 + rr;
                        const f32x4 o = (v[rr][q] - mean[rr]) * rstd[rr] * gg[q] + bbv[q];
                        u32x2 w; w.x = pack2(o[0], o[1]); w.y = pack2(o[2], o[3]);
                        *(u32x2*)(HB + (size_t)row * 1024 + col) = w;
                        const f32x4 om = o * (sc1[q] + 1.f) + sh1[q];
                        u32x2 wm; wm.x = pack2(om[0], om[1]); wm.y = pack2(om[2], om[3]);
                        *(u32x2*)(HM + (size_t)row * 1024 + col) = wm;
                    }
                }
            }
            SEC_END(6);
        }
        SEAM(1);
        for (int rep_ = 0; rep_ < REPS(2); ++rep_) if (IN(2)) { if (rep_) xcd_barrier(bar); TIDS;
            { WinSched S{(const char*)HM, (const char*)BTIN, nb, bid};
              EpiWin E{US5, ULRU};
              gp::gemm_phase(lds, 1024, S, E); }
            {
                int bid_ = bid; asm volatile("" : "+s"(bid_));
                int tid2 = threadIdx.x; asm volatile("" : "+v"(tid2));
                const int wid2 = tid2 >> 6, lane2 = tid2 & 63;
                const int nfull = (136 * 6) % nb;
                const int nlow = nfull ? nb - nfull : nb, myi = nfull ? bid_ - nfull : bid_;
                if (myi >= 0) {
                    LAS float* tile = (LAS float*)lds + wid2 * (64 * 65);
                    const int step = nlow * 8; int it = myi * 8 + wid2;
                    f32x4 va[16], vb[16];
                    TrTile ta, tb;
                    if (it < 12480) { ta = expert_tile(p, it); tr_load(ta, lane2, va); }
#pragma unroll 1
                    while (it < 12480) {
                        const int i1 = it + step, i2 = it + 2 * step;
                        if (i1 < 12480) { tb = expert_tile(p, i1); tr_load(tb, lane2, vb); }
                        tr_store(ta, lane2, va, tile);
                        if (i1 >= 12480) break;
                        if (i2 < 12480) { ta = expert_tile(p, i2); tr_load(ta, lane2, va); }
                        tr_store(tb, lane2, vb, tile);
                        it = i2;
                    }
                }
            }
        }
        SEAM(2);
        for (int rep_ = 0; rep_ < REPS(3); ++rep_) if (IN(3)) { if (rep_) xcd_barrier(bar); TIDS;
            const bf16_t* ES5 = (const bf16_t*)(ws + WS_ES5);
            { S5Sched S{(const char*)US5, (const char*)ES5, 512, 5, 1, 256, nb, bid}; EpiS5Loc E{SLOC}; gp::gemm_phase(lds, 512, S, E); }
            __syncthreads();
            int bid_ = bid; asm volatile("" : "+s"(bid_));
#if PROBE_SUB == 6 || PROBE_SUB == 7
            lru_load_probe(p, bid_, nb);
#endif
            for (int sr_ = 0; sr_ < SUBREPS(4); ++sr_) lru_phase<false>(p, lds, bid_, nb);
        }
        SEAM(3);
#if PROBE_SUB == 8
        for (int xb_ = 0; xb_ < 10; ++xb_) xcd_barrier(bar);
#endif
        for (int rep_ = 0; rep_ < REPS(4); ++rep_) if (IN(4)) { if (rep_) xcd_barrier(bar); TIDS;
            const float* ALC = (const float*)(ws + WS_ALC);
            if (tid < 128) for (int i = bid * 128 + tid; i < 32768; i += nb * 128) {
                const int pp = i & 63, dir = (i >> 6) & 1, g = (i >> 7) & 31, b = i >> 12;
                const float ar = ALC[((dir * 32 + g) * 64 + pp) * 2], ai = ALC[((dir * 32 + g) * 64 + pp) * 2 + 1];
                float xr = 0.f, xi = 0.f;
                const float* Sg = SLOC + (size_t)g * M5 * 256 + dir * 128 + pp;
                {
                    float sr[NCC], si[NCC];
#pragma unroll
                    for (int s = 0; s < NCC; ++s) { const int j = dir ? NCC - 1 - s : s, m = M5LAT + b * NCC + j; sr[s] = Sg[(size_t)m * 256]; si[s] = Sg[(size_t)m * 256 + 64]; }
#pragma unroll
                    for (int s = 0; s < NCC; ++s) { const float nr = ar * xr - ai * xi + sr[s], ni = ar * xi + ai * xr + si[s]; xr = nr; xi = ni; }
                }
#pragma unroll 1
                for (int s0 = 0; s0 < NCH; s0 += 32) {
                    float sr[32], si[32];
#pragma unroll
                    for (int q = 0; q < 32; ++q) { const int k = dir ? NCH - 1 - (s0 + q) : s0 + q, m = b * NCH + k; sr[q] = Sg[(size_t)m * 256]; si[q] = Sg[(size_t)m * 256 + 64]; }
#pragma unroll
                    for (int q = 0; q < 32; ++q) {
                        const int k = dir ? NCH - 1 - (s0 + q) : s0 + q, m = b * NCH + k;
                        bf16_t* dst = US5 + ((size_t)(g * M5PAD + m)) * KT5 + 512 + dir * 128 + pp;
                        dst[0] = (bf16_t)f2bf(xr); dst[64] = (bf16_t)f2bf(xi);
                        const float nr = ar * xr - ai * xi + sr[q], ni = ar * xi + ai * xr + si[q]; xr = nr; xi = ni;
                    }
                }
            }
            const float* SA = (const float*)(ws + WS_SA); const float* SB = (const float*)(ws + WS_SB); float* HIN = (float*)(ws + WS_HIN);
            if (tid >= 128 && tid < 160) for (int i = bid * 32 + (tid - 128); i < 8192; i += nb * 32) {
                const int chn = i & 511, dir = (i >> 9) & 1, b = i >> 10;
                float H = 0.f;
                {
                    float av[4], bv[4];
#pragma unroll
                    for (int s = 0; s < 4; ++s) { const int c = 64 + (dir ? 3 - s : s); const size_t o = ((size_t)(b * 68 + c) * 2 + dir) * 512 + chn; av[s] = SA[o]; bv[s] = SB[o]; }
#pragma unroll
                    for (int s = 0; s < 4; ++s) H = av[s] * H + bv[s];
                }
#pragma unroll 1
                for (int s0 = 0; s0 < 64; s0 += 32) {
                    float av[32], bv[32];
#pragma unroll
                    for (int q = 0; q < 32; ++q) { const int c = dir ? 63 - (s0 + q) : s0 + q; const size_t o = ((size_t)(b * 68 + c) * 2 + dir) * 512 + chn; av[q] = SA[o]; bv[q] = SB[o]; }
#pragma unroll
                    for (int q = 0; q < 32; ++q) {
                        const int c = dir ? 63 - (s0 + q) : s0 + q;
                        HIN[((size_t)(b * 64 + c) * 2 + dir) * 512 + chn] = H;
                        H = av[q] * H + bv[q];
                    }
                }
            }
        }
        SEAM(4);
        for (int rep_ = 0; rep_ < REPS(5); ++rep_) if (IN(5)) { if (rep_) xcd_barrier(bar); TIDS;
            const bf16_t* BS5 = (const bf16_t*)(ws + WS_BS5);
            { S5Sched S{(const char*)US5, (const char*)BS5, KT5, 4, 2, 512, nb, bid}; EpiS5Out E{YS5}; gp::gemm_phase(lds, KT5, S, E); }
            __syncthreads();
            int bid_ = bid; asm volatile("" : "+s"(bid_));
            for (int sr_ = 0; sr_ < SUBREPS(5); ++sr_) lru_phase<true>(p, lds, bid_, nb);
        }
        SEAM(5);
        for (int rep_ = 0; rep_ < REPS(6); ++rep_) if (IN(6)) { if (rep_) xcd_barrier(bar); TIDS;
            const bf16_t* BTGLU = (const bf16_t*)(ws + WS_BTGLU); const float* b_glu = p.in[18];
            PlainSched S{(const char*)YS5, (const char*)BTGLU, 512, 512, 128, 2, nb, bid};
            EpiGlu E{YS5, b_glu, YCAT};
            gp::gemm_phase(lds, 512, S, E);
        }
        SEAM(6);
        for (int rep_ = 0; rep_ < REPS(7); ++rep_) if (IN(7)) { if (rep_) xcd_barrier(bar); TIDS;
            const bf16_t* BTOUT = (const bf16_t*)(ws + WS_BTOUT);
            PlainSched S{(const char*)YCAT, (const char*)BTOUT, 1024, 1024, 128, 4, nb, bid};
            EpiBf16 E{Y, 1024};
            gp::gemm_phase(lds, 1024, S, E);
        }
        SEAM(7);
        if (IN(8)) { TIDS;
            LAS unsigned char* VH = lds;
            LAS float* PART = (LAS float*)lds;
            LAS int* DEC = (LAS int*)(lds + 132096);
            LAS float* DECW = (LAS float*)(lds + 132096 + 4096);
            LAS int* lcnt = (LAS int*)(lds + 148480); LAS int* gbase = lcnt + 128;
            const int fr = lane & 15, fq = lane >> 4;
            const float rbias = p.in[30][lane];
            if (tid < 128) lcnt[tid] = 0;
            bf16x8 bw[4][4];
#pragma unroll
            for (int kk = 0; kk < 4; ++kk)
#pragma unroll
                for (int nt = 0; nt < 4; ++nt) bw[kk][nt] = *(const bf16x8*)((const bf16_t*)(ws + WS_RWH) + (size_t)(nt * 16 + fr) * 1024 + (wid * 4 + kk) * 32 + fq * 8);
            int nit = 0, it_first = bid;
            for (int it = bid; it < T / 64; it += nb) {
                const int t0 = it * 64;
                SEC_BEGIN(1);
#pragma unroll 1
                for (int rnd = 0; rnd < 4; ++rnd) {
                    const size_t tok0 = (size_t)t0 + wid * 8 + rnd * 2; const int b = (int)(tok0 >> 12);
                    const float* ada = ADA + b * 6144;
                    f32x4 z[2][4]; float s4[2];
                    {
                        u32x2 hh[2][4], yv[2][4]; f32x4 g1[4];
#pragma unroll
                        for (int q = 0; q < 4; ++q) g1[q] = *(const f32x4*)(ada + 2048 + q * 256 + lane * 4);
#pragma unroll
                        for (int rr = 0; rr < 2; ++rr)
#pragma unroll
                            for (int q = 0; q < 4; ++q) { const int col = q * 256 + lane * 4; hh[rr][q] = *(const u32x2*)(HB + (tok0 + rr) * 1024 + col); yv[rr][q] = *(const u32x2*)(Y + (size_t)cmaj((int)(tok0 + rr)) * 1024 + col); }
#pragma unroll
                        for (int rr = 0; rr < 2; ++rr) { float a = 0.f;
#pragma unroll
                            for (int q = 0; q < 4; ++q) {
                                f32x4 hv; hv[0] = __uint_as_float(hh[rr][q].x << 16); hv[1] = __uint_as_float(hh[rr][q].x & 0xffff0000u); hv[2] = __uint_as_float(hh[rr][q].y << 16); hv[3] = __uint_as_float(hh[rr][q].y & 0xffff0000u);
                                f32x4 yf; yf[0] = __uint_as_float(yv[rr][q].x << 16); yf[1] = __uint_as_float(yv[rr][q].x & 0xffff0000u); yf[2] = __uint_as_float(yv[rr][q].y << 16); yf[3] = __uint_as_float(yv[rr][q].y & 0xffff0000u);
                                z[rr][q] = hv * ALPHA_F + g1[q] * yf;
                                a += (z[rr][q][0] + z[rr][q][1]) + (z[rr][q][2] + z[rr][q][3]);
                            }
                            s4[rr] = a; }
                    }
                    f32x4 gg[4], bbv[4], sc2[4], sh2[4];
#pragma unroll
                    for (int q = 0; q < 4; ++q) { const int col = q * 256 + lane * 4; gg[q] = *(const f32x4*)(p.in[27] + col); bbv[q] = *(const f32x4*)(p.in[28] + col); sc2[q] = *(const f32x4*)(ada + 4096 + col); sh2[q] = *(const f32x4*)(ada + 3072 + col); }
#pragma unroll
                    for (int o = 1; o < 64; o <<= 1) {
#pragma unroll
                        for (int rr = 0; rr < 2; ++rr) s4[rr] += __shfl_xor(s4[rr], o); }
                    float mean[2], q4[2];
#pragma unroll
                    for (int rr = 0; rr < 2; ++rr) { mean[rr] = s4[rr] * (1.f / 1024.f); float a = 0.f;
#pragma unroll
                        for (int q = 0; q < 4; ++q) { const f32x4 d = z[rr][q] - mean[rr]; a += (d[0] * d[0] + d[1] * d[1]) + (d[2] * d[2] + d[3] * d[3]); }
                        q4[rr] = a; }
#pragma unroll
                    for (int o = 1; o < 64; o <<= 1) {
#pragma unroll
                        for (int rr = 0; rr < 2; ++rr) q4[rr] += __shfl_xor(q4[rr], o); }
#pragma unroll
                    for (int rr = 0; rr < 2; ++rr) {
                        const float rstd = rsqrtf(q4[rr] * (1.f / 1024.f) + LN_EPS_F);
                        const size_t tok = tok0 + rr; const int tl = wid * 8 + rnd * 2 + rr;
#pragma unroll
                        for (int q = 0; q < 4; ++q) {
                            const int col = q * 256 + lane * 4;
                            const f32x4 h1 = (z[rr][q] - mean[rr]) * rstd * gg[q] + bbv[q];
                            { u32x2 wh; wh.x = pack2(h1[0], h1[1]); wh.y = pack2(h1[2], h1[3]); *(u32x2*)((bf16_t*)p.out + tok * 2048 + col) = wh; }
                            const f32x4 v = h1 * (sc2[q] + 1.f) + sh2[q];
                            u32x2 w; w.x = pack2(v[0], v[1]); w.y = pack2(v[2], v[3]);
                            *(u32x2*)((bf16_t*)p.out + tok * 2048 + 1024 + col) = w;
                            *(LAS u32x2*)(VH + tl * 2064 + col * 2) = w;
                        }
                    }
                }
                __syncthreads();
                SEC_END(1); SEC_BEGIN(2);
                {
                    f32x4 acc[4][4];
#pragma unroll
                    for (int mt = 0; mt < 4; ++mt)
#pragma unroll
                        for (int nt = 0; nt < 4; ++nt) acc[mt][nt] = (f32x4){0.f, 0.f, 0.f, 0.f};
#pragma unroll
                    for (int kk = 0; kk < 4; ++kk) {
                        const int k0 = (wid * 4 + kk) * 32 + fq * 8;
#pragma unroll
                        for (int mt = 0; mt < 4; ++mt) {
                            const bf16x8 av = *(LAS const bf16x8*)(VH + (mt * 16 + fr) * 2064 + k0 * 2);
#pragma unroll
                            for (int nt = 0; nt < 4; ++nt) acc[mt][nt] = __builtin_amdgcn_mfma_f32_16x16x32_bf16(bw[kk][nt], av, acc[mt][nt], 0, 0, 0);
                        }
                    }
                    __syncthreads();
#pragma unroll
                    for (int mt = 0; mt < 4; ++mt)
#pragma unroll
                        for (int nt = 0; nt < 4; ++nt) *(LAS f32x4*)(PART + (wid * 64 + mt * 16 + fr) * 64 + nt * 16 + 4 * fq) = acc[mt][nt];
                }
                __syncthreads();
                SEC_END(2); SEC_BEGIN(3);
                {
                    const int hh = t0 / HALF_T;
#pragma unroll 1
                    for (int r = 0; r < 8; r += 2) {
                        float lg[2] = {0.f, 0.f};
#pragma unroll
                        for (int w8 = 0; w8 < 8; ++w8) {
#pragma unroll
                            for (int u = 0; u < 2; ++u) lg[u] += PART[(w8 * 64 + wid * 8 + r + u) * 64 + lane]; }
                        float sc[2], sel[2], m1[2], m2[2], gs[2], mv[2]; unsigned long long gmask[2]; int rank[2]; bool selected[2];
#pragma unroll
                        for (int u = 0; u < 2; ++u) { sc[u] = sigmoid_f(lg[u]); sel[u] = sc[u] + rbias; m1[u] = sel[u]; }
#pragma unroll
                        for (int o = 1; o < 8; o <<= 1) {
#pragma unroll
                            for (int u = 0; u < 2; ++u) m1[u] = fmaxf(m1[u], __shfl_xor(m1[u], o)); }
#pragma unroll
                        for (int u = 0; u < 2; ++u) {
                            const unsigned long long bal = __ballot(sel[u] == m1[u]);
                            const unsigned gb = (unsigned)(bal >> (lane & 56)) & 0xffu;
                            const int first = __builtin_ctz(gb | 0x100u);
                            m2[u] = ((lane & 7) == first) ? -INFINITY : sel[u];
                        }
#pragma unroll
                        for (int o = 1; o < 8; o <<= 1) {
#pragma unroll
                            for (int u = 0; u < 2; ++u) m2[u] = fmaxf(m2[u], __shfl_xor(m2[u], o)); }
                        const int mygrp = lane >> 3;
                        int grank[2] = {0, 0};
#pragma unroll
                        for (int u = 0; u < 2; ++u) gs[u] = m1[u] + m2[u];
#pragma unroll
                        for (int j = 0; j < 8; ++j) {
#pragma unroll
                            for (int u = 0; u < 2; ++u) { const float gj = __builtin_bit_cast(float, __builtin_amdgcn_readlane(__builtin_bit_cast(int, gs[u]), 8 * j)); grank[u] += (gj > gs[u] || (gj == gs[u] && j < mygrp)) ? 1 : 0; } }
#pragma unroll
                        for (int u = 0; u < 2; ++u) { selected[u] = grank[u] < 4; gmask[u] = __ballot(selected[u]); mv[u] = selected[u] ? sel[u] : -INFINITY; rank[u] = 0; }
#pragma unroll
                        for (int j = 0; j < 64; ++j) {
#pragma unroll
                            for (int u = 0; u < 2; ++u)
                                if ((gmask[u] >> j) & 1ull) { const float vj = __builtin_bit_cast(float, __builtin_amdgcn_readlane(__builtin_bit_cast(int, mv[u]), j)); rank[u] += (vj > mv[u] || (vj == mv[u] && j < lane)) ? 1 : 0; }
                        }
#pragma unroll
                        for (int u = 0; u < 2; ++u) {
                            const int tl = wid * 8 + r + u;
                            const bool chosen = selected[u] && rank[u] < 8;
                            const float wsum = wave_sum(chosen ? sc[u] : 0.f);
                            if (chosen) {
                                const int lr = __hip_atomic_fetch_add(lcnt + hh * 64 + lane, 1, __ATOMIC_RELAXED, __HIP_MEMORY_SCOPE_WORKGROUP);
                                DEC[((nit & 1) * 64 + tl) * 8 + rank[u]] = (lane << 16) | lr; DECW[((nit & 1) * 64 + tl) * 8 + rank[u]] = sc[u] / wsum * 2.5f;
                            }
                        }
                    }
                }
                __syncthreads();
                SEC_END(3); SEC_BEGIN(4);
                ++nit;
                const bool last = (it + nb >= T / 64);
                if ((nit & 1) == 0 || last) {
                    const int nflush = (nit & 1) == 0 ? 2 : 1;
                    if (tid < 128) { const int c = lcnt[tid]; gbase[tid] = c ? atomicAdd(CNT + tid, c) : 0; lcnt[tid] = 0; }
                    __syncthreads();
                    for (int n = tid; n < nflush * 512; n += 512) {
                        const int g2 = n >> 9, tl = (n >> 3) & 63, tok = (it_first + g2 * nb) * 64 + tl, hq = tok / HALF_T;
                        const int d = DEC[n], e = d >> 16, rk = gbase[hq * 64 + e] + (d & 0xffff);
                        const size_t pos = (size_t)(hq * 64 + e) * HALF_T + rk;
                        LIST[pos] = ((unsigned)tok << 16) | f2bf(DECW[n]); PAIR[(size_t)tok * 8 + (n & 7)] = (e << 16) | rk;
                    }
                    __syncthreads();
                    it_first = it + nb;
                }
                SEC_END(4);
            }
        }
        SEAM(8);
        for (int rep_ = 0; rep_ < REPS(9); ++rep_) if (IN(9)) { if (rep_) xcd_barrier(bar); TIDS;
            moe_tables(p, lds, 0);
            LAS const int* tp = (LAS const int*)(lds + MOE_TAB_OFF); LAS const int* pc = tp + 72; LAS const int* cn = pc + 72;
            MoeSched<true> S{tp, pc, cn, (const char*)p.out, (const char*)(ws + WS_BTGU), LIST, 0, 2, tp[65] * 2, nb, bid};
            EpiMoeGU E{pc, cn, LIST, HMID};
            gp::gemm_phase(lds, 1024, S, E);
        }
        SEAM(9);
        for (int rep_ = 0; rep_ < REPS(10); ++rep_) if (IN(10)) { if (rep_) xcd_barrier(bar); TIDS;
            moe_tables(p, lds, 0);
            LAS const int* tp = (LAS const int*)(lds + MOE_TAB_OFF); LAS const int* pc = tp + 72; LAS const int* cn = pc + 72;
            MoeSched<false> S{tp, pc, cn, (const char*)HMID, (const char*)(ws + WS_BTDN), LIST, 0, 4, tp[65] * 4, nb, bid};
            EpiMoeDN E{pc, cn, ws, (bf16_t*)p.out};
            gp::gemm_phase(lds, 256, S, E);
        }
        SEAM(10);
        if (IN(11)) { TIDS;
            moe_tables(p, lds, 0);
            moe_reduce(p, lds, 0, bid, nb);
        }
        if (PROBE_SEC >= 0 && bid == 0) { const unsigned long long d_ = tsec_acc_ * 8ull, t0_ = __builtin_amdgcn_s_memrealtime(); while (__builtin_amdgcn_s_memrealtime() - t0_ < d_) __builtin_amdgcn_s_sleep(8); }
        if (PROBE_TIME >= 0) {
            if (PROBE_TIME == 11) { xcd_barrier(bar); tprobe1_ = __builtin_amdgcn_s_memrealtime(); }
            if (bid == 0) { const unsigned long long d_ = (tprobe1_ - tprobe0_) * 8ull, t0_ = __builtin_amdgcn_s_memrealtime(); while (__builtin_amdgcn_s_memrealtime() - t0_ < d_) __builtin_amdgcn_s_sleep(8); }
        }
    }
}

extern "C" void kernel_launch(void* const* d_in, const int* in_sizes, int n_in, void* d_out, int out_size, void* d_ws, size_t ws_size, hipStream_t stream) {
    static int grid = 0;
    if (grid == 0) {
        if (n_in != 39 || out_size != T * D || ws_size < WS_END) { fprintf(stderr, "kernel_launch: unexpected problem (n_in %d, out %d, ws %zu); nothing launched\n", n_in, out_size, ws_size); grid = -1; return; }
        int dev = 0, cus = 0;
        if (hipGetDevice(&dev) != hipSuccess || hipDeviceGetAttribute(&cus, hipDeviceAttributeMultiprocessorCount, dev) != hipSuccess) { grid = -1; return; }
        if (hipFuncSetAttribute((const void*)mk_fwd, hipFuncAttributeMaxDynamicSharedMemorySize, LDS_BYTES) != hipSuccess) { fprintf(stderr, "kernel_launch: hipFuncSetAttribute failed\n"); grid = -1; return; }
        grid = cus > 0 ? cus : 256;
    }
    if (grid < 0) return;
    (void)in_sizes;
    if (hipMemsetAsync((char*)d_ws + WS_CTL, 0, CTL_ZERO_BYTES, stream) != hipSuccess) return;
    Params p{};
    for (int i = 0; i < 39; ++i) p.in[i] = (const float*)d_in[i];
    p.out = (float*)d_out; p.ws = (unsigned char*)d_ws;
#if MK_N_LAUNCHES == 1
    p.ph_lo = 0; p.ph_hi = NPHASE;
    hipLaunchKernelGGL(mk_fwd, dim3(grid), dim3(512), LDS_BYTES, stream, p);
#else
    for (int ph = 0; ph < NPHASE; ++ph) {
        p.ph_lo = ph; p.ph_hi = ph + 1;
        hipLaunchKernelGGL(mk_fwd, dim3(grid), dim3(512), LDS_BYTES, stream, p);
    }
#endif
}
```

```cpp
#include <hip/hip_runtime.h>
#include <cstdio>
#include <cstdint>

#ifndef MK_N_LAUNCHES
#define MK_N_LAUNCHES 1
#endif

#define DEV __device__ __forceinline__
#define LAS __attribute__((address_space(3)))
typedef unsigned short bf16_t;
typedef short bf16x8 __attribute__((ext_vector_type(8)));
typedef float f32x4 __attribute__((ext_vector_type(4)));
typedef unsigned u32x2 __attribute__((ext_vector_type(2)));
typedef unsigned u32x4 __attribute__((ext_vector_type(4)));
typedef int i32x4 __attribute__((ext_vector_type(4)));
typedef int i32x8 __attribute__((ext_vector_type(8)));

constexpr int D = 1024, NBATCH = 8, SEQ = 4096, T = NBATCH * SEQ, CTXL = 256, TC = NBATCH * CTXL, TT = T + TC;
constexpr int NWIN = 1536;
constexpr int LC = 32, KT5 = 768, NCH = SEQ / LC  , NCC = CTXL / LC  ;
constexpr int M5LAT = NBATCH * NCH  , M5 = M5LAT + NBATCH * NCC  , M5PAD = 1280;
constexpr int NE = 64;
constexpr int NPHASE = 12;
constexpr int HALF_T = T;
constexpr float ALPHA_F = 1.189207115002721f, LN_EPS_F = 1e-5f;

constexpr size_t MiB = 1u << 20;
constexpr size_t WS_CTL = 0, CTL_ZERO_BYTES = 65536;
constexpr size_t WS_CNT = 32768;
constexpr size_t WS_SCW = 40960;
constexpr size_t WS_SCIN = 45056;
constexpr size_t WS_SHM = 832 * 1024;
constexpr size_t WS_ADA = 65536;
constexpr size_t WS_RWH = 384 * 1024;
constexpr size_t WS_RWL = 512 * 1024;
constexpr size_t WS_ALC = 640 * 1024;
constexpr size_t WS_LCA = 768 * 1024;
constexpr size_t WS_SA = 1 * MiB, WS_SB = 4 * MiB, WS_HIN = 7 * MiB;
constexpr size_t WS_BTGLU = 10 * MiB;
constexpr size_t WS_BTOUT = 10 * MiB + 512 * 1024;
constexpr size_t WS_BTLRU = 12 * MiB + 512 * 1024;
constexpr size_t WS_BS5 = 13 * MiB;
constexpr size_t WS_ES5 = 37 * MiB;
constexpr size_t WS_BTGU = 45 * MiB;
constexpr size_t WS_BTDN = 110 * MiB;
constexpr size_t WS_HB = 143 * MiB;
constexpr size_t WS_BTIN = 211 * MiB;
constexpr size_t WS_KTAB = 214 * MiB;
constexpr size_t WS_APR = 216 * MiB, WS_API = 217 * MiB;
constexpr size_t WS_BBR = 218 * MiB, WS_BBI = 218 * MiB + 256 * 1024;
constexpr size_t WS_HM = 366 * MiB;
constexpr size_t WS_US5 = 238 * MiB;
constexpr size_t WS_ULRU = 298 * MiB;
constexpr size_t WS_SLOC = 366 * MiB;
constexpr size_t WS_YS5 = 400 * MiB;
constexpr size_t WS_YCAT = 448 * MiB;
constexpr size_t WS_Y = 295 * MiB;
constexpr size_t WS_LIST = 1 * MiB;
constexpr size_t WS_PAIR = 9 * MiB;
constexpr size_t WS_HMID = 143 * MiB;
constexpr size_t WS_LIST2 = 10 * MiB;
constexpr size_t WS_SLABA = 10 * MiB;
constexpr size_t WS_SLABB = 288 * MiB;
constexpr int SLAB_ROWS_A = 35 * 1024;
constexpr float SLAB_SCALE = 8.f;
constexpr float HMID_SCALE = 16.f;
constexpr float DNW_MAX = 224.f;
constexpr size_t WS_END = 512 * MiB;

constexpr int LDS_BYTES = 155648;
constexpr int MISC_OFF = LDS_BYTES - 256;

DEV float bf2f(bf16_t h) { return __uint_as_float(((unsigned)h) << 16); }
DEV unsigned f2bf(float f) { unsigned u = __float_as_uint(f); return (u + 0x7fffu + ((u >> 16) & 1u)) >> 16; }
typedef float f32x2_t __attribute__((ext_vector_type(2)));
typedef __bf16 bf16x2_t __attribute__((ext_vector_type(2)));
DEV unsigned pack2(float a, float b) { const f32x2_t v = {a, b}; return __builtin_bit_cast(unsigned, __builtin_convertvector(v, bf16x2_t)); }
DEV float sigmoid_f(float x) { return __builtin_amdgcn_rcpf(1.f + __builtin_amdgcn_exp2f(-1.4426950408889634f * x)); }
DEV float gelu_tanh(float x) {
    return x * __builtin_amdgcn_rcpf(1.f + __builtin_amdgcn_exp2f(x * fmaf(x * x, -0.1029432395800235f, -2.302208198144325f)));
}
DEV int cmaj(int tok) { const int t = tok & 4095; return (tok & ~4095) | ((t & 63) << 6) | (t >> 6); }
DEV float wave_sum(float v) {
#pragma unroll
    for (int o = 1; o < 64; o <<= 1) v += __shfl_xor(v, o);
    return v;
}

struct Params { const float* in[39]; float* out; unsigned char* ws; int ph_lo, ph_hi; };

#define XB_TMO      128
#define XB_XCNT(j)  (256  + 64 * (j))
#define XB_XSUB(j)  (1280 + 64 * (j))
#define XB_XGEN(j)  (2304 + 64 * (j))
#define XB_TOP      3328
#define XB_TOPGEN   3392
#define XCD_BAR_WORDS 3456
#define XB_SPIN_CAP (1u << 20)
DEV unsigned xb_ld(unsigned* p)              { return __hip_atomic_load(p, __ATOMIC_RELAXED, __HIP_MEMORY_SCOPE_AGENT); }
DEV unsigned xb_add(unsigned* p, unsigned v) { return __hip_atomic_fetch_add(p, v, __ATOMIC_RELAXED, __HIP_MEMORY_SCOPE_AGENT); }
DEV unsigned xb_xcc_id() { return (unsigned)__builtin_amdgcn_s_getreg((3 << 11) | 20) & 0xFu; }
#define XB_SPIN(cond, bar) do { unsigned _sp = 0; while (cond) { __builtin_amdgcn_s_sleep(1); \
    if ((++_sp & 255u) == 0u) { if (xb_ld(&(bar)[XB_TMO])) break; if (_sp > XB_SPIN_CAP) { atomicAdd(&(bar)[XB_TMO], 1u); break; } } } } while (0)
struct XcdBarrier { unsigned* bar; unsigned x; volatile LAS unsigned* st; };
DEV XcdBarrier xcd_barrier_post(unsigned* bar, volatile LAS unsigned* st) {
    XcdBarrier b; b.bar = bar; b.x = xb_xcc_id(); b.st = st;
    if (threadIdx.x == 0) (void)xb_add(&bar[XB_XCNT(b.x)], 1u);
    return b;
}
DEV void xcd_barrier_complete(unsigned* bar, unsigned x, unsigned& nloc, unsigned& nx) {
    const unsigned G = gridDim.x * gridDim.y * gridDim.z;
    unsigned sum, cnt, mine, sp = 0u;
    for (;;) {
        sum = 0u; cnt = 0u; mine = 0u;
#pragma unroll
        for (unsigned j = 0; j < 16; ++j) { const unsigned c = xb_ld(&bar[XB_XCNT(j)]); sum += c; cnt += (c > 0u) ? 1u : 0u; mine = (j == x) ? c : mine; }
        if (sum == G) break;
        __builtin_amdgcn_s_sleep(1);
        if ((++sp & 255u) == 0u) { if (xb_ld(&bar[XB_TMO])) break; if (sp > XB_SPIN_CAP) { atomicAdd(&bar[XB_TMO], 1u); break; } }
    }
    nloc = mine > 0u ? mine : 1u; nx = cnt > 0u ? cnt : 1u;
}
DEV void xcd_barrier(const XcdBarrier& b) {
    asm volatile("s_waitcnt vmcnt(0)" ::: "memory");
    __syncthreads();
    if (threadIdx.x == 0) {
        unsigned* bar = b.bar;
        __builtin_amdgcn_s_waitcnt(0);
        unsigned nloc = b.st[0], nx = b.st[1];
        if (nloc == 0u) { xcd_barrier_complete(bar, b.x, nloc, nx); b.st[0] = nloc; b.st[1] = nx; }
        const unsigned old = xb_add(&bar[XB_XSUB(b.x)], 1u);
        const unsigned gen = old / nloc;
        if (old + 1u == (gen + 1u) * nloc) {
            __builtin_amdgcn_fence(__ATOMIC_RELEASE, "agent");
            asm volatile("s_waitcnt vmcnt(0)" ::: "memory");
            const unsigned og = xb_add(&bar[XB_TOP], 1u);
            if (og + 1u == (gen + 1u) * nx) xb_add(&bar[XB_TOPGEN], 1u);
        }
        XB_SPIN(xb_ld(&bar[XB_TOPGEN]) == gen, bar);
        __builtin_amdgcn_fence(__ATOMIC_ACQUIRE, "agent");
        asm volatile("s_waitcnt vmcnt(0)" ::: "memory");
    }
    __syncthreads();
}

namespace gp {
constexpr int BK = 64, HALF = 128, HTB = HALF * BK * 2, STAGE_BYTES = 8 * HTB;
DEV int lds_byte(int r, int c) { const int st = (r >> 4) * 2 + (c >> 5), rr = r & 15, cc = c & 31, ob = rr * 64 + cc * 2; return st * 1024 + (ob ^ (((ob >> 9) & 1) << 5)); }
DEV void stage_rc(int b, int& R, int& C) { const int st = b / 1024, sb = b % 1024, swz = sb ^ (((sb >> 9) & 1) << 5); R = (st >> 1) * 16 + swz / 64; C = (st & 1) * 32 + (swz % 64) / 2; }
DEV int perm32(int rho) { const int n = rho >> 4, i = rho & 15; return 8 * (i >> 2) + 4 * n + (i & 3); }
struct UAddr { const char* a; const char* b; unsigned ao00, ao01, ao10, ao11; };
#ifndef PROBE_GEMM
#define PROBE_GEMM -1
#endif
#ifndef PROBE_GEMM_PH
#define PROBE_GEMM_PH -1
#endif
#define GSEC_B(id) do { if (PROBE_GEMM == (id) && (PROBE_GEMM_PH < 0 || PROBE_GEMM_PH == Epi::PID)) { __builtin_amdgcn_s_waitcnt(0); gt0_ = __builtin_amdgcn_s_memrealtime(); } } while (0)
#define GSEC_E(id) do { if (PROBE_GEMM == (id) && (PROBE_GEMM_PH < 0 || PROBE_GEMM_PH == Epi::PID)) { __builtin_amdgcn_s_waitcnt(0); gacc_ += __builtin_amdgcn_s_memrealtime() - gt0_; } } while (0)
template <class Epi, class Sched, int MODE = 0>
DEV void gemm_phase(LAS unsigned char* lds, const int K, const Sched& S, const Epi& E) {
    unsigned long long gt0_ = 0, gacc_ = 0;
    typedef typename Sched::Unit Unit;
    int tid_ = threadIdx.x; asm volatile("" : "+v"(tid_));
    const int tid = tid_, wid = __builtin_amdgcn_readfirstlane(tid >> 6), lane = tid & 63, wr = wid >> 2, wc = wid & 3, fr = lane & 15, fq = lane >> 4;
    int nt = K / BK;
    if constexpr (MODE == 2) asm volatile("" : "+s"(nt));
    int R0, C0, R1, C1; stage_rc(tid * 16, R0, C0); stage_rc(tid * 16 + 8192, R1, C1);
    const int Rb0 = Epi::PERM ? ((R0 & ~31) + perm32(R0 & 31)) : R0, Rb1 = Epi::PERM ? ((R1 & ~31) + perm32(R1 & 31)) : R1;
    const unsigned vb0 = (unsigned)(Rb0 * K + C0) * 2u, vb1 = (unsigned)(Rb1 * K + C1) * 2u;
    const size_t kstep = (size_t)(BK * 2);
    const size_t hstepB = (size_t)HALF * K * 2;
    const int lda_ = S.lda();
    const unsigned va0 = (unsigned)(R0 * lda_ + C0) * 2u, va1 = (unsigned)(R1 * lda_ + C1) * 2u;
    const size_t hstepA = (size_t)HALF * lda_ * 2;
    const unsigned ldsw = (unsigned)wid * 1024u;
    const int aoff = lds_byte(wr * 64 + fr, fq * 8), boff = lds_byte(wc * 32 + fr, fq * 8);
#define GP_SA(b, h) (((b) * 2 + (h)) * HTB)
#define GP_SB(b, h) ((4 + (b) * 2 + (h)) * HTB)
#define GP_GLDS(gp_, bufoff, i_) __builtin_amdgcn_global_load_lds((const unsigned*)(gp_), (LAS unsigned*)(lds + (bufoff) + ldsw + (i_) * 8192), 16, 0, 0)
#define GP_STAGE_A(bufoff, ab, o0, o1, h, kb) do { if constexpr (Sched::GATHER) { const char* up_ = (ab) + (kb); GP_GLDS(up_ + (o0), bufoff, 0); GP_GLDS(up_ + (o1), bufoff, 1); } \
        else { const char* up_ = (ab) + (((h) ? hstepA : (size_t)0) + (kb)); GP_GLDS(up_ + va0, bufoff, 0); GP_GLDS(up_ + va1, bufoff, 1); } } while (0)
#define GP_STAGE_B(bufoff, bb, h, kb) do { const char* up_ = (bb) + (((h) ? hstepB : (size_t)0) + (kb)); GP_GLDS(up_ + vb0, bufoff, 0); GP_GLDS(up_ + vb1, bufoff, 1); } while (0)
#define GP_LDA(dst, b, h) do { _Pragma("unroll") for (int m = 0; m < 4; ++m) _Pragma("unroll") for (int k = 0; k < 2; ++k) dst[m][k] = *(const LAS bf16x8*)(lds + GP_SA(b, h) + aoff + m * 2048 + k * 1024); } while (0)
#define GP_LDB(dst, b, h) do { _Pragma("unroll") for (int n = 0; n < 2; ++n) _Pragma("unroll") for (int k = 0; k < 2; ++k) dst[n][k] = *(const LAS bf16x8*)(lds + GP_SB(b, h) + boff + n * 2048 + k * 1024); } while (0)
#define GP_MMA(ai, bj, At, Bt) do { __builtin_amdgcn_s_setprio(1); _Pragma("unroll") for (int m = 0; m < 4; ++m) _Pragma("unroll") for (int n = 0; n < 2; ++n) { \
        if constexpr (MODE == 2) acc[ai][bj][m][n] = __builtin_amdgcn_mfma_scale_f32_16x16x128_f8f6f4(__builtin_shufflevector(__builtin_bit_cast(i32x4, Bt[n][0]), __builtin_bit_cast(i32x4, Bt[n][1]), 0, 1, 2, 3, 4, 5, 6, 7), \
                __builtin_shufflevector(__builtin_bit_cast(i32x4, At[m][0]), __builtin_bit_cast(i32x4, At[m][1]), 0, 1, 2, 3, 4, 5, 6, 7), acc[ai][bj][m][n], 0, 0, 0, 0, 0, 0); \
        else { _Pragma("unroll") for (int k = 0; k < 2; ++k) \
        { if constexpr (MODE == 1) acc[ai][bj][m][n] = __builtin_bit_cast(f32x4, __builtin_amdgcn_mfma_i32_16x16x64_i8(__builtin_bit_cast(i32x4, Bt[n][k]), __builtin_bit_cast(i32x4, At[m][k]), __builtin_bit_cast(i32x4, acc[ai][bj][m][n]), 0, 0, 0)); \
          else acc[ai][bj][m][n] = __builtin_amdgcn_mfma_f32_16x16x32_bf16(Bt[n][k], At[m][k], acc[ai][bj][m][n], 0, 0, 0); } } } __builtin_amdgcn_s_setprio(0); } while (0)
#define GP_WAIT_V(n) asm volatile("s_waitcnt vmcnt(" #n ")" ::: "memory")
#define GP_WAIT_L(n) asm volatile("s_waitcnt lgkmcnt(" #n ")" ::: "memory")
#define GP_BAR __builtin_amdgcn_s_barrier()
#define GP_SCHED __builtin_amdgcn_sched_barrier(0)
    Unit cur, nxt; int ui = 0;
    if (!S.next(0, cur)) return;
    const char* cA; const char* cB; unsigned c00 = 0, c01 = 0, c10 = 0, c11 = 0;
    const char* nA; const char* nB; unsigned n00 = 0, n01 = 0, n10 = 0, n11 = 0;
    { UAddr t_; S.addr(cur, R0, C0, R1, C1, t_); cA = t_.a; cB = t_.b; if constexpr (Sched::GATHER) { c00 = S.fix(t_.ao00, C0); c01 = S.fix(t_.ao01, C1); c10 = S.fix(t_.ao10, C0); c11 = S.fix(t_.ao11, C1); } }
    f32x4 acc[2][2][4][2];
#pragma unroll
    for (int a = 0; a < 2; ++a)
#pragma unroll
        for (int b = 0; b < 2; ++b)
#pragma unroll
            for (int m = 0; m < 4; ++m)
#pragma unroll
                for (int n = 0; n < 2; ++n) acc[a][b][m][n] = (f32x4){0.f, 0.f, 0.f, 0.f};
    bf16x8 At[4][2], B0[2][2], B1[2][2];
    GP_STAGE_B(GP_SB(0, 0), cB, 0, 0); GP_STAGE_B(GP_SB(0, 1), cB, 1, 0); GP_STAGE_A(GP_SA(0, 0), cA, c00, c01, 0, 0); GP_STAGE_A(GP_SA(0, 1), cA, c10, c11, 1, 0);
    if (wr == 1) GP_BAR;
    GP_WAIT_V(2); GP_BAR;
    GP_STAGE_B(GP_SB(1, 0), cB, 0, kstep); GP_STAGE_A(GP_SA(1, 0), cA, c00, c01, 0, kstep); GP_STAGE_B(GP_SB(1, 1), cB, 1, kstep);
    GP_WAIT_V(0); GP_BAR;
    for (;;) {
        GSEC_B(3);
        const bool has_next = S.next(ui + 1, nxt);
        if (has_next) { UAddr t_; S.addr(nxt, R0, C0, R1, C1, t_); nA = t_.a; nB = t_.b; if constexpr (Sched::GATHER) { n00 = t_.ao00; n01 = t_.ao01; n10 = t_.ao10; n11 = t_.ao11; } }
        else { nA = cA; nB = cB; n00 = c00; n01 = c01; n10 = c10; n11 = c11; }
        if constexpr (Epi::PREFETCH) E.prefetch(cur, wr, wc, lane);
        GSEC_E(3); GSEC_B(2);
#pragma unroll 1
        for (int t = 0; t < nt; t += 2) {
            const bool last = (t == nt - 2);
            const size_t k1 = (size_t)(t + 1) * kstep;
            const char* sA = cA; const char* sB = cB; unsigned s00 = c00, s01 = c01, s10 = c10, s11 = c11; size_t k2 = (size_t)(t + 2) * kstep;
            if (last) {
                if constexpr (Sched::GATHER) { asm volatile("" : "+v"(n00), "+v"(n01), "+v"(n10), "+v"(n11)); if (has_next) { n00 = S.fix(n00, C0); n01 = S.fix(n01, C1); n10 = S.fix(n10, C0); n11 = S.fix(n11, C1); } }
                sA = nA; sB = nB; s00 = n00; s01 = n01; s10 = n10; s11 = n11; k2 = 0;
            }
            const size_t k3 = k2 + kstep;
            const bool first = (t == 0);
            GP_LDB(B0, 0, 0); GP_LDB(B1, 0, 1); GP_SCHED; GP_LDA(At, 0, 0); GP_STAGE_A(GP_SA(1, 1), cA, c10, c11, 1, k1);
            if (!first) GP_WAIT_V(8); GP_WAIT_L(0); GP_BAR; GP_MMA(0, 0, At, B0); GP_MMA(0, 1, At, B1); GP_BAR; GP_SCHED;
            GP_LDA(At, 0, 1); GP_STAGE_B(GP_SB(0, 0), sB, 0, k2); GP_STAGE_B(GP_SB(0, 1), sB, 1, k2); GP_STAGE_A(GP_SA(0, 0), sA, s00, s01, 0, k2);
            if (!first) GP_WAIT_V(8); GP_WAIT_L(0); GP_BAR; GP_MMA(1, 0, At, B0); GP_MMA(1, 1, At, B1); GP_BAR; GP_SCHED;
            GP_LDB(B0, 1, 0); GP_LDB(B1, 1, 1); GP_SCHED; GP_LDA(At, 1, 0); GP_STAGE_A(GP_SA(0, 1), sA, s10, s11, 1, k2);
            GP_WAIT_V(8); GP_WAIT_L(0); GP_BAR; GP_MMA(0, 0, At, B0); GP_MMA(0, 1, At, B1); GP_BAR; GP_SCHED;
            GP_LDA(At, 1, 1); GP_STAGE_B(GP_SB(1, 0), sB, 0, k3); GP_STAGE_B(GP_SB(1, 1), sB, 1, k3); GP_STAGE_A(GP_SA(1, 0), sA, s00, s01, 0, k3);
            GP_WAIT_V(8); GP_WAIT_L(0); GP_BAR; GP_MMA(1, 0, At, B0); GP_MMA(1, 1, At, B1); GP_BAR; GP_SCHED;
        }
        GSEC_E(2);
        if (wr == 0) GP_BAR;
        GSEC_B(1);
#define GP_ZERO_ACC _Pragma("unroll") for (int a = 0; a < 2; ++a) _Pragma("unroll") for (int b = 0; b < 2; ++b) _Pragma("unroll") for (int m = 0; m < 4; ++m) _Pragma("unroll") for (int n = 0; n < 2; ++n) acc[a][b][m][n] = (f32x4){0.f, 0.f, 0.f, 0.f}
        if constexpr (Epi::OWN_DRAIN) {
            typename Epi::Packed pk;
            E.convert(acc, cur, wr, wc, fr, fq, pk);
            GP_ZERO_ACC;
            GP_SCHED;
            asm volatile("s_waitcnt vmcnt(0)" ::: "memory");
            E.store(pk, cur, wr, wc, fr, fq);
            GSEC_E(1);
            if (!has_next) break;
        } else {
            GP_WAIT_V(0);
            E(acc, cur, wr, wc, fr, fq);
            GSEC_E(1);
            if (!has_next) break;
            GP_ZERO_ACC;
        }
#undef GP_ZERO_ACC
        cur = nxt; cA = nA; cB = nB; c00 = n00; c01 = n01; c10 = n10; c11 = n11; ++ui;
        if (wr == 1) GP_BAR;
    }
    GP_WAIT_V(0);
    GP_BAR;
    if (PROBE_GEMM >= 0 && blockIdx.x == 0) { const unsigned long long d_ = gacc_ * 8ull, t0_ = __builtin_amdgcn_s_memrealtime(); while (__builtin_amdgcn_s_memrealtime() - t0_ < d_) __builtin_amdgcn_s_sleep(8); }
#undef GP_SA
#undef GP_SB
#undef GP_GLDS
#undef GP_STAGE_A
#undef GP_STAGE_B
#undef GP_LDA
#undef GP_LDB
#undef GP_MMA
#undef GP_WAIT_V
#undef GP_WAIT_L
#undef GP_BAR
#undef GP_SCHED
}
DEV bool static_order(int i, int G, int c, int nM, int nN, int& pm, int& pn) {
    const int nwg = nM * nN; const long L = (long)i * G + c; if (L >= nwg) return false;
    int wgid = (int)L; { const int q = nwg / 8, r = nwg % 8, xcd = wgid % 8, off = wgid / 8; wgid = (xcd < r ? xcd * (q + 1) : r * (q + 1) + (xcd - r) * q) + off; }
    const int nig = 8 * nN, gid = wgid / nig, fm = gid * 8, gsz = (nM - fm) < 8 ? (nM - fm) : 8;
    pm = fm + ((wgid % nig) % gsz); pn = (wgid % nig) / gsz; return true;
}
}

struct PlainSched {
    struct Unit { int pm, pn; };
    static constexpr bool GATHER = false;
    const char* A; const char* Bt; int lda_, K, nM, nN, G, c;
    DEV int lda() const { return lda_; }
    DEV bool next(int i, Unit& u) const { return gp::static_order(i, G, c, nM, nN, u.pm, u.pn); }
    DEV void addr(const Unit& u, int R0, int C0, int R1, int C1, gp::UAddr& o) const {
        o.a = A + (size_t)u.pm * 256 * lda_ * 2; o.b = Bt + (size_t)u.pn * 256 * K * 2;
    }
};
struct EpiBf16 {
    static constexpr int PID = 7;
    static constexpr bool OWN_DRAIN = true;
    static constexpr bool PREFETCH = false;
    static constexpr bool PERM = true;
    bf16_t* O; int ldc;
    struct Packed { u32x4 w[2][4][2]; };
    template <class U> DEV void convert(const f32x4 (&acc)[2][2][4][2], const U& u, int wr, int wc, int fr, int fq, Packed& pk) const {
#pragma unroll
        for (int ai = 0; ai < 2; ++ai)
#pragma unroll
            for (int m = 0; m < 4; ++m)
#pragma unroll
                for (int bj = 0; bj < 2; ++bj) {
                    const f32x4 v0 = acc[ai][bj][m][0], v1 = acc[ai][bj][m][1];
                    u32x4 w; w.x = pack2(v0[0], v0[1]); w.y = pack2(v0[2], v0[3]); w.z = pack2(v1[0], v1[1]); w.w = pack2(v1[2], v1[3]);
                    pk.w[ai][m][bj] = w;
                }
    }
    template <class U> DEV void store(const Packed& pk, const U& u, int wr, int wc, int fr, int fq) const {
        const int row0 = u.pm * 256 + wr * 64 + fr, col0 = u.pn * 256 + wc * 32 + 8 * fq;
#pragma unroll
        for (int ai = 0; ai < 2; ++ai)
#pragma unroll
            for (int m = 0; m < 4; ++m) {
                bf16_t* rowp = O + (size_t)(row0 + ai * 128 + m * 16) * ldc + col0;
#pragma unroll
                for (int bj = 0; bj < 2; ++bj) *(u32x4*)(rowp + bj * 128) = pk.w[ai][m][bj];
            }
    }
};
struct EpiF32 {
    static constexpr int PID = 12;
    static constexpr bool OWN_DRAIN = false;
    static constexpr bool PREFETCH = false;
    static constexpr bool PERM = false;
    float* O; int ldc;
    template <class U> DEV void operator()(const f32x4 (&acc)[2][2][4][2], const U& u, int wr, int wc, int fr, int fq) const {
        const int row0 = u.pm * 256 + wr * 64 + fr, col0 = u.pn * 256 + wc * 32 + 4 * fq;
#pragma unroll
        for (int ai = 0; ai < 2; ++ai)
#pragma unroll
            for (int m = 0; m < 4; ++m) {
                float* rowp = O + (size_t)(row0 + ai * 128 + m * 16) * ldc + col0;
#pragma unroll
                for (int bj = 0; bj < 2; ++bj)
#pragma unroll
                    for (int n = 0; n < 2; ++n) *(f32x4*)(rowp + bj * 128 + n * 16) = acc[ai][bj][m][n];
            }
    }
};

DEV void bf8_unpack(const u32x4 w, float (&y)[8]) {
    y[0] = __uint_as_float(w.x << 16); y[1] = __uint_as_float(w.x & 0xffff0000u); y[2] = __uint_as_float(w.y << 16); y[3] = __uint_as_float(w.y & 0xffff0000u);
    y[4] = __uint_as_float(w.z << 16); y[5] = __uint_as_float(w.z & 0xffff0000u); y[6] = __uint_as_float(w.w << 16); y[7] = __uint_as_float(w.w & 0xffff0000u);
}
struct WinSched {
    struct Unit { int pm, pn; };
    static constexpr bool GATHER = false;
    const char* A; const char* Bt; int G, c;
    DEV int lda() const { return 512; }
    DEV bool next(int i, Unit& u) const { return gp::static_order(i, G, c, 136, 6, u.pm, u.pn); }
    DEV void addr(const Unit& u, int R0, int C0, int R1, int C1, gp::UAddr& o) const {
        o.a = A + (size_t)u.pm * 256 * 1024; o.b = Bt + ((size_t)u.pn * 256) * 1024;
    }
};
struct EpiWin {
    static constexpr int PID = 2;
    static constexpr bool OWN_DRAIN = false;
    static constexpr bool PREFETCH = false;
    static constexpr bool PERM = true;
    bf16_t* US5; bf16_t* ULRU; const float* shm; const unsigned* scw;
    template <class U> DEV void operator()(const f32x4 (&acc)[2][2][4][2], const U& u, int wr, int wc, int fr, int fq) const {
        float sr[2][4];
#pragma unroll
        for (int ai = 0; ai < 2; ++ai)
#pragma unroll
            for (int m = 0; m < 4; ++m) sr[ai][m] = shm[u.pm * 256 + ai * 128 + wr * 64 + m * 16 + fr] * (1.f / 127.f);
        u32x4 cs[2][2];
#pragma unroll
        for (int bj = 0; bj < 2; ++bj) { const int c8 = u.pn * 256 + bj * 128 + wc * 32 + 8 * fq; cs[bj][0] = *(const u32x4*)(scw + c8); cs[bj][1] = *(const u32x4*)(scw + c8 + 4); }
#pragma unroll
        for (int bj = 0; bj < 2; ++bj) {
            const int col8 = u.pn * 256 + bj * 128 + wc * 32 + 8 * fq;
#pragma unroll
            for (int ai = 0; ai < 2; ++ai)
#pragma unroll
                for (int m = 0; m < 4; ++m) {
                    const int row = u.pm * 256 + ai * 128 + wr * 64 + m * 16 + fr;
                    const i32x4 i0 = __builtin_bit_cast(i32x4, acc[ai][bj][m][0]), i1 = __builtin_bit_cast(i32x4, acc[ai][bj][m][1]); const float sc_ = sr[ai][m];
                    const f32x4 c0 = (f32x4){__uint_as_float(cs[bj][0].x), __uint_as_float(cs[bj][0].y), __uint_as_float(cs[bj][0].z), __uint_as_float(cs[bj][0].w)}, c1 = (f32x4){__uint_as_float(cs[bj][1].x), __uint_as_float(cs[bj][1].y), __uint_as_float(cs[bj][1].z), __uint_as_float(cs[bj][1].w)};
                    const f32x4 v0 = (f32x4){(float)i0[0], (float)i0[1], (float)i0[2], (float)i0[3]} * c0 * sc_, v1 = (f32x4){(float)i1[0], (float)i1[1], (float)i1[2], (float)i1[3]} * c1 * sc_;
                    u32x4 w; w.x = pack2(v0[0], v0[1]); w.y = pack2(v0[2], v0[3]); w.z = pack2(v1[0], v1[1]); w.w = pack2(v1[2], v1[3]);
                    if (col8 < 512) {
                        int mm, ss;
                        if (row < T) { const int bq = row >> 12, t = row & 4095; mm = bq * 128 + (t >> 5); ss = t & 31; }
                        else { const int q = row - T, bq = q >> 8, j = q & 255; mm = M5LAT + bq * 8 + (j >> 5); ss = j & 31; }
                        *(u32x4*)(US5 + ((size_t)((col8 >> 4) * M5PAD + mm)) * KT5 + ss * 16 + (col8 & 15)) = w;
                    } else *(u32x4*)(ULRU + (size_t)(row < T ? cmaj(row) : row) * 1024 + (col8 - 512)) = w;
                }
        }
    }
};
struct S5Sched {
    struct Unit { int g, pm, pn; };
    static constexpr bool GATHER = false;
    const char* A; const char* Bt; int K, nPm, nPn, brows  , G, c;
    DEV int lda() const { return KT5; }
    DEV bool next(int i, Unit& u) const {
        if (i > 0) return false;
        const int per = nPm * nPn * 4;
        const int x = c & 7, j = c >> 3; if (j >= per) return false;
        const int U = x * per + j; u.g = U / (nPm * nPn); const int r = U % (nPm * nPn); u.pm = r / nPn; u.pn = r % nPn; return true;
    }
    DEV void addr(const Unit& u, int R0, int C0, int R1, int C1, gp::UAddr& o) const {
        o.a = A + ((size_t)u.g * M5PAD + u.pm * 256) * KT5 * 2; o.b = Bt + ((size_t)u.g * brows + u.pn * 256) * K * 2;
    }
};
struct EpiS5Loc {
    static constexpr int PID = 3;
    static constexpr bool OWN_DRAIN = false;
    static constexpr bool PREFETCH = false;
    static constexpr bool PERM = false;
    float* SLOC;
    template <class U> DEV void operator()(const f32x4 (&acc)[2][2][4][2], const U& u, int wr, int wc, int fr, int fq) const {
#pragma unroll
        for (int ai = 0; ai < 2; ++ai)
#pragma unroll
            for (int m = 0; m < 4; ++m) {
                const int mm = u.pm * 256 + ai * 128 + wr * 64 + m * 16 + fr;
                if (mm < M5) {
                    float* rowp = SLOC + ((size_t)(u.g * M5 + mm)) * 256 + wc * 32 + 4 * fq;
#pragma unroll
                    for (int bj = 0; bj < 2; ++bj)
#pragma unroll
                        for (int n = 0; n < 2; ++n) *(f32x4*)(rowp + bj * 128 + n * 16) = acc[ai][bj][m][n];
                }
            }
    }
};
struct EpiS5Out {
    static constexpr int PID = 5;
    static constexpr bool OWN_DRAIN = false;
    static constexpr bool PREFETCH = false;
    static constexpr bool PERM = true;
    bf16_t* YS5;
    template <class U> DEV void operator()(const f32x4 (&acc)[2][2][4][2], const U& u, int wr, int wc, int fr, int fq) const {
#pragma unroll
        for (int ai = 0; ai < 2; ++ai)
#pragma unroll
            for (int m = 0; m < 4; ++m) {
                const int mm = u.pm * 256 + ai * 128 + wr * 64 + m * 16 + fr, bq = mm >> 7, chunk = mm & 127;
#pragma unroll
                for (int bj = 0; bj < 2; ++bj) {
                    const int n8 = u.pn * 256 + bj * 128 + wc * 32 + 8 * fq, t = n8 >> 4, c0 = n8 & 15;
                    const size_t tok = (size_t)bq * 4096 + chunk * 32 + t;
                    const f32x4 v0 = acc[ai][bj][m][0], v1 = acc[ai][bj][m][1];
                    u32x4 w; w.x = pack2(gelu_tanh(v0[0]), gelu_tanh(v0[1])); w.y = pack2(gelu_tanh(v0[2]), gelu_tanh(v0[3]));
                    w.z = pack2(gelu_tanh(v1[0]), gelu_tanh(v1[1])); w.w = pack2(gelu_tanh(v1[2]), gelu_tanh(v1[3]));
                    *(u32x4*)(YS5 + tok * 512 + u.g * 16 + c0) = w;
                }
            }
    }
};
struct EpiGlu {
    static constexpr int PID = 6;
    static constexpr bool OWN_DRAIN = false;
    static constexpr bool PREFETCH = false;
    static constexpr bool PERM = true;
    const bf16_t* YS5; const float* b_glu; bf16_t* YCAT;
    template <class U> DEV void operator()(const f32x4 (&acc)[2][2][4][2], const U& u, int wr, int wc, int fr, int fq) const {
        const int col0 = u.pn * 256 + wc * 32 + 8 * fq; const size_t row0 = (size_t)u.pm * 256 + wr * 64 + fr;
        f32x4 bv[2][2];
#pragma unroll
        for (int bj = 0; bj < 2; ++bj) { bv[bj][0] = *(const f32x4*)(b_glu + col0 + bj * 128); bv[bj][1] = *(const f32x4*)(b_glu + col0 + bj * 128 + 4); }
        u32x4 yv[2][4][2];
#pragma unroll
        for (int ai = 0; ai < 2; ++ai)
#pragma unroll
            for (int m = 0; m < 4; ++m)
#pragma unroll
                for (int bj = 0; bj < 2; ++bj) yv[ai][m][bj] = *(const u32x4*)(YS5 + (row0 + ai * 128 + m * 16) * 512 + col0 + bj * 128);
#pragma unroll
        for (int ai = 0; ai < 2; ++ai)
#pragma unroll
            for (int m = 0; m < 4; ++m)
#pragma unroll
                for (int bj = 0; bj < 2; ++bj) {
                    float y[8]; bf8_unpack(yv[ai][m][bj], y);
                    const f32x4 z0 = acc[ai][bj][m][0] + bv[bj][0], z1 = acc[ai][bj][m][1] + bv[bj][1];
                    u32x4 w; w.x = pack2(y[0] * sigmoid_f(z0[0]), y[1] * sigmoid_f(z0[1])); w.y = pack2(y[2] * sigmoid_f(z0[2]), y[3] * sigmoid_f(z0[3]));
                    w.z = pack2(y[4] * sigmoid_f(z1[0]), y[5] * sigmoid_f(z1[1])); w.w = pack2(y[6] * sigmoid_f(z1[2]), y[7] * sigmoid_f(z1[3]));
                    *(u32x4*)(YCAT + (size_t)cmaj((int)(row0 + ai * 128 + m * 16)) * 1024 + col0 + bj * 128) = w;
                }
    }
};

DEV int gu_row(int j, bool up) { return (j >> 7) * 256 + ((j >> 2) & 1) * 128 + ((j >> 5) & 3) * 32 + (up ? 16 : 0) + ((j >> 3) & 3) * 4 + (j & 3); }
struct TrTile { const float* W; bf16_t* dst; int ldw, k0, n0, ldd, mode; float q; const unsigned* qcol; };
DEV void tr_load(const TrTile& t, int lane, f32x4 (&v)[16]) {
#pragma unroll
    for (int i = 0; i < 16; ++i) v[i] = *(const f32x4*)(t.W + (size_t)(t.k0 + i * 4 + (lane >> 4)) * t.ldw + t.n0 + (lane & 15) * 4);
}
template <int OUT>
DEV void tr_store(const TrTile& t, int lane, const f32x4 (&v)[16], LAS float* tile) {
#pragma unroll
    for (int i = 0; i < 16; ++i) { LAS float* tp = tile + (i * 4 + (lane >> 4)) * 65 + (lane & 15) * 4; tp[0] = v[i][0]; tp[1] = v[i][1]; tp[2] = v[i][2]; tp[3] = v[i][3]; }
    __builtin_amdgcn_fence(__ATOMIC_RELEASE, "wavefront"); __builtin_amdgcn_wave_barrier(); __builtin_amdgcn_fence(__ATOMIC_ACQUIRE, "wavefront");
    const int mode = __builtin_amdgcn_readfirstlane(t.mode);
    if constexpr (OUT != 0) {
        const int kc4 = lane & 3;
#pragma unroll
        for (int jn = 0; jn < 4; ++jn) {
            const int nn = (lane >> 2) + 16 * jn;
            const float qn = (OUT == 1 && t.qcol) ? 127.f / fmaxf(__uint_as_float(t.qcol[t.n0 + nn]), 1e-30f) : t.q;
            float e[16];
#pragma unroll
            for (int kk = 0; kk < 16; ++kk) e[kk] = tile[(kc4 * 16 + kk) * 65 + nn] * qn;
            unsigned w4[4];
#pragma unroll
            for (int c = 0; c < 4; ++c) {
                if constexpr (OUT == 2) {
                    int a8 = 0;
                    a8 = __builtin_amdgcn_cvt_pk_fp8_f32(__builtin_amdgcn_fmed3f(e[c * 4], -448.f, 448.f), __builtin_amdgcn_fmed3f(e[c * 4 + 1], -448.f, 448.f), a8, false);
                    a8 = __builtin_amdgcn_cvt_pk_fp8_f32(__builtin_amdgcn_fmed3f(e[c * 4 + 2], -448.f, 448.f), __builtin_amdgcn_fmed3f(e[c * 4 + 3], -448.f, 448.f), a8, true);
                    w4[c] = (unsigned)a8;
                } else {
                    unsigned acc_ = 0u;
#pragma unroll
                    for (int jj = 0; jj < 4; ++jj) { int qv = (int)rintf(e[c * 4 + jj]); qv = qv < -127 ? -127 : (qv > 127 ? 127 : qv); acc_ |= ((unsigned)qv & 0xffu) << (8 * jj); }
                    w4[c] = acc_;
                }
            }
            const int j = t.n0 + nn;
            const int row = (mode == 0 || mode == 3) ? j : gu_row(j, mode == 2);
            *(u32x4*)((unsigned char*)t.dst + (size_t)row * t.ldd + t.k0 + kc4 * 16) = (u32x4){w4[0], w4[1], w4[2], w4[3]};
        }
        __builtin_amdgcn_fence(__ATOMIC_RELEASE, "wavefront"); __builtin_amdgcn_wave_barrier(); __builtin_amdgcn_fence(__ATOMIC_ACQUIRE, "wavefront");
        return;
    }
    const int kc = lane & 7;
#pragma unroll
    for (int jn = 0; jn < 8; ++jn) {
        const int nn = (lane >> 3) + 8 * jn;
        float e[8];
#pragma unroll
        for (int jj = 0; jj < 8; ++jj) e[jj] = tile[(kc * 8 + jj) * 65 + nn];
        const int j = t.n0 + nn;
        const int row = mode == 0 ? j : gu_row(j, mode == 2);
        u32x4 w; w.x = pack2(e[0], e[1]); w.y = pack2(e[2], e[3]); w.z = pack2(e[4], e[5]); w.w = pack2(e[6], e[7]);
        *(u32x4*)(t.dst + (size_t)row * t.ldd + t.k0 + kc * 8) = w;
    }
    __builtin_amdgcn_fence(__ATOMIC_RELEASE, "wavefront"); __builtin_amdgcn_wave_barrier(); __builtin_amdgcn_fence(__ATOMIC_ACQUIRE, "wavefront");
}
DEV void tr_tile_wave(const float* __restrict__ W, int ldw, int k0, int n0, bf16_t* __restrict__ dst, int ldd, int mode, LAS float* tile, int lane) {
    TrTile t{W, dst, ldw, k0, n0, ldd, mode, 0.f, nullptr}; f32x4 v[16]; tr_load(t, lane, v); tr_store<0>(t, lane, v, tile);
}
DEV TrTile expert_tile(const Params& p, int it, float q) {
    const int e = it / 192, r = it % 192, which = r >> 6, tt = r & 63;
    TrTile t;
    if (which < 2) {
        t.W = e < 64 ? (which == 0 ? p.in[31] : p.in[32]) + (size_t)e * 262144 : (which == 0 ? p.in[34] : p.in[35]);
        t.ldw = 256; t.k0 = (tt >> 2) * 64; t.n0 = (tt & 3) * 64; t.dst = (bf16_t*)(p.ws + WS_BTGU + (size_t)e * 524288); t.ldd = 1024; t.mode = which + 1;
        t.q = q; t.qcol = nullptr;
    } else {
        t.W = e < 64 ? p.in[33] + (size_t)e * 262144 : p.in[36];
        t.ldw = 1024; t.k0 = (tt >> 4) * 64; t.n0 = (tt & 15) * 64; t.dst = (bf16_t*)(p.ws + WS_BTDN + (size_t)e * 262144); t.ldd = 256; t.mode = 3; t.q = q; t.qcol = nullptr;
    }
    return t;
}

DEV float sample_amax(const float* __restrict__ W, int lane) {
    float a = 0.f;
#pragma unroll
    for (int i = 0; i < 4; ++i) { const f32x4 v = *(const f32x4*)(W + i * 256 + lane * 4); a = fmaxf(a, fmaxf(fmaxf(fabsf(v[0]), fabsf(v[1])), fmaxf(fabsf(v[2]), fabsf(v[3])))); }
#pragma unroll
    for (int o = 1; o < 64; o <<= 1) a = fmaxf(a, __shfl_xor(a, o));
    return fmaxf(a * 1.75f, 1e-30f);
}
DEV void convert_tiles(const Params& p, LAS unsigned char* lds, int t_lo, int t_hi, int lane, int wid) {
    LAS float* tile = (LAS float*)lds + wid * (64 * 65);
    if (t_lo >= t_hi) return;
    f32x4 va[16], vb[16];
    int curm = -1; float q = 0.f;
#define CT_SETUP(t_, it_) do { const int e_ = (it_) / 192, r_ = (it_) % 192, which_ = r_ >> 6, m_ = which_ < 2 ? e_ * 2 + which_ : 130 + e_; \
        t_ = expert_tile(p, (it_), 1.f); \
        if (m_ != curm) { curm = m_; const float a_ = sample_amax(t_.W, lane); q = (which_ == 2 ? DNW_MAX : 127.f) / a_; \
            if ((r_ & 63) == 0 && lane == 0) ((unsigned*)(p.ws + WS_SCW))[m_] = __float_as_uint(a_); }        \
        t_.q = q; } while (0)
    TrTile ta, tb;
    CT_SETUP(ta, t_lo); tr_load(ta, lane, va);
#pragma unroll 1
    for (int it = t_lo; it < t_hi; it += 16) {
        { const int i1 = it + 8 < t_hi ? it + 8 : it; CT_SETUP(tb, i1); tr_load(tb, lane, vb); }
        __builtin_amdgcn_sched_barrier(0);
        if (__builtin_amdgcn_readfirstlane(ta.mode) == 3) tr_store<2>(ta, lane, va, tile); else tr_store<1>(ta, lane, va, tile);
        __builtin_amdgcn_sched_barrier(0);
        { const int i2 = it + 16 < t_hi ? it + 16 : it; CT_SETUP(ta, i2); tr_load(ta, lane, va); }
        __builtin_amdgcn_sched_barrier(0);
        if (it + 8 < t_hi) { if (__builtin_amdgcn_readfirstlane(tb.mode) == 3) tr_store<2>(tb, lane, vb, tile); else tr_store<1>(tb, lane, vb, tile); }
        __builtin_amdgcn_sched_barrier(0);
    }
#undef CT_SETUP
}

DEV void gemv9_item(LAS const float* S, const float* __restrict__ W, int ldw, int col0, const float* __restrict__ bias, float* __restrict__ out, int ldo, LAS float* red) {
    const int tid = threadIdx.x, col = tid & 31, kp = tid >> 5;
    float acc[9];
#pragma unroll
    for (int b = 0; b < 9; ++b) acc[b] = 0.f;
    for (int k = kp * 64; k < kp * 64 + 64; ++k) {
        const float w = W[(size_t)k * ldw + col0 + col];
#pragma unroll
        for (int b = 0; b < 9; ++b) acc[b] += S[b * 1024 + k] * w;
    }
#pragma unroll
    for (int b = 0; b < 9; ++b) red[(kp * 9 + b) * 32 + col] = acc[b];
    __syncthreads();
    if (tid < 288) {
        const int b = tid >> 5, c = tid & 31; float s = 0.f;
#pragma unroll
        for (int q = 0; q < 16; ++q) s += red[(q * 9 + b) * 32 + c];
        out[b * ldo + col0 + c] = s + (bias ? bias[col0 + c] : 0.f);
    }
    __syncthreads();
}

DEV void cpow_d(double lr, double li, double dt, int l, double& re, double& im) {
    const double mag = exp(lr * dt * (double)l);
    const double ang = li * dt * (double)l;
    const double kq = rint(ang * 0.63661977236758134308);
    double x = fma(-kq, 1.57079632679489655800e+00, ang);
    x = fma(-kq, 6.12323399573676603587e-17, x);
    const double x2 = x * x;
    double s = -1.0 / 6227020800.0; s = fma(s, x2, 1.0 / 39916800.0); s = fma(s, x2, -1.0 / 362880.0); s = fma(s, x2, 1.0 / 5040.0);
    s = fma(s, x2, -1.0 / 120.0); s = fma(s, x2, 1.0 / 6.0); s = fma(-s, x2, 1.0); s = s * x;
    double c = 1.0 / 479001600.0; c = fma(c, x2, -1.0 / 3628800.0); c = fma(c, x2, 1.0 / 40320.0); c = fma(c, x2, -1.0 / 720.0);
    c = fma(c, x2, 1.0 / 24.0); c = fma(c, x2, -0.5); c = fma(c, x2, 1.0);
    const int q = ((int)(long long)kq) & 3;
    const double sn = (q == 0) ? s : (q == 1) ? c : (q == 2) ? -s : -c;
    const double cs = (q == 0) ? c : (q == 1) ? -s : (q == 2) ? -c : s;
    re = mag * cs; im = mag * sn;
}

DEV void s5_tables(const Params& p, LAS unsigned char* lds, int g, int part) {
    int tid = threadIdx.x; asm volatile("" : "+v"(tid));
    LAS float* apr = (LAS float*)lds;
    LAS float* api = apr + 640;
    LAS float* bbr = api + 640;
    LAS float* bbi = bbr + 2048;
    const float* lam_re = p.in[9]; const float* lam_im = p.in[10]; const float* log_dt = p.in[11];
    const float* b_re = p.in[12]; const float* b_im = p.in[13]; const float* c_re = p.in[14]; const float* c_im = p.in[15];
    float* APR = (float*)(p.ws + WS_APR) + (size_t)g * 4224; float* API = (float*)(p.ws + WS_API) + (size_t)g * 4224;
    float* BBR = (float*)(p.ws + WS_BBR) + (size_t)g * 2048; float* BBI = (float*)(p.ws + WS_BBI) + (size_t)g * 2048;
    float* KTAB = (float*)(p.ws + WS_KTAB) + (size_t)g * 16384;
    const int nl = part == 7 ? 5 : 4;
    for (int i = tid; i < 2 * nl * 64; i += 512) {
        const int dir = i / (nl * 64), rem = i % (nl * 64), li = rem >> 6, pp = rem & 63, l = part * 4 + li, gi = dir * 32 + g;
        const double dt = exp((double)log_dt[gi]);
        double re, im; cpow_d((double)lam_re[gi * 64 + pp], (double)lam_im[gi * 64 + pp], dt, l, re, im);
        apr[(dir * 5 + li) * 64 + pp] = (float)re; api[(dir * 5 + li) * 64 + pp] = (float)im;
        APR[(dir * 33 + l) * 64 + pp] = (float)re; API[(dir * 33 + l) * 64 + pp] = (float)im;
    }
    for (int i = tid; i < 2048; i += 512) {
        const int dir = i >> 10, pp = (i >> 4) & 63, c = i & 15, gi = dir * 32 + g;
        const double dt = exp((double)log_dt[gi]);
        const double lr = (double)lam_re[gi * 64 + pp], li = (double)lam_im[gi * 64 + pp];
        double ar, ai; cpow_d(lr, li, dt, 1, ar, ai);
        const double nr = ar - 1.0, den = lr * lr + li * li;
        const double fr = (nr * lr + ai * li) / den, fi = (ai * lr - nr * li) / den;
        const double br = (double)b_re[((size_t)(gi * 64 + pp)) * 16 + c], bi = (double)b_im[((size_t)(gi * 64 + pp)) * 16 + c];
        const float vr = (float)(fr * br - fi * bi), vi = (float)(fr * bi + fi * br);
        bbr[i] = vr; bbi[i] = vi;
        if (part == 0) { BBR[i] = vr; BBI[i] = vi; }
    }
    __syncthreads();
    if (tid < 128) {
        const int dir = tid >> 6, li = (tid >> 4) & 3, c = tid & 15, l = part * 4 + li;
        const float* cr_ = c_re + ((size_t)((dir * 32 + g) * 16 + c)) * 64; const float* ci_ = c_im + ((size_t)((dir * 32 + g) * 16 + c)) * 64;
        f32x4 s0 = (f32x4){0.f, 0.f, 0.f, 0.f}, s1 = s0, s2 = s0, s3 = s0;
#pragma unroll 2
        for (int pp = 0; pp < 64; ++pp) {
            const float ar = apr[(dir * 5 + li) * 64 + pp], ai = api[(dir * 5 + li) * 64 + pp];
            const float cr = cr_[pp], ci = ci_[pp];
            const float qr = cr * ar - ci * ai, qi = cr * ai + ci * ar;
            LAS const f32x4* br = (LAS const f32x4*)(bbr + (dir * 64 + pp) * 16); LAS const f32x4* bi = (LAS const f32x4*)(bbi + (dir * 64 + pp) * 16);
            s0 += br[0] * qr - bi[0] * qi; s1 += br[1] * qr - bi[1] * qi; s2 += br[2] * qr - bi[2] * qi; s3 += br[3] * qr - bi[3] * qi;
        }
        f32x4* kd = (f32x4*)(KTAB + ((dir * 32 + l) * 16 + c) * 16);
        kd[0] = s0; kd[1] = s1; kd[2] = s2; kd[3] = s3;
    }
    __syncthreads();
}
DEV void s5_fill(const Params& p, LAS unsigned char* lds, int g, int part) {
    int tid = threadIdx.x; asm volatile("" : "+v"(tid));
    LAS float* apr = (LAS float*)lds;
    LAS float* api = apr + 4224;
    LAS float* bbr = api + 4224;
    LAS float* bbi = bbr + 2048;
    LAS float* ccr = bbi + 2048;
    LAS float* cci = ccr + 2048;
    LAS float* Kt = cci + 2048;
    const float* c_re = p.in[14]; const float* c_im = p.in[15]; const float* dvec = p.in[16];
    bf16_t* BS5 = (bf16_t*)(p.ws + WS_BS5); bf16_t* ES5 = (bf16_t*)(p.ws + WS_ES5); float* ALC = (float*)(p.ws + WS_ALC);
    {
        const f32x4* s0 = (const f32x4*)((const float*)(p.ws + WS_APR) + (size_t)g * 4224); const f32x4* s1 = (const f32x4*)((const float*)(p.ws + WS_API) + (size_t)g * 4224);
        const f32x4* s2 = (const f32x4*)((const float*)(p.ws + WS_BBR) + (size_t)g * 2048); const f32x4* s3 = (const f32x4*)((const float*)(p.ws + WS_BBI) + (size_t)g * 2048);
        const f32x4* s4 = (const f32x4*)((const float*)(p.ws + WS_KTAB) + (size_t)g * 16384);
        f32x4 ra[3], ri[3], rb0, rb1, rk[8]; float rc[4], rd[4];
#pragma unroll
        for (int u = 0; u < 3; ++u) { const int i = tid + u * 512; if (i < 1056) { ra[u] = s0[i]; ri[u] = s1[i]; } }
        rb0 = s2[tid]; rb1 = s3[tid];
#pragma unroll
        for (int u = 0; u < 8; ++u) rk[u] = s4[tid + u * 512];
#pragma unroll
        for (int u = 0; u < 4; ++u) { const int i = tid + u * 512; const int dir = i >> 10, cc = (i >> 6) & 15, pp = i & 63; const size_t src = ((size_t)((dir * 32 + g) * 16 + cc)) * 64 + pp; rc[u] = c_re[src]; rd[u] = c_im[src]; }
#pragma unroll
        for (int u = 0; u < 3; ++u) { const int i = tid + u * 512; if (i < 1056) { ((LAS f32x4*)apr)[i] = ra[u]; ((LAS f32x4*)api)[i] = ri[u]; } }
        ((LAS f32x4*)bbr)[tid] = rb0; ((LAS f32x4*)bbi)[tid] = rb1;
#pragma unroll
        for (int u = 0; u < 8; ++u) { const int i = tid + u * 512; LAS float* kd = Kt + (i >> 6) * 257 + (i & 63) * 4; kd[0] = rk[u][0]; kd[1] = rk[u][1]; kd[2] = rk[u][2]; kd[3] = rk[u][3]; }
#pragma unroll
        for (int u = 0; u < 4; ++u) { const int i = tid + u * 512; ccr[i] = rc[u]; cci[i] = rd[u]; }
    }
    LAS float* dvl = Kt + 64 * 257;
    if (tid < 16) dvl[tid] = dvec[g * 16 + tid];
    __syncthreads();
    for (int q = tid; q < 64 * 64; q += 512) {
        const int n = part * 64 + (q >> 6), k8 = (q & 63) * 8, t = n >> 4, c = n & 15;
        const int s = k8 >> 4, c0 = k8 & 15, delta = t - s;
        const int i1 = (delta > 0 ? delta : 32 - delta) * 257 + c * 16 + c0, i0 = c * 16 + c0;
        const float dz = delta == 0 ? 1.f : 0.f, dv = dvl[c];
        float e[8];
#pragma unroll
        for (int i = 0; i < 8; ++i) e[i] = Kt[i1 + i] + dz * (Kt[i0 + i] + (c == c0 + i ? dv : 0.f));
        u32x4 w; w.x = pack2(e[0], e[1]); w.y = pack2(e[2], e[3]); w.z = pack2(e[4], e[5]); w.w = pack2(e[6], e[7]);
        *(u32x4*)(BS5 + ((size_t)g * 512 + n) * 768 + k8) = w;
    }
    for (int q = tid; q < 64 * 32; q += 512) {
        const int n = part * 64 + (q >> 5), kk = (q & 31) * 8, t = n >> 4, c = n & 15;
        const int seg = kk >> 6, p0 = kk & 63, dir = seg >> 1, l = dir == 0 ? t + 1 : 32 - t;
        float e[8];
#pragma unroll
        for (int i = 0; i < 8; ++i) {
            const int pp = p0 + i;
            const float ar = apr[(dir * 33 + l) * 64 + pp], ai = api[(dir * 33 + l) * 64 + pp];
            const float cr = ccr[(dir * 16 + c) * 64 + pp], ci = cci[(dir * 16 + c) * 64 + pp];
            e[i] = (seg & 1) ? -(cr * ai + ci * ar) : (cr * ar - ci * ai);
        }
        u32x4 w; w.x = pack2(e[0], e[1]); w.y = pack2(e[2], e[3]); w.z = pack2(e[4], e[5]); w.w = pack2(e[6], e[7]);
        *(u32x4*)(BS5 + ((size_t)g * 512 + n) * 768 + 512 + kk) = w;
    }
    for (int q = tid; q < 32 * 64; q += 512) {
        const int n = part * 32 + (q >> 6), k8 = (q & 63) * 8, s = k8 >> 4, c0 = k8 & 15, seg = n >> 6, pp = n & 63, dir = seg >> 1, l = dir == 0 ? 31 - s : s;
        const float ar = apr[(dir * 33 + l) * 64 + pp], ai = api[(dir * 33 + l) * 64 + pp];
        float e[8];
#pragma unroll
        for (int i = 0; i < 8; ++i) {
            const float br = bbr[(dir * 64 + pp) * 16 + c0 + i], bi = bbi[(dir * 64 + pp) * 16 + c0 + i];
            e[i] = (seg & 1) ? (ar * bi + ai * br) : (ar * br - ai * bi);
        }
        u32x4 w; w.x = pack2(e[0], e[1]); w.y = pack2(e[2], e[3]); w.z = pack2(e[4], e[5]); w.w = pack2(e[6], e[7]);
        *(u32x4*)(ES5 + ((size_t)g * 256 + n) * 512 + k8) = w;
    }
    if (part == 0 && tid < 128) {
        const int dir = tid >> 6, pp = tid & 63;
        ALC[((dir * 32 + g) * 64 + pp) * 2 + 0] = apr[(dir * 33 + 32) * 64 + pp];
        ALC[((dir * 32 + g) * 64 + pp) * 2 + 1] = api[(dir * 33 + 32) * 64 + pp];
    }
    __syncthreads();
}

template <int CTRL> DEV float dpp_f(float oldv, float src) {
    return __builtin_bit_cast(float, __builtin_amdgcn_update_dpp(__builtin_bit_cast(int, oldv), __builtin_bit_cast(int, src), CTRL, 0xf, 0xf, false));
}
DEV float grp8_max(float x) { x = fmaxf(x, dpp_f<0xB1>(x, x)); x = fmaxf(x, dpp_f<0x4E>(x, x)); x = fmaxf(x, dpp_f<0x141>(x, x)); return x; }
DEV float rdl_f(float x, int l) { return __builtin_bit_cast(float, __builtin_amdgcn_readlane(__builtin_bit_cast(int, x), l)); }
DEV float wave_max_u(float x) { x = grp8_max(x); x = fmaxf(x, dpp_f<0x140>(x, x)); return fmaxf(fmaxf(rdl_f(x, 0), rdl_f(x, 16)), fmaxf(rdl_f(x, 32), rdl_f(x, 48))); }
DEV float wave_sum_u(float x) { x += dpp_f<0xB1>(x, x); x += dpp_f<0x4E>(x, x); x += dpp_f<0x141>(x, x); x += dpp_f<0x140>(x, x); return (rdl_f(x, 0) + rdl_f(x, 16)) + (rdl_f(x, 32) + rdl_f(x, 48)); }
#define LRU_DPP_STEP(SH) "s_nop 1\n\tv_fmac_f32_dpp %0, %0, %1 " SH " row_mask:0xf bank_mask:0xf\n\ts_nop 1\n\tv_mul_f32_dpp %1, %1, %1 " SH " row_mask:0xf bank_mask:0xf\n\t"
#define LRU_DPP_STEP2(SH) "v_fmac_f32_dpp %0, %0, %1 " SH " row_mask:0xf bank_mask:0xf\n\tv_fmac_f32_dpp %2, %2, %3 " SH " row_mask:0xf bank_mask:0xf\n\t" \
                          "v_mul_f32_dpp %1, %1, %1 " SH " row_mask:0xf bank_mask:0xf\n\tv_mul_f32_dpp %3, %3, %3 " SH " row_mask:0xf bank_mask:0xf\n\t"
template <bool REV> DEV void row_scan2(float& a0, float& b0, float& a1, float& b1) {
    if (!REV) asm volatile("s_nop 1\n\t" LRU_DPP_STEP2("row_shr:1") LRU_DPP_STEP2("row_shr:2") LRU_DPP_STEP2("row_shr:4") LRU_DPP_STEP2("row_shr:8") "s_nop 1" : "+v"(b0), "+v"(a0), "+v"(b1), "+v"(a1));
    else      asm volatile("s_nop 1\n\t" LRU_DPP_STEP2("row_shl:1") LRU_DPP_STEP2("row_shl:2") LRU_DPP_STEP2("row_shl:4") LRU_DPP_STEP2("row_shl:8") "s_nop 1" : "+v"(b0), "+v"(a0), "+v"(b1), "+v"(a1));
}
template <bool REV> DEV void row_scan(float& a, float& b) {
    if (!REV) asm volatile(LRU_DPP_STEP("row_shr:1") LRU_DPP_STEP("row_shr:2") LRU_DPP_STEP("row_shr:4") LRU_DPP_STEP("row_shr:8") "s_nop 1" : "+v"(b), "+v"(a));
    else      asm volatile(LRU_DPP_STEP("row_shl:1") LRU_DPP_STEP("row_shl:2") LRU_DPP_STEP("row_shl:4") LRU_DPP_STEP("row_shl:8") "s_nop 1" : "+v"(b), "+v"(a));
}
#ifndef PROBE_LRU
#define PROBE_LRU -1
#endif
#define LSEC_B(id) do { if (PROBE_LRU == (id)) { __builtin_amdgcn_sched_barrier(0); __builtin_amdgcn_s_waitcnt(0); lt0_ = __builtin_amdgcn_s_memrealtime(); __builtin_amdgcn_sched_barrier(0); } } while (0)
#define LSEC_E(id) do { if (PROBE_LRU == (id)) { __builtin_amdgcn_sched_barrier(0); __builtin_amdgcn_s_waitcnt(0); lacc_ += __builtin_amdgcn_s_memrealtime() - lt0_; __builtin_amdgcn_sched_barrier(0); } } while (0)
template <bool APPLY>
DEV void lru_phase(const Params& p, LAS unsigned char* lds, int bid, int nb) {
    unsigned long long lt0_ = 0, lacc_ = 0;
    int tid = threadIdx.x; asm volatile("" : "+v"(tid));
    const int wid = __builtin_amdgcn_readfirstlane(tid >> 6), lane = tid & 63, fr = lane & 15, fq = lane >> 4;
    const int w = bid * 8 + wid, h = (w & 31) >> 2, q = w & 3;
    const bf16_t* ULRU = (const bf16_t*)(p.ws + WS_ULRU);
    const bf16_t* BTLRU = (const bf16_t*)(p.ws + WS_BTLRU);
    const float* conv_w = p.in[19]; const float* conv_b = p.in[20];
    const int c4 = h * 64 + q * 16 + 4 * fq;
    const int nch = APPLY ? 64 : 68, npairs = NBATCH * nch;
    LAS unsigned char* gl = lds + (wid >> 2) * 32768;
    LAS unsigned char* convb = gl + 17408;
    LAS float* cwl = (LAS float*)(gl + 25600 + q * 1664);
    for (int i = lane; i < 320; i += 64) cwl[i] = i < 256 ? conv_w[(i >> 6) * 512 + h * 64 + (i & 63)] : conv_b[h * 64 + (i & 63)];
    bf16x8 bfr[2][4];
#pragma unroll
    for (int ks = 0; ks < 2; ++ks)
#pragma unroll
        for (int nt = 0; nt < 4; ++nt) bfr[ks][nt] = *(const bf16x8*)(BTLRU + ((size_t)(h * 256 + (nt >> 1) * 128 + (nt & 1) * 64 + q * 16 + fr)) * 64 + ks * 32 + fq * 8);
    for (int i = lane; i < 96; i += 64) { const int kind = i >> 5, dir = (i >> 4) & 1, c = i & 15, o = dir * 512 + h * 64 + q * 16 + c; cwl[320 + i] = kind == 0 ? ((const float*)(p.ws + WS_LCA))[o] : (kind == 1 ? p.in[22][o] : p.in[24][o]); }
    const char* UB = (const char*)ULRU;
#define LRU_GEO(jj, base0_, plo_, phi_) const int b_##jj = (jj) / nch, ch_##jj = (jj) % nch; const bool lat_##jj = ch_##jj < 64; \
        const unsigned base0_ = (lat_##jj ? (unsigned)(b_##jj * 4096 + ch_##jj * 64) * 2048u : (unsigned)(T + b_##jj * 256 + (ch_##jj - 64) * 64) * 2048u) + (unsigned)h * 128u; \
        const int plo_ = lat_##jj ? 0 : -(ch_##jj - 64) * 64, phi_ = lat_##jj ? 64 : 256 - (ch_##jj - 64) * 64;
#define LRU_DMA(base0_, plo_, phi_, buf_) _Pragma("unroll") for (int i_ = 0; i_ < 9; ++i_) if ((i_ & 3) == q) { const int s_ = i_ * 64 + lane; if (s_ < 536) { const int row_ = s_ >> 3, chk_ = (s_ & 7) ^ (row_ & 7); \
        int pos_ = row_ - 2; pos_ = pos_ < (plo_) ? (plo_) : (pos_ >= (phi_) ? (phi_) - 1 : pos_); \
        __builtin_amdgcn_global_load_lds((const unsigned*)(UB + ((base0_) + (unsigned)pos_ * 2048u + (unsigned)chk_ * 16u)), (LAS unsigned*)(gl + (buf_) * 8704 + i_ * 1024), 16, 0, 0); } }
    int j0 = w >> 5, jstep = (nb * 8) >> 5, jend = npairs;
    if (!APPLY && nb == 256) { const int grp = w >> 5; if (grp < 40) { j0 = grp; jstep = 40; jend = 320; } else { j0 = 320 + (grp - 40); jstep = 24; } }
    int jcur = j0, it_ = 0;
    if (jcur < jend) { LRU_GEO(jcur, bz, pl, ph) LRU_DMA(bz, pl, ph, 0) }
#pragma unroll 1
    for (int j = j0; j < jend; j += jstep, ++it_) {
        const int b = j / nch, ch = j % nch;
        LRU_GEO(j, base0, plo, phi)
        (void)base0;
        LAS const unsigned char* xb = gl + (it_ & 1) * 8704;
        LSEC_B(4);
        asm volatile("s_waitcnt vmcnt(0)" ::: "memory");
        __builtin_amdgcn_s_barrier();
        LSEC_E(4);
        { const int jn = j + jstep; if (jn < jend) { LRU_GEO(jn, bz, pl, ph) LRU_DMA(bz, pl, ph, (it_ + 1) & 1) } }
        asm volatile("" ::: "memory");
        f32x4 hf = (f32x4){0.f, 0.f, 0.f, 0.f}, hr = hf; u32x2 gwv[4] = {};
        if (APPLY) {
            const float* HIN = (const float*)(p.ws + WS_HIN);
            hf = *(const f32x4*)(HIN + ((size_t)(b * 64 + ch) * 2 + 0) * 512 + c4); hr = *(const f32x4*)(HIN + ((size_t)(b * 64 + ch) * 2 + 1) * 512 + c4);
#pragma unroll
            for (int mt = 0; mt < 4; ++mt) gwv[mt] = *(const u32x2*)(ULRU + ((size_t)b * 4096 + (size_t)ch * 64 + (mt * 16 + fr)) * 1024 + 512 + c4);
        }
        LSEC_B(1);
        f32x4 xo[4];
        {
            f32x4 cwo[4];
#pragma unroll
            for (int k = 0; k < 4; ++k) cwo[k] = *(LAS const f32x4*)(cwl + k * 64 + q * 16 + 4 * fq);
            const f32x4 cbo = *(LAS const f32x4*)(cwl + 256 + q * 16 + 4 * fq);
#pragma unroll
            for (int mt = 0; mt < 4; ++mt) {
                f32x4 xv = cbo;
#pragma unroll
                for (int k = 0; k < 4; ++k) {
                    const int row = mt * 16 + fr + k, pos = row - 2;
                    const u32x2 xr = *(LAS const u32x2*)(xb + (row * 8 + ((q * 2 + (fq >> 1)) ^ (row & 7))) * 16 + (fq & 1) * 8);
                    const unsigned mk_ = (pos >= plo && pos < phi) ? 0xffffffffu : 0u;
                    const unsigned x0 = xr.x & mk_, x1 = xr.y & mk_;
                    xv += cwo[k] * (f32x4){__uint_as_float(x0 << 16), __uint_as_float(x0 & 0xffff0000u), __uint_as_float(x1 << 16), __uint_as_float(x1 & 0xffff0000u)};
                }
                xo[mt] = xv;
                const int orow = mt * 16 + fr;
                *(LAS u32x2*)(convb + (orow * 8 + ((q * 2 + (fq >> 1)) ^ (orow & 7))) * 16 + (fq & 1) * 8) = (u32x2){pack2(xv[0], xv[1]), pack2(xv[2], xv[3])};
            }
        }
        asm volatile("s_waitcnt lgkmcnt(0)" ::: "memory");
        __builtin_amdgcn_s_barrier();
        f32x4 acc[4][4];
#pragma unroll
        for (int mt = 0; mt < 4; ++mt)
#pragma unroll
            for (int nt = 0; nt < 4; ++nt) acc[mt][nt] = (f32x4){0.f, 0.f, 0.f, 0.f};
#pragma unroll
        for (int ks = 0; ks < 2; ++ks)
#pragma unroll
            for (int mt = 0; mt < 4; ++mt) {
                const int orow = mt * 16 + fr;
                const bf16x8 af = *(LAS const bf16x8*)(convb + (orow * 8 + ((ks * 4 + fq) ^ (orow & 7))) * 16);
#pragma unroll
                for (int nt = 0; nt < 4; ++nt) acc[mt][nt] = __builtin_amdgcn_mfma_f32_16x16x32_bf16(bfr[ks][nt], af, acc[mt][nt], 0, 0, 0);
            }
        LSEC_E(1); LSEC_B(2);
        f32x4 cA[2], ba[2], bx[2];
#pragma unroll
        for (int dir = 0; dir < 2; ++dir) { cA[dir] = *(LAS const f32x4*)(cwl + 320 + dir * 16 + 4 * fq); ba[dir] = *(LAS const f32x4*)(cwl + 352 + dir * 16 + 4 * fq); bx[dir] = *(LAS const f32x4*)(cwl + 384 + dir * 16 + 4 * fq); }
#pragma unroll
        for (int mt = 0; mt < 4; ++mt) {
#pragma unroll
            for (int dir = 0; dir < 2; ++dir)
#pragma unroll
                for (int r = 0; r < 4; ++r) {
                    const float za = acc[mt][2 * dir][r] + ba[dir][r], zx = acc[mt][2 * dir + 1][r] + bx[dir][r];
                    const float a = __builtin_amdgcn_exp2f(cA[dir][r] * sigmoid_f(za));
                    acc[mt][2 * dir][r] = a;
                    acc[mt][2 * dir + 1][r] = __builtin_amdgcn_sqrtf(fmaf(-a, a, 1.f)) * sigmoid_f(zx) * xo[mt][r];
                }
        }
        LSEC_E(2); LSEC_B(3);
        const int bsel15 = ((lane & 48) | 15) << 2, bsel0 = (lane & 48) << 2;
        if (!APPLY) {
            f32x4 PA[2], PH[2];
#pragma unroll
            for (int r = 0; r < 4; ++r) {
                float cAf = 1.f, cHf = 0.f, cAr = 1.f, cHr = 0.f;
#pragma unroll
                for (int mt = 0; mt < 4; mt += 2) {
                    float a = acc[mt][0][r], bq = acc[mt][1][r], a1 = acc[mt + 1][0][r], bq1 = acc[mt + 1][1][r]; row_scan2<false>(a, bq, a1, bq1);
                    const float At = dpp_f<0x140>(a, a), Ht = dpp_f<0x140>(bq, bq), At1 = dpp_f<0x140>(a1, a1), Ht1 = dpp_f<0x140>(bq1, bq1);
                    cHf = At * cHf + Ht; cAf *= At; cHf = At1 * cHf + Ht1; cAf *= At1;
                }
#pragma unroll
                for (int mt = 3; mt >= 0; mt -= 2) {
                    float a = acc[mt][2][r], bq = acc[mt][3][r], a1 = acc[mt - 1][2][r], bq1 = acc[mt - 1][3][r]; row_scan2<true>(a, bq, a1, bq1);
                    cHr = a * cHr + bq; cAr *= a; cHr = a1 * cHr + bq1; cAr *= a1;
                }
                PA[0][r] = cAf; PH[0][r] = cHf; PA[1][r] = cAr; PH[1][r] = cHr;
            }
            if (fr == 0) {
                float* SA = (float*)(p.ws + WS_SA); float* SB = (float*)(p.ws + WS_SB);
#pragma unroll
                for (int dir = 0; dir < 2; ++dir) { const size_t o = ((size_t)(b * 68 + ch) * 2 + dir) * 512 + c4; *(f32x4*)(SA + o) = PA[dir]; *(f32x4*)(SB + o) = PH[dir]; }
            }
        } else {
            f32x4 Ho[4];
#pragma unroll
            for (int r = 0; r < 4; ++r) {
                float sa[4], sb[4], At[4], Ht[4];
#pragma unroll
                for (int mt = 0; mt < 4; ++mt) { sa[mt] = acc[mt][0][r]; sb[mt] = acc[mt][1][r]; }
                row_scan2<false>(sa[0], sb[0], sa[1], sb[1]); row_scan2<false>(sa[2], sb[2], sa[3], sb[3]);
#pragma unroll
                for (int mt = 0; mt < 4; ++mt) { At[mt] = __builtin_bit_cast(float, __builtin_amdgcn_ds_bpermute(bsel15, __builtin_bit_cast(int, sa[mt]))); Ht[mt] = __builtin_bit_cast(float, __builtin_amdgcn_ds_bpermute(bsel15, __builtin_bit_cast(int, sb[mt]))); }
                float carry = hf[r];
#pragma unroll
                for (int mt = 0; mt < 4; ++mt) { Ho[mt][r] = sb[mt] + sa[mt] * carry; carry = Ht[mt] + At[mt] * carry; }
#pragma unroll
                for (int mt = 0; mt < 4; ++mt) { sa[mt] = acc[mt][2][r]; sb[mt] = acc[mt][3][r]; }
                row_scan2<true>(sa[0], sb[0], sa[1], sb[1]); row_scan2<true>(sa[2], sb[2], sa[3], sb[3]);
#pragma unroll
                for (int mt = 0; mt < 4; ++mt) { At[mt] = __builtin_bit_cast(float, __builtin_amdgcn_ds_bpermute(bsel0, __builtin_bit_cast(int, sa[mt]))); Ht[mt] = __builtin_bit_cast(float, __builtin_amdgcn_ds_bpermute(bsel0, __builtin_bit_cast(int, sb[mt]))); }
                carry = hr[r];
#pragma unroll
                for (int mt = 3; mt >= 0; --mt) { Ho[mt][r] += sb[mt] + sa[mt] * carry; carry = Ht[mt] + At[mt] * carry; }
            }
            bf16_t* YCAT = (bf16_t*)(p.ws + WS_YCAT);
#pragma unroll
            for (int mt = 0; mt < 4; ++mt) {
                const size_t row = (size_t)b * 4096 + (size_t)ch * 64 + (mt * 16 + fr);
                const u32x2 gw = gwv[mt];
                const float g0 = __uint_as_float(gw.x << 16), g1 = __uint_as_float(gw.x & 0xffff0000u), g2 = __uint_as_float(gw.y << 16), g3 = __uint_as_float(gw.y & 0xffff0000u);
                u32x2 ow; ow.x = pack2(Ho[mt][0] * gelu_tanh(g0), Ho[mt][1] * gelu_tanh(g1)); ow.y = pack2(Ho[mt][2] * gelu_tanh(g2), Ho[mt][3] * gelu_tanh(g3));
                *(u32x2*)(YCAT + row * 1024 + 512 + c4) = ow;
            }
        }
        LSEC_E(3);
    }
    if (PROBE_LRU >= 0 && !APPLY && bid == 0) { const unsigned long long d_ = lacc_ * 8ull, t0_ = __builtin_amdgcn_s_memrealtime(); while (__builtin_amdgcn_s_memrealtime() - t0_ < d_) __builtin_amdgcn_s_sleep(8); }
}

DEV unsigned char* slab_row(unsigned char* ws, size_t row) { return row < (size_t)SLAB_ROWS_A ? ws + WS_SLABA + row * 1024 : ws + WS_SLABB + (row - SLAB_ROWS_A) * 1024; }
constexpr int MOE_TAB_OFF = 132096;
DEV void moe_tables(const Params& p, LAS unsigned char* lds, int h) {
    LAS int* tp = (LAS int*)(lds + MOE_TAB_OFF); LAS int* pc = tp + 72; LAS int* cn = pc + 72; LAS int* texp = cn + 72;
    int tid_ = threadIdx.x; asm volatile("" : "+v"(tid_));
    if (tid_ < 64) {
        const int lane = tid_;
        const int c = ((const int*)(p.ws + WS_CNT) + h * 64)[lane], tl = (c + 255) >> 8;
        int q = c, t = tl;
#pragma unroll
        for (int o = 1; o < 64; o <<= 1) { const int a = __shfl_up(q, o), b = __shfl_up(t, o); if (lane >= o) { q += a; t += b; } }
        cn[lane] = c; pc[lane] = q - c; tp[lane] = t - tl;
        if (lane == 63) { cn[64] = HALF_T; pc[64] = q; tp[64] = t; pc[65] = q + HALF_T; tp[65] = t + ((HALF_T + 255) >> 8); }
    }
    __syncthreads();
    for (int e = tid_ >> 3; e < 65; e += 64) for (int r = tp[e] + (tid_ & 7); r < tp[e + 1]; r += 8) texp[r] = e;
    __syncthreads();
}
template <bool GU>
struct MoeSched {
    struct Unit { int e, r0t, pn; };
    static constexpr bool GATHER = GU;
    LAS const int* tp; LAS const int* pc; LAS const int* cn;
    const char* Abase; const char* Bt; const unsigned* list; int h, nN, nunits, G, c;
    DEV int lda() const { return GU ? 256 : 128; }
    DEV bool next(int i, Unit& u) const {
        const long L = (long)i * G + c; if (L >= nunits) return false;
        int w = (int)L; { const int q = nunits / 8, r = nunits % 8, xcd = w % 8, off = w / 8; w = (xcd < r ? xcd * (q + 1) : r * (q + 1) + (xcd - r) * q) + off; }
        const int rt = w / nN; u.pn = w % nN;
        const int e = tp[216 + rt];
        u.e = e; u.r0t = (rt - tp[e]) * 256; return true;
    }
    DEV unsigned tokraw(int e, int ce, int idx) const {
        idx = idx < ce ? idx : ce - 1;
        return e < 64 ? list[(size_t)e * HALF_T + idx] : ((unsigned)idx << 16);
    }
    DEV unsigned fix(unsigned raw, int C) const { return (raw >> 16) * 4096u + 2048u + (unsigned)C * 2u; }
    DEV void addr(const Unit& u, int R0, int C0, int R1, int C1, gp::UAddr& o) const {
        if constexpr (GU) {
            const int ce = cn[u.e];
            o.a = Abase; o.b = Bt + ((size_t)u.e * 512 + u.pn * 256) * 1024;
            o.ao00 = tokraw(u.e, ce, u.r0t + R0); o.ao01 = tokraw(u.e, ce, u.r0t + R1);
            o.ao10 = tokraw(u.e, ce, u.r0t + 128 + R0); o.ao11 = tokraw(u.e, ce, u.r0t + 128 + R1);
        } else {
            o.a = Abase + ((size_t)pc[u.e] + u.r0t) * 256; o.b = Bt + ((size_t)u.e * 1024 + u.pn * 256) * 256;
        }
    }
};
struct EpiMoeGU {
    static constexpr int PID = 9;
    static constexpr bool OWN_DRAIN = true;
    static constexpr bool PREFETCH = true;
    static constexpr bool PERM = false;
    LAS const int* pc; LAS const int* cn; unsigned char* HMID; const unsigned* scw; const char* list2; LAS unsigned char* ept;
    template <class U> DEV void prefetch(const U& u, int wr, int wc, int lane) const {
        const int idx = u.r0t + (lane >> 5) * 128 + wr * 64 + (lane & 31) * 2;
        __builtin_amdgcn_global_load_lds((const unsigned*)(list2 + ((size_t)u.e * HALF_T + idx) * 8), (LAS unsigned*)(ept + (wr * 4 + wc) * 1024), 16, 0, 0);
    }
    struct Packed { int w[2][4][2]; };
    template <class U> DEV void convert(const f32x4 (&acc)[2][2][4][2], const U& u, int wr, int wc, int fr, int fq, Packed& pk) const {
        typedef float f32x2_ __attribute__((ext_vector_type(2)));
        const float sg = __uint_as_float(scw[u.e * 2]) * (1.f / 127.f), su = __uint_as_float(scw[u.e * 2 + 1]) * (1.f / 127.f);
        LAS const unsigned char* ew = ept + (wr * 4 + wc) * 1024;
#pragma unroll
        for (int ai = 0; ai < 2; ++ai)
#pragma unroll
            for (int m = 0; m < 4; ++m) {
                const f32x2_ l2 = *(LAS const f32x2_*)(ew + (ai * 64 + m * 16 + fr) * 8);
                const float cg = l2.x * sg, cu = l2.y * su * HMID_SCALE;
                const float cg2 = cg * -1.4426950408889634f, ccu = cg * cu;
#pragma unroll
                for (int bj = 0; bj < 2; ++bj) {
                    const i32x4 gi = __builtin_bit_cast(i32x4, acc[ai][bj][m][0]), ui = __builtin_bit_cast(i32x4, acc[ai][bj][m][1]);
                    float o[4];
#pragma unroll
                    for (int r = 0; r < 4; ++r) { const float gf = (float)gi[r]; o[r] = __builtin_amdgcn_fmed3f((gf * (float)ui[r]) * ccu * __builtin_amdgcn_rcpf(1.f + __builtin_amdgcn_exp2f(gf * cg2)), -448.f, 448.f); }
                    int w_ = 0; w_ = __builtin_amdgcn_cvt_pk_fp8_f32(o[0], o[1], w_, false); w_ = __builtin_amdgcn_cvt_pk_fp8_f32(o[2], o[3], w_, true);
                    pk.w[ai][m][bj] = w_;
                }
            }
    }
    template <class U> DEV void store(const Packed& pk, const U& u, int wr, int wc, int fr, int fq) const {
        const int ce = cn[u.e]; const size_t prow = (size_t)pc[u.e];
#pragma unroll
        for (int ai = 0; ai < 2; ++ai)
#pragma unroll
            for (int m = 0; m < 4; ++m) {
                const int idx = u.r0t + ai * 128 + wr * 64 + m * 16 + fr;
                if (idx < ce) *(u32x2*)(HMID + (prow + idx) * 256 + u.pn * 128 + wc * 32 + 8 * fq) = (u32x2){(unsigned)pk.w[ai][m][0], (unsigned)pk.w[ai][m][1]};
            }
    }
};
struct EpiMoeDN {
    static constexpr int PID = 10;
    static constexpr bool OWN_DRAIN = true;
    static constexpr bool PREFETCH = false;
    static constexpr bool PERM = true;
    LAS const int* pc; LAS const int* cn; unsigned char* ws; bf16_t* out2; const unsigned* scw;
    struct Packed { int w[2][4][4]; };
    template <class U> DEV void convert(const f32x4 (&acc)[2][2][4][2], const U& u, int wr, int wc, int fr, int fq, Packed& pk) const {
        const float invs = __uint_as_float(scw[130 + u.e]) * (SLAB_SCALE / (DNW_MAX * HMID_SCALE));
#pragma unroll
        for (int ai = 0; ai < 2; ++ai)
#pragma unroll
            for (int m = 0; m < 4; ++m)
#pragma unroll
                for (int bj = 0; bj < 2; ++bj) {
                    const f32x4 v0 = acc[ai][bj][m][0] * invs, v1 = acc[ai][bj][m][1] * invs;
                    int w0 = 0, w1 = 0;
                    w0 = __builtin_amdgcn_cvt_pk_fp8_f32(v0[0], v0[1], w0, false); w0 = __builtin_amdgcn_cvt_pk_fp8_f32(v0[2], v0[3], w0, true);
                    w1 = __builtin_amdgcn_cvt_pk_fp8_f32(v1[0], v1[1], w1, false); w1 = __builtin_amdgcn_cvt_pk_fp8_f32(v1[2], v1[3], w1, true);
                    pk.w[ai][m][bj * 2] = w0; pk.w[ai][m][bj * 2 + 1] = w1;
                }
    }
    template <class U> DEV void store(const Packed& pk, const U& u, int wr, int wc, int fr, int fq) const {
        const int ce = cn[u.e]; const size_t prow = (size_t)pc[u.e];
#pragma unroll
        for (int ai = 0; ai < 2; ++ai)
#pragma unroll
            for (int m = 0; m < 4; ++m) {
                const int idx = u.r0t + ai * 128 + wr * 64 + m * 16 + fr;
                unsigned char* rowp = u.e < 64 ? slab_row(ws, prow + idx) : (unsigned char*)out2 + (size_t)idx * 4096 + 2048;
                if (idx < ce) *(u32x4*)(rowp + u.pn * 256 + wc * 64 + fq * 16) = (u32x4){(unsigned)pk.w[ai][m][0], (unsigned)pk.w[ai][m][1], (unsigned)pk.w[ai][m][2], (unsigned)pk.w[ai][m][3]};
            }
    }
};
DEV void fp8x16_add(const u32x4 w, float (&f)[16]) {
    typedef float f2 __attribute__((ext_vector_type(2)));
    const unsigned ww[4] = {w.x, w.y, w.z, w.w};
#pragma unroll
    for (int j = 0; j < 4; ++j) {
        const f2 a = __builtin_amdgcn_cvt_pk_f32_fp8((int)ww[j], false), b = __builtin_amdgcn_cvt_pk_f32_fp8((int)ww[j], true);
        f[4 * j] += a.x; f[4 * j + 1] += a.y; f[4 * j + 2] += b.x; f[4 * j + 3] += b.y;
    }
}
DEV void moe_reduce(const Params& p, LAS unsigned char* lds, int h, int bid, int nb) {
    int tid = threadIdx.x; asm volatile("" : "+v"(tid));
    const int wid = tid >> 6, lane = tid & 63;
    LAS const int* pc = (LAS const int*)(lds + MOE_TAB_OFF) + 72;
    const int* PAIR = (const int*)(p.ws + WS_PAIR); const float* ADA = (const float*)(p.ws + WS_ADA);
    constexpr int NIT = HALF_T / 8;
    const int col = lane * 16;
    const int c0 = (lane >> 4) * 256 + ((lane >> 2) & 3) * 32 + (lane & 3) * 8;
#define RED_COLQ(q) (c0 + ((q) & 1) * 4 + ((q) >> 1) * 128)
    LAS float* PV = (LAS float*)lds;
    for (int i = tid; i < 10 * 256; i += 512) { const int v = i >> 8, o4 = (i & 255) * 4;
        *(LAS f32x4*)(PV + v * 1024 + o4) = *(const f32x4*)((v == 0 ? p.in[37] : v == 1 ? p.in[38] : ADA + (v - 2) * 6144 + 5120) + o4); }
    __syncthreads();
    u32x4 rowsA[8], shA[1], hrA[2], rowsB[8], shB[1], hrB[2];
#define RED_LOAD(rows_, sh_, hr_, k_) do { \
        const size_t tok_ = (size_t)h * HALF_T + (size_t)(it0 + (k_) * nb) * 8 + wid; \
        _Pragma("unroll") for (int s_ = 0; s_ < 8; ++s_) { const int pr_ = __builtin_amdgcn_readlane((int)((s_ & 1) ? pw.y : pw.x), (k_) * 4 + (s_ >> 1)); \
            rows_[s_] = *(const u32x4*)(slab_row(p.ws, (size_t)pc[pr_ >> 16] + (pr_ & 0xffff)) + col); } \
        sh_[0] = *(const u32x4*)((const unsigned char*)p.out + tok_ * 4096 + 2048 + col); \
        hr_[0] = *(const u32x4*)((const bf16_t*)p.out + tok_ * 2048 + c0); hr_[1] = *(const u32x4*)((const bf16_t*)p.out + tok_ * 2048 + c0 + 128); } while (0)
#define RED_COMP(rows_, sh_, hr_, k_) do { \
        const size_t tok_ = (size_t)h * HALF_T + (size_t)(it0 + (k_) * nb) * 8 + wid; const int b_ = (int)(tok_ >> 12); \
        float f[16]; \
        _Pragma("unroll") for (int j = 0; j < 16; ++j) f[j] = 0.f; \
        _Pragma("unroll") for (int s_ = 0; s_ < 8; ++s_) fp8x16_add(rows_[s_], f); \
        fp8x16_add(sh_[0], f); \
        __builtin_amdgcn_sched_barrier(0); \
        f32x4 g2_[4]; \
        _Pragma("unroll") for (int q = 0; q < 4; ++q) g2_[q] = *(LAS const f32x4*)(PV + (2 + b_) * 1024 + RED_COLQ(q)); \
        float z[16]; float s = 0.f; \
        { float y0[8], y1[8]; bf8_unpack(hr_[0], y0); bf8_unpack(hr_[1], y1); \
          _Pragma("unroll") for (int j = 0; j < 8; ++j) { z[j] = y0[j] * ALPHA_F + g2_[j >> 2][j & 3] * (f[j] * (1.f / SLAB_SCALE)); z[8 + j] = y1[j] * ALPHA_F + g2_[2 + (j >> 2)][j & 3] * (f[8 + j] * (1.f / SLAB_SCALE)); } \
          _Pragma("unroll") for (int j = 0; j < 16; ++j) s += z[j]; } \
        const float mean = wave_sum(s) * (1.f / 1024.f); float qq = 0.f; \
        _Pragma("unroll") for (int j = 0; j < 16; ++j) { const float d = z[j] - mean; qq += d * d; } \
        const float rstd = rsqrtf(wave_sum(qq) * (1.f / 1024.f) + LN_EPS_F); \
        __builtin_amdgcn_sched_barrier(0); \
        _Pragma("unroll") for (int q = 0; q < 4; ++q) { f32x4 o; const f32x4 gg_ = *(LAS const f32x4*)(PV + RED_COLQ(q)), bb_ = *(LAS const f32x4*)(PV + 1024 + RED_COLQ(q)); \
            _Pragma("unroll") for (int j = 0; j < 4; ++j) o[j] = (z[q * 4 + j] - mean) * rstd * gg_[j] + bb_[j]; \
            *(f32x4*)(p.out + tok_ * 1024 + RED_COLQ(q)) = o; } } while (0)
    for (int it0 = bid; it0 < NIT; it0 += nb * 16) {
        u32x2 pw = (u32x2){0u, 0u};
        { const int itk = it0 + (lane >> 2) * nb; if (itk < NIT) pw = *(const u32x2*)(PAIR + ((size_t)h * HALF_T + (size_t)itk * 8 + wid) * 8 + (lane & 3) * 2); }
        const int rem = (NIT - it0 + nb - 1) / nb, n = rem < 16 ? rem : 16;
        RED_LOAD(rowsA, shA, hrA, 0);
#pragma unroll 1
        for (int k = 0; k < n; k += 2) {
            if (k + 1 < n) RED_LOAD(rowsB, shB, hrB, k + 1);
            __builtin_amdgcn_sched_barrier(0);
            RED_COMP(rowsA, shA, hrA, k);
            __builtin_amdgcn_sched_barrier(0);
            if (k + 2 < n) RED_LOAD(rowsA, shA, hrA, k + 2);
            __builtin_amdgcn_sched_barrier(0);
            if (k + 1 < n) RED_COMP(rowsB, shB, hrB, k + 1);
            __builtin_amdgcn_sched_barrier(0);
        }
    }
#undef RED_LOAD
#undef RED_COMP
#undef RED_COLQ
}

#define ADA ((float*)(p.ws + WS_ADA))
#define HB ((bf16_t*)(p.ws + WS_HB))
#define BTIN ((bf16_t*)(p.ws + WS_BTIN))
#define HM ((bf16_t*)(p.ws + WS_HM))
#define US5 ((bf16_t*)(p.ws + WS_US5))
#define ULRU ((bf16_t*)(p.ws + WS_ULRU))
#define SLOC ((float*)(p.ws + WS_SLOC))
#define YS5 ((bf16_t*)(p.ws + WS_YS5))
#define YCAT ((bf16_t*)(p.ws + WS_YCAT))
#define Y ((bf16_t*)(p.ws + WS_Y))
#define LIST ((unsigned*)(p.ws + WS_LIST))
#define HMID ((bf16_t*)(p.ws + WS_HMID))
#define PAIR ((int*)(p.ws + WS_PAIR))
#define CNT ((int*)(p.ws + WS_CNT))
__global__ void __launch_bounds__(512) mk_fwd(Params p) {
    extern __shared__ __attribute__((aligned(16))) unsigned char lds_raw[];
    LAS unsigned char* lds = (LAS unsigned char*)lds_raw;
    const int bid = blockIdx.x, nb = gridDim.x;
    volatile LAS unsigned* MISC = (volatile LAS unsigned*)(lds + MISC_OFF);
    if (threadIdx.x < 64) MISC[threadIdx.x] = 0u;
    __syncthreads();
    unsigned char* const ws = p.ws;
    XcdBarrier bar; bar.bar = (unsigned*)(ws + WS_CTL); bar.x = 0; bar.st = nullptr;
    const bool fused = (p.ph_hi - p.ph_lo) > 1;
    if (fused) bar = xcd_barrier_post((unsigned*)(ws + WS_CTL), MISC + 8);

    const int lo = p.ph_lo, hi = p.ph_hi;
#ifndef PROBE_REP_PH
#define PROBE_REP_PH -1
#endif
#define IN(k) (lo <= (k) && (k) < hi)
#ifndef PROBE_TIME
#define PROBE_TIME -1
#endif
    unsigned long long tprobe0_ = 0, tprobe1_ = 0;
#ifndef PROBE_SEC
#define PROBE_SEC -1
#endif
    unsigned long long tsec_acc_ = 0, tsec_t0_ = 0;
#define SEC_BEGIN(id) do { if (PROBE_SEC == (id)) { __builtin_amdgcn_s_waitcnt(0); tsec_t0_ = __builtin_amdgcn_s_memrealtime(); } } while (0)
#define SEC_END(id) do { if (PROBE_SEC == (id)) { __builtin_amdgcn_s_waitcnt(0); tsec_acc_ += __builtin_amdgcn_s_memrealtime() - tsec_t0_; } } while (0)
#define TSTAMP(k) do { if (PROBE_TIME >= 0) { if ((k) == PROBE_TIME) tprobe0_ = __builtin_amdgcn_s_memrealtime(); if ((k) == PROBE_TIME + 1) tprobe1_ = __builtin_amdgcn_s_memrealtime(); } } while (0)
#define TIDS int tid = threadIdx.x; asm volatile("" : "+v"(tid)); const int wid = tid >> 6, lane = tid & 63; (void)wid; (void)lane
#define REPS(k) (((k) == PROBE_REP_PH) ? 2 : 1)
#ifndef PROBE_SUB
#define PROBE_SUB -1
#endif
#define SUBREPS(k) (((k) == PROBE_SUB) ? 2 : 1)
#define SEAM(k) do { if (IN(k) && IN((k) + 1)) xcd_barrier(bar); else __syncthreads(); TSTAMP((k) + 1); } while (0)
    {
        TSTAMP(0);
        for (int rep_ = 0; rep_ < REPS(0); ++rep_) if (IN(0)) { if (rep_) xcd_barrier(bar); TIDS;
            for (int sr_ = 0; sr_ < SUBREPS(1); ++sr_)
            for (int it = bid; it < 256; it += nb) s5_tables(p, lds, it >> 3, it & 7);
            {
                LAS float* S = (LAS float*)lds; LAS float* red = S + 9216;
                __syncthreads();
                for (int i = tid; i < 9216; i += 512) { const float c = i < 8192 ? p.in[1][i] : p.in[3][i - 8192]; S[i] = c * sigmoid_f(c); }
                if (bid == nb - 1) for (int i = tid; i < 1024; i += 512) ((float*)(ws + WS_LCA))[i] = -8.f * 1.4426950408889634f * log1pf(__expf(-p.in[25][i]));
                if (bid >= nb - 9 && bid < nb - 1) for (int i = (bid - (nb - 9)) * 8192 + tid; i < (bid - (nb - 9) + 1) * 8192; i += 512) {
                    const int e = i & 63, k = i >> 6; const float wv = p.in[29][i]; const unsigned hi = f2bf(wv); const float rem = wv - __uint_as_float(hi << 16);
                    ((bf16_t*)(ws + WS_RWH))[e * 1024 + k] = (bf16_t)hi; ((bf16_t*)(ws + WS_RWL))[e * 1024 + k] = (bf16_t)f2bf(rem);
                }
                __syncthreads();
                for (int sr_ = 0; sr_ < SUBREPS(2); ++sr_)
                for (int it = bid; it < 192; it += nb) gemv9_item(S, p.in[6], 6144, it * 32, p.in[7], ADA, 6144, red);
                __syncthreads();
            }
            {
                LAS float* tile = (LAS float*)lds + wid * (64 * 65);
                for (int sr_ = 0; sr_ < SUBREPS(3); ++sr_)
                for (int it = bid * 8 + wid; it < 736; it += nb * 8) {
                    if (it < 64) { tr_tile_wave(p.in[17], 512, (it >> 3) * 64, (it & 7) * 64, (bf16_t*)(ws + WS_BTGLU), 512, 0, tile, lane); }
                    else if (it < 320) { const int i2 = it - 64; tr_tile_wave(p.in[26], 1024, (i2 >> 4) * 64, (i2 & 15) * 64, (bf16_t*)(ws + WS_BTOUT), 1024, 0, tile, lane); }
                    else if (it < 352) {
                        const int i2 = it - 320, dir = i2 >> 4, ax = (i2 >> 3) & 1, h = i2 & 7;
                        const float* W = (ax ? p.in[23] : p.in[21]) + (size_t)(dir * 8 + h) * 4096;
                        tr_tile_wave(W, 64, 0, 0, (bf16_t*)(ws + WS_BTLRU) + (size_t)(h * 256 + dir * 128 + ax * 64) * 64, 64, 0, tile, lane);
                    } else {
                        const int i2 = it - 352;
                        const float* W = p.in[8] + (size_t)((i2 / 24) * 64) * NWIN + (i2 % 24) * 64;
                        f32x4 a = (f32x4){0.f, 0.f, 0.f, 0.f};
#pragma unroll
                        for (int i = 0; i < 16; ++i) { const f32x4 v = *(const f32x4*)(W + (size_t)(i * 4 + (lane >> 4)) * NWIN + (lane & 15) * 4); a = (f32x4){fmaxf(a[0], fabsf(v[0])), fmaxf(a[1], fabsf(v[1])), fmaxf(a[2], fabsf(v[2])), fmaxf(a[3], fabsf(v[3]))}; }
#pragma unroll
                        for (int j = 0; j < 4; ++j) { a[j] = fmaxf(a[j], __shfl_xor(a[j], 16)); a[j] = fmaxf(a[j], __shfl_xor(a[j], 32)); }
                        if (lane < 16) {
                            unsigned* sc = (unsigned*)(ws + WS_SCIN) + (i2 % 24) * 64 + lane * 4;
#pragma unroll
                            for (int j = 0; j < 4; ++j) atomicMax(sc + j, __float_as_uint(a[j]));
                        }
                    }
                }
            }
        }
        SEAM(0);
        for (int rep_ = 0; rep_ < REPS(1); ++rep_) if (IN(1)) { if (rep_) xcd_barrier(bar); TIDS;
            SEC_BEGIN(5);
            for (int it = bid; it < 256; it += nb) s5_fill(p, lds, it >> 3, it & 7);
            {
                LAS float* tile = (LAS float*)lds + wid * (64 * 65);
                const int cb = (bid + nb - (TT / 32) % nb) % nb;
                for (int it = cb * 8 + wid; it < 384; it += nb * 8) {
                    TrTile t{p.in[8], BTIN, NWIN, (it / 24) * 64, (it % 24) * 64, 1024, 0, 1.f, (const unsigned*)(ws + WS_SCIN)}; f32x4 v[16]; tr_load(t, lane, v); tr_store<1>(t, lane, v, tile);
                }
                __syncthreads();
            }
            SEC_END(5); SEC_BEGIN(6);
            for (int it = bid; it < TT / 32; it += nb) {
                const int row0 = it * 32 + wid * 4;
                f32x4 v[4][4]; float s[4];
#pragma unroll
                for (int rr = 0; rr < 4; ++rr) {
                    const int row = row0 + rr;
                    const float* src = row < T ? p.in[0] + (size_t)row * 1024 : p.in[2] + (size_t)(row - T) * 1024;
#pragma unroll
                    for (int q = 0; q < 4; ++q) v[rr][q] = *(const f32x4*)(src + q * 256 + lane * 4);
                }
                f32x4 gg[4], bbv[4], sh1[4], sc1[4];
                { const float* ada = ADA + (row0 < T ? (row0 >> 12) : 8) * 6144;
#pragma unroll
                  for (int q = 0; q < 4; ++q) { const int col = q * 256 + lane * 4; gg[q] = *(const f32x4*)(p.in[4] + col); bbv[q] = *(const f32x4*)(p.in[5] + col); sh1[q] = *(const f32x4*)(ada + col); sc1[q] = *(const f32x4*)(ada + 1024 + col); } }
#pragma unroll
                for (int rr = 0; rr < 4; ++rr) { float a = 0.f;
#pragma unroll
                    for (int q = 0; q < 4; ++q) a += (v[rr][q][0] + v[rr][q][1]) + (v[rr][q][2] + v[rr][q][3]);
                    s[rr] = a; }
#pragma unroll
                for (int o = 1; o < 64; o <<= 1) {
#pragma unroll
                    for (int rr = 0; rr < 4; ++rr) s[rr] += __shfl_xor(s[rr], o); }
                float mean[4], qq[4];
#pragma unroll
                for (int rr = 0; rr < 4; ++rr) { mean[rr] = s[rr] * (1.f / 1024.f); float a = 0.f;
#pragma unroll
                    for (int q = 0; q < 4; ++q) { const f32x4 d = v[rr][q] - mean[rr]; a += (d[0] * d[0] + d[1] * d[1]) + (d[2] * d[2] + d[3] * d[3]); }
                    qq[rr] = a; }
#pragma unroll
                for (int o = 1; o < 64; o <<= 1) {
#pragma unroll
                    for (int rr = 0; rr < 4; ++rr) qq[rr] += __shfl_xor(qq[rr], o); }
                float rstd[4], am[4];
#pragma unroll
                for (int rr = 0; rr < 4; ++rr) { rstd[rr] = rsqrtf(qq[rr] * (1.f / 1024.f) + LN_EPS_F); am[rr] = 0.f; }
#pragma unroll
                for (int q = 0; q < 4; ++q) {
                    const int col = q * 256 + lane * 4;
#pragma unroll
                    for (int rr = 0; rr < 4; ++rr) {
                        const int row = row0 + rr;
                        const f32x4 o = (v[rr][q] - mean[rr]) * rstd[rr] * gg[q] + bbv[q];
                        u32x2 w; w.x = pack2(o[0], o[1]); w.y = pack2(o[2], o[3]);
                        *(u32x2*)(HB + (size_t)row * 1024 + col) = w;
                        const f32x4 om = o * (sc1[q] + 1.f) + sh1[q];
                        v[rr][q] = om;
                        am[rr] = fmaxf(am[rr], fmaxf(fmaxf(fabsf(om[0]), fabsf(om[1])), fmaxf(fabsf(om[2]), fabsf(om[3]))));
                    }
                }
#pragma unroll
                for (int o = 1; o < 64; o <<= 1) {
#pragma unroll
                    for (int rr = 0; rr < 4; ++rr) am[rr] = fmaxf(am[rr], __shfl_xor(am[rr], o)); }
#pragma unroll
                for (int rr = 0; rr < 4; ++rr) {
                    const int row = row0 + rr; const float amx = fmaxf(am[rr], 1e-30f), qs = 127.f / amx;
                    if (lane == 0) ((float*)(ws + WS_SHM))[row] = amx * (1.f / 127.f);
#pragma unroll
                    for (int q = 0; q < 4; ++q) {
                        unsigned wq = 0u;
#pragma unroll
                        for (int jj = 0; jj < 4; ++jj) { int qv = (int)rintf(v[rr][q][jj] * qs); qv = qv < -127 ? -127 : (qv > 127 ? 127 : qv); wq |= ((unsigned)qv & 0xffu) << (8 * jj); }
                        *(unsigned*)((unsigned char*)HM + (size_t)row * 1024 + q * 256 + lane * 4) = wq;
                    }
                }
            }
            SEC_END(6);
        }
        SEAM(1);
        for (int rep_ = 0; rep_ < REPS(2); ++rep_) if (IN(2)) { if (rep_) xcd_barrier(bar); TIDS;
            { WinSched S{(const char*)HM, (const char*)BTIN, nb, bid};
              EpiWin E{US5, ULRU, (const float*)(ws + WS_SHM), (const unsigned*)(ws + WS_SCIN)};
              gp::gemm_phase<EpiWin, WinSched, true>(lds, 512, S, E); }
            {
                int bid_ = bid; asm volatile("" : "+s"(bid_));
                int tid2 = threadIdx.x; asm volatile("" : "+v"(tid2));
                const int wid2 = tid2 >> 6, lane2 = tid2 & 63;
                const int nfull = (136 * 6) % nb;
                constexpr int NTILE = 65 * 192;
                constexpr int TF = 5;
                const int fullw = nfull * 8, loww = (nb - nfull) * 8, nf = fullw * TF < NTILE ? fullw * TF : 0, nl = NTILE - nf;
                int t_lo, t_hi;
                if (bid_ < nfull && nf) { t_lo = nl + bid_ * (8 * TF); t_hi = t_lo + 8 * TF; }
                else if (bid_ >= nfull) { const int w = (bid_ - nfull) * 8; t_lo = (int)((long)w * nl / loww); t_hi = (int)((long)(w + 8) * nl / loww); }
                else { t_lo = 0; t_hi = 0; }
                convert_tiles(p, lds, t_lo + wid2, t_hi, lane2, wid2);
            }
        }
        SEAM(2);
        for (int rep_ = 0; rep_ < REPS(3); ++rep_) if (IN(3)) { if (rep_) xcd_barrier(bar); TIDS;
            const bf16_t* ES5 = (const bf16_t*)(ws + WS_ES5);
            { S5Sched S{(const char*)US5, (const char*)ES5, 512, 5, 1, 256, nb, bid}; EpiS5Loc E{SLOC}; gp::gemm_phase(lds, 512, S, E); }
            __syncthreads();
            int bid_ = bid; asm volatile("" : "+s"(bid_));
            for (int sr_ = 0; sr_ < SUBREPS(4); ++sr_) lru_phase<false>(p, lds, bid_, nb);
        }
        SEAM(3);
#if PROBE_SUB == 8
        for (int xb_ = 0; xb_ < 10; ++xb_) xcd_barrier(bar);
#endif
        for (int rep_ = 0; rep_ < REPS(4); ++rep_) if (IN(4)) { if (rep_) xcd_barrier(bar); TIDS;
            const float* ALC = (const float*)(ws + WS_ALC);
            if (tid < 128) for (int i = bid * 128 + tid; i < 32768; i += nb * 128) {
                const int pp = i & 63, dir = (i >> 6) & 1, g = (i >> 7) & 31, b = i >> 12;
                const float ar = ALC[((dir * 32 + g) * 64 + pp) * 2], ai = ALC[((dir * 32 + g) * 64 + pp) * 2 + 1];
                float xr = 0.f, xi = 0.f;
                const float* Sg = SLOC + (size_t)g * M5 * 256 + dir * 128 + pp;
                {
                    float sr[NCC], si[NCC];
#pragma unroll
                    for (int s = 0; s < NCC; ++s) { const int j = dir ? NCC - 1 - s : s, m = M5LAT + b * NCC + j; sr[s] = Sg[(size_t)m * 256]; si[s] = Sg[(size_t)m * 256 + 64]; }
#pragma unroll
                    for (int s = 0; s < NCC; ++s) { const float nr = ar * xr - ai * xi + sr[s], ni = ar * xi + ai * xr + si[s]; xr = nr; xi = ni; }
                }
#pragma unroll 1
                for (int s0 = 0; s0 < NCH; s0 += 32) {
                    float sr[32], si[32];
#pragma unroll
                    for (int q = 0; q < 32; ++q) { const int k = dir ? NCH - 1 - (s0 + q) : s0 + q, m = b * NCH + k; sr[q] = Sg[(size_t)m * 256]; si[q] = Sg[(size_t)m * 256 + 64]; }
#pragma unroll
                    for (int q = 0; q < 32; ++q) {
                        const int k = dir ? NCH - 1 - (s0 + q) : s0 + q, m = b * NCH + k;
                        bf16_t* dst = US5 + ((size_t)(g * M5PAD + m)) * KT5 + 512 + dir * 128 + pp;
                        dst[0] = (bf16_t)f2bf(xr); dst[64] = (bf16_t)f2bf(xi);
                        const float nr = ar * xr - ai * xi + sr[q], ni = ar * xi + ai * xr + si[q]; xr = nr; xi = ni;
                    }
                }
            }
            const float* SA = (const float*)(ws + WS_SA); const float* SB = (const float*)(ws + WS_SB); float* HIN = (float*)(ws + WS_HIN);
            if (tid >= 128 && tid < 160) for (int i = bid * 32 + (tid - 128); i < 8192; i += nb * 32) {
                const int chn = i & 511, dir = (i >> 9) & 1, b = i >> 10;
                float H = 0.f;
                {
                    float av[4], bv[4];
#pragma unroll
                    for (int s = 0; s < 4; ++s) { const int c = 64 + (dir ? 3 - s : s); const size_t o = ((size_t)(b * 68 + c) * 2 + dir) * 512 + chn; av[s] = SA[o]; bv[s] = SB[o]; }
#pragma unroll
                    for (int s = 0; s < 4; ++s) H = av[s] * H + bv[s];
                }
#pragma unroll 1
                for (int s0 = 0; s0 < 64; s0 += 32) {
                    float av[32], bv[32];
#pragma unroll
                    for (int q = 0; q < 32; ++q) { const int c = dir ? 63 - (s0 + q) : s0 + q; const size_t o = ((size_t)(b * 68 + c) * 2 + dir) * 512 + chn; av[q] = SA[o]; bv[q] = SB[o]; }
#pragma unroll
                    for (int q = 0; q < 32; ++q) {
                        const int c = dir ? 63 - (s0 + q) : s0 + q;
                        HIN[((size_t)(b * 64 + c) * 2 + dir) * 512 + chn] = H;
                        H = av[q] * H + bv[q];
                    }
                }
            }
        }
        SEAM(4);
        for (int rep_ = 0; rep_ < REPS(5); ++rep_) if (IN(5)) { if (rep_) xcd_barrier(bar); TIDS;
            const bf16_t* BS5 = (const bf16_t*)(ws + WS_BS5);
            { S5Sched S{(const char*)US5, (const char*)BS5, KT5, 4, 2, 512, nb, bid}; EpiS5Out E{YS5}; gp::gemm_phase(lds, KT5, S, E); }
            __syncthreads();
            int bid_ = bid; asm volatile("" : "+s"(bid_));
            for (int sr_ = 0; sr_ < SUBREPS(5); ++sr_) lru_phase<true>(p, lds, bid_, nb);
        }
        SEAM(5);
        for (int rep_ = 0; rep_ < REPS(6); ++rep_) if (IN(6)) { if (rep_) xcd_barrier(bar); TIDS;
            const bf16_t* BTGLU = (const bf16_t*)(ws + WS_BTGLU); const float* b_glu = p.in[18];
            PlainSched S{(const char*)YS5, (const char*)BTGLU, 512, 512, 128, 2, nb, bid};
            EpiGlu E{YS5, b_glu, YCAT};
            gp::gemm_phase(lds, 512, S, E);
        }
        SEAM(6);
        for (int rep_ = 0; rep_ < REPS(7); ++rep_) if (IN(7)) { if (rep_) xcd_barrier(bar); TIDS;
            const bf16_t* BTOUT = (const bf16_t*)(ws + WS_BTOUT);
            PlainSched S{(const char*)YCAT, (const char*)BTOUT, 1024, 1024, 128, 4, nb, bid};
            EpiBf16 E{Y, 1024};
            gp::gemm_phase(lds, 1024, S, E);
        }
        SEAM(7);
        if (IN(8)) { TIDS;
            LAS unsigned char* VH = lds;
            LAS float* PART = (LAS float*)lds;
            LAS int* DEC = (LAS int*)(lds + 132096);
            LAS float* DECW = (LAS float*)(lds + 132096 + 4096);
            LAS int* lcnt = (LAS int*)(lds + 148480); LAS int* gbase = lcnt + 128;
            LAS float* SAL = (LAS float*)(lds + 149504);
            typedef float f32x2_ __attribute__((ext_vector_type(2)));
            const int fr = lane & 15, fq = lane >> 4;
            const float rbias = p.in[30][lane];
            if (tid < 128) lcnt[tid] = 0;
            int nit = 0, it_first = bid;
            for (int it = bid; it < T / 64; it += nb) {
                const int t0 = it * 64;
                SEC_BEGIN(1);
#pragma unroll 1
                for (int rnd = 0; rnd < 2; ++rnd) {
                    const size_t tok0 = (size_t)t0 + wid * 8 + rnd * 4; const int b = (int)(tok0 >> 12);
                    const float* ada = ADA + b * 6144;
                    f32x4 z[4][4]; float s4[4];
                    {
                        u32x2 hh[4][4], yv[4][4]; f32x4 g1[4];
#pragma unroll
                        for (int q = 0; q < 4; ++q) g1[q] = *(const f32x4*)(ada + 2048 + q * 256 + lane * 4);
#pragma unroll
                        for (int rr = 0; rr < 4; ++rr)
#pragma unroll
                            for (int q = 0; q < 4; ++q) { const int col = q * 256 + lane * 4; hh[rr][q] = *(const u32x2*)(HB + (tok0 + rr) * 1024 + col); yv[rr][q] = *(const u32x2*)(Y + (size_t)cmaj((int)(tok0 + rr)) * 1024 + col); }
#pragma unroll
                        for (int rr = 0; rr < 4; ++rr) { float a = 0.f;
#pragma unroll
                            for (int q = 0; q < 4; ++q) {
                                f32x4 hv; hv[0] = __uint_as_float(hh[rr][q].x << 16); hv[1] = __uint_as_float(hh[rr][q].x & 0xffff0000u); hv[2] = __uint_as_float(hh[rr][q].y << 16); hv[3] = __uint_as_float(hh[rr][q].y & 0xffff0000u);
                                f32x4 yf; yf[0] = __uint_as_float(yv[rr][q].x << 16); yf[1] = __uint_as_float(yv[rr][q].x & 0xffff0000u); yf[2] = __uint_as_float(yv[rr][q].y << 16); yf[3] = __uint_as_float(yv[rr][q].y & 0xffff0000u);
                                z[rr][q] = hv * ALPHA_F + g1[q] * yf;
                                a += (z[rr][q][0] + z[rr][q][1]) + (z[rr][q][2] + z[rr][q][3]);
                            }
                            s4[rr] = a; }
                    }
                    f32x4 gg[4], bbv[4], sc2[4], sh2[4];
#pragma unroll
                    for (int q = 0; q < 4; ++q) { const int col = q * 256 + lane * 4; gg[q] = *(const f32x4*)(p.in[27] + col); bbv[q] = *(const f32x4*)(p.in[28] + col); sc2[q] = *(const f32x4*)(ada + 4096 + col); sh2[q] = *(const f32x4*)(ada + 3072 + col); }
#pragma unroll
                    for (int o = 1; o < 64; o <<= 1) {
#pragma unroll
                        for (int rr = 0; rr < 4; ++rr) s4[rr] += __shfl_xor(s4[rr], o); }
                    float mean[4], q4[4];
#pragma unroll
                    for (int rr = 0; rr < 4; ++rr) { mean[rr] = s4[rr] * (1.f / 1024.f); float a = 0.f;
#pragma unroll
                        for (int q = 0; q < 4; ++q) { const f32x4 d = z[rr][q] - mean[rr]; a += (d[0] * d[0] + d[1] * d[1]) + (d[2] * d[2] + d[3] * d[3]); }
                        q4[rr] = a; }
#pragma unroll
                    for (int o = 1; o < 64; o <<= 1) {
#pragma unroll
                        for (int rr = 0; rr < 4; ++rr) q4[rr] += __shfl_xor(q4[rr], o); }
#pragma unroll
                    for (int rr = 0; rr < 4; ++rr) {
                        const float rstd = rsqrtf(q4[rr] * (1.f / 1024.f) + LN_EPS_F);
                        const size_t tok = tok0 + rr; const int tl = wid * 8 + rnd * 4 + rr;
                        f32x4 vq[4]; float am = 0.f;
#pragma unroll
                        for (int q = 0; q < 4; ++q) {
                            const int col = q * 256 + lane * 4;
                            const f32x4 h1 = (z[rr][q] - mean[rr]) * rstd * gg[q] + bbv[q];
                            { u32x2 wh; wh.x = pack2(h1[0], h1[1]); wh.y = pack2(h1[2], h1[3]); *(u32x2*)((bf16_t*)p.out + tok * 2048 + col) = wh; }
                            const f32x4 v = h1 * (sc2[q] + 1.f) + sh2[q];
                            vq[q] = v; am = fmaxf(am, fmaxf(fmaxf(fabsf(v[0]), fabsf(v[1])), fmaxf(fabsf(v[2]), fabsf(v[3]))));
                            u32x2 w; w.x = pack2(v[0], v[1]); w.y = pack2(v[2], v[3]);
                            *(LAS u32x2*)(VH + tl * 2064 + col * 2) = w;
                        }
#pragma unroll
                        for (int o = 1; o < 64; o <<= 1) am = fmaxf(am, __shfl_xor(am, o));
                        am = fmaxf(am, 1e-30f);
                        const float qs = 127.f / am;
                        if (lane == 0) { const float sa = am * (1.f / 127.f); SAL[(nit & 1) * 64 + tl] = sa; *(f32x2_*)(ws + WS_LIST2 + ((size_t)64 * HALF_T + tok) * 8) = (f32x2_){sa, sa}; }
#pragma unroll
                        for (int q = 0; q < 4; ++q) {
                            unsigned wq = 0u;
#pragma unroll
                            for (int jj = 0; jj < 4; ++jj) { int qv = (int)rintf(vq[q][jj] * qs); qv = qv < -127 ? -127 : (qv > 127 ? 127 : qv); wq |= ((unsigned)qv & 0xffu) << (8 * jj); }
                            *(unsigned*)((unsigned char*)p.out + tok * 4096 + 2048 + q * 256 + lane * 4) = wq;
                        }
                    }
                }
                __syncthreads();
                SEC_END(1); SEC_BEGIN(2);
                {
                    unsigned zo = 0; asm volatile("" : "+v"(zo));
                    bf16x8 bw[4][4];
#pragma unroll
                    for (int kk = 0; kk < 4; ++kk)
#pragma unroll
                        for (int nt = 0; nt < 4; ++nt) bw[kk][nt] = *(const bf16x8*)((const char*)(ws + WS_RWH) + (((unsigned)(nt * 16 + fr) * 1024u + (unsigned)((wid * 4 + kk) * 32 + fq * 8)) * 2u + zo));
                    f32x4 acc[4][4];
#pragma unroll
                    for (int mt = 0; mt < 4; ++mt)
#pragma unroll
                        for (int nt = 0; nt < 4; ++nt) acc[mt][nt] = (f32x4){0.f, 0.f, 0.f, 0.f};
#pragma unroll
                    for (int kk = 0; kk < 4; ++kk) {
                        const int k0 = (wid * 4 + kk) * 32 + fq * 8;
#pragma unroll
                        for (int mt = 0; mt < 4; ++mt) {
                            const bf16x8 av = *(LAS const bf16x8*)(VH + (mt * 16 + fr) * 2064 + k0 * 2);
#pragma unroll
                            for (int nt = 0; nt < 4; ++nt) acc[mt][nt] = __builtin_amdgcn_mfma_f32_16x16x32_bf16(bw[kk][nt], av, acc[mt][nt], 0, 0, 0);
                        }
                    }
                    __syncthreads();
#pragma unroll
                    for (int mt = 0; mt < 4; ++mt)
#pragma unroll
                        for (int nt = 0; nt < 4; ++nt) *(LAS f32x4*)(PART + (wid * 64 + mt * 16 + fr) * 64 + nt * 16 + 4 * fq) = acc[mt][nt];
                }
                __syncthreads();
                SEC_END(2); SEC_BEGIN(3);
                {
                    const int hh = t0 / HALF_T;
#pragma unroll 1
                    for (int r = 0; r < 8; r += 2) {
                        float lg[2] = {0.f, 0.f};
#pragma unroll
                        for (int w8 = 0; w8 < 8; ++w8) {
#pragma unroll
                            for (int u = 0; u < 2; ++u) lg[u] += PART[(w8 * 64 + wid * 8 + r + u) * 64 + lane]; }
                        float sc[2], sel[2], m1[2], m2[2], gs[2], mv[2]; int rank[2]; bool selected[2];
#pragma unroll
                        for (int u = 0; u < 2; ++u) { sc[u] = sigmoid_f(lg[u]); sel[u] = sc[u] + rbias; m1[u] = grp8_max(sel[u]); }
#pragma unroll
                        for (int u = 0; u < 2; ++u) {
                            const unsigned long long bal = __ballot(sel[u] == m1[u]);
                            const unsigned gb = (unsigned)(bal >> (lane & 56)) & 0xffu;
                            const int first = __builtin_ctz(gb | 0x100u);
                            m2[u] = grp8_max(((lane & 7) == first) ? -INFINITY : sel[u]);
                        }
                        const int mygrp = lane >> 3;
                        int grank[2] = {0, 0};
#pragma unroll
                        for (int u = 0; u < 2; ++u) gs[u] = m1[u] + m2[u];
#pragma unroll
                        for (int j = 0; j < 8; ++j) {
#pragma unroll
                            for (int u = 0; u < 2; ++u) { const float gj = rdl_f(gs[u], 8 * j); grank[u] += (gj > gs[u] || (gj == gs[u] && j < mygrp)) ? 1 : 0; } }
#pragma unroll
                        for (int u = 0; u < 2; ++u) { selected[u] = grank[u] < 4; mv[u] = selected[u] ? sel[u] : -INFINITY; rank[u] = 8; }
#pragma unroll
                        for (int k = 0; k < 8; ++k) {
#pragma unroll
                            for (int u = 0; u < 2; ++u) {
                                const float mx = wave_max_u(mv[u]);
                                const int first = __builtin_ctzll(__ballot(mv[u] == mx));
                                if (lane == first) { rank[u] = k; mv[u] = -INFINITY; }
                            }
                        }
#pragma unroll
                        for (int u = 0; u < 2; ++u) {
                            const int tl = wid * 8 + r + u;
                            const bool chosen = rank[u] < 8;
                            const float wsum = wave_sum_u(chosen ? sc[u] : 0.f);
                            if (chosen) {
                                const int lr = __hip_atomic_fetch_add(lcnt + hh * 64 + lane, 1, __ATOMIC_RELAXED, __HIP_MEMORY_SCOPE_WORKGROUP);
                                DEC[((nit & 1) * 64 + tl) * 8 + rank[u]] = (lane << 16) | lr; DECW[((nit & 1) * 64 + tl) * 8 + rank[u]] = sc[u] / wsum * 2.5f;
                            }
                        }
                    }
                }
                __syncthreads();
                SEC_END(3); SEC_BEGIN(4);
                ++nit;
                const bool last = (it + nb >= T / 64);
                if ((nit & 1) == 0 || last) {
                    const int nflush = (nit & 1) == 0 ? 2 : 1;
                    if (tid < 128) { const int c = lcnt[tid]; gbase[tid] = c ? atomicAdd(CNT + tid, c) : 0; lcnt[tid] = 0; }
                    __syncthreads();
                    for (int n = tid; n < nflush * 512; n += 512) {
                        const int g2 = n >> 9, tl = (n >> 3) & 63, tok = (it_first + g2 * nb) * 64 + tl, hq = tok / HALF_T;
                        const int d = DEC[n], e = d >> 16, rk = gbase[hq * 64 + e] + (d & 0xffff);
                        const size_t pos = (size_t)(hq * 64 + e) * HALF_T + rk;
                        const float sa = SAL[g2 * 64 + tl];
                        LIST[pos] = (unsigned)tok << 16; *(f32x2_*)(ws + WS_LIST2 + pos * 8) = (f32x2_){sa, sa * DECW[n]}; PAIR[(size_t)tok * 8 + (n & 7)] = (e << 16) | rk;
                    }
                    __syncthreads();
                    it_first = it + nb;
                }
                SEC_END(4);
            }
        }
        SEAM(8);
        for (int rep_ = 0; rep_ < REPS(9); ++rep_) if (IN(9)) { if (rep_) xcd_barrier(bar); TIDS;
            moe_tables(p, lds, 0);
            LAS const int* tp = (LAS const int*)(lds + MOE_TAB_OFF); LAS const int* pc = tp + 72; LAS const int* cn = pc + 72;
            MoeSched<true> S{tp, pc, cn, (const char*)p.out, (const char*)(ws + WS_BTGU), LIST, 0, 2, tp[65] * 2, nb, bid};
            EpiMoeGU E{pc, cn, ws + WS_HMID, (const unsigned*)(ws + WS_SCW), (const char*)(ws + WS_LIST2), lds + 139264};
            gp::gemm_phase<EpiMoeGU, MoeSched<true>, true>(lds, 512, S, E);
        }
        SEAM(9);
        for (int rep_ = 0; rep_ < REPS(10); ++rep_) if (IN(10)) { if (rep_) xcd_barrier(bar); TIDS;
            moe_tables(p, lds, 0);
            LAS const int* tp = (LAS const int*)(lds + MOE_TAB_OFF); LAS const int* pc = tp + 72; LAS const int* cn = pc + 72;
            MoeSched<false> S{tp, pc, cn, (const char*)HMID, (const char*)(ws + WS_BTDN), LIST, 0, 4, tp[65] * 4, nb, bid};
            EpiMoeDN E{pc, cn, ws, (bf16_t*)p.out, (const unsigned*)(ws + WS_SCW)};
            gp::gemm_phase<EpiMoeDN, MoeSched<false>, 2>(lds, 128, S, E);
        }
        SEAM(10);
        if (IN(11)) { TIDS;
            moe_tables(p, lds, 0);
            moe_reduce(p, lds, 0, bid, nb);
        }
        if (PROBE_SEC >= 0 && bid == 0) { const unsigned long long d_ = tsec_acc_ * 8ull, t0_ = __builtin_amdgcn_s_memrealtime(); while (__builtin_amdgcn_s_memrealtime() - t0_ < d_) __builtin_amdgcn_s_sleep(8); }
        if (PROBE_TIME >= 0) {
            if (PROBE_TIME == 11) { xcd_barrier(bar); tprobe1_ = __builtin_amdgcn_s_memrealtime(); }
            if (bid == 0) { const unsigned long long d_ = (tprobe1_ - tprobe0_) * 8ull, t0_ = __builtin_amdgcn_s_memrealtime(); while (__builtin_amdgcn_s_memrealtime() - t0_ < d_) __builtin_amdgcn_s_sleep(8); }
        }
    }
}

extern "C" void kernel_launch(void* const* d_in, const int* in_sizes, int n_in, void* d_out, int out_size, void* d_ws, size_t ws_size, hipStream_t stream) {
    static int grid = 0;
    if (grid == 0) {
        if (n_in != 39 || out_size != T * D || ws_size < WS_END) { fprintf(stderr, "kernel_launch: unexpected problem (n_in %d, out %d, ws %zu); nothing launched\n", n_in, out_size, ws_size); grid = -1; return; }
        int dev = 0, cus = 0;
        if (hipGetDevice(&dev) != hipSuccess || hipDeviceGetAttribute(&cus, hipDeviceAttributeMultiprocessorCount, dev) != hipSuccess) { grid = -1; return; }
        if (hipFuncSetAttribute((const void*)mk_fwd, hipFuncAttributeMaxDynamicSharedMemorySize, LDS_BYTES) != hipSuccess) { fprintf(stderr, "kernel_launch: hipFuncSetAttribute failed\n"); grid = -1; return; }
        grid = cus > 0 ? cus : 256;
    }
    if (grid < 0) return;
    (void)in_sizes;
    if (hipMemsetAsync((char*)d_ws + WS_CTL, 0, CTL_ZERO_BYTES, stream) != hipSuccess) return;
    Params p{};
    for (int i = 0; i < 39; ++i) p.in[i] = (const float*)d_in[i];
    p.out = (float*)d_out; p.ws = (unsigned char*)d_ws;
#if MK_N_LAUNCHES == 1
    p.ph_lo = 0; p.ph_hi = NPHASE;
    hipLaunchKernelGGL(mk_fwd, dim3(grid), dim3(512), LDS_BYTES, stream, p);
#else
    for (int ph = 0; ph < NPHASE; ++ph) {
        p.ph_lo = ph; p.ph_hi = ph + 1;
        hipLaunchKernelGGL(mk_fwd, dim3(grid), dim3(512), LDS_BYTES, stream, p);
    }
#endif
}
```
